# Optimizing an MI355X kernel written in HIP

```python
import math
import jax, jax.numpy as jnp
from jax import lax
import numpy as np

D_MODEL = 1024
BATCH = 8
SEQ = 2048
DEPTH = 1
DEC_BATCH = 128
DEC_SEQ = 1
PAST_LEN = 16384
PAGE_SIZE = 128

D_LRU = D_MODEL // 2
D_S5 = D_MODEL - D_LRU
D_MIX = D_LRU + D_S5
LRU_HEADS = 8
LRU_HEAD_DIM = D_LRU // LRU_HEADS
CONV_W = 4
LRU_C = 8.0
S5_GROUP = 16
S5_GROUPS = D_S5 // S5_GROUP
S5_STATE = 64
D_FF = int(math.ceil(8 * D_MODEL / 3 / 256)) * 256
EPS = 1e-6
DT_MIN = 1e-3
DT_MAX = 1e-1

kernel_name = 'hymba_rglru_s5_adaln_decode_step'

F32 = jnp.float32


def rmsnorm(x, g):
    x32 = x.astype(F32)
    y = x32 * lax.rsqrt(jnp.mean(x32 * x32, axis=-1, keepdims=True) + EPS)
    return y * g.astype(F32)


def _real_combine(l, r):
    a_l, b_l = l
    a_r, b_r = r
    return a_l * a_r, a_r * b_l + b_r


def linear_scan(a, b, h0):
    a_cum, h = lax.associative_scan(_real_combine, (a, b), axis=1)
    return h + a_cum * h0[:, None]


def _complex_combine(l, r):
    ar_l, ai_l, br_l, bi_l = l
    ar_r, ai_r, br_r, bi_r = r
    ar = ar_l * ar_r - ai_l * ai_r
    ai = ar_l * ai_r + ai_l * ar_r
    br = ar_r * br_l - ai_r * bi_l + br_r
    bi = ar_r * bi_l + ai_r * br_l + bi_r
    return ar, ai, br, bi


def complex_linear_scan(ar, ai, br, bi, h0r, h0i):
    cr, ci, hr, hi = lax.associative_scan(_complex_combine, (ar, ai, br, bi), axis=1)
    h0r_ = h0r[:, None]
    h0i_ = h0i[:, None]
    return hr + cr * h0r_ - ci * h0i_, hi + cr * h0i_ + ci * h0r_


def rg_lru(xc, h0, wa, ba, wx, bx, lam):
    B, T, _ = xc.shape
    xh = xc.reshape(B, T, LRU_HEADS, LRU_HEAD_DIM)
    r = jax.nn.sigmoid(jnp.einsum('bthi,hij->bthj', xh, wa.astype(F32)).reshape(B, T, D_LRU) + ba.astype(F32))
    i = jax.nn.sigmoid(jnp.einsum('bthi,hij->bthj', xh, wx.astype(F32)).reshape(B, T, D_LRU) + bx.astype(F32))
    log_a = LRU_C * r * jax.nn.log_sigmoid(lam.astype(F32))
    a = jnp.exp(log_a)
    mult = jnp.sqrt(-jnp.expm1(2.0 * log_a))
    hs = linear_scan(a, mult * (i * xc), h0.astype(F32))
    return hs, hs[:, -1]


def s5_layer(u, h0r, h0i, lam_re, lam_im, log_dt, b_re, b_im, c_re, c_im, d, w_glu):
    B, T, _ = u.shape
    ug = u.reshape(B, T, S5_GROUPS, S5_GROUP)
    lr = lam_re.astype(F32)
    li = lam_im.astype(F32)
    dt = jnp.exp(log_dt.astype(F32))[:, None]
    mag = jnp.exp(lr * dt)
    ab_r = mag * jnp.cos(li * dt)
    ab_i = mag * jnp.sin(li * dt)
    den = lr * lr + li * li
    fr = ((ab_r - 1.0) * lr + ab_i * li) / den
    fi = (ab_i * lr - (ab_r - 1.0) * li) / den
    br32 = b_re.astype(F32)
    bi32 = b_im.astype(F32)
    bb_r = fr[..., None] * br32 - fi[..., None] * bi32
    bb_i = fr[..., None] * bi32 + fi[..., None] * br32
    bu_r = jnp.einsum('btgc,gnc->btgn', ug, bb_r)
    bu_i = jnp.einsum('btgc,gnc->btgn', ug, bb_i)
    ar = jnp.broadcast_to(ab_r, bu_r.shape)
    ai = jnp.broadcast_to(ab_i, bu_i.shape)
    hr, hi = complex_linear_scan(ar, ai, bu_r, bu_i, h0r.astype(F32), h0i.astype(F32))
    y = jnp.einsum('btgn,gcn->btgc', hr, c_re.astype(F32)) - jnp.einsum('btgn,gcn->btgc', hi, c_im.astype(F32))
    y = y.reshape(B, T, D_S5) + d.astype(F32) * u
    z = jax.nn.gelu(y) @ w_glu.astype(F32)
    za, zb = jnp.split(z, 2, axis=-1)
    return za * jax.nn.sigmoid(zb), hr[:, -1], hi[:, -1]


def decoder_layer(x, c, conv_buf, lru_h0, s5_h0r, s5_h0i, p):
    T = x.shape[1]
    mod = jax.nn.silu(c.astype(F32)) @ p['ada_w'].astype(F32) + p['ada_b'].astype(F32)
    sh1, sc1, g1, sh2, sc2, g2 = jnp.split(mod[:, None, :], 6, axis=-1)

    hn = rmsnorm(x, p['norm1_g']) * (1.0 + sc1) + sh1
    proj = hn @ p['w_in'].astype(F32)
    lru_x = proj[..., :D_LRU]
    lru_gate = proj[..., D_LRU:2 * D_LRU]
    s5_u = proj[..., 2 * D_LRU:]

    xc_full = jnp.concatenate([conv_buf.astype(F32), lru_x], axis=1)
    conv_w = p['conv_w'].astype(F32)
    conv = p['conv_b'].astype(F32) + sum(conv_w[k] * xc_full[:, k:k + T] for k in range(CONV_W))
    new_conv = xc_full[:, -(CONV_W - 1):]
    hs, lru_last = rg_lru(conv, lru_h0, p['lru_wa'], p['lru_ba'], p['lru_wx'], p['lru_bx'], p['lru_lambda'])
    lru_out = hs * jax.nn.gelu(lru_gate)

    s5_out, s5_r, s5_i = s5_layer(s5_u, s5_h0r, s5_h0i, p['s5_lambda_re'], p['s5_lambda_im'], p['s5_log_dt'],
                                  p['s5_b_re'], p['s5_b_im'], p['s5_c_re'], p['s5_c_im'], p['s5_d'], p['s5_w_glu'])

    merged = jnp.concatenate([rmsnorm(lru_out, p['g_lru_out']), rmsnorm(s5_out, p['g_s5_out'])], axis=-1)
    x32 = x.astype(F32) + g1 * (merged @ p['w_out'].astype(F32))

    hn2 = rmsnorm(x32, p['norm2_g']) * (1.0 + sc2) + sh2
    ffn = (jax.nn.silu(hn2 @ p['ffn_w_gate'].astype(F32)) * (hn2 @ p['ffn_w_up'].astype(F32))) @ p['ffn_w_down'].astype(F32)
    x32 = x32 + g2 * ffn
    return x32.astype(x.dtype), new_conv, lru_last, s5_r, s5_i


def setup_inputs(seed: int = 0) -> dict:
    key = jax.random.key(seed)
    ks = jax.random.split(key, 40)
    nrm = lambda k, shape, s: jax.random.normal(k, shape, F32) * s
    u = jax.random.uniform(ks[12], (DEPTH, D_LRU), F32, 0.9, 0.999)
    s = u ** (1.0 / LRU_C)
    lru_lambda = jnp.log(s) - jnp.log1p(-s)
    n_idx = jnp.arange(S5_STATE, dtype=F32)
    s5_lambda_re = -0.5 + nrm(ks[13], (DEPTH, S5_GROUPS, S5_STATE), 0.01)
    s5_lambda_im = math.pi * n_idx + nrm(ks[14], (DEPTH, S5_GROUPS, S5_STATE), 0.01)
    s5_log_dt = jax.random.uniform(ks[15], (DEPTH, S5_GROUPS), F32, math.log(DT_MIN), math.log(DT_MAX))
    return {
        'x_prompt': nrm(ks[0], (BATCH, SEQ, D_MODEL), 1.0),
        'x_sample': nrm(ks[1], (DEC_BATCH, DEC_SEQ, D_MODEL), 1.0),
        'state_conv': nrm(ks[2], (DEPTH, DEC_BATCH, CONV_W - 1, D_LRU), 1.0),
        'state_lru': nrm(ks[3], (DEPTH, DEC_BATCH, D_LRU), 0.5),
        'state_s5_re': nrm(ks[4], (DEPTH, DEC_BATCH, S5_GROUPS, S5_STATE), 0.5),
        'state_s5_im': nrm(ks[5], (DEPTH, DEC_BATCH, S5_GROUPS, S5_STATE), 0.5),
        'c_prompt': nrm(ks[6], (BATCH, D_MODEL), 1.0),
        'c_sample': nrm(ks[7], (DEC_BATCH, D_MODEL), 1.0),
        'ada_w': nrm(ks[8], (DEPTH, D_MODEL, 6 * D_MODEL), 0.5 * D_MODEL ** -0.5),
        'ada_b': nrm(ks[9], (DEPTH, 6 * D_MODEL), 0.01),
        'norm1_g': 1.0 + nrm(ks[10], (DEPTH, D_MODEL), 0.01),
        'w_in': nrm(ks[11], (DEPTH, D_MODEL, 2 * D_LRU + D_S5), D_MODEL ** -0.5),
        'conv_w': nrm(ks[16], (DEPTH, CONV_W, D_LRU), CONV_W ** -0.5),
        'conv_b': nrm(ks[17], (DEPTH, D_LRU), 0.01),
        'lru_wa': nrm(ks[18], (DEPTH, LRU_HEADS, LRU_HEAD_DIM, LRU_HEAD_DIM), LRU_HEAD_DIM ** -0.5),
        'lru_ba': nrm(ks[19], (DEPTH, D_LRU), 0.01),
        'lru_wx': nrm(ks[20], (DEPTH, LRU_HEADS, LRU_HEAD_DIM, LRU_HEAD_DIM), LRU_HEAD_DIM ** -0.5),
        'lru_bx': nrm(ks[21], (DEPTH, D_LRU), 0.01),
        'lru_lambda': lru_lambda,
        's5_lambda_re': s5_lambda_re,
        's5_lambda_im': s5_lambda_im,
        's5_log_dt': s5_log_dt,
        's5_b_re': nrm(ks[22], (DEPTH, S5_GROUPS, S5_STATE, S5_GROUP), (2 * S5_GROUP) ** -0.5),
        's5_b_im': nrm(ks[23], (DEPTH, S5_GROUPS, S5_STATE, S5_GROUP), (2 * S5_GROUP) ** -0.5),
        's5_c_re': nrm(ks[24], (DEPTH, S5_GROUPS, S5_GROUP, S5_STATE), (2 * S5_STATE) ** -0.5),
        's5_c_im': nrm(ks[25], (DEPTH, S5_GROUPS, S5_GROUP, S5_STATE), (2 * S5_STATE) ** -0.5),
        's5_d': nrm(ks[26], (DEPTH, D_S5), 1.0),
        's5_w_glu': nrm(ks[27], (DEPTH, D_S5, 2 * D_S5), D_S5 ** -0.5),
        'g_lru_out': 1.0 + nrm(ks[28], (DEPTH, D_LRU), 0.01),
        'g_s5_out': 1.0 + nrm(ks[29], (DEPTH, D_S5), 0.01),
        'w_out': nrm(ks[30], (DEPTH, D_MIX, D_MODEL), D_MIX ** -0.5),
        'norm2_g': 1.0 + nrm(ks[31], (DEPTH, D_MODEL), 0.01),
        'ffn_w_gate': nrm(ks[32], (DEPTH, D_MODEL, D_FF), D_MODEL ** -0.5),
        'ffn_w_up': nrm(ks[33], (DEPTH, D_MODEL, D_FF), D_MODEL ** -0.5),
        'ffn_w_down': nrm(ks[34], (DEPTH, D_FF, D_MODEL), D_FF ** -0.5),
        'final_norm_g': 1.0 + nrm(ks[35], (D_MODEL,), 0.01),
    }


def reference(x_prompt, x_sample, state_conv, state_lru, state_s5_re, state_s5_im, c_prompt, c_sample,
              ada_w, ada_b, norm1_g, w_in, conv_w, conv_b, lru_wa, lru_ba, lru_wx, lru_bx, lru_lambda,
              s5_lambda_re, s5_lambda_im, s5_log_dt, s5_b_re, s5_b_im, s5_c_re, s5_c_im, s5_d, s5_w_glu,
              g_lru_out, g_s5_out, w_out, norm2_g, ffn_w_gate, ffn_w_up, ffn_w_down, final_norm_g):
    bp = x_prompt.shape[0]
    yp = x_prompt
    ys = x_sample
    conv_p, lru_p, s5r_p, s5i_p = [], [], [], []
    conv_s, lru_s, s5r_s, s5i_s = [], [], [], []
    for l in range(DEPTH):
        p = dict(ada_w=ada_w[l], ada_b=ada_b[l], norm1_g=norm1_g[l], w_in=w_in[l], conv_w=conv_w[l],
                 conv_b=conv_b[l], lru_wa=lru_wa[l], lru_ba=lru_ba[l], lru_wx=lru_wx[l], lru_bx=lru_bx[l],
                 lru_lambda=lru_lambda[l], s5_lambda_re=s5_lambda_re[l], s5_lambda_im=s5_lambda_im[l],
                 s5_log_dt=s5_log_dt[l], s5_b_re=s5_b_re[l], s5_b_im=s5_b_im[l], s5_c_re=s5_c_re[l],
                 s5_c_im=s5_c_im[l], s5_d=s5_d[l], s5_w_glu=s5_w_glu[l], g_lru_out=g_lru_out[l],
                 g_s5_out=g_s5_out[l], w_out=w_out[l], norm2_g=norm2_g[l], ffn_w_gate=ffn_w_gate[l],
                 ffn_w_up=ffn_w_up[l], ffn_w_down=ffn_w_down[l])
        yp, cp, hp, rp, ip = decoder_layer(
            yp, c_prompt,
            jnp.zeros((bp, CONV_W - 1, D_LRU), F32), jnp.zeros((bp, D_LRU), F32),
            jnp.zeros((bp, S5_GROUPS, S5_STATE), F32), jnp.zeros((bp, S5_GROUPS, S5_STATE), F32), p)
        ys, cs, hs, rs, is_ = decoder_layer(
            ys, c_sample, state_conv[l], state_lru[l], state_s5_re[l], state_s5_im[l], p)
        conv_p.append(cp); lru_p.append(hp); s5r_p.append(rp); s5i_p.append(ip)
        conv_s.append(cs); lru_s.append(hs); s5r_s.append(rs); s5i_s.append(is_)
    y_prompt = rmsnorm(yp, final_norm_g).astype(x_prompt.dtype)
    y_sample = rmsnorm(ys, final_norm_g).astype(x_sample.dtype)
    conv_prompt = jnp.stack(conv_p, 0).astype(state_conv.dtype)
    lru_prompt = jnp.stack(lru_p, 0).astype(state_lru.dtype)
    s5_re_prompt = jnp.stack(s5r_p, 0).astype(state_s5_re.dtype)
    s5_im_prompt = jnp.stack(s5i_p, 0).astype(state_s5_im.dtype)
    conv_sample = jnp.stack(conv_s, 0).astype(state_conv.dtype)
    lru_sample = jnp.stack(lru_s, 0).astype(state_lru.dtype)
    s5_re_sample = jnp.stack(s5r_s, 0).astype(state_s5_re.dtype)
    s5_im_sample = jnp.stack(s5i_s, 0).astype(state_s5_im.dtype)
    return (y_prompt, y_sample, conv_prompt, lru_prompt, s5_re_prompt, s5_im_prompt,
            conv_sample, lru_sample, s5_re_sample, s5_im_sample)
```

```cpp
#include <hip/hip_runtime.h>
#include <hip/hip_cooperative_groups.h>
#include <cstdio>
#include <cstdint>
namespace cg = cooperative_groups;
namespace pg8 {
#define PG8_LAS __attribute__((address_space(3)))
typedef unsigned short bf16_t;
typedef short bf16x8 __attribute__((ext_vector_type(8)));
typedef float f32x4 __attribute__((ext_vector_type(4)));
typedef unsigned u32x4 __attribute__((ext_vector_type(4)));
constexpr int BM = 256, BK = 64, HALF = 128, HTB = HALF * BK * 2  , STAGE_BYTES = 8 * HTB, NXCD = 8, WGM = 8;

__host__ __device__ __forceinline__ int lds_byte(int r, int c) { const int st = (r >> 4) * 2 + (c >> 5), rr = r & 15, cc = c & 31, ob = rr * 64 + cc * 2; return st * 1024 + (ob ^ (((ob >> 9) & 1) << 5)); }
__host__ __device__ __forceinline__ void stage_rc(int b, int& R, int& C) { const int st = b / 1024, sb = b % 1024, swz = sb ^ (((sb >> 9) & 1) << 5); R = (st >> 1) * 16 + swz / 64; C = (st & 1) * 32 + (swz % 64) / 2; }
__host__ __device__ __forceinline__ int perm32(int rho) { const int n = rho >> 4, i = rho & 15; return 8 * (i >> 2) + 4 * n + (i & 3); }

struct Unit { int pm, pn; };
struct Gemm { const bf16_t* A; const bf16_t* Bt; int M, N, K; };

struct StaticOrder {
    int nM, nN, nwg, G, c;
    __host__ __device__ void init(int M, int N, int G_, int c_) { nM = M / BM; nN = N / BM; nwg = nM * nN; G = G_; c = c_; }
    __host__ __device__ bool next(int i, Unit& u) const {
        const long L = (long)i * G + c; if (L >= nwg) return false;
        int wgid = (int)L; { const int q = nwg / NXCD, r = nwg % NXCD, xcd = wgid % NXCD, off = wgid / NXCD; wgid = (xcd < r ? xcd * (q + 1) : r * (q + 1) + (xcd - r) * q) + off; }
        const int nig = WGM * nN, gid = wgid / nig, fm = gid * WGM, gsz = (nM - fm) < WGM ? (nM - fm) : WGM;
        u.pm = fm + ((wgid % nig) % gsz); u.pn = (wgid % nig) / gsz; return true;
    }
    __device__ __forceinline__ void a_ready(const Unit&) const {}
    __device__ __forceinline__ void done(const Unit&) const {}
};

__device__ __forceinline__ unsigned cvt_pk_bf16(float lo, float hi) { unsigned r; asm volatile("v_cvt_pk_bf16_f32 %0, %1, %2" : "=v"(r) : "v"(lo), "v"(hi)); return r; }
typedef float f32x2 __attribute__((ext_vector_type(2)));
template <class Epi, class Sched, bool ALIGN_EPI = false, bool SP2 = false>
__device__ __forceinline__ void gemm_phase(PG8_LAS unsigned char* lds, const Gemm g, const Sched& S, const Epi& E) {
    const int tid = threadIdx.x, wid = __builtin_amdgcn_readfirstlane(tid >> 6), lane = tid & 63, wr = wid >> 2, wc = wid & 3, fr = lane & 15, fq = lane >> 4;
    const int K = g.K, nt = K / BK;
    unsigned voffA[2], voffB[2];
#pragma unroll
    for (int i = 0; i < 2; ++i) { int R, C; stage_rc(tid * 16 + i * 8192, R, C); const int Rb = Epi::PERM ? ((R & ~31) + perm32(R & 31)) : R;
        voffA[i] = (unsigned)(R * K + C) * 2u; voffB[i] = (unsigned)(Rb * K + C) * 2u; }
    const size_t kstep = (size_t)(BK * 2);
    const size_t hstep = (size_t)HALF * K * 2;
    const size_t tstep = 2 * hstep;
    const unsigned ldsw = (unsigned)wid * 1024u;
    const int aoff = lds_byte(wr * 64 + fr, fq * 8), boff = lds_byte(wc * 32 + fr, fq * 8);
#define PG8_SA(b, h) (((b) * 2 + (h)) * HTB)
#define PG8_SB(b, h) ((4 + (b) * 2 + (h)) * HTB)
#define PG8_STAGE(bufoff, gbase, voff) do { _Pragma("unroll") for (int _i = 0; _i < 2; ++_i) \
        __builtin_amdgcn_global_load_lds((const unsigned*)((const char*)(gbase) + (voff)[_i]), (PG8_LAS unsigned*)(lds + (bufoff) + ldsw + _i * 8192), 16, 0, 0); } while (0)
#define PG8_LDA(dst, b, h) do { _Pragma("unroll") for (int m = 0; m < 4; ++m) _Pragma("unroll") for (int k = 0; k < 2; ++k) dst[m][k] = *(const PG8_LAS bf16x8*)(lds + PG8_SA(b, h) + aoff + m * 2048 + k * 1024); } while (0)
#define PG8_LDB(dst, b, h) do { _Pragma("unroll") for (int n = 0; n < 2; ++n) _Pragma("unroll") for (int k = 0; k < 2; ++k) dst[n][k] = *(const PG8_LAS bf16x8*)(lds + PG8_SB(b, h) + boff + n * 2048 + k * 1024); } while (0)
#define PG8_MMA(ai, bj, At, Bt) do { __builtin_amdgcn_s_setprio(1); _Pragma("unroll") for (int m = 0; m < 4; ++m) _Pragma("unroll") for (int n = 0; n < 2; ++n) _Pragma("unroll") for (int k = 0; k < 2; ++k) \
        acc[ai][bj][m][n] = __builtin_amdgcn_mfma_f32_16x16x32_bf16(Bt[n][k], At[m][k], acc[ai][bj][m][n], 0, 0, 0); __builtin_amdgcn_s_setprio(0); } while (0)
#define PG8_WAIT_V(n) asm volatile("s_waitcnt vmcnt(" #n ")" ::: "memory")
#define PG8_WAIT_L(n) asm volatile("s_waitcnt lgkmcnt(" #n ")" ::: "memory")
#define PG8_BAR __builtin_amdgcn_s_barrier()
#define PG8_SCHED __builtin_amdgcn_sched_barrier(0)
    Unit cur, nxt; int ui = 0;
    if (!S.next(0, cur)) return;
    f32x4 acc[2][2][4][2];
#pragma unroll
    for (int a = 0; a < 2; ++a)
#pragma unroll
        for (int b = 0; b < 2; ++b)
#pragma unroll
            for (int m = 0; m < 4; ++m)
#pragma unroll
                for (int n = 0; n < 2; ++n) acc[a][b][m][n] = (f32x4){0.f, 0.f, 0.f, 0.f};
    bf16x8 At[4][2], B0[2][2], B1[2][2];
    const char* cA = (const char*)g.A + (size_t)cur.pm * tstep; const char* cB = (const char*)g.Bt + (size_t)cur.pn * tstep;
    S.a_ready(cur);
    if constexpr (SP2) {
        PG8_STAGE(PG8_SB(0, 0), cB, voffB); PG8_STAGE(PG8_SB(0, 1), cB + hstep, voffB); PG8_STAGE(PG8_SA(0, 0), cA, voffA); PG8_STAGE(PG8_SA(0, 1), cA + hstep, voffA);
        if (wr == 1) PG8_BAR;
        PG8_WAIT_V(2); PG8_BAR;
        PG8_STAGE(PG8_SB(1, 0), cB + kstep, voffB); PG8_STAGE(PG8_SA(1, 0), cA + kstep, voffA); PG8_STAGE(PG8_SB(1, 1), cB + hstep + kstep, voffB);
        PG8_WAIT_V(6); PG8_BAR;
    } else {
        PG8_STAGE(PG8_SB(0, 0), cB, voffB); PG8_STAGE(PG8_SA(0, 0), cA, voffA); PG8_STAGE(PG8_SB(0, 1), cB + hstep, voffB); PG8_STAGE(PG8_SA(0, 1), cA + hstep, voffA);
        if (wr == 1) PG8_BAR;
        PG8_WAIT_V(4); PG8_BAR;
        PG8_STAGE(PG8_SB(1, 0), cB + kstep, voffB); PG8_STAGE(PG8_SA(1, 0), cA + kstep, voffA); PG8_STAGE(PG8_SB(1, 1), cB + hstep + kstep, voffB);
        PG8_WAIT_V(6); PG8_BAR;
    }
    for (;;) {
        const bool has_next = S.next(ui + 1, nxt);
        const char* nA = has_next ? (const char*)g.A + (size_t)nxt.pm * tstep : cA; const char* nB = has_next ? (const char*)g.Bt + (size_t)nxt.pn * tstep : cB;
        for (int t = 0; t < nt; t += 2) {
            const bool last = (t == nt - 2);
            const char* a1 = cA + (size_t)(t + 1) * kstep;
            const char* a2 = last ? nA : cA + (size_t)(t + 2) * kstep; const char* b2 = last ? nB : cB + (size_t)(t + 2) * kstep;
            const char* a3 = a2 + kstep; const char* b3 = b2 + kstep;
            if (last && has_next) S.a_ready(nxt);
            if constexpr (SP2) {
            PG8_LDB(B0, 0, 0); PG8_LDB(B1, 0, 1); PG8_SCHED; PG8_LDA(At, 0, 0); PG8_STAGE(PG8_SA(1, 1), a1 + hstep, voffA);
            PG8_WAIT_V(8); PG8_WAIT_L(0); PG8_BAR; PG8_MMA(0, 0, At, B0); PG8_MMA(0, 1, At, B1); PG8_BAR; PG8_SCHED;
            PG8_LDA(At, 0, 1); PG8_STAGE(PG8_SB(0, 0), b2, voffB); PG8_STAGE(PG8_SB(0, 1), b2 + hstep, voffB); PG8_STAGE(PG8_SA(0, 0), a2, voffA);
            PG8_WAIT_V(8); PG8_WAIT_L(0); PG8_BAR; PG8_MMA(1, 0, At, B0); PG8_MMA(1, 1, At, B1); PG8_BAR; PG8_SCHED;
            PG8_LDB(B0, 1, 0); PG8_LDB(B1, 1, 1); PG8_SCHED; PG8_LDA(At, 1, 0); PG8_STAGE(PG8_SA(0, 1), a2 + hstep, voffA);
            PG8_WAIT_V(8); PG8_WAIT_L(0); PG8_BAR; PG8_MMA(0, 0, At, B0); PG8_MMA(0, 1, At, B1); PG8_BAR; PG8_SCHED;
            PG8_LDA(At, 1, 1); PG8_STAGE(PG8_SB(1, 0), b3, voffB); PG8_STAGE(PG8_SB(1, 1), b3 + hstep, voffB); PG8_STAGE(PG8_SA(1, 0), a3, voffA);
            PG8_WAIT_V(8); PG8_WAIT_L(0); PG8_BAR; PG8_MMA(1, 0, At, B0); PG8_MMA(1, 1, At, B1); PG8_BAR; PG8_SCHED;
            } else {
            PG8_LDB(B0, 0, 0); PG8_SCHED; PG8_LDA(At, 0, 0); PG8_STAGE(PG8_SA(1, 1), a1 + hstep, voffA);
            PG8_WAIT_L(8); PG8_BAR; PG8_WAIT_L(0); PG8_MMA(0, 0, At, B0); PG8_BAR; PG8_SCHED;
            PG8_LDB(B1, 0, 1); PG8_STAGE(PG8_SB(0, 0), b2, voffB);
            PG8_BAR; PG8_WAIT_L(0); PG8_MMA(0, 1, At, B1); PG8_BAR;
            PG8_LDA(At, 0, 1); PG8_STAGE(PG8_SA(0, 0), a2, voffA);
            PG8_BAR; PG8_WAIT_L(0); PG8_MMA(1, 0, At, B0); PG8_BAR; PG8_SCHED;
            PG8_STAGE(PG8_SB(0, 1), b2 + hstep, voffB);
            PG8_WAIT_V(6); PG8_BAR; PG8_MMA(1, 1, At, B1); PG8_BAR;
            PG8_LDB(B0, 1, 0); PG8_SCHED; PG8_LDA(At, 1, 0); PG8_STAGE(PG8_SA(0, 1), a2 + hstep, voffA);
            PG8_WAIT_L(8); PG8_BAR; PG8_WAIT_L(0); PG8_MMA(0, 0, At, B0); PG8_BAR; PG8_SCHED;
            PG8_LDB(B1, 1, 1); PG8_STAGE(PG8_SB(1, 0), b3, voffB);
            PG8_BAR; PG8_WAIT_L(0); PG8_MMA(0, 1, At, B1); PG8_BAR;
            PG8_LDA(At, 1, 1); PG8_STAGE(PG8_SA(1, 0), a3, voffA);
            PG8_BAR; PG8_WAIT_L(0); PG8_MMA(1, 0, At, B0); PG8_BAR; PG8_SCHED;
            PG8_STAGE(PG8_SB(1, 1), b3 + hstep, voffB);
            PG8_WAIT_V(6); PG8_BAR; PG8_MMA(1, 1, At, B1); PG8_BAR;
            }
        }
        if constexpr (ALIGN_EPI) { if (wr == 0) PG8_BAR; }
        if constexpr (!Epi::AFTER_DRAIN) { E(acc, cur, wr, wc, fr, fq); S.done(cur); }
        if (!has_next) break;
#pragma unroll
        for (int a = 0; a < 2; ++a)
#pragma unroll
            for (int b = 0; b < 2; ++b)
#pragma unroll
                for (int m = 0; m < 4; ++m)
#pragma unroll
                    for (int n = 0; n < 2; ++n) acc[a][b][m][n] = (f32x4){0.f, 0.f, 0.f, 0.f};
        cur = nxt; cA = nA; cB = nB; ++ui;
        if constexpr (ALIGN_EPI) { if (wr == 1) PG8_BAR; }
    }
    PG8_WAIT_V(0);
    if constexpr (!ALIGN_EPI) { if (wr == 0) PG8_BAR; }
    PG8_BAR;
    if constexpr (Epi::AFTER_DRAIN) { E.fused(acc, cur, wr, wc, fr, fq, lds, wid, lane); S.done(cur); }
#undef PG8_SA
#undef PG8_SB
#undef PG8_STAGE
#undef PG8_LDA
#undef PG8_LDB
#undef PG8_MMA
#undef PG8_WAIT_V
#undef PG8_WAIT_L
#undef PG8_BAR
#undef PG8_SCHED
}
}

#define LAS __attribute__((address_space(3)))
typedef unsigned short bf16;
typedef float f32x4 __attribute__((ext_vector_type(4)));
typedef float f32x2 __attribute__((ext_vector_type(2)));
typedef short bf16x8 __attribute__((ext_vector_type(8)));
typedef unsigned u32x4 __attribute__((ext_vector_type(4)));
typedef unsigned u32x2 __attribute__((ext_vector_type(2)));

constexpr int DM = 1024, NBP = 8, SEQ = 2048, MPR = NBP * SEQ, NBS = 128, MTOK = MPR + NBS, MPAD = 16640;
constexpr int DL = 512, NPROJ = 1536, NMOD = 6144, NBT = NBP + NBS, DFF = 2816;
constexpr int LCH = 64, NCH = SEQ / LCH;
constexpr int SCH = 16;
constexpr int SL = 16, SNCH = SEQ / SL, SROWS = NBP * SNCH;
constexpr float EPS = 1e-6f;
constexpr int NPHASE = 13;

constexpr size_t O_Y = 0, O_CONVP = (size_t)MTOK * DM, O_LRUP = O_CONVP + 8 * 3 * 512, O_S5RP = O_LRUP + 8 * 512, O_S5IP = O_S5RP + 8 * 32 * 64,
                 O_CONVS = O_S5IP + 8 * 32 * 64, O_LRUS = O_CONVS + 128 * 3 * 512, O_S5RS = O_LRUS + 128 * 512, O_S5IS = O_S5RS + 128 * 32 * 64, O_END = O_S5IS + 128 * 32 * 64;

constexpr size_t HM = 1u << 19;
constexpr size_t WS_WIN = 2 * HM, WS_WGLU = 8 * HM, WS_WOUT = 10 * HM, WS_WGU = 14 * HM, WS_WDN = 36 * HM  , WS_MOD = 48 * HM  ,
                 WS_TF = 56 * HM  , WS_E = 68 * HM  , WS_TAB = 72 * HM, WS_AGG = 74 * HM  ,
                 WS_XN = 80 * HM  , WS_LRUX = 146 * HM  , WS_GATE = 211 * HM  ,
                 WS_S5U = 244 * HM  , WS_HLOC = 277 * HM  , WS_CUM = 342 * HM, WS_GY = 407 * HM  ,
                 WS_SK = 440 * HM  , WS_HIN = 472 * HM  , WS_HB = 244 * HM  , WS_END = 512 * HM;
constexpr size_t T_ABAR = 0, T_A16 = 4096, T_BBR = 8192, T_BBI = 8192 + 32768;

struct KArgs { const float* in[36]; float* out; unsigned char* ws; int lo, hi; };

struct Ctx {
    const float* const* in; float* out; unsigned char* ws;
    __device__ __forceinline__ const float* I(int i) const { return in[i]; }
    __device__ __forceinline__ bf16* WIN() const { return (bf16*)(ws + WS_WIN); }
    __device__ __forceinline__ bf16* WGLU() const { return (bf16*)(ws + WS_WGLU); }
    __device__ __forceinline__ bf16* WOUT() const { return (bf16*)(ws + WS_WOUT); }
    __device__ __forceinline__ bf16* WGU() const { return (bf16*)(ws + WS_WGU); }
    __device__ __forceinline__ bf16* WDN() const { return (bf16*)(ws + WS_WDN); }
    __device__ __forceinline__ float* MOD() const { return (float*)(ws + WS_MOD); }
    __device__ __forceinline__ bf16* TF() const { return (bf16*)(ws + WS_TF); }
    __device__ __forceinline__ bf16* EM() const { return (bf16*)(ws + WS_E); }
    __device__ __forceinline__ float* TAB() const { return (float*)(ws + WS_TAB); }
    __device__ __forceinline__ f32x2* AGG() const { return (f32x2*)(ws + WS_AGG); }
    __device__ __forceinline__ bf16* XN() const { return (bf16*)(ws + WS_XN); }
    __device__ __forceinline__ bf16* MERGED() const { return (bf16*)(ws + WS_XN); }
    __device__ __forceinline__ float* LRUX() const { return (float*)(ws + WS_LRUX); }
    __device__ __forceinline__ bf16* XN2() const { return (bf16*)(ws + WS_LRUX); }
    __device__ __forceinline__ bf16* GATE() const { return (bf16*)(ws + WS_GATE); }
    __device__ __forceinline__ bf16* S5U() const { return (bf16*)(ws + WS_S5U); }
    __device__ __forceinline__ float* HLOC() const { return (float*)(ws + WS_HLOC); }
    __device__ __forceinline__ float* S5OUT() const { return (float*)(ws + WS_HLOC); }
    __device__ __forceinline__ float* CUM() const { return (float*)(ws + WS_CUM); }
    __device__ __forceinline__ bf16* GY() const { return (bf16*)(ws + WS_GY); }
    __device__ __forceinline__ float* SK() const { return (float*)(ws + WS_SK); }
    __device__ __forceinline__ bf16* HIN() const { return (bf16*)(ws + WS_HIN); }
    __device__ __forceinline__ bf16* HB() const { return (bf16*)(ws + WS_HB); }
};

#define LDS_WAIT() asm volatile("s_waitcnt lgkmcnt(0)" ::: "memory")
__device__ __forceinline__ unsigned pk2(float lo, float hi) { return pg8::cvt_pk_bf16(lo, hi); }
__device__ __forceinline__ float bf2f(unsigned b) { return __uint_as_float(b << 16); }
__device__ __forceinline__ float bflo(unsigned w) { return __uint_as_float(w << 16); }
__device__ __forceinline__ float bfhi(unsigned w) { return __uint_as_float(w & 0xffff0000u); }
__device__ __forceinline__ float wave_sum(float v) {
#pragma unroll
    for (int o = 1; o < 64; o <<= 1) v += __shfl_xor(v, o);
    return v;
}
__device__ __forceinline__ float sigm(float v) { return 1.f / (1.f + __expf(-v)); }
__device__ __forceinline__ float gelu_tanh(float x) { const float u = 1.5957691216f * (x + 0.044715f * x * x * x); return x / (1.f + __expf(-u)); }
__device__ __forceinline__ int mod_row(int row) { return row < MPR ? (row >> 11) : (NBP + row - MPR); }
__device__ __forceinline__ u32x4 pack8(f32x4 a, f32x4 b) { u32x4 w; w.x = pk2(a[0], a[1]); w.y = pk2(a[2], a[3]); w.z = pk2(b[0], b[1]); w.w = pk2(b[2], b[3]); return w; }

struct EpiProj {
    static constexpr bool PERM = true, AFTER_DRAIN = false; float* lrux; bf16* gate; bf16* s5u;
    __device__ __forceinline__ void operator()(const f32x4 (&acc)[2][2][4][2], const pg8::Unit& u, int wr, int wc, int fr, int fq) const {
        const int colt = u.pn * 256 + wc * 32 + 8 * fq;
#pragma unroll
        for (int ai = 0; ai < 2; ++ai)
#pragma unroll
            for (int m = 0; m < 4; ++m) { const int row = u.pm * 256 + ai * 128 + wr * 64 + m * 16 + fr; if (row >= MTOK) continue;
#pragma unroll
                for (int bj = 0; bj < 2; ++bj) { const int col = colt + bj * 128; const f32x4 v0 = acc[ai][bj][m][0], v1 = acc[ai][bj][m][1];
                    if (u.pn < 2) { float* p = lrux + (size_t)row * 512 + col; *(f32x4*)p = v0; *(f32x4*)(p + 4) = v1; }
                    else if (u.pn < 4) { *(u32x4*)(gate + (size_t)row * 512 + (col - 512)) = pack8(v0, v1); }
                    else { *(u32x4*)(s5u + (size_t)row * 512 + (col - 1024)) = pack8(v0, v1); } } }
    }
};
struct EpiGlu {
    static constexpr bool PERM = true, AFTER_DRAIN = false; float* o;
    __device__ __forceinline__ void operator()(const f32x4 (&acc)[2][2][4][2], const pg8::Unit& u, int wr, int wc, int fr, int fq) const {
        const int col = u.pn * 128 + wc * 32 + 8 * fq;
#pragma unroll
        for (int ai = 0; ai < 2; ++ai)
#pragma unroll
            for (int m = 0; m < 4; ++m) { const int row = u.pm * 256 + ai * 128 + wr * 64 + m * 16 + fr; if (row >= MTOK) continue;
#pragma unroll
                for (int n = 0; n < 2; ++n) { const f32x4 a = acc[ai][0][m][n], b = acc[ai][1][m][n]; f32x4 s;
#pragma unroll
                    for (int i = 0; i < 4; ++i) s[i] = a[i] * sigm(b[i]);
                    *(f32x4*)(o + (size_t)row * 512 + col + 4 * n) = s; } }
    }
};
template <int GOFF> struct EpiRes {
    static constexpr bool PERM = true, AFTER_DRAIN = false; const float* xp; const float* xs; const float* mod; float* out;
    __device__ __forceinline__ void operator()(const f32x4 (&acc)[2][2][4][2], const pg8::Unit& u, int wr, int wc, int fr, int fq) const {
        const int colt = u.pn * 256 + wc * 32 + 8 * fq;
#pragma unroll
        for (int ai = 0; ai < 2; ++ai)
#pragma unroll
            for (int m = 0; m < 4; ++m) { const int row = u.pm * 256 + ai * 128 + wr * 64 + m * 16 + fr; if (row >= MTOK) continue;
                const float* gp = mod + (size_t)mod_row(row) * NMOD + GOFF; float* op = out + (size_t)row * DM;
                const float* bp = xp ? (row < MPR ? xp + (size_t)row * DM : xs + (size_t)(row - MPR) * DM) : op;
#pragma unroll
                for (int bj = 0; bj < 2; ++bj)
#pragma unroll
                    for (int n = 0; n < 2; ++n) { const int c = colt + bj * 128 + 4 * n; const f32x4 x4 = *(const f32x4*)(bp + c), g4 = *(const f32x4*)(gp + c);
                        *(f32x4*)(op + c) = x4 + g4 * acc[ai][bj][m][n]; } }
    }
};
struct EpiSwiglu {
    static constexpr bool PERM = true, AFTER_DRAIN = false; bf16* h;
    __device__ __forceinline__ void operator()(const f32x4 (&acc)[2][2][4][2], const pg8::Unit& u, int wr, int wc, int fr, int fq) const {
        const int col = u.pn * 128 + wc * 32 + 8 * fq;
#pragma unroll
        for (int ai = 0; ai < 2; ++ai)
#pragma unroll
            for (int m = 0; m < 4; ++m) { const int row = u.pm * 256 + ai * 128 + wr * 64 + m * 16 + fr; if (row >= MTOK) continue;
                f32x4 s[2];
#pragma unroll
                for (int n = 0; n < 2; ++n) { const f32x4 a = acc[ai][0][m][n], b = acc[ai][1][m][n];
#pragma unroll
                    for (int i = 0; i < 4; ++i) s[n][i] = a[i] * sigm(a[i]) * b[i]; }
                *(u32x4*)(h + (size_t)row * DFF + col) = pack8(s[0], s[1]); }
    }
};

__device__ __forceinline__ void transpose_item(const float* W, int ldw, int k0, int n0, bf16* WT, int K, int drow0, LAS float* scr, int lane) {
#pragma unroll 8
    for (int i = 0; i < 32; ++i) { const int kk = 2 * i + (lane >> 5); scr[kk * 33 + (lane & 31)] = W[(size_t)(k0 + kk) * ldw + n0 + (lane & 31)]; }
    LDS_WAIT();
    const int c = lane & 7;
#pragma unroll
    for (int j = 0; j < 4; ++j) { const int n = (lane >> 3) + 8 * j; const LAS float* s = scr + (8 * c) * 33 + n;
        u32x4 o; o.x = pk2(s[0 * 33], s[1 * 33]); o.y = pk2(s[2 * 33], s[3 * 33]); o.z = pk2(s[4 * 33], s[5 * 33]); o.w = pk2(s[6 * 33], s[7 * 33]);
        *(u32x4*)(WT + (size_t)(drow0 + n) * K + k0 + 8 * c) = o; }
    LDS_WAIT();
}
__device__ __forceinline__ void transpose_dispatch(const Ctx& cx, int it, LAS float* scr, int lane) {
    if (it < 768) { const int kb = it / 48, nb = it % 48; transpose_item(cx.I(11), NPROJ, 64 * kb, 32 * nb, cx.WIN(), DM, 32 * nb, scr, lane); return; } it -= 768;
    if (it < 256) { const int kb = it / 32, nb = it % 32, n0 = 32 * nb; const int dr = 256 * ((n0 & 511) >> 7) + 128 * (n0 >> 9) + (n0 & 127);
        transpose_item(cx.I(27), 1024, 64 * kb, n0, cx.WGLU(), 512, dr, scr, lane); return; } it -= 256;
    if (it < 512) { const int kb = it / 32, nb = it % 32; transpose_item(cx.I(30), DM, 64 * kb, 32 * nb, cx.WOUT(), DM, 32 * nb, scr, lane); return; } it -= 512;
    if (it < 1408) { const int kb = it / 88, nb = it % 88, n0 = 32 * nb; transpose_item(cx.I(32), DFF, 64 * kb, n0, cx.WGU(), DM, 256 * (n0 >> 7) + (n0 & 127), scr, lane); return; } it -= 1408;
    if (it < 1408) { const int kb = it / 88, nb = it % 88, n0 = 32 * nb; transpose_item(cx.I(33), DFF, 64 * kb, n0, cx.WGU(), DM, 256 * (n0 >> 7) + 128 + (n0 & 127), scr, lane); return; } it -= 1408;
    { const int kb = it / 32, nb = it % 32; transpose_item(cx.I(34), DM, 64 * kb, 32 * nb, cx.WDN(), DFF, 32 * nb, scr, lane); }
}
constexpr int N_TR_ITEMS = 768 + 256 + 512 + 1408 + 1408 + 1408;

__device__ __forceinline__ void ada_item(const Ctx& cx, int item, int lane) {
    const int n0 = 16 * item, fr = lane & 15, fq = lane >> 4;
    const float* W = cx.I(8); const float* cp = cx.I(6); const float* cs = cx.I(7);
    f32x4 acc[9];
#pragma unroll
    for (int i = 0; i < 9; ++i) acc[i] = (f32x4){0.f, 0.f, 0.f, 0.f};
    for (int k0 = 0; k0 < DM; k0 += 32) {
        float wv[8];
#pragma unroll
        for (int j = 0; j < 8; ++j) wv[j] = W[(size_t)(k0 + 8 * fq + j) * NMOD + n0 + fr];
        u32x4 wp; wp.x = pk2(wv[0], wv[1]); wp.y = pk2(wv[2], wv[3]); wp.z = pk2(wv[4], wv[5]); wp.w = pk2(wv[6], wv[7]);
        const bf16x8 wf = __builtin_bit_cast(bf16x8, wp);
#pragma unroll
        for (int mt = 0; mt < 9; ++mt) { int row = 16 * mt + fr; row = row < NBT ? row : NBT - 1;
            const float* src = (row < NBP ? cp + (size_t)row * DM : cs + (size_t)(row - NBP) * DM) + k0 + 8 * fq;
            f32x4 a0 = *(const f32x4*)src, a1 = *(const f32x4*)(src + 4);
#pragma unroll
            for (int i = 0; i < 4; ++i) { a0[i] = a0[i] * sigm(a0[i]); a1[i] = a1[i] * sigm(a1[i]); }
            const bf16x8 af = __builtin_bit_cast(bf16x8, pack8(a0, a1));
            acc[mt] = __builtin_amdgcn_mfma_f32_16x16x32_bf16(wf, af, acc[mt], 0, 0, 0); }
    }
    const f32x4 b4 = *(const f32x4*)(cx.I(9) + n0 + 4 * fq);
#pragma unroll
    for (int mt = 0; mt < 9; ++mt) { const int row = 16 * mt + fr; if (row < NBT) *(f32x4*)(cx.MOD() + (size_t)row * NMOD + n0 + 4 * fq) = acc[mt] + b4; }
}

__device__ __forceinline__ void s5_tables(const Ctx& cx, int g, LAS unsigned char* lds) {
    LAS f32x2* Ap = (LAS f32x2*)lds;
    LAS f32x2* Bb = Ap + 17 * 64;
    LAS f32x2* Cc = Bb + 1024;
    LAS f32x2* Ff = Cc + 1024;
    LAS float* Kt = (LAS float*)(Ff + 64);
    const int tid = threadIdx.x;
    float* tab = cx.TAB();
    if (tid < 64) {
        const int n = tid; const float lr = cx.I(19)[g * 64 + n], li = cx.I(20)[g * 64 + n], dt = expf(cx.I(21)[g]);
        const float mag = expf(lr * dt);
        const double ang = (double)li * (double)dt; const double kq = rint(ang * 0.63661977236758134308); const double r = ang - kq * 1.57079632679489661923; const double r2 = r * r;
        const double sn = r * (1.0 + r2 * (-1.0 / 6 + r2 * (1.0 / 120 + r2 * (-1.0 / 5040 + r2 * (1.0 / 362880 + r2 * (-1.0 / 39916800 + r2 * (1.0 / 6227020800.0)))))));
        const double cn = 1.0 + r2 * (-0.5 + r2 * (1.0 / 24 + r2 * (-1.0 / 720 + r2 * (1.0 / 40320 + r2 * (-1.0 / 3628800 + r2 * (1.0 / 479001600.0))))));
        const int q = ((int)kq) & 3; const double cv = q == 0 ? cn : q == 1 ? -sn : q == 2 ? -cn : sn, sv = q == 0 ? sn : q == 1 ? cn : q == 2 ? -sn : -cn;
        const float abr = mag * (float)cv, abi = mag * (float)sv; const float den = lr * lr + li * li;
        const float frr = ((abr - 1.f) * lr + abi * li) / den, fii = (abi * lr - (abr - 1.f) * li) / den;
        f32x2 p = (f32x2){1.f, 0.f}; Ap[n] = p;
#pragma unroll 1
        for (int t = 1; t <= 16; ++t) { const float pr = p.x * abr - p.y * abi, pi = p.x * abi + p.y * abr; p = (f32x2){pr, pi}; Ap[t * 64 + n] = p; }
        Ff[n] = (f32x2){frr, fii};
        ((f32x2*)(tab + T_ABAR))[g * 64 + n] = (f32x2){abr, abi}; ((f32x2*)(tab + T_A16))[g * 64 + n] = p;
    }
    __syncthreads();
    for (int e = tid; e < 1024; e += 512) { const int n = e >> 4; const float br = cx.I(22)[g * 1024 + e], bi = cx.I(23)[g * 1024 + e]; const f32x2 f = Ff[n];
        const float bbr = f.x * br - f.y * bi, bbi = f.x * bi + f.y * br; Bb[e] = (f32x2){bbr, bbi}; tab[T_BBR + g * 1024 + e] = bbr; tab[T_BBI + g * 1024 + e] = bbi;
        Cc[e] = (f32x2){cx.I(24)[g * 1024 + e], cx.I(25)[g * 1024 + e]}; }
    __syncthreads();
    for (int e = tid; e < 4096; e += 512) { const int tau = e >> 8, c = (e >> 4) & 15, cp = e & 15; float sum = 0.f;
        for (int n = 0; n < 64; ++n) { const f32x2 a = Ap[tau * 64 + n], b = Bb[n * 16 + cp], cc = Cc[c * 64 + n];
            const float pr = a.x * b.x - a.y * b.y, pi = a.x * b.y + a.y * b.x; sum += cc.x * pr - cc.y * pi; }
        Kt[e] = sum; }
    __syncthreads();
    bf16* TFg = cx.TF() + (size_t)g * 256 * 384;
    for (int pc = tid; pc < 256 * 48; pc += 512) { const int row = pc / 48, k8 = (pc % 48) * 8, j = row >> 4, c = row & 15; float v[8];
#pragma unroll
        for (int q = 0; q < 8; ++q) { const int kk = k8 + q;
            if (kk < 256) { const int s = kk >> 4, cp = kk & 15; v[q] = (j >= s) ? Kt[((j - s) << 8) + (c << 4) + cp] : 0.f; }
            else { const int n = (kk - 256) & 63; const f32x2 p = Ap[(j + 1) * 64 + n], cc = Cc[c * 64 + n]; v[q] = (kk < 320) ? (cc.x * p.x - cc.y * p.y) : (-cc.x * p.y - cc.y * p.x); } }
        u32x4 o; o.x = pk2(v[0], v[1]); o.y = pk2(v[2], v[3]); o.z = pk2(v[4], v[5]); o.w = pk2(v[6], v[7]);
        *(u32x4*)(TFg + (size_t)row * 384 + k8) = o; }
    bf16* Eg = cx.EM() + (size_t)g * 128 * 256;
    for (int pc = tid; pc < 128 * 32; pc += 512) { const int np = pc >> 5, k8 = (pc & 31) * 8, n = np & 63, im = np >> 6; float v[8];
#pragma unroll
        for (int q = 0; q < 8; ++q) { const int kk = k8 + q, s = kk >> 4, cp = kk & 15; const f32x2 a = Ap[(15 - s) * 64 + n], b = Bb[n * 16 + cp];
            v[q] = im ? (a.x * b.y + a.y * b.x) : (a.x * b.x - a.y * b.y); }
        u32x4 o; o.x = pk2(v[0], v[1]); o.y = pk2(v[2], v[3]); o.z = pk2(v[4], v[5]); o.w = pk2(v[6], v[7]);
        *(u32x4*)(Eg + (size_t)np * 256 + k8) = o; }
    __syncthreads();
}

__device__ __forceinline__ void norm_mod_row(const float* xrow, const float* g, const float* sc, const float* sh, bf16* orow, int lane) {
    f32x4 v[4]; float ss = 0.f;
#pragma unroll
    for (int j = 0; j < 4; ++j) { v[j] = ((const f32x4*)xrow)[lane + 64 * j]; ss += (v[j].x * v[j].x + v[j].y * v[j].y) + (v[j].z * v[j].z + v[j].w * v[j].w); }
    const float rstd = rsqrtf(wave_sum(ss) * (1.f / DM) + EPS);
#pragma unroll
    for (int j = 0; j < 4; ++j) { const int col = 4 * (lane + 64 * j); const f32x4 gg = *(const f32x4*)(g + col), s1 = *(const f32x4*)(sc + col), s2 = *(const f32x4*)(sh + col);
        const f32x4 o = v[j] * rstd * gg * (1.f + s1) + s2; u32x2 w; w.x = pk2(o.x, o.y); w.y = pk2(o.z, o.w); *(u32x2*)(orow + col) = w; }
}

__device__ __forceinline__ void lru_local_unit(const Ctx& cx, int row0, int ntok, bool samp, int aggidx, LAS unsigned char* lds) {
    const int d = threadIdx.x, w = __builtin_amdgcn_readfirstlane(d >> 6), lane = d & 63, fr = lane & 15, fq = lane >> 4;
    LAS float* cf = (LAS float*)(lds + w * 8192);
    LAS bf16* cbf = (LAS bf16*)(lds + w * 8192 + 4608);
    bf16x8 wf[8][2];
#pragma unroll
    for (int nt = 0; nt < 8; ++nt)
#pragma unroll
        for (int ks = 0; ks < 2; ++ks) { const float* src = (nt < 4 ? cx.I(14) : cx.I(16)) + (size_t)w * 4096 + (32 * ks + 8 * fq) * 64 + 16 * (nt & 3) + fr;
            u32x4 o; o.x = pk2(src[0], src[64]); o.y = pk2(src[128], src[192]); o.z = pk2(src[256], src[320]); o.w = pk2(src[384], src[448]); wf[nt][ks] = __builtin_bit_cast(bf16x8, o); }
    const float cw0 = cx.I(12)[d], cw1 = cx.I(12)[512 + d], cw2 = cx.I(12)[1024 + d], cw3 = cx.I(12)[1536 + d], cb = cx.I(13)[d];
    float gba[4], gbx[4], gcd[4], hc[4], cc[4];
#pragma unroll
    for (int nt = 0; nt < 4; ++nt) { const int ch = 64 * w + 16 * nt + fr; gba[nt] = cx.I(15)[ch]; gbx[nt] = cx.I(17)[ch]; gcd[nt] = -8.f * log1pf(expf(-cx.I(18)[ch])); hc[nt] = 0.f; cc[nt] = 1.f; }
    const float* X = cx.LRUX(); float* HL = cx.HLOC(); float* CU = cx.CUM();
    float xm3 = 0.f, xm2 = 0.f, xm1 = 0.f;
    if (!samp) { const int t0 = row0 & (SEQ - 1); if (t0 >= 3) { xm3 = X[(size_t)(row0 - 3) * DL + d]; xm2 = X[(size_t)(row0 - 2) * DL + d]; xm1 = X[(size_t)(row0 - 1) * DL + d]; } }
    for (int t0 = 0; t0 < ntok; t0 += 16) {
        if (samp) {
#pragma unroll 4
            for (int i = 0; i < 16; ++i) { const int row = row0 + t0 + i; const float* sc = cx.I(2) + (size_t)(row - MPR) * 1536 + d;
                const float cv = cb + cw0 * sc[0] + cw1 * sc[512] + cw2 * sc[1024] + cw3 * X[(size_t)row * DL + d];
                cf[i * 68 + lane] = cv; cbf[i * 72 + lane] = (bf16)(pk2(cv, cv) & 0xffffu); }
        } else {
#pragma unroll 4
            for (int i = 0; i < 16; ++i) { const float x = X[(size_t)(row0 + t0 + i) * DL + d]; const float cv = cb + cw0 * xm3 + cw1 * xm2 + cw2 * xm1 + cw3 * x; xm3 = xm2; xm2 = xm1; xm1 = x;
                cf[i * 68 + lane] = cv; cbf[i * 72 + lane] = (bf16)(pk2(cv, cv) & 0xffffu); }
        }
        LDS_WAIT();
        f32x4 acc[8];
#pragma unroll
        for (int nt = 0; nt < 8; ++nt) acc[nt] = (f32x4){0.f, 0.f, 0.f, 0.f};
#pragma unroll
        for (int ks = 0; ks < 2; ++ks) { const bf16x8 af = *(const LAS bf16x8*)(cbf + fr * 72 + 32 * ks + 8 * fq);
#pragma unroll
            for (int nt = 0; nt < 8; ++nt) acc[nt] = __builtin_amdgcn_mfma_f32_16x16x32_bf16(af, wf[nt][ks], acc[nt], 0, 0, 0); }
#pragma unroll
        for (int nt = 0; nt < 4; ++nt) { const int ch = 64 * w + 16 * nt + fr;
            float av[4], hv[4]; float P = 1.f, H = 0.f;
#pragma unroll
            for (int r = 0; r < 4; ++r) { const int tok = 4 * fq + r; const float cvv = cf[tok * 68 + 16 * nt + fr];
                const float rr = sigm(acc[nt][r] + gba[nt]), ig = sigm(acc[nt + 4][r] + gbx[nt]); const float la = gcd[nt] * rr; const float z = 2.f * la;
                const float em = z * (1.f + z * (0.5f + z * (1.f / 6 + z * (1.f / 24 + z * (1.f / 120 + z * (1.f / 720 + z * (1.f / 5040)))))));
                const float a = __expf(la); const float bb = sqrtf(-em) * ig * cvv;
                if (samp) { const float h0 = cx.I(3)[(size_t)(row0 + t0 + tok - MPR) * DL + ch]; hv[r] = a * h0 + bb; av[r] = 0.f; }
                else { H = a * H + bb; P = P * a; hv[r] = H; av[r] = P; } }
            if (!samp) {
                float Pp = __shfl_up(P, 16), Hp = __shfl_up(H, 16); if (fq >= 1) { H = P * Hp + H; P = P * Pp; }
                Pp = __shfl_up(P, 32); Hp = __shfl_up(H, 32); if (fq >= 2) { H = P * Hp + H; P = P * Pp; }
                float Pe = __shfl_up(P, 16), He = __shfl_up(H, 16); if (fq == 0) { Pe = 1.f; He = 0.f; }
                const float hstart = He + Pe * hc[nt], cstart = Pe * cc[nt];
#pragma unroll
                for (int r = 0; r < 4; ++r) { hv[r] = hv[r] + av[r] * hstart; av[r] = av[r] * cstart; }
                const float Pl = __shfl(P, 48 + fr), Hl = __shfl(H, 48 + fr); hc[nt] = Hl + Pl * hc[nt]; cc[nt] = Pl * cc[nt];
            }
#pragma unroll
            for (int r = 0; r < 4; ++r) { const size_t o = (size_t)(row0 + t0 + 4 * fq + r) * DL + ch; HL[o] = hv[r]; CU[o] = av[r]; }
        }
        LDS_WAIT();
    }
    if (!samp && fq == 0) {
#pragma unroll
        for (int nt = 0; nt < 4; ++nt) cx.AGG()[(size_t)aggidx * DL + 64 * w + 16 * nt + fr] = (f32x2){cc[nt], hc[nt]}; }
}

__device__ __forceinline__ void s5_gemm_e_item(const Ctx& cx, int item, int lane) {
    const int g = item >> 5, rb = item & 31, fr = lane & 15, fq = lane >> 4;
    const bf16* U = cx.S5U(); const bf16* Eg = cx.EM() + (size_t)g * 128 * 256;
    f32x4 acc[2][8];
#pragma unroll
    for (int a = 0; a < 2; ++a)
#pragma unroll
        for (int n = 0; n < 8; ++n) acc[a][n] = (f32x4){0.f, 0.f, 0.f, 0.f};
#pragma unroll 2
    for (int ks = 0; ks < 8; ++ks) {
        bf16x8 af[2];
#pragma unroll
        for (int mt = 0; mt < 2; ++mt) { const int cr = rb * 32 + 16 * mt + fr; af[mt] = *(const bf16x8*)(U + ((size_t)(16 * cr + 2 * ks + (fq >> 1)) * 512 + 16 * g + 8 * (fq & 1))); }
#pragma unroll
        for (int nt = 0; nt < 8; ++nt) { const bf16x8 wf = *(const bf16x8*)(Eg + (size_t)(16 * nt + fr) * 256 + 32 * ks + 8 * fq);
#pragma unroll
            for (int mt = 0; mt < 2; ++mt) acc[mt][nt] = __builtin_amdgcn_mfma_f32_16x16x32_bf16(wf, af[mt], acc[mt][nt], 0, 0, 0); }
    }
    float* S = cx.SK();
#pragma unroll
    for (int mt = 0; mt < 2; ++mt) { const int cr = rb * 32 + 16 * mt + fr;
#pragma unroll
        for (int nt = 0; nt < 8; ++nt) *(f32x4*)(S + ((size_t)cr * 32 + g) * 128 + 16 * nt + 4 * fq) = acc[mt][nt]; }
}

__device__ __forceinline__ void s5_chain_item(const Ctx& cx, int item) {
    const int idx = item * 512 + threadIdx.x, b = idx >> 11, g = (idx >> 6) & 31, n = idx & 63;
    const f32x2 A = ((const f32x2*)(cx.TAB() + T_A16))[g * 64 + n];
    const float* S = cx.SK() + ((size_t)(b * SNCH) * 32 + g) * 128 + n; bf16* H = cx.HIN() + ((size_t)g * SROWS + b * SNCH) * 128 + n;
    float hr = 0.f, hi = 0.f;
    for (int k0 = 0; k0 < SNCH; k0 += 8) { float sr[8], si[8];
#pragma unroll
        for (int i = 0; i < 8; ++i) { sr[i] = S[(size_t)(k0 + i) * 4096]; si[i] = S[(size_t)(k0 + i) * 4096 + 64]; }
#pragma unroll
        for (int i = 0; i < 8; ++i) { H[(size_t)(k0 + i) * 128] = (bf16)(pk2(hr, hr) & 0xffffu); H[(size_t)(k0 + i) * 128 + 64] = (bf16)(pk2(hi, hi) & 0xffffu);
            const float nr = A.x * hr - A.y * hi + sr[i], ni = A.x * hi + A.y * hr + si[i]; hr = nr; hi = ni; } }
    cx.out[O_S5RP + (size_t)(b * 32 + g) * 64 + n] = hr; cx.out[O_S5IP + (size_t)(b * 32 + g) * 64 + n] = hi;
}

__device__ __forceinline__ void lru_fix_unit(const Ctx& cx, int row0, int ntok, bool samp, int b, int k, LAS unsigned char* lds) {
    const int d = threadIdx.x, w = d >> 6, lane = d & 63;
    LAS float* hs = (LAS float*)lds;
    float hin = 0.f;
    if (!samp) { const f32x2* ag = cx.AGG() + (size_t)(b * NCH) * DL + d; for (int kk = 0; kk < k; ++kk) { const f32x2 p = ag[(size_t)kk * DL]; hin = p.x * hin + p.y; } }
    hs[d] = hin;
    const float* X = cx.LRUX();
    if (!samp && k == NCH - 1) {
#pragma unroll
        for (int j = 0; j < 3; ++j) cx.out[O_CONVP + (size_t)(b * 3 + j) * DL + d] = X[(size_t)(row0 + LCH - 3 + j) * DL + d]; }
    if (samp) { for (int t = 0; t < ntok; ++t) { const int sb = row0 + t - MPR; const float* sc = cx.I(2) + (size_t)sb * 1536 + d; float* o = cx.out + O_CONVS + (size_t)sb * 1536 + d;
            o[0] = sc[512]; o[512] = sc[1024]; o[1024] = X[(size_t)(row0 + t) * DL + d]; } }
    __syncthreads();
    const float* HL = cx.HLOC(); const float* CU = cx.CUM(); const bf16* GT = cx.GATE(); bf16* MG = cx.MERGED(); const float* gl = cx.I(28);
    const f32x4 hi0 = *(const LAS f32x4*)(hs + 8 * lane), hi1 = *(const LAS f32x4*)(hs + 8 * lane + 4);
    const f32x4 g0 = *(const f32x4*)(gl + 8 * lane), g1 = *(const f32x4*)(gl + 8 * lane + 4);
    for (int t = w; t < ntok; t += 8) { const size_t ro = (size_t)(row0 + t) * DL + 8 * lane;
        const f32x4 a0 = *(const f32x4*)(HL + ro), a1 = *(const f32x4*)(HL + ro + 4), c0 = *(const f32x4*)(CU + ro), c1 = *(const f32x4*)(CU + ro + 4);
        const u32x4 gw = *(const u32x4*)(GT + ro);
        const f32x4 h0 = a0 + c0 * hi0, h1 = a1 + c1 * hi1;
        f32x4 l0, l1;
        l0[0] = h0[0] * gelu_tanh(bflo(gw.x)); l0[1] = h0[1] * gelu_tanh(bfhi(gw.x)); l0[2] = h0[2] * gelu_tanh(bflo(gw.y)); l0[3] = h0[3] * gelu_tanh(bfhi(gw.y));
        l1[0] = h1[0] * gelu_tanh(bflo(gw.z)); l1[1] = h1[1] * gelu_tanh(bfhi(gw.z)); l1[2] = h1[2] * gelu_tanh(bflo(gw.w)); l1[3] = h1[3] * gelu_tanh(bfhi(gw.w));
        float ss = (l0[0] * l0[0] + l0[1] * l0[1]) + (l0[2] * l0[2] + l0[3] * l0[3]) + (l1[0] * l1[0] + l1[1] * l1[1]) + (l1[2] * l1[2] + l1[3] * l1[3]);
        const float rstd = rsqrtf(wave_sum(ss) * (1.f / DL) + EPS);
        *(u32x4*)(MG + (size_t)(row0 + t) * DM + 8 * lane) = pack8(l0 * rstd * g0, l1 * rstd * g1);
        if (samp) { float* o = cx.out + O_LRUS + (size_t)(row0 + t - MPR) * DL + 8 * lane; *(f32x4*)o = h0; *(f32x4*)(o + 4) = h1; }
        else if (k == NCH - 1 && t == LCH - 1) { float* o = cx.out + O_LRUP + (size_t)b * DL + 8 * lane; *(f32x4*)o = h0; *(f32x4*)(o + 4) = h1; }
    }
    __syncthreads();
}

__device__ __forceinline__ void s5_gemm_tf_item(const Ctx& cx, int item, int lane) {
    const int half = item & 1, g = item >> 6, rb = (item >> 1) & 31, fr = lane & 15, fq = lane >> 4;
    const bf16* U = cx.S5U(); const bf16* TFg = cx.TF() + ((size_t)g * 256 + 128 * half) * 384; const bf16* Hg = cx.HIN() + (size_t)g * SROWS * 128;
    f32x4 acc[2][8];
#pragma unroll
    for (int a = 0; a < 2; ++a)
#pragma unroll
        for (int n = 0; n < 8; ++n) acc[a][n] = (f32x4){0.f, 0.f, 0.f, 0.f};
#pragma unroll 2
    for (int ks = 0; ks < 12; ++ks) {
        bf16x8 af[2];
#pragma unroll
        for (int mt = 0; mt < 2; ++mt) { const int cr = rb * 32 + 16 * mt + fr;
            af[mt] = (ks < 8) ? *(const bf16x8*)(U + ((size_t)(16 * cr + 2 * ks + (fq >> 1)) * 512 + 16 * g + 8 * (fq & 1))) : *(const bf16x8*)(Hg + (size_t)cr * 128 + 32 * (ks - 8) + 8 * fq); }
#pragma unroll
        for (int nt = 0; nt < 8; ++nt) { const bf16x8 wf = *(const bf16x8*)(TFg + (size_t)(16 * nt + fr) * 384 + 32 * ks + 8 * fq);
#pragma unroll
            for (int mt = 0; mt < 2; ++mt) acc[mt][nt] = __builtin_amdgcn_mfma_f32_16x16x32_bf16(wf, af[mt], acc[mt][nt], 0, 0, 0); }
    }
    const f32x4 d4 = *(const f32x4*)(cx.I(26) + 16 * g + 4 * fq); bf16* GY = cx.GY();
#pragma unroll
    for (int mt = 0; mt < 2; ++mt) { const int cr = rb * 32 + 16 * mt + fr;
#pragma unroll
        for (int nt = 0; nt < 8; ++nt) { const size_t off = (size_t)(16 * cr + 8 * half + nt) * 512 + 16 * g + 4 * fq; const u32x2 uw = *(const u32x2*)(U + off);
            const f32x4 y = acc[mt][nt] + d4 * (f32x4){bflo(uw.x), bfhi(uw.x), bflo(uw.y), bfhi(uw.y)};
            u32x2 o; o.x = pk2(gelu_tanh(y[0]), gelu_tanh(y[1])); o.y = pk2(gelu_tanh(y[2]), gelu_tanh(y[3])); *(u32x2*)(GY + off) = o; } }
}
__device__ __forceinline__ void s5_sample_item(const Ctx& cx, int item, int lane) {
    const int sb = item >> 5, g = item & 31, n = lane; const int row = MPR + sb;
    const float* tab = cx.TAB(); const f32x2 A = ((const f32x2*)(tab + T_ABAR))[g * 64 + n];
    const float h0r = cx.I(4)[((size_t)sb * 32 + g) * 64 + n], h0i = cx.I(5)[((size_t)sb * 32 + g) * 64 + n];
    const bf16* up = cx.S5U() + (size_t)row * 512 + 16 * g; const u32x4 u0 = *(const u32x4*)up, u1 = *(const u32x4*)(up + 8);
    float uu[16]; uu[0] = bflo(u0.x); uu[1] = bfhi(u0.x); uu[2] = bflo(u0.y); uu[3] = bfhi(u0.y); uu[4] = bflo(u0.z); uu[5] = bfhi(u0.z); uu[6] = bflo(u0.w); uu[7] = bfhi(u0.w);
    uu[8] = bflo(u1.x); uu[9] = bfhi(u1.x); uu[10] = bflo(u1.y); uu[11] = bfhi(u1.y); uu[12] = bflo(u1.z); uu[13] = bfhi(u1.z); uu[14] = bflo(u1.w); uu[15] = bfhi(u1.w);
    float bur = 0.f, bui = 0.f; const float* br = tab + T_BBR + (size_t)(g * 64 + n) * 16; const float* bi = tab + T_BBI + (size_t)(g * 64 + n) * 16;
#pragma unroll
    for (int c4 = 0; c4 < 4; ++c4) { const f32x4 r4 = *(const f32x4*)(br + 4 * c4), i4 = *(const f32x4*)(bi + 4 * c4);
#pragma unroll
        for (int i = 0; i < 4; ++i) { bur += r4[i] * uu[4 * c4 + i]; bui += i4[i] * uu[4 * c4 + i]; } }
    const float hr = A.x * h0r - A.y * h0i + bur, hi = A.x * h0i + A.y * h0r + bui;
    cx.out[O_S5RS + ((size_t)sb * 32 + g) * 64 + n] = hr; cx.out[O_S5IS + ((size_t)sb * 32 + g) * 64 + n] = hi;
    float my = 0.f, myu = 0.f;
#pragma unroll
    for (int c = 0; c < 16; ++c) { const float v = wave_sum(cx.I(24)[((size_t)g * 16 + c) * 64 + n] * hr - cx.I(25)[((size_t)g * 16 + c) * 64 + n] * hi); if (lane == c) { my = v; myu = uu[c]; } }
    if (lane < 16) { const float y = my + cx.I(26)[16 * g + lane] * myu; cx.GY()[(size_t)row * 512 + 16 * g + lane] = (bf16)(pk2(gelu_tanh(y), 0.f) & 0xffffu); }
}

__global__ void __launch_bounds__(512, 2) fwd_kernel(KArgs a) {
    extern __shared__ __attribute__((aligned(16))) unsigned char lds_raw[];
    LAS unsigned char* lds = (LAS unsigned char*)lds_raw;
    cg::grid_group grid = cg::this_grid();
    Ctx cx; cx.in = a.in; cx.out = a.out; cx.ws = a.ws;
    const int tid = threadIdx.x, lane = tid & 63, wave = __builtin_amdgcn_readfirstlane(tid >> 6);
    const int G = gridDim.x, bid = blockIdx.x, gw = bid * 8 + wave, NGW = G * 8;
#ifndef PHMASK
#define PHMASK 0x1fff
#endif
#define IN(k) (((PHMASK >> (k)) & 1) && a.lo <= (k) && (k) < a.hi)
#define SEAM(k) do { if (IN(k) && IN((k) + 1)) grid.sync(); } while (0)

    if (IN(0)) {
        for (int g = bid; g < 32; g += G) s5_tables(cx, g, lds);
        { const int sh = (gw + NGW - 32 * 8) % NGW; for (int it = sh; it < 384; it += NGW) ada_item(cx, it, lane); }
        LAS float* scr = (LAS float*)(lds + wave * 16384);
        for (int it = gw; it < N_TR_ITEMS; it += NGW) transpose_dispatch(cx, it, scr, lane);
    }
    SEAM(0);
    if (IN(1)) {
        for (int r = gw; r < MTOK; r += NGW) { const float* xr = r < MPR ? cx.I(0) + (size_t)r * DM : cx.I(1) + (size_t)(r - MPR) * DM; const float* md = cx.MOD() + (size_t)mod_row(r) * NMOD;
            norm_mod_row(xr, cx.I(10), md + 1024, md, cx.XN() + (size_t)r * DM, lane); }
    }
    SEAM(1);
    if (IN(2)) {
        pg8::Gemm g{cx.XN(), cx.WIN(), MPAD, NPROJ, DM}; pg8::StaticOrder S; S.init(MPAD, NPROJ, G, bid);
        EpiProj E{cx.LRUX(), cx.GATE(), cx.S5U()};
        pg8::gemm_phase<EpiProj, pg8::StaticOrder, true, true>(lds, g, S, E);
    }
    SEAM(2);
    if (IN(3)) {
#ifndef NO_LRU
        for (int u = bid; u < 256 + NBS / SCH; u += G) {
            if (u < 256) lru_local_unit(cx, u * LCH, LCH, false, u, lds); else lru_local_unit(cx, MPR + (u - 256) * SCH, SCH, true, 0, lds);
        }
#endif
#ifndef NO_E
        for (int it = gw; it < 1024; it += NGW) s5_gemm_e_item(cx, it, lane);
#endif
    }
    SEAM(3);
    if (IN(4)) {
        { const int ci = bid - (G - 32); if (ci >= 0) s5_chain_item(cx, ci); else if (G < 32) { for (int c2 = bid; c2 < 32; c2 += G) s5_chain_item(cx, c2); } }
        for (int u = bid; u < 256 + NBS / SCH; u += G) {
            if (u < 256) lru_fix_unit(cx, u * LCH, LCH, false, u >> 5, u & 31, lds); else lru_fix_unit(cx, MPR + (u - 256) * SCH, SCH, true, 0, 0, lds);
        }
    }
    SEAM(4);
    if (IN(5)) {
        for (int it = gw; it < 2048; it += NGW) s5_gemm_tf_item(cx, it, lane);
        for (int it = gw; it < NBS * 32; it += NGW) s5_sample_item(cx, it, lane);
    }
    SEAM(5);
    if (IN(6)) {
        pg8::Gemm g{cx.GY(), cx.WGLU(), MPAD, 1024, 512}; pg8::StaticOrder S; S.init(MPAD, 1024, G, bid);
        EpiGlu E{cx.S5OUT()};
        pg8::gemm_phase<EpiGlu, pg8::StaticOrder, true, true>(lds, g, S, E);
    }
    SEAM(6);
    if (IN(7)) {
        const float* gs = cx.I(29);
        for (int r = gw; r < MTOK; r += NGW) { const float* sr = cx.S5OUT() + (size_t)r * 512;
            const f32x4 v0 = ((const f32x4*)sr)[lane], v1 = ((const f32x4*)sr)[lane + 64];
            const float ss = (v0.x * v0.x + v0.y * v0.y) + (v0.z * v0.z + v0.w * v0.w) + (v1.x * v1.x + v1.y * v1.y) + (v1.z * v1.z + v1.w * v1.w);
            const float rstd = rsqrtf(wave_sum(ss) * (1.f / 512) + EPS);
            const f32x4 o0 = v0 * rstd * ((const f32x4*)gs)[lane], o1 = v1 * rstd * ((const f32x4*)gs)[lane + 64];
            bf16* mp = cx.MERGED() + (size_t)r * DM + 512; u32x2 w0, w1; w0.x = pk2(o0.x, o0.y); w0.y = pk2(o0.z, o0.w); w1.x = pk2(o1.x, o1.y); w1.y = pk2(o1.z, o1.w);
            *(u32x2*)(mp + 4 * lane) = w0; *(u32x2*)(mp + 256 + 4 * lane) = w1; }
    }
    SEAM(7);
    if (IN(8)) {
        pg8::Gemm g{cx.MERGED(), cx.WOUT(), MPAD, DM, DM}; pg8::StaticOrder S; S.init(MPAD, DM, G, bid);
        EpiRes<2048> E{cx.I(0), cx.I(1), cx.MOD(), cx.out};
        pg8::gemm_phase<EpiRes<2048>, pg8::StaticOrder, true, true>(lds, g, S, E);
    }
    SEAM(8);
    if (IN(9)) {
        for (int r = gw; r < MTOK; r += NGW) { const float* md = cx.MOD() + (size_t)mod_row(r) * NMOD;
            norm_mod_row(cx.out + (size_t)r * DM, cx.I(31), md + 4096, md + 3072, cx.XN2() + (size_t)r * DM, lane); }
    }
    SEAM(9);
    if (IN(10)) {
        pg8::Gemm g{cx.XN2(), cx.WGU(), MPAD, 2 * DFF, DM}; pg8::StaticOrder S; S.init(MPAD, 2 * DFF, G, bid);
        EpiSwiglu E{cx.HB()};
        pg8::gemm_phase<EpiSwiglu, pg8::StaticOrder, true, true>(lds, g, S, E);
    }
    SEAM(10);
    if (IN(11)) {
        pg8::Gemm g{cx.HB(), cx.WDN(), MPAD, DM, DFF}; pg8::StaticOrder S; S.init(MPAD, DM, G, bid);
        EpiRes<5120> E{nullptr, nullptr, cx.MOD(), cx.out};
        pg8::gemm_phase<EpiRes<5120>, pg8::StaticOrder, true, true>(lds, g, S, E);
    }
    SEAM(11);
    if (IN(12)) {
        const float* fg = cx.I(35);
        for (int r = gw; r < MTOK; r += NGW) { float* xr = cx.out + (size_t)r * DM; f32x4 v[4]; float ss = 0.f;
#pragma unroll
            for (int j = 0; j < 4; ++j) { v[j] = ((const f32x4*)xr)[lane + 64 * j]; ss += (v[j].x * v[j].x + v[j].y * v[j].y) + (v[j].z * v[j].z + v[j].w * v[j].w); }
            const float rstd = rsqrtf(wave_sum(ss) * (1.f / DM) + EPS);
#pragma unroll
            for (int j = 0; j < 4; ++j) ((f32x4*)xr)[lane + 64 * j] = v[j] * rstd * ((const f32x4*)fg)[lane + 64 * j]; }
    }
#undef IN
#undef SEAM
}

constexpr int LDS_BYTES = 131072;
#ifndef MK_SINGLE
#define MK_SINGLE 0
#endif
extern "C" void kernel_launch(void* const* d_in, const int* in_sizes, int n_in, void* d_out, int out_size, void* d_ws, size_t ws_size, hipStream_t stream) {
    static int grid = 0;
    if (grid == 0) {
        if (n_in != 36 || (size_t)out_size != O_END || ws_size < WS_END) { fprintf(stderr, "kernel_launch: unexpected shapes n_in %d out %d ws %zu\n", n_in, out_size, ws_size); grid = -1; return; }
        int dev = 0, cus = 0, per_cu = 0;
        hipGetDevice(&dev); hipDeviceGetAttribute(&cus, hipDeviceAttributeMultiprocessorCount, dev);
        hipFuncSetAttribute((const void*)fwd_kernel, hipFuncAttributeMaxDynamicSharedMemorySize, LDS_BYTES);
        hipOccupancyMaxActiveBlocksPerMultiprocessor(&per_cu, (const void*)fwd_kernel, 512, LDS_BYTES);
        if (per_cu < 1) { fprintf(stderr, "kernel_launch: occupancy query says %d blocks per CU\n", per_cu); grid = -1; return; }
        grid = cus;
    }
    if (grid < 0) return;
    KArgs a{};
    for (int i = 0; i < 36; ++i) a.in[i] = (const float*)d_in[i];
    a.out = (float*)d_out; a.ws = (unsigned char*)d_ws;
#if MK_SINGLE
    a.lo = 0; a.hi = NPHASE;
    void* args[] = {&a};
    hipError_t e = hipLaunchCooperativeKernel((const void*)fwd_kernel, dim3(grid), dim3(512), args, LDS_BYTES, stream);
    if (e != hipSuccess) fprintf(stderr, "cooperative launch failed: %s (grid %d)\n", hipGetErrorString(e), grid);
#else
    for (int p = 0; p < NPHASE; ++p) { a.lo = p; a.hi = p + 1; hipLaunchKernelGGL(fwd_kernel, dim3(grid), dim3(512), LDS_BYTES, stream, a); }
#endif
}
```

```cpp
#include <hip/hip_runtime.h>
#include <hip/hip_cooperative_groups.h>
#include <cstdio>
#include <cstdint>
namespace cg = cooperative_groups;
namespace pg8 {
#define PG8_LAS __attribute__((address_space(3)))
typedef unsigned short bf16_t;
typedef short bf16x8 __attribute__((ext_vector_type(8)));
typedef float f32x4 __attribute__((ext_vector_type(4)));
typedef unsigned u32x4 __attribute__((ext_vector_type(4)));
constexpr int BM = 256, BK = 64, HALF = 128, HTB = HALF * BK * 2  , STAGE_BYTES = 8 * HTB, NXCD = 8, WGM = 8;

__host__ __device__ __forceinline__ int lds_byte(int r, int c) { const int st = (r >> 4) * 2 + (c >> 5), rr = r & 15, cc = c & 31, ob = rr * 64 + cc * 2; return st * 1024 + (ob ^ (((ob >> 9) & 1) << 5)); }
__host__ __device__ __forceinline__ void stage_rc(int b, int& R, int& C) { const int st = b / 1024, sb = b % 1024, swz = sb ^ (((sb >> 9) & 1) << 5); R = (st >> 1) * 16 + swz / 64; C = (st & 1) * 32 + (swz % 64) / 2; }
__host__ __device__ __forceinline__ int perm32(int rho) { const int n = rho >> 4, i = rho & 15; return 8 * (i >> 2) + 4 * n + (i & 3); }

struct Unit { int pm, pn; };
struct Gemm { const bf16_t* A; const bf16_t* Bt; int M, N, K; };

struct StaticOrder {
    int nM, nN, nwg, G, c;
    __host__ __device__ void init(int M, int N, int G_, int c_) { nM = M / BM; nN = N / BM; nwg = nM * nN; G = G_; c = c_; }
    __host__ __device__ bool next(int i, Unit& u) const {
        const long L = (long)i * G + c; if (L >= nwg) return false;
        int wgid = (int)L; { const int q = nwg / NXCD, r = nwg % NXCD, xcd = wgid % NXCD, off = wgid / NXCD; wgid = (xcd < r ? xcd * (q + 1) : r * (q + 1) + (xcd - r) * q) + off; }
        const int nig = WGM * nN, gid = wgid / nig, fm = gid * WGM, gsz = (nM - fm) < WGM ? (nM - fm) : WGM;
        u.pm = fm + ((wgid % nig) % gsz); u.pn = (wgid % nig) / gsz; return true;
    }
    __device__ __forceinline__ void a_ready(const Unit&) const {}
    __device__ __forceinline__ void done(const Unit&) const {}
};

__device__ __forceinline__ unsigned cvt_pk_bf16(float lo, float hi) { unsigned r; asm volatile("v_cvt_pk_bf16_f32 %0, %1, %2" : "=v"(r) : "v"(lo), "v"(hi)); return r; }
typedef float f32x2 __attribute__((ext_vector_type(2)));
template <class Epi, class Sched, bool ALIGN_EPI = false, bool SP2 = false>
__device__ __forceinline__ void gemm_phase(PG8_LAS unsigned char* lds, const Gemm g, const Sched& S, const Epi& E) {
    const int tid = threadIdx.x, wid = __builtin_amdgcn_readfirstlane(tid >> 6), lane = tid & 63, wr = wid >> 2, wc = wid & 3, fr = lane & 15, fq = lane >> 4;
    const int K = g.K, nt = K / BK;
    unsigned voffA[2], voffB[2];
#pragma unroll
    for (int i = 0; i < 2; ++i) { int R, C; stage_rc(tid * 16 + i * 8192, R, C); const int Rb = Epi::PERM ? ((R & ~31) + perm32(R & 31)) : R;
        voffA[i] = (unsigned)(R * K + C) * 2u; voffB[i] = (unsigned)(Rb * K + C) * 2u; }
    const size_t kstep = (size_t)(BK * 2);
    const size_t hstep = (size_t)HALF * K * 2;
    const size_t tstep = 2 * hstep;
    const unsigned ldsw = (unsigned)wid * 1024u;
    const int aoff = lds_byte(wr * 64 + fr, fq * 8), boff = lds_byte(wc * 32 + fr, fq * 8);
#define PG8_SA(b, h) (((b) * 2 + (h)) * HTB)
#define PG8_SB(b, h) ((4 + (b) * 2 + (h)) * HTB)
#define PG8_STAGE(bufoff, gbase, voff) do { _Pragma("unroll") for (int _i = 0; _i < 2; ++_i) \
        __builtin_amdgcn_global_load_lds((const unsigned*)((const char*)(gbase) + (voff)[_i]), (PG8_LAS unsigned*)(lds + (bufoff) + ldsw + _i * 8192), 16, 0, 0); } while (0)
#define PG8_LDA(dst, b, h) do { _Pragma("unroll") for (int m = 0; m < 4; ++m) _Pragma("unroll") for (int k = 0; k < 2; ++k) dst[m][k] = *(const PG8_LAS bf16x8*)(lds + PG8_SA(b, h) + aoff + m * 2048 + k * 1024); } while (0)
#define PG8_LDB(dst, b, h) do { _Pragma("unroll") for (int n = 0; n < 2; ++n) _Pragma("unroll") for (int k = 0; k < 2; ++k) dst[n][k] = *(const PG8_LAS bf16x8*)(lds + PG8_SB(b, h) + boff + n * 2048 + k * 1024); } while (0)
#define PG8_MMA(ai, bj, At, Bt) do { __builtin_amdgcn_s_setprio(1); _Pragma("unroll") for (int m = 0; m < 4; ++m) _Pragma("unroll") for (int n = 0; n < 2; ++n) _Pragma("unroll") for (int k = 0; k < 2; ++k) \
        acc[ai][bj][m][n] = __builtin_amdgcn_mfma_f32_16x16x32_bf16(Bt[n][k], At[m][k], acc[ai][bj][m][n], 0, 0, 0); __builtin_amdgcn_s_setprio(0); } while (0)
#define PG8_WAIT_V(n) asm volatile("s_waitcnt vmcnt(" #n ")" ::: "memory")
#define PG8_WAIT_L(n) asm volatile("s_waitcnt lgkmcnt(" #n ")" ::: "memory")
#define PG8_BAR __builtin_amdgcn_s_barrier()
#define PG8_SCHED __builtin_amdgcn_sched_barrier(0)
    Unit cur, nxt; int ui = 0;
    if (!S.next(0, cur)) return;
    f32x4 acc[2][2][4][2];
#pragma unroll
    for (int a = 0; a < 2; ++a)
#pragma unroll
        for (int b = 0; b < 2; ++b)
#pragma unroll
            for (int m = 0; m < 4; ++m)
#pragma unroll
                for (int n = 0; n < 2; ++n) acc[a][b][m][n] = (f32x4){0.f, 0.f, 0.f, 0.f};
    bf16x8 At[4][2], B0[2][2], B1[2][2];
    const char* cA = (const char*)g.A + (size_t)cur.pm * tstep; const char* cB = (const char*)g.Bt + (size_t)cur.pn * tstep;
    S.a_ready(cur);
    if constexpr (SP2) {
        PG8_STAGE(PG8_SB(0, 0), cB, voffB); PG8_STAGE(PG8_SB(0, 1), cB + hstep, voffB); PG8_STAGE(PG8_SA(0, 0), cA, voffA); PG8_STAGE(PG8_SA(0, 1), cA + hstep, voffA);
        if (wr == 1) PG8_BAR;
        PG8_WAIT_V(2); PG8_BAR;
        PG8_STAGE(PG8_SB(1, 0), cB + kstep, voffB); PG8_STAGE(PG8_SA(1, 0), cA + kstep, voffA); PG8_STAGE(PG8_SB(1, 1), cB + hstep + kstep, voffB);
        PG8_WAIT_V(6); PG8_BAR;
    } else {
        PG8_STAGE(PG8_SB(0, 0), cB, voffB); PG8_STAGE(PG8_SA(0, 0), cA, voffA); PG8_STAGE(PG8_SB(0, 1), cB + hstep, voffB); PG8_STAGE(PG8_SA(0, 1), cA + hstep, voffA);
        if (wr == 1) PG8_BAR;
        PG8_WAIT_V(4); PG8_BAR;
        PG8_STAGE(PG8_SB(1, 0), cB + kstep, voffB); PG8_STAGE(PG8_SA(1, 0), cA + kstep, voffA); PG8_STAGE(PG8_SB(1, 1), cB + hstep + kstep, voffB);
        PG8_WAIT_V(6); PG8_BAR;
    }
    for (;;) {
        const bool has_next = S.next(ui + 1, nxt);
        const char* nA = has_next ? (const char*)g.A + (size_t)nxt.pm * tstep : cA; const char* nB = has_next ? (const char*)g.Bt + (size_t)nxt.pn * tstep : cB;
        for (int t = 0; t < nt; t += 2) {
            const bool last = (t == nt - 2);
            const char* a1 = cA + (size_t)(t + 1) * kstep;
            const char* a2 = last ? nA : cA + (size_t)(t + 2) * kstep; const char* b2 = last ? nB : cB + (size_t)(t + 2) * kstep;
            const char* a3 = a2 + kstep; const char* b3 = b2 + kstep;
            if (last && has_next) S.a_ready(nxt);
            if constexpr (SP2) {
            PG8_LDB(B0, 0, 0); PG8_LDB(B1, 0, 1); PG8_SCHED; PG8_LDA(At, 0, 0); PG8_STAGE(PG8_SA(1, 1), a1 + hstep, voffA);
            PG8_WAIT_V(8); PG8_WAIT_L(0); PG8_BAR; PG8_MMA(0, 0, At, B0); PG8_MMA(0, 1, At, B1); PG8_BAR; PG8_SCHED;
            PG8_LDA(At, 0, 1); PG8_STAGE(PG8_SB(0, 0), b2, voffB); PG8_STAGE(PG8_SB(0, 1), b2 + hstep, voffB); PG8_STAGE(PG8_SA(0, 0), a2, voffA);
            PG8_WAIT_V(8); PG8_WAIT_L(0); PG8_BAR; PG8_MMA(1, 0, At, B0); PG8_MMA(1, 1, At, B1); PG8_BAR; PG8_SCHED;
            PG8_LDB(B0, 1, 0); PG8_LDB(B1, 1, 1); PG8_SCHED; PG8_LDA(At, 1, 0); PG8_STAGE(PG8_SA(0, 1), a2 + hstep, voffA);
            PG8_WAIT_V(8); PG8_WAIT_L(0); PG8_BAR; PG8_MMA(0, 0, At, B0); PG8_MMA(0, 1, At, B1); PG8_BAR; PG8_SCHED;
            PG8_LDA(At, 1, 1); PG8_STAGE(PG8_SB(1, 0), b3, voffB); PG8_STAGE(PG8_SB(1, 1), b3 + hstep, voffB); PG8_STAGE(PG8_SA(1, 0), a3, voffA);
            PG8_WAIT_V(8); PG8_WAIT_L(0); PG8_BAR; PG8_MMA(1, 0, At, B0); PG8_MMA(1, 1, At, B1); PG8_BAR; PG8_SCHED;
            } else {
            PG8_LDB(B0, 0, 0); PG8_SCHED; PG8_LDA(At, 0, 0); PG8_STAGE(PG8_SA(1, 1), a1 + hstep, voffA);
            PG8_WAIT_L(8); PG8_BAR; PG8_WAIT_L(0); PG8_MMA(0, 0, At, B0); PG8_BAR; PG8_SCHED;
            PG8_LDB(B1, 0, 1); PG8_STAGE(PG8_SB(0, 0), b2, voffB);
            PG8_BAR; PG8_WAIT_L(0); PG8_MMA(0, 1, At, B1); PG8_BAR;
            PG8_LDA(At, 0, 1); PG8_STAGE(PG8_SA(0, 0), a2, voffA);
            PG8_BAR; PG8_WAIT_L(0); PG8_MMA(1, 0, At, B0); PG8_BAR; PG8_SCHED;
            PG8_STAGE(PG8_SB(0, 1), b2 + hstep, voffB);
            PG8_WAIT_V(6); PG8_BAR; PG8_MMA(1, 1, At, B1); PG8_BAR;
            PG8_LDB(B0, 1, 0); PG8_SCHED; PG8_LDA(At, 1, 0); PG8_STAGE(PG8_SA(0, 1), a2 + hstep, voffA);
            PG8_WAIT_L(8); PG8_BAR; PG8_WAIT_L(0); PG8_MMA(0, 0, At, B0); PG8_BAR; PG8_SCHED;
            PG8_LDB(B1, 1, 1); PG8_STAGE(PG8_SB(1, 0), b3, voffB);
            PG8_BAR; PG8_WAIT_L(0); PG8_MMA(0, 1, At, B1); PG8_BAR;
            PG8_LDA(At, 1, 1); PG8_STAGE(PG8_SA(1, 0), a3, voffA);
            PG8_BAR; PG8_WAIT_L(0); PG8_MMA(1, 0, At, B0); PG8_BAR; PG8_SCHED;
            PG8_STAGE(PG8_SB(1, 1), b3 + hstep, voffB);
            PG8_WAIT_V(6); PG8_BAR; PG8_MMA(1, 1, At, B1); PG8_BAR;
            }
        }
        if constexpr (ALIGN_EPI) { if (wr == 0) PG8_BAR; }
        if constexpr (!Epi::AFTER_DRAIN) { E(acc, cur, wr, wc, fr, fq); S.done(cur); }
        if (!has_next) break;
#pragma unroll
        for (int a = 0; a < 2; ++a)
#pragma unroll
            for (int b = 0; b < 2; ++b)
#pragma unroll
                for (int m = 0; m < 4; ++m)
#pragma unroll
                    for (int n = 0; n < 2; ++n) acc[a][b][m][n] = (f32x4){0.f, 0.f, 0.f, 0.f};
        cur = nxt; cA = nA; cB = nB; ++ui;
        if constexpr (ALIGN_EPI) { if (wr == 1) PG8_BAR; }
    }
    PG8_WAIT_V(0);
    if constexpr (!ALIGN_EPI) { if (wr == 0) PG8_BAR; }
    PG8_BAR;
    if constexpr (Epi::AFTER_DRAIN) { E.fused(acc, cur, wr, wc, fr, fq, lds, wid, lane); S.done(cur); }
#undef PG8_SA
#undef PG8_SB
#undef PG8_STAGE
#undef PG8_LDA
#undef PG8_LDB
#undef PG8_MMA
#undef PG8_WAIT_V
#undef PG8_WAIT_L
#undef PG8_BAR
#undef PG8_SCHED
}
}

#define LAS __attribute__((address_space(3)))
typedef unsigned short bf16;
typedef float f32x4 __attribute__((ext_vector_type(4)));
typedef float f32x2 __attribute__((ext_vector_type(2)));
typedef short bf16x8 __attribute__((ext_vector_type(8)));
typedef unsigned u32x4 __attribute__((ext_vector_type(4)));
typedef unsigned u32x2 __attribute__((ext_vector_type(2)));

constexpr int DM = 1024, NBP = 8, SEQ = 2048, MPR = NBP * SEQ, NBS = 128, MTOK = MPR + NBS, MPAD = 16640;
constexpr int DL = 512, NPROJ = 1536, NMOD = 6144, NBT = NBP + NBS, DFF = 2816;
constexpr int LCH = 64, NCH = SEQ / LCH;
constexpr int SCH = 16;
constexpr int SL = 16, SNCH = SEQ / SL, SROWS = NBP * SNCH;
constexpr float EPS = 1e-6f;
constexpr int NPHASE = 13;

constexpr size_t O_Y = 0, O_CONVP = (size_t)MTOK * DM, O_LRUP = O_CONVP + 8 * 3 * 512, O_S5RP = O_LRUP + 8 * 512, O_S5IP = O_S5RP + 8 * 32 * 64,
                 O_CONVS = O_S5IP + 8 * 32 * 64, O_LRUS = O_CONVS + 128 * 3 * 512, O_S5RS = O_LRUS + 128 * 512, O_S5IS = O_S5RS + 128 * 32 * 64, O_END = O_S5IS + 128 * 32 * 64;

constexpr size_t HM = 1u << 19;
constexpr size_t WS_WIN = 2 * HM, WS_WGLU = 8 * HM, WS_WOUT = 10 * HM, WS_WGU = 14 * HM, WS_WDN = 36 * HM  , WS_MOD = 48 * HM  ,
                 WS_TF = 56 * HM  , WS_E = 68 * HM  , WS_TAB = 72 * HM, WS_AGG = 74 * HM  ,
                 WS_XN = 80 * HM  , WS_LRUX = 146 * HM  , WS_GATE = 211 * HM  ,
                 WS_S5U = 244 * HM  , WS_HLOC = 277 * HM  , WS_CUM = 342 * HM, WS_GY = 407 * HM  ,
                 WS_SK = 440 * HM  , WS_HIN = 472 * HM  , WS_HB = 244 * HM  , WS_END = 512 * HM;
constexpr size_t T_ABAR = 0, T_A16 = 4096, T_BBR = 8192, T_BBI = 8192 + 32768;

struct KArgs { const float* in[36]; float* out; unsigned char* ws; int lo, hi; };

struct Ctx {
    const float* const* in; float* out; unsigned char* ws;
    __device__ __forceinline__ const float* I(int i) const { return in[i]; }
    __device__ __forceinline__ bf16* WIN() const { return (bf16*)(ws + WS_WIN); }
    __device__ __forceinline__ bf16* WGLU() const { return (bf16*)(ws + WS_WGLU); }
    __device__ __forceinline__ bf16* WOUT() const { return (bf16*)(ws + WS_WOUT); }
    __device__ __forceinline__ bf16* WGU() const { return (bf16*)(ws + WS_WGU); }
    __device__ __forceinline__ bf16* WDN() const { return (bf16*)(ws + WS_WDN); }
    __device__ __forceinline__ float* MOD() const { return (float*)(ws + WS_MOD); }
    __device__ __forceinline__ bf16* TF() const { return (bf16*)(ws + WS_TF); }
    __device__ __forceinline__ bf16* EM() const { return (bf16*)(ws + WS_E); }
    __device__ __forceinline__ float* TAB() const { return (float*)(ws + WS_TAB); }
    __device__ __forceinline__ f32x2* AGG() const { return (f32x2*)(ws + WS_AGG); }
    __device__ __forceinline__ bf16* XN() const { return (bf16*)(ws + WS_XN); }
    __device__ __forceinline__ bf16* MERGED() const { return (bf16*)(ws + WS_XN); }
    __device__ __forceinline__ float* LRUX() const { return (float*)(ws + WS_LRUX); }
    __device__ __forceinline__ bf16* XN2() const { return (bf16*)(ws + WS_LRUX); }
    __device__ __forceinline__ bf16* GATE() const { return (bf16*)(ws + WS_GATE); }
    __device__ __forceinline__ bf16* S5U() const { return (bf16*)(ws + WS_S5U); }
    __device__ __forceinline__ float* HLOC() const { return (float*)(ws + WS_HLOC); }
    __device__ __forceinline__ float* S5OUT() const { return (float*)(ws + WS_HLOC); }
    __device__ __forceinline__ float* CUM() const { return (float*)(ws + WS_CUM); }
    __device__ __forceinline__ bf16* GY() const { return (bf16*)(ws + WS_GY); }
    __device__ __forceinline__ float* SK() const { return (float*)(ws + WS_SK); }
    __device__ __forceinline__ bf16* HIN() const { return (bf16*)(ws + WS_HIN); }
    __device__ __forceinline__ bf16* HB() const { return (bf16*)(ws + WS_HB); }
};

#define LDS_WAIT() asm volatile("s_waitcnt lgkmcnt(0)" ::: "memory")
__device__ __forceinline__ unsigned pk2(float lo, float hi) { return pg8::cvt_pk_bf16(lo, hi); }
__device__ __forceinline__ float bf2f(unsigned b) { return __uint_as_float(b << 16); }
__device__ __forceinline__ float bflo(unsigned w) { return __uint_as_float(w << 16); }
__device__ __forceinline__ float bfhi(unsigned w) { return __uint_as_float(w & 0xffff0000u); }
__device__ __forceinline__ float wave_sum(float v) {
#pragma unroll
    for (int o = 1; o < 64; o <<= 1) v += __shfl_xor(v, o);
    return v;
}
__device__ __forceinline__ float sigm(float v) { return 1.f / (1.f + __expf(-v)); }
__device__ __forceinline__ float gelu_tanh(float x) { const float u = 1.5957691216f * (x + 0.044715f * x * x * x); return x / (1.f + __expf(-u)); }
__device__ __forceinline__ int mod_row(int row) { return row < MPR ? (row >> 11) : (NBP + row - MPR); }
__device__ __forceinline__ u32x4 pack8(f32x4 a, f32x4 b) { u32x4 w; w.x = pk2(a[0], a[1]); w.y = pk2(a[2], a[3]); w.z = pk2(b[0], b[1]); w.w = pk2(b[2], b[3]); return w; }

struct EpiProj {
    static constexpr bool PERM = true, AFTER_DRAIN = false; float* lrux; bf16* gate; bf16* s5u;
    __device__ __forceinline__ void operator()(const f32x4 (&acc)[2][2][4][2], const pg8::Unit& u, int wr, int wc, int fr, int fq) const {
        const int colt = u.pn * 256 + wc * 32 + 8 * fq;
#pragma unroll
        for (int ai = 0; ai < 2; ++ai)
#pragma unroll
            for (int m = 0; m < 4; ++m) { const int row = u.pm * 256 + ai * 128 + wr * 64 + m * 16 + fr; if (row >= MTOK) continue;
#pragma unroll
                for (int bj = 0; bj < 2; ++bj) { const int col = colt + bj * 128; const f32x4 v0 = acc[ai][bj][m][0], v1 = acc[ai][bj][m][1];
                    if (u.pn < 2) { float* p = lrux + (size_t)row * 512 + col; *(f32x4*)p = v0; *(f32x4*)(p + 4) = v1; }
                    else if (u.pn < 4) { *(u32x4*)(gate + (size_t)row * 512 + (col - 512)) = pack8(v0, v1); }
                    else { *(u32x4*)(s5u + (size_t)row * 512 + (col - 1024)) = pack8(v0, v1); } } }
    }
};
struct EpiGlu {
    static constexpr bool PERM = true, AFTER_DRAIN = false; float* o;
    __device__ __forceinline__ void operator()(const f32x4 (&acc)[2][2][4][2], const pg8::Unit& u, int wr, int wc, int fr, int fq) const {
        const int col = u.pn * 128 + wc * 32 + 8 * fq;
#pragma unroll
        for (int ai = 0; ai < 2; ++ai)
#pragma unroll
            for (int m = 0; m < 4; ++m) { const int row = u.pm * 256 + ai * 128 + wr * 64 + m * 16 + fr; if (row >= MTOK) continue;
#pragma unroll
                for (int n = 0; n < 2; ++n) { const f32x4 a = acc[ai][0][m][n], b = acc[ai][1][m][n]; f32x4 s;
#pragma unroll
                    for (int i = 0; i < 4; ++i) s[i] = a[i] * sigm(b[i]);
                    *(f32x4*)(o + (size_t)row * 512 + col + 4 * n) = s; } }
    }
};
template <int GOFF> struct EpiRes {
    static constexpr bool PERM = true, AFTER_DRAIN = false; const float* xp; const float* xs; const float* mod; float* out;
    __device__ __forceinline__ void operator()(const f32x4 (&acc)[2][2][4][2], const pg8::Unit& u, int wr, int wc, int fr, int fq) const {
        const int colt = u.pn * 256 + wc * 32 + 8 * fq;
#pragma unroll
        for (int ai = 0; ai < 2; ++ai)
#pragma unroll
            for (int m = 0; m < 4; ++m) { const int row = u.pm * 256 + ai * 128 + wr * 64 + m * 16 + fr; if (row >= MTOK) continue;
                const float* gp = mod + (size_t)mod_row(row) * NMOD + GOFF; float* op = out + (size_t)row * DM;
                const float* bp = xp ? (row < MPR ? xp + (size_t)row * DM : xs + (size_t)(row - MPR) * DM) : op;
#pragma unroll
                for (int bj = 0; bj < 2; ++bj)
#pragma unroll
                    for (int n = 0; n < 2; ++n) { const int c = colt + bj * 128 + 4 * n; const f32x4 x4 = *(const f32x4*)(bp + c), g4 = *(const f32x4*)(gp + c);
                        *(f32x4*)(op + c) = x4 + g4 * acc[ai][bj][m][n]; } }
    }
};
struct EpiSwiglu {
    static constexpr bool PERM = true, AFTER_DRAIN = false; bf16* h;
    __device__ __forceinline__ void operator()(const f32x4 (&acc)[2][2][4][2], const pg8::Unit& u, int wr, int wc, int fr, int fq) const {
        const int col = u.pn * 128 + wc * 32 + 8 * fq;
#pragma unroll
        for (int ai = 0; ai < 2; ++ai)
#pragma unroll
            for (int m = 0; m < 4; ++m) { const int row = u.pm * 256 + ai * 128 + wr * 64 + m * 16 + fr; if (row >= MTOK) continue;
                f32x4 s[2];
#pragma unroll
                for (int n = 0; n < 2; ++n) { const f32x4 a = acc[ai][0][m][n], b = acc[ai][1][m][n];
#pragma unroll
                    for (int i = 0; i < 4; ++i) s[n][i] = a[i] * sigm(a[i]) * b[i]; }
                *(u32x4*)(h + (size_t)row * DFF + col) = pack8(s[0], s[1]); }
    }
};

__device__ __forceinline__ void transpose_item(const float* W, int ldw, int k0, int n0, bf16* WT, int K, int drow0, LAS float* scr, int lane) {
#pragma unroll 8
    for (int i = 0; i < 32; ++i) { const int kk = 2 * i + (lane >> 5); scr[kk * 33 + (lane & 31)] = W[(size_t)(k0 + kk) * ldw + n0 + (lane & 31)]; }
    LDS_WAIT();
    const int c = lane & 7;
#pragma unroll
    for (int j = 0; j < 4; ++j) { const int n = (lane >> 3) + 8 * j; const LAS float* s = scr + (8 * c) * 33 + n;
        u32x4 o; o.x = pk2(s[0 * 33], s[1 * 33]); o.y = pk2(s[2 * 33], s[3 * 33]); o.z = pk2(s[4 * 33], s[5 * 33]); o.w = pk2(s[6 * 33], s[7 * 33]);
        *(u32x4*)(WT + (size_t)(drow0 + n) * K + k0 + 8 * c) = o; }
    LDS_WAIT();
}
__device__ __forceinline__ void transpose_dispatch(const Ctx& cx, int it, LAS float* scr, int lane) {
    if (it < 768) { const int kb = it / 48, nb = it % 48; transpose_item(cx.I(11), NPROJ, 64 * kb, 32 * nb, cx.WIN(), DM, 32 * nb, scr, lane); return; } it -= 768;
    if (it < 256) { const int kb = it / 32, nb = it % 32, n0 = 32 * nb; const int dr = 256 * ((n0 & 511) >> 7) + 128 * (n0 >> 9) + (n0 & 127);
        transpose_item(cx.I(27), 1024, 64 * kb, n0, cx.WGLU(), 512, dr, scr, lane); return; } it -= 256;
    if (it < 512) { const int kb = it / 32, nb = it % 32; transpose_item(cx.I(30), DM, 64 * kb, 32 * nb, cx.WOUT(), DM, 32 * nb, scr, lane); return; } it -= 512;
    if (it < 1408) { const int kb = it / 88, nb = it % 88, n0 = 32 * nb; transpose_item(cx.I(32), DFF, 64 * kb, n0, cx.WGU(), DM, 256 * (n0 >> 7) + (n0 & 127), scr, lane); return; } it -= 1408;
    if (it < 1408) { const int kb = it / 88, nb = it % 88, n0 = 32 * nb; transpose_item(cx.I(33), DFF, 64 * kb, n0, cx.WGU(), DM, 256 * (n0 >> 7) + 128 + (n0 & 127), scr, lane); return; } it -= 1408;
    { const int kb = it / 32, nb = it % 32; transpose_item(cx.I(34), DM, 64 * kb, 32 * nb, cx.WDN(), DFF, 32 * nb, scr, lane); }
}
constexpr int N_TR_ITEMS = 768 + 256 + 512 + 1408 + 1408 + 1408;

__device__ __forceinline__ void ada_item(const Ctx& cx, int item, int lane) {
    const int n0 = 16 * item, fr = lane & 15, fq = lane >> 4;
    const float* W = cx.I(8); const float* cp = cx.I(6); const float* cs = cx.I(7);
    f32x4 acc[9];
#pragma unroll
    for (int i = 0; i < 9; ++i) acc[i] = (f32x4){0.f, 0.f, 0.f, 0.f};
    for (int k0 = 0; k0 < DM; k0 += 32) {
        float wv[8];
#pragma unroll
        for (int j = 0; j < 8; ++j) wv[j] = W[(size_t)(k0 + 8 * fq + j) * NMOD + n0 + fr];
        u32x4 wp; wp.x = pk2(wv[0], wv[1]); wp.y = pk2(wv[2], wv[3]); wp.z = pk2(wv[4], wv[5]); wp.w = pk2(wv[6], wv[7]);
        const bf16x8 wf = __builtin_bit_cast(bf16x8, wp);
#pragma unroll
        for (int mt = 0; mt < 9; ++mt) { int row = 16 * mt + fr; row = row < NBT ? row : NBT - 1;
            const float* src = (row < NBP ? cp + (size_t)row * DM : cs + (size_t)(row - NBP) * DM) + k0 + 8 * fq;
            f32x4 a0 = *(const f32x4*)src, a1 = *(const f32x4*)(src + 4);
#pragma unroll
            for (int i = 0; i < 4; ++i) { a0[i] = a0[i] * sigm(a0[i]); a1[i] = a1[i] * sigm(a1[i]); }
            const bf16x8 af = __builtin_bit_cast(bf16x8, pack8(a0, a1));
            acc[mt] = __builtin_amdgcn_mfma_f32_16x16x32_bf16(wf, af, acc[mt], 0, 0, 0); }
    }
    const f32x4 b4 = *(const f32x4*)(cx.I(9) + n0 + 4 * fq);
#pragma unroll
    for (int mt = 0; mt < 9; ++mt) { const int row = 16 * mt + fr; if (row < NBT) *(f32x4*)(cx.MOD() + (size_t)row * NMOD + n0 + 4 * fq) = acc[mt] + b4; }
}

__device__ __forceinline__ void s5_tables(const Ctx& cx, int g, LAS unsigned char* lds) {
    LAS f32x2* Ap = (LAS f32x2*)lds;
    LAS f32x2* Bb = Ap + 17 * 64;
    LAS f32x2* Cc = Bb + 1024;
    LAS f32x2* Ff = Cc + 1024;
    LAS float* Kt = (LAS float*)(Ff + 64);
    const int tid = threadIdx.x;
    float* tab = cx.TAB();
    if (tid < 64) {
        const int n = tid; const float lr = cx.I(19)[g * 64 + n], li = cx.I(20)[g * 64 + n], dt = expf(cx.I(21)[g]);
        const float mag = expf(lr * dt);
        const double ang = (double)li * (double)dt; const double kq = rint(ang * 0.63661977236758134308); const double r = ang - kq * 1.57079632679489661923; const double r2 = r * r;
        const double sn = r * (1.0 + r2 * (-1.0 / 6 + r2 * (1.0 / 120 + r2 * (-1.0 / 5040 + r2 * (1.0 / 362880 + r2 * (-1.0 / 39916800 + r2 * (1.0 / 6227020800.0)))))));
        const double cn = 1.0 + r2 * (-0.5 + r2 * (1.0 / 24 + r2 * (-1.0 / 720 + r2 * (1.0 / 40320 + r2 * (-1.0 / 3628800 + r2 * (1.0 / 479001600.0))))));
        const int q = ((int)kq) & 3; const double cv = q == 0 ? cn : q == 1 ? -sn : q == 2 ? -cn : sn, sv = q == 0 ? sn : q == 1 ? cn : q == 2 ? -sn : -cn;
        const float abr = mag * (float)cv, abi = mag * (float)sv; const float den = lr * lr + li * li;
        const float frr = ((abr - 1.f) * lr + abi * li) / den, fii = (abi * lr - (abr - 1.f) * li) / den;
        f32x2 p = (f32x2){1.f, 0.f}; Ap[n] = p;
#pragma unroll 1
        for (int t = 1; t <= 16; ++t) { const float pr = p.x * abr - p.y * abi, pi = p.x * abi + p.y * abr; p = (f32x2){pr, pi}; Ap[t * 64 + n] = p; }
        Ff[n] = (f32x2){frr, fii};
        ((f32x2*)(tab + T_ABAR))[g * 64 + n] = (f32x2){abr, abi}; ((f32x2*)(tab + T_A16))[g * 64 + n] = p;
    }
    __syncthreads();
    for (int e = tid; e < 1024; e += 512) { const int n = e >> 4; const float br = cx.I(22)[g * 1024 + e], bi = cx.I(23)[g * 1024 + e]; const f32x2 f = Ff[n];
        const float bbr = f.x * br - f.y * bi, bbi = f.x * bi + f.y * br; Bb[e] = (f32x2){bbr, bbi}; tab[T_BBR + g * 1024 + e] = bbr; tab[T_BBI + g * 1024 + e] = bbi;
        Cc[e] = (f32x2){cx.I(24)[g * 1024 + e], cx.I(25)[g * 1024 + e]}; }
    __syncthreads();
    for (int e = tid; e < 4096; e += 512) { const int tau = e >> 8, c = (e >> 4) & 15, cp = e & 15; float sum = 0.f;
        for (int n = 0; n < 64; ++n) { const f32x2 a = Ap[tau * 64 + n], b = Bb[n * 16 + cp], cc = Cc[c * 64 + n];
            const float pr = a.x * b.x - a.y * b.y, pi = a.x * b.y + a.y * b.x; sum += cc.x * pr - cc.y * pi; }
        Kt[e] = sum; }
    __syncthreads();
    bf16* TFg = cx.TF() + (size_t)g * 256 * 384;
    for (int pc = tid; pc < 256 * 48; pc += 512) { const int row = pc / 48, k8 = (pc % 48) * 8, j = row >> 4, c = row & 15; float v[8];
#pragma unroll
        for (int q = 0; q < 8; ++q) { const int kk = k8 + q;
            if (kk < 256) { const int s = kk >> 4, cp = kk & 15; v[q] = (j >= s) ? Kt[((j - s) << 8) + (c << 4) + cp] : 0.f; }
            else { const int n = (kk - 256) & 63; const f32x2 p = Ap[(j + 1) * 64 + n], cc = Cc[c * 64 + n]; v[q] = (kk < 320) ? (cc.x * p.x - cc.y * p.y) : (-cc.x * p.y - cc.y * p.x); } }
        u32x4 o; o.x = pk2(v[0], v[1]); o.y = pk2(v[2], v[3]); o.z = pk2(v[4], v[5]); o.w = pk2(v[6], v[7]);
        *(u32x4*)(TFg + (size_t)row * 384 + k8) = o; }
    bf16* Eg = cx.EM() + (size_t)g * 128 * 256;
    for (int pc = tid; pc < 128 * 32; pc += 512) { const int np = pc >> 5, k8 = (pc & 31) * 8, n = np & 63, im = np >> 6; float v[8];
#pragma unroll
        for (int q = 0; q < 8; ++q) { const int kk = k8 + q, s = kk >> 4, cp = kk & 15; const f32x2 a = Ap[(15 - s) * 64 + n], b = Bb[n * 16 + cp];
            v[q] = im ? (a.x * b.y + a.y * b.x) : (a.x * b.x - a.y * b.y); }
        u32x4 o; o.x = pk2(v[0], v[1]); o.y = pk2(v[2], v[3]); o.z = pk2(v[4], v[5]); o.w = pk2(v[6], v[7]);
        *(u32x4*)(Eg + (size_t)np * 256 + k8) = o; }
    __syncthreads();
}

__device__ __forceinline__ void norm_mod_row(const float* xrow, const float* g, const float* sc, const float* sh, bf16* orow, int lane) {
    f32x4 v[4]; float ss = 0.f;
#pragma unroll
    for (int j = 0; j < 4; ++j) { v[j] = ((const f32x4*)xrow)[lane + 64 * j]; ss += (v[j].x * v[j].x + v[j].y * v[j].y) + (v[j].z * v[j].z + v[j].w * v[j].w); }
    const float rstd = rsqrtf(wave_sum(ss) * (1.f / DM) + EPS);
#pragma unroll
    for (int j = 0; j < 4; ++j) { const int col = 4 * (lane + 64 * j); const f32x4 gg = *(const f32x4*)(g + col), s1 = *(const f32x4*)(sc + col), s2 = *(const f32x4*)(sh + col);
        const f32x4 o = v[j] * rstd * gg * (1.f + s1) + s2; u32x2 w; w.x = pk2(o.x, o.y); w.y = pk2(o.z, o.w); *(u32x2*)(orow + col) = w; }
}

__device__ __forceinline__ void lru_local_unit(const Ctx& cx, int row0, int ntok, bool samp, int aggidx, LAS unsigned char* lds) {
    const int d = threadIdx.x, w = __builtin_amdgcn_readfirstlane(d >> 6), lane = d & 63, fr = lane & 15, fq = lane >> 4;
    LAS float* cf = (LAS float*)(lds + w * 8192);
    LAS bf16* cbf = (LAS bf16*)(lds + w * 8192 + 4608);
    bf16x8 wf[8][2];
#pragma unroll
    for (int nt = 0; nt < 8; ++nt)
#pragma unroll
        for (int ks = 0; ks < 2; ++ks) { const float* src = (nt < 4 ? cx.I(14) : cx.I(16)) + (size_t)w * 4096 + (32 * ks + 8 * fq) * 64 + 16 * (nt & 3) + fr;
            u32x4 o; o.x = pk2(src[0], src[64]); o.y = pk2(src[128], src[192]); o.z = pk2(src[256], src[320]); o.w = pk2(src[384], src[448]); wf[nt][ks] = __builtin_bit_cast(bf16x8, o); }
    const float cw0 = cx.I(12)[d], cw1 = cx.I(12)[512 + d], cw2 = cx.I(12)[1024 + d], cw3 = cx.I(12)[1536 + d], cb = cx.I(13)[d];
    float gba[4], gbx[4], gcd[4], hc[4], cc[4];
#pragma unroll
    for (int nt = 0; nt < 4; ++nt) { const int ch = 64 * w + 16 * nt + fr; gba[nt] = cx.I(15)[ch]; gbx[nt] = cx.I(17)[ch]; gcd[nt] = -8.f * log1pf(expf(-cx.I(18)[ch])); hc[nt] = 0.f; cc[nt] = 1.f; }
    const float* X = cx.LRUX(); float* HL = cx.HLOC(); float* CU = cx.CUM();
    float xm3 = 0.f, xm2 = 0.f, xm1 = 0.f;
    if (!samp) { const int t0 = row0 & (SEQ - 1); if (t0 >= 3) { xm3 = X[(size_t)(row0 - 3) * DL + d]; xm2 = X[(size_t)(row0 - 2) * DL + d]; xm1 = X[(size_t)(row0 - 1) * DL + d]; } }
    for (int t0 = 0; t0 < ntok; t0 += 16) {
        if (samp) {
#pragma unroll 4
            for (int i = 0; i < 16; ++i) { const int row = row0 + t0 + i; const float* sc = cx.I(2) + (size_t)(row - MPR) * 1536 + d;
                const float cv = cb + cw0 * sc[0] + cw1 * sc[512] + cw2 * sc[1024] + cw3 * X[(size_t)row * DL + d];
                cf[i * 68 + lane] = cv; cbf[i * 72 + lane] = (bf16)(pk2(cv, cv) & 0xffffu); }
        } else {
#pragma unroll 4
            for (int i = 0; i < 16; ++i) { const float x = X[(size_t)(row0 + t0 + i) * DL + d]; const float cv = cb + cw0 * xm3 + cw1 * xm2 + cw2 * xm1 + cw3 * x; xm3 = xm2; xm2 = xm1; xm1 = x;
                cf[i * 68 + lane] = cv; cbf[i * 72 + lane] = (bf16)(pk2(cv, cv) & 0xffffu); }
        }
        LDS_WAIT();
        f32x4 acc[8];
#pragma unroll
        for (int nt = 0; nt < 8; ++nt) acc[nt] = (f32x4){0.f, 0.f, 0.f, 0.f};
#pragma unroll
        for (int ks = 0; ks < 2; ++ks) { const bf16x8 af = *(const LAS bf16x8*)(cbf + fr * 72 + 32 * ks + 8 * fq);
#pragma unroll
            for (int nt = 0; nt < 8; ++nt) acc[nt] = __builtin_amdgcn_mfma_f32_16x16x32_bf16(af, wf[nt][ks], acc[nt], 0, 0, 0); }
#pragma unroll
        for (int nt = 0; nt < 4; ++nt) { const int ch = 64 * w + 16 * nt + fr;
            float av[4], hv[4]; float P = 1.f, H = 0.f;
#pragma unroll
            for (int r = 0; r < 4; ++r) { const int tok = 4 * fq + r; const float cvv = cf[tok * 68 + 16 * nt + fr];
                const float rr = sigm(acc[nt][r] + gba[nt]), ig = sigm(acc[nt + 4][r] + gbx[nt]); const float la = gcd[nt] * rr; const float z = 2.f * la;
                const float em = z * (1.f + z * (0.5f + z * (1.f / 6 + z * (1.f / 24 + z * (1.f / 120 + z * (1.f / 720 + z * (1.f / 5040)))))));
                const float a = __expf(la); const float bb = sqrtf(-em) * ig * cvv;
                if (samp) { const float h0 = cx.I(3)[(size_t)(row0 + t0 + tok - MPR) * DL + ch]; hv[r] = a * h0 + bb; av[r] = 0.f; }
                else { H = a * H + bb; P = P * a; hv[r] = H; av[r] = P; } }
            if (!samp) {
                float Pp = __shfl_up(P, 16), Hp = __shfl_up(H, 16); if (fq >= 1) { H = P * Hp + H; P = P * Pp; }
                Pp = __shfl_up(P, 32); Hp = __shfl_up(H, 32); if (fq >= 2) { H = P * Hp + H; P = P * Pp; }
                float Pe = __shfl_up(P, 16), He = __shfl_up(H, 16); if (fq == 0) { Pe = 1.f; He = 0.f; }
                const float hstart = He + Pe * hc[nt], cstart = Pe * cc[nt];
#pragma unroll
                for (int r = 0; r < 4; ++r) { hv[r] = hv[r] + av[r] * hstart; av[r] = av[r] * cstart; }
                const float Pl = __shfl(P, 48 + fr), Hl = __shfl(H, 48 + fr); hc[nt] = Hl + Pl * hc[nt]; cc[nt] = Pl * cc[nt];
            }
#pragma unroll
            for (int r = 0; r < 4; ++r) { const size_t o = (size_t)(row0 + t0 + 4 * fq + r) * DL + ch; HL[o] = hv[r]; CU[o] = av[r]; }
        }
        LDS_WAIT();
    }
    if (!samp && fq == 0) {
#pragma unroll
        for (int nt = 0; nt < 4; ++nt) cx.AGG()[(size_t)aggidx * DL + 64 * w + 16 * nt + fr] = (f32x2){cc[nt], hc[nt]}; }
}

__device__ __forceinline__ void s5_gemm_e_item(const Ctx& cx, int item, int lane) {
    const int g = item >> 5, rb = item & 31, fr = lane & 15, fq = lane >> 4;
    const bf16* U = cx.S5U(); const bf16* Eg = cx.EM() + (size_t)g * 128 * 256;
    f32x4 acc[2][8];
#pragma unroll
    for (int a = 0; a < 2; ++a)
#pragma unroll
        for (int n = 0; n < 8; ++n) acc[a][n] = (f32x4){0.f, 0.f, 0.f, 0.f};
#pragma unroll 2
    for (int ks = 0; ks < 8; ++ks) {
        bf16x8 af[2];
#pragma unroll
        for (int mt = 0; mt < 2; ++mt) { const int cr = rb * 32 + 16 * mt + fr; af[mt] = *(const bf16x8*)(U + ((size_t)(16 * cr + 2 * ks + (fq >> 1)) * 512 + 16 * g + 8 * (fq & 1))); }
#pragma unroll
        for (int nt = 0; nt < 8; ++nt) { const bf16x8 wf = *(const bf16x8*)(Eg + (size_t)(16 * nt + fr) * 256 + 32 * ks + 8 * fq);
#pragma unroll
            for (int mt = 0; mt < 2; ++mt) acc[mt][nt] = __builtin_amdgcn_mfma_f32_16x16x32_bf16(wf, af[mt], acc[mt][nt], 0, 0, 0); }
    }
    float* S = cx.SK();
#pragma unroll
    for (int mt = 0; mt < 2; ++mt) { const int cr = rb * 32 + 16 * mt + fr;
#pragma unroll
        for (int nt = 0; nt < 8; ++nt) *(f32x4*)(S + ((size_t)cr * 32 + g) * 128 + 16 * nt + 4 * fq) = acc[mt][nt]; }
}

__device__ __forceinline__ void s5_chain_item(const Ctx& cx, int item) {
    const int idx = item * 512 + threadIdx.x, b = idx >> 11, g = (idx >> 6) & 31, n = idx & 63;
    const f32x2 A = ((const f32x2*)(cx.TAB() + T_A16))[g * 64 + n];
    const float* S = cx.SK() + ((size_t)(b * SNCH) * 32 + g) * 128 + n; bf16* H = cx.HIN() + ((size_t)g * SROWS + b * SNCH) * 128 + n;
    float hr = 0.f, hi = 0.f;
    for (int k0 = 0; k0 < SNCH; k0 += 8) { float sr[8], si[8];
#pragma unroll
        for (int i = 0; i < 8; ++i) { sr[i] = S[(size_t)(k0 + i) * 4096]; si[i] = S[(size_t)(k0 + i) * 4096 + 64]; }
#pragma unroll
        for (int i = 0; i < 8; ++i) { H[(size_t)(k0 + i) * 128] = (bf16)(pk2(hr, hr) & 0xffffu); H[(size_t)(k0 + i) * 128 + 64] = (bf16)(pk2(hi, hi) & 0xffffu);
            const float nr = A.x * hr - A.y * hi + sr[i], ni = A.x * hi + A.y * hr + si[i]; hr = nr; hi = ni; } }
    cx.out[O_S5RP + (size_t)(b * 32 + g) * 64 + n] = hr; cx.out[O_S5IP + (size_t)(b * 32 + g) * 64 + n] = hi;
}

__device__ __forceinline__ void lru_fix_unit(const Ctx& cx, int row0, int ntok, bool samp, int b, int k, LAS unsigned char* lds) {
    const int d = threadIdx.x, w = d >> 6, lane = d & 63;
    LAS float* hs = (LAS float*)lds;
    float hin = 0.f;
    if (!samp) { const f32x2* ag = cx.AGG() + (size_t)(b * NCH) * DL + d; for (int kk = 0; kk < k; ++kk) { const f32x2 p = ag[(size_t)kk * DL]; hin = p.x * hin + p.y; } }
    hs[d] = hin;
    const float* X = cx.LRUX();
    if (!samp && k == NCH - 1) {
#pragma unroll
        for (int j = 0; j < 3; ++j) cx.out[O_CONVP + (size_t)(b * 3 + j) * DL + d] = X[(size_t)(row0 + LCH - 3 + j) * DL + d]; }
    if (samp) { for (int t = 0; t < ntok; ++t) { const int sb = row0 + t - MPR; const float* sc = cx.I(2) + (size_t)sb * 1536 + d; float* o = cx.out + O_CONVS + (size_t)sb * 1536 + d;
            o[0] = sc[512]; o[512] = sc[1024]; o[1024] = X[(size_t)(row0 + t) * DL + d]; } }
    __syncthreads();
    const float* HL = cx.HLOC(); const float* CU = cx.CUM(); const bf16* GT = cx.GATE(); bf16* MG = cx.MERGED(); const float* gl = cx.I(28);
    const f32x4 hi0 = *(const LAS f32x4*)(hs + 8 * lane), hi1 = *(const LAS f32x4*)(hs + 8 * lane + 4);
    const f32x4 g0 = *(const f32x4*)(gl + 8 * lane), g1 = *(const f32x4*)(gl + 8 * lane + 4);
    for (int t = w; t < ntok; t += 8) { const size_t ro = (size_t)(row0 + t) * DL + 8 * lane;
        const f32x4 a0 = *(const f32x4*)(HL + ro), a1 = *(const f32x4*)(HL + ro + 4), c0 = *(const f32x4*)(CU + ro), c1 = *(const f32x4*)(CU + ro + 4);
        const u32x4 gw = *(const u32x4*)(GT + ro);
        const f32x4 h0 = a0 + c0 * hi0, h1 = a1 + c1 * hi1;
        f32x4 l0, l1;
        l0[0] = h0[0] * gelu_tanh(bflo(gw.x)); l0[1] = h0[1] * gelu_tanh(bfhi(gw.x)); l0[2] = h0[2] * gelu_tanh(bflo(gw.y)); l0[3] = h0[3] * gelu_tanh(bfhi(gw.y));
        l1[0] = h1[0] * gelu_tanh(bflo(gw.z)); l1[1] = h1[1] * gelu_tanh(bfhi(gw.z)); l1[2] = h1[2] * gelu_tanh(bflo(gw.w)); l1[3] = h1[3] * gelu_tanh(bfhi(gw.w));
        float ss = (l0[0] * l0[0] + l0[1] * l0[1]) + (l0[2] * l0[2] + l0[3] * l0[3]) + (l1[0] * l1[0] + l1[1] * l1[1]) + (l1[2] * l1[2] + l1[3] * l1[3]);
        const float rstd = rsqrtf(wave_sum(ss) * (1.f / DL) + EPS);
        *(u32x4*)(MG + (size_t)(row0 + t) * DM + 8 * lane) = pack8(l0 * rstd * g0, l1 * rstd * g1);
        if (samp) { float* o = cx.out + O_LRUS + (size_t)(row0 + t - MPR) * DL + 8 * lane; *(f32x4*)o = h0; *(f32x4*)(o + 4) = h1; }
        else if (k == NCH - 1 && t == LCH - 1) { float* o = cx.out + O_LRUP + (size_t)b * DL + 8 * lane; *(f32x4*)o = h0; *(f32x4*)(o + 4) = h1; }
    }
    __syncthreads();
}

__device__ __forceinline__ void s5_gemm_tf_item(const Ctx& cx, int item, int lane) {
    const int half = item & 1, g = item >> 6, rb = (item >> 1) & 31, fr = lane & 15, fq = lane >> 4;
    const bf16* U = cx.S5U(); const bf16* TFg = cx.TF() + ((size_t)g * 256 + 128 * half) * 384; const bf16* Hg = cx.HIN() + (size_t)g * SROWS * 128;
    f32x4 acc[2][8];
#pragma unroll
    for (int a = 0; a < 2; ++a)
#pragma unroll
        for (int n = 0; n < 8; ++n) acc[a][n] = (f32x4){0.f, 0.f, 0.f, 0.f};
#pragma unroll 2
    for (int ks = 0; ks < 12; ++ks) {
        bf16x8 af[2];
#pragma unroll
        for (int mt = 0; mt < 2; ++mt) { const int cr = rb * 32 + 16 * mt + fr;
            af[mt] = (ks < 8) ? *(const bf16x8*)(U + ((size_t)(16 * cr + 2 * ks + (fq >> 1)) * 512 + 16 * g + 8 * (fq & 1))) : *(const bf16x8*)(Hg + (size_t)cr * 128 + 32 * (ks - 8) + 8 * fq); }
#pragma unroll
        for (int nt = 0; nt < 8; ++nt) { const bf16x8 wf = *(const bf16x8*)(TFg + (size_t)(16 * nt + fr) * 384 + 32 * ks + 8 * fq);
#pragma unroll
            for (int mt = 0; mt < 2; ++mt) acc[mt][nt] = __builtin_amdgcn_mfma_f32_16x16x32_bf16(wf, af[mt], acc[mt][nt], 0, 0, 0); }
    }
    const f32x4 d4 = *(const f32x4*)(cx.I(26) + 16 * g + 4 * fq); bf16* GY = cx.GY();
#pragma unroll
    for (int mt = 0; mt < 2; ++mt) { const int cr = rb * 32 + 16 * mt + fr;
#pragma unroll
        for (int nt = 0; nt < 8; ++nt) { const size_t off = (size_t)(16 * cr + 8 * half + nt) * 512 + 16 * g + 4 * fq; const u32x2 uw = *(const u32x2*)(U + off);
            const f32x4 y = acc[mt][nt] + d4 * (f32x4){bflo(uw.x), bfhi(uw.x), bflo(uw.y), bfhi(uw.y)};
            u32x2 o; o.x = pk2(gelu_tanh(y[0]), gelu_tanh(y[1])); o.y = pk2(gelu_tanh(y[2]), gelu_tanh(y[3])); *(u32x2*)(GY + off) = o; } }
}
__device__ __forceinline__ void s5_sample_item(const Ctx& cx, int item, int lane) {
    const int sb = item >> 5, g = item & 31, n = lane; const int row = MPR + sb;
    const float* tab = cx.TAB(); const f32x2 A = ((const f32x2*)(tab + T_ABAR))[g * 64 + n];
    const float h0r = cx.I(4)[((size_t)sb * 32 + g) * 64 + n], h0i = cx.I(5)[((size_t)sb * 32 + g) * 64 + n];
    const bf16* up = cx.S5U() + (size_t)row * 512 + 16 * g; const u32x4 u0 = *(const u32x4*)up, u1 = *(const u32x4*)(up + 8);
    float uu[16]; uu[0] = bflo(u0.x); uu[1] = bfhi(u0.x); uu[2] = bflo(u0.y); uu[3] = bfhi(u0.y); uu[4] = bflo(u0.z); uu[5] = bfhi(u0.z); uu[6] = bflo(u0.w); uu[7] = bfhi(u0.w);
    uu[8] = bflo(u1.x); uu[9] = bfhi(u1.x); uu[10] = bflo(u1.y); uu[11] = bfhi(u1.y); uu[12] = bflo(u1.z); uu[13] = bfhi(u1.z); uu[14] = bflo(u1.w); uu[15] = bfhi(u1.w);
    float bur = 0.f, bui = 0.f; const float* br = tab + T_BBR + (size_t)(g * 64 + n) * 16; const float* bi = tab + T_BBI + (size_t)(g * 64 + n) * 16;
#pragma unroll
    for (int c4 = 0; c4 < 4; ++c4) { const f32x4 r4 = *(const f32x4*)(br + 4 * c4), i4 = *(const f32x4*)(bi + 4 * c4);
#pragma unroll
        for (int i = 0; i < 4; ++i) { bur += r4[i] * uu[4 * c4 + i]; bui += i4[i] * uu[4 * c4 + i]; } }
    const float hr = A.x * h0r - A.y * h0i + bur, hi = A.x * h0i + A.y * h0r + bui;
    cx.out[O_S5RS + ((size_t)sb * 32 + g) * 64 + n] = hr; cx.out[O_S5IS + ((size_t)sb * 32 + g) * 64 + n] = hi;
    float my = 0.f, myu = 0.f;
#pragma unroll
    for (int c = 0; c < 16; ++c) { const float v = wave_sum(cx.I(24)[((size_t)g * 16 + c) * 64 + n] * hr - cx.I(25)[((size_t)g * 16 + c) * 64 + n] * hi); if (lane == c) { my = v; myu = uu[c]; } }
    if (lane < 16) { const float y = my + cx.I(26)[16 * g + lane] * myu; cx.GY()[(size_t)row * 512 + 16 * g + lane] = (bf16)(pk2(gelu_tanh(y), 0.f) & 0xffffu); }
}

__global__ void __launch_bounds__(512, 2) fwd_kernel(KArgs a) {
    extern __shared__ __attribute__((aligned(16))) unsigned char lds_raw[];
    LAS unsigned char* lds = (LAS unsigned char*)lds_raw;
    cg::grid_group grid = cg::this_grid();
    Ctx cx; cx.in = a.in; cx.out = a.out; cx.ws = a.ws;
    const int tid = threadIdx.x, lane = tid & 63, wave = __builtin_amdgcn_readfirstlane(tid >> 6);
    const int G = gridDim.x, bid = blockIdx.x, gw = bid * 8 + wave, NGW = G * 8;
#ifndef PHMASK
#define PHMASK 0x1fff
#endif
#define IN(k) (((PHMASK >> (k)) & 1) && a.lo <= (k) && (k) < a.hi)
#define SEAM(k) do { if (IN(k) && IN((k) + 1)) grid.sync(); } while (0)

    if (IN(0)) {
        for (int g = bid; g < 32; g += G) s5_tables(cx, g, lds);
        { const int sh = (gw + NGW - 32 * 8) % NGW; for (int it = sh; it < 384; it += NGW) ada_item(cx, it, lane); }
        LAS float* scr = (LAS float*)(lds + wave * 16384);
        for (int it = gw; it < N_TR_ITEMS; it += NGW) transpose_dispatch(cx, it, scr, lane);
    }
    SEAM(0);
    if (IN(1)) {
        for (int r = gw; r < MTOK; r += NGW) { const float* xr = r < MPR ? cx.I(0) + (size_t)r * DM : cx.I(1) + (size_t)(r - MPR) * DM; const float* md = cx.MOD() + (size_t)mod_row(r) * NMOD;
            norm_mod_row(xr, cx.I(10), md + 1024, md, cx.XN() + (size_t)r * DM, lane); }
    }
    SEAM(1);
    if (IN(2)) {
        pg8::Gemm g{cx.XN(), cx.WIN(), MPAD, NPROJ, DM}; pg8::StaticOrder S; S.init(MPAD, NPROJ, G, bid);
        EpiProj E{cx.LRUX(), cx.GATE(), cx.S5U()};
        pg8::gemm_phase<EpiProj, pg8::StaticOrder, true, true>(lds, g, S, E);
    }
    SEAM(2);
    if (IN(3)) {
#ifndef NO_LRU
        for (int u = bid; u < 256 + NBS / SCH; u += G) {
            if (u < 256) lru_local_unit(cx, u * LCH, LCH, false, u, lds); else lru_local_unit(cx, MPR + (u - 256) * SCH, SCH, true, 0, lds);
        }
#endif
#ifndef NO_E
        for (int it = gw; it < 1024; it += NGW) s5_gemm_e_item(cx, it, lane);
#endif
    }
    SEAM(3);
    if (IN(4)) {
        { const int ci = bid - (G - 32); if (ci >= 0) s5_chain_item(cx, ci); else if (G < 32) { for (int c2 = bid; c2 < 32; c2 += G) s5_chain_item(cx, c2); } }
        for (int u = bid; u < 256 + NBS / SCH; u += G) {
            if (u < 256) lru_fix_unit(cx, u * LCH, LCH, false, u >> 5, u & 31, lds); else lru_fix_unit(cx, MPR + (u - 256) * SCH, SCH, true, 0, 0, lds);
        }
    }
    SEAM(4);
    if (IN(5)) {
        for (int it = gw; it < 2048; it += NGW) s5_gemm_tf_item(cx, it, lane);
        for (int it = gw; it < NBS * 32; it += NGW) s5_sample_item(cx, it, lane);
    }
    SEAM(5);
    if (IN(6)) {
        pg8::Gemm g{cx.GY(), cx.WGLU(), MPAD, 1024, 512}; pg8::StaticOrder S; S.init(MPAD, 1024, G, bid);
        EpiGlu E{cx.S5OUT()};
        pg8::gemm_phase<EpiGlu, pg8::StaticOrder, true, true>(lds, g, S, E);
    }
    SEAM(6);
    if (IN(7)) {
        const float* gs = cx.I(29);
        for (int r = gw; r < MTOK; r += NGW) { const float* sr = cx.S5OUT() + (size_t)r * 512;
            const f32x4 v0 = ((const f32x4*)sr)[lane], v1 = ((const f32x4*)sr)[lane + 64];
            const float ss = (v0.x * v0.x + v0.y * v0.y) + (v0.z * v0.z + v0.w * v0.w) + (v1.x * v1.x + v1.y * v1.y) + (v1.z * v1.z + v1.w * v1.w);
            const float rstd = rsqrtf(wave_sum(ss) * (1.f / 512) + EPS);
            const f32x4 o0 = v0 * rstd * ((const f32x4*)gs)[lane], o1 = v1 * rstd * ((const f32x4*)gs)[lane + 64];
            bf16* mp = cx.MERGED() + (size_t)r * DM + 512; u32x2 w0, w1; w0.x = pk2(o0.x, o0.y); w0.y = pk2(o0.z, o0.w); w1.x = pk2(o1.x, o1.y); w1.y = pk2(o1.z, o1.w);
            *(u32x2*)(mp + 4 * lane) = w0; *(u32x2*)(mp + 256 + 4 * lane) = w1; }
    }
    SEAM(7);
    if (IN(8)) {
        pg8::Gemm g{cx.MERGED(), cx.WOUT(), MPAD, DM, DM}; pg8::StaticOrder S; S.init(MPAD, DM, G, bid);
        EpiRes<2048> E{cx.I(0), cx.I(1), cx.MOD(), cx.out};
        pg8::gemm_phase<EpiRes<2048>, pg8::StaticOrder, true, true>(lds, g, S, E);
    }
    SEAM(8);
    if (IN(9)) {
        for (int r = gw; r < MTOK; r += NGW) { const float* md = cx.MOD() + (size_t)mod_row(r) * NMOD;
            norm_mod_row(cx.out + (size_t)r * DM, cx.I(31), md + 4096, md + 3072, cx.XN2() + (size_t)r * DM, lane); }
    }
    SEAM(9);
    if (IN(10)) {
        pg8::Gemm g{cx.XN2(), cx.WGU(), MPAD, 2 * DFF, DM}; pg8::StaticOrder S; S.init(MPAD, 2 * DFF, G, bid);
        EpiSwiglu E{cx.HB()};
        pg8::gemm_phase<EpiSwiglu, pg8::StaticOrder, true, true>(lds, g, S, E);
    }
    SEAM(10);
    if (IN(11)) {
        pg8::Gemm g{cx.HB(), cx.WDN(), MPAD, DM, DFF}; pg8::StaticOrder S; S.init(MPAD, DM, G, bid);
        EpiRes<5120> E{nullptr, nullptr, cx.MOD(), cx.out};
        pg8::gemm_phase<EpiRes<5120>, pg8::StaticOrder, true, true>(lds, g, S, E);
    }
    SEAM(11);
    if (IN(12)) {
        const float* fg = cx.I(35);
        for (int r = gw; r < MTOK; r += NGW) { float* xr = cx.out + (size_t)r * DM; f32x4 v[4]; float ss = 0.f;
#pragma unroll
            for (int j = 0; j < 4; ++j) { v[j] = ((const f32x4*)xr)[lane + 64 * j]; ss += (v[j].x * v[j].x + v[j].y * v[j].y) + (v[j].z * v[j].z + v[j].w * v[j].w); }
            const float rstd = rsqrtf(wave_sum(ss) * (1.f / DM) + EPS);
#pragma unroll
            for (int j = 0; j < 4; ++j) ((f32x4*)xr)[lane + 64 * j] = v[j] * rstd * ((const f32x4*)fg)[lane + 64 * j]; }
    }
#undef IN
#undef SEAM
}

constexpr int LDS_BYTES = 131072;
#ifndef MK_SINGLE
#define MK_SINGLE 1
#endif
extern "C" void kernel_launch(void* const* d_in, const int* in_sizes, int n_in, void* d_out, int out_size, void* d_ws, size_t ws_size, hipStream_t stream) {
    static int grid = 0;
    if (grid == 0) {
        if (n_in != 36 || (size_t)out_size != O_END || ws_size < WS_END) { fprintf(stderr, "kernel_launch: unexpected shapes n_in %d out %d ws %zu\n", n_in, out_size, ws_size); grid = -1; return; }
        int dev = 0, cus = 0, per_cu = 0;
        hipGetDevice(&dev); hipDeviceGetAttribute(&cus, hipDeviceAttributeMultiprocessorCount, dev);
        hipFuncSetAttribute((const void*)fwd_kernel, hipFuncAttributeMaxDynamicSharedMemorySize, LDS_BYTES);
        hipOccupancyMaxActiveBlocksPerMultiprocessor(&per_cu, (const void*)fwd_kernel, 512, LDS_BYTES);
        if (per_cu < 1) { fprintf(stderr, "kernel_launch: occupancy query says %d blocks per CU\n", per_cu); grid = -1; return; }
        grid = cus;
    }
    if (grid < 0) return;
    KArgs a{};
    for (int i = 0; i < 36; ++i) a.in[i] = (const float*)d_in[i];
    a.out = (float*)d_out; a.ws = (unsigned char*)d_ws;
#if MK_SINGLE
    a.lo = 0; a.hi = NPHASE;
    void* args[] = {&a};
    hipError_t e = hipLaunchCooperativeKernel((const void*)fwd_kernel, dim3(grid), dim3(512), args, LDS_BYTES, stream);
    if (e != hipSuccess) fprintf(stderr, "cooperative launch failed: %s (grid %d)\n", hipGetErrorString(e), grid);
#else
    for (int p = 0; p < NPHASE; ++p) { a.lo = p; a.hi = p + 1; hipLaunchKernelGGL(fwd_kernel, dim3(grid), dim3(512), LDS_BYTES, stream, a); }
#endif
}
```

```cpp
#include <hip/hip_runtime.h>
#include <hip/hip_cooperative_groups.h>
#include <cstdio>
#include <cstdint>
namespace cg = cooperative_groups;
namespace pg8 {
#define PG8_LAS __attribute__((address_space(3)))
typedef unsigned short bf16_t;
typedef short bf16x8 __attribute__((ext_vector_type(8)));
typedef float f32x4 __attribute__((ext_vector_type(4)));
typedef unsigned u32x4 __attribute__((ext_vector_type(4)));
constexpr int BM = 256, BK = 64, HALF = 128, HTB = HALF * BK * 2  , STAGE_BYTES = 8 * HTB, NXCD = 8, WGM = 8;

__host__ __device__ __forceinline__ int lds_byte(int r, int c) { const int st = (r >> 4) * 2 + (c >> 5), rr = r & 15, cc = c & 31, ob = rr * 64 + cc * 2; return st * 1024 + (ob ^ (((ob >> 9) & 1) << 5)); }
__host__ __device__ __forceinline__ void stage_rc(int b, int& R, int& C) { const int st = b / 1024, sb = b % 1024, swz = sb ^ (((sb >> 9) & 1) << 5); R = (st >> 1) * 16 + swz / 64; C = (st & 1) * 32 + (swz % 64) / 2; }
__host__ __device__ __forceinline__ int perm32(int rho) { const int n = rho >> 4, i = rho & 15; return 8 * (i >> 2) + 4 * n + (i & 3); }

struct Unit { int pm, pn; };
struct Gemm { const bf16_t* A; const bf16_t* Bt; int M, N, K; };

struct StaticOrder {
    int nM, nN, nwg, G, c;
    __host__ __device__ void init(int M, int N, int G_, int c_) { nM = M / BM; nN = N / BM; nwg = nM * nN; G = G_; c = c_; }
    __host__ __device__ bool next(int i, Unit& u) const {
        const long L = (long)i * G + c; if (L >= nwg) return false;
        int wgid = (int)L; { const int q = nwg / NXCD, r = nwg % NXCD, xcd = wgid % NXCD, off = wgid / NXCD; wgid = (xcd < r ? xcd * (q + 1) : r * (q + 1) + (xcd - r) * q) + off; }
        const int nig = WGM * nN, gid = wgid / nig, fm = gid * WGM, gsz = (nM - fm) < WGM ? (nM - fm) : WGM;
        u.pm = fm + ((wgid % nig) % gsz); u.pn = (wgid % nig) / gsz; return true;
    }
    __device__ __forceinline__ void a_ready(const Unit&) const {}
    __device__ __forceinline__ void done(const Unit&) const {}
};

__device__ __forceinline__ unsigned cvt_pk_bf16(float lo, float hi) { unsigned r; asm volatile("v_cvt_pk_bf16_f32 %0, %1, %2" : "=v"(r) : "v"(lo), "v"(hi)); return r; }
typedef float f32x2 __attribute__((ext_vector_type(2)));
template <class Epi, class Sched, bool ALIGN_EPI = false, bool SP2 = false>
__device__ __forceinline__ void gemm_phase(PG8_LAS unsigned char* lds, const Gemm g, const Sched& S, const Epi& E) {
    const int tid = threadIdx.x, wid = __builtin_amdgcn_readfirstlane(tid >> 6), lane = tid & 63, wr = wid >> 2, wc = wid & 3, fr = lane & 15, fq = lane >> 4;
    const int K = g.K, nt = K / BK;
    unsigned voffA[2], voffB[2];
#pragma unroll
    for (int i = 0; i < 2; ++i) { int R, C; stage_rc(tid * 16 + i * 8192, R, C); const int Rb = Epi::PERM ? ((R & ~31) + perm32(R & 31)) : R;
        voffA[i] = (unsigned)(R * K + C) * 2u; voffB[i] = (unsigned)(Rb * K + C) * 2u; }
    const size_t kstep = (size_t)(BK * 2);
    const size_t hstep = (size_t)HALF * K * 2;
    const size_t tstep = 2 * hstep;
    const unsigned ldsw = (unsigned)wid * 1024u;
    const int aoff = lds_byte(wr * 64 + fr, fq * 8), boff = lds_byte(wc * 32 + fr, fq * 8);
#define PG8_SA(b, h) (((b) * 2 + (h)) * HTB)
#define PG8_SB(b, h) ((4 + (b) * 2 + (h)) * HTB)
#define PG8_STAGE(bufoff, gbase, voff) do { _Pragma("unroll") for (int _i = 0; _i < 2; ++_i) \
        __builtin_amdgcn_global_load_lds((const unsigned*)((const char*)(gbase) + (voff)[_i]), (PG8_LAS unsigned*)(lds + (bufoff) + ldsw + _i * 8192), 16, 0, 0); } while (0)
#define PG8_LDA(dst, b, h) do { _Pragma("unroll") for (int m = 0; m < 4; ++m) _Pragma("unroll") for (int k = 0; k < 2; ++k) dst[m][k] = *(const PG8_LAS bf16x8*)(lds + PG8_SA(b, h) + aoff + m * 2048 + k * 1024); } while (0)
#define PG8_LDB(dst, b, h) do { _Pragma("unroll") for (int n = 0; n < 2; ++n) _Pragma("unroll") for (int k = 0; k < 2; ++k) dst[n][k] = *(const PG8_LAS bf16x8*)(lds + PG8_SB(b, h) + boff + n * 2048 + k * 1024); } while (0)
#define PG8_MMA(ai, bj, At, Bt) do { __builtin_amdgcn_s_setprio(1); _Pragma("unroll") for (int m = 0; m < 4; ++m) _Pragma("unroll") for (int n = 0; n < 2; ++n) _Pragma("unroll") for (int k = 0; k < 2; ++k) \
        acc[ai][bj][m][n] = __builtin_amdgcn_mfma_f32_16x16x32_bf16(Bt[n][k], At[m][k], acc[ai][bj][m][n], 0, 0, 0); __builtin_amdgcn_s_setprio(0); } while (0)
#define PG8_WAIT_V(n) asm volatile("s_waitcnt vmcnt(" #n ")" ::: "memory")
#define PG8_WAIT_L(n) asm volatile("s_waitcnt lgkmcnt(" #n ")" ::: "memory")
#define PG8_BAR __builtin_amdgcn_s_barrier()
#define PG8_SCHED __builtin_amdgcn_sched_barrier(0)
    Unit cur, nxt; int ui = 0;
    if (!S.next(0, cur)) return;
    f32x4 acc[2][2][4][2];
#pragma unroll
    for (int a = 0; a < 2; ++a)
#pragma unroll
        for (int b = 0; b < 2; ++b)
#pragma unroll
            for (int m = 0; m < 4; ++m)
#pragma unroll
                for (int n = 0; n < 2; ++n) acc[a][b][m][n] = (f32x4){0.f, 0.f, 0.f, 0.f};
    bf16x8 At[4][2], B0[2][2], B1[2][2];
    const char* cA = (const char*)g.A + (size_t)cur.pm * tstep; const char* cB = (const char*)g.Bt + (size_t)cur.pn * tstep;
    S.a_ready(cur);
    if constexpr (SP2) {
        PG8_STAGE(PG8_SB(0, 0), cB, voffB); PG8_STAGE(PG8_SB(0, 1), cB + hstep, voffB); PG8_STAGE(PG8_SA(0, 0), cA, voffA); PG8_STAGE(PG8_SA(0, 1), cA + hstep, voffA);
        if (wr == 1) PG8_BAR;
        PG8_WAIT_V(2); PG8_BAR;
        PG8_STAGE(PG8_SB(1, 0), cB + kstep, voffB); PG8_STAGE(PG8_SA(1, 0), cA + kstep, voffA); PG8_STAGE(PG8_SB(1, 1), cB + hstep + kstep, voffB);
        PG8_WAIT_V(6); PG8_BAR;
    } else {
        PG8_STAGE(PG8_SB(0, 0), cB, voffB); PG8_STAGE(PG8_SA(0, 0), cA, voffA); PG8_STAGE(PG8_SB(0, 1), cB + hstep, voffB); PG8_STAGE(PG8_SA(0, 1), cA + hstep, voffA);
        if (wr == 1) PG8_BAR;
        PG8_WAIT_V(4); PG8_BAR;
        PG8_STAGE(PG8_SB(1, 0), cB + kstep, voffB); PG8_STAGE(PG8_SA(1, 0), cA + kstep, voffA); PG8_STAGE(PG8_SB(1, 1), cB + hstep + kstep, voffB);
        PG8_WAIT_V(6); PG8_BAR;
    }
    for (;;) {
        const bool has_next = S.next(ui + 1, nxt);
        const char* nA = has_next ? (const char*)g.A + (size_t)nxt.pm * tstep : cA; const char* nB = has_next ? (const char*)g.Bt + (size_t)nxt.pn * tstep : cB;
        for (int t = 0; t < nt; t += 2) {
            const bool last = (t == nt - 2);
            const char* a1 = cA + (size_t)(t + 1) * kstep;
            const char* a2 = last ? nA : cA + (size_t)(t + 2) * kstep; const char* b2 = last ? nB : cB + (size_t)(t + 2) * kstep;
            const char* a3 = a2 + kstep; const char* b3 = b2 + kstep;
            if (last && has_next) S.a_ready(nxt);
            if constexpr (SP2) {
            PG8_LDB(B0, 0, 0); PG8_LDB(B1, 0, 1); PG8_SCHED; PG8_LDA(At, 0, 0); PG8_STAGE(PG8_SA(1, 1), a1 + hstep, voffA);
            PG8_WAIT_V(8); PG8_WAIT_L(0); PG8_BAR; PG8_MMA(0, 0, At, B0); PG8_MMA(0, 1, At, B1); PG8_BAR; PG8_SCHED;
            PG8_LDA(At, 0, 1); PG8_STAGE(PG8_SB(0, 0), b2, voffB); PG8_STAGE(PG8_SB(0, 1), b2 + hstep, voffB); PG8_STAGE(PG8_SA(0, 0), a2, voffA);
            PG8_WAIT_V(8); PG8_WAIT_L(0); PG8_BAR; PG8_MMA(1, 0, At, B0); PG8_MMA(1, 1, At, B1); PG8_BAR; PG8_SCHED;
            PG8_LDB(B0, 1, 0); PG8_LDB(B1, 1, 1); PG8_SCHED; PG8_LDA(At, 1, 0); PG8_STAGE(PG8_SA(0, 1), a2 + hstep, voffA);
            PG8_WAIT_V(8); PG8_WAIT_L(0); PG8_BAR; PG8_MMA(0, 0, At, B0); PG8_MMA(0, 1, At, B1); PG8_BAR; PG8_SCHED;
            PG8_LDA(At, 1, 1); PG8_STAGE(PG8_SB(1, 0), b3, voffB); PG8_STAGE(PG8_SB(1, 1), b3 + hstep, voffB); PG8_STAGE(PG8_SA(1, 0), a3, voffA);
            PG8_WAIT_V(8); PG8_WAIT_L(0); PG8_BAR; PG8_MMA(1, 0, At, B0); PG8_MMA(1, 1, At, B1); PG8_BAR; PG8_SCHED;
            } else {
            PG8_LDB(B0, 0, 0); PG8_SCHED; PG8_LDA(At, 0, 0); PG8_STAGE(PG8_SA(1, 1), a1 + hstep, voffA);
            PG8_WAIT_L(8); PG8_BAR; PG8_WAIT_L(0); PG8_MMA(0, 0, At, B0); PG8_BAR; PG8_SCHED;
            PG8_LDB(B1, 0, 1); PG8_STAGE(PG8_SB(0, 0), b2, voffB);
            PG8_BAR; PG8_WAIT_L(0); PG8_MMA(0, 1, At, B1); PG8_BAR;
            PG8_LDA(At, 0, 1); PG8_STAGE(PG8_SA(0, 0), a2, voffA);
            PG8_BAR; PG8_WAIT_L(0); PG8_MMA(1, 0, At, B0); PG8_BAR; PG8_SCHED;
            PG8_STAGE(PG8_SB(0, 1), b2 + hstep, voffB);
            PG8_WAIT_V(6); PG8_BAR; PG8_MMA(1, 1, At, B1); PG8_BAR;
            PG8_LDB(B0, 1, 0); PG8_SCHED; PG8_LDA(At, 1, 0); PG8_STAGE(PG8_SA(0, 1), a2 + hstep, voffA);
            PG8_WAIT_L(8); PG8_BAR; PG8_WAIT_L(0); PG8_MMA(0, 0, At, B0); PG8_BAR; PG8_SCHED;
            PG8_LDB(B1, 1, 1); PG8_STAGE(PG8_SB(1, 0), b3, voffB);
            PG8_BAR; PG8_WAIT_L(0); PG8_MMA(0, 1, At, B1); PG8_BAR;
            PG8_LDA(At, 1, 1); PG8_STAGE(PG8_SA(1, 0), a3, voffA);
            PG8_BAR; PG8_WAIT_L(0); PG8_MMA(1, 0, At, B0); PG8_BAR; PG8_SCHED;
            PG8_STAGE(PG8_SB(1, 1), b3 + hstep, voffB);
            PG8_WAIT_V(6); PG8_BAR; PG8_MMA(1, 1, At, B1); PG8_BAR;
            }
        }
        if constexpr (ALIGN_EPI) { if (wr == 0) PG8_BAR; }
        if constexpr (!Epi::AFTER_DRAIN) { E(acc, cur, wr, wc, fr, fq); S.done(cur); }
        if (!has_next) break;
#pragma unroll
        for (int a = 0; a < 2; ++a)
#pragma unroll
            for (int b = 0; b < 2; ++b)
#pragma unroll
                for (int m = 0; m < 4; ++m)
#pragma unroll
                    for (int n = 0; n < 2; ++n) acc[a][b][m][n] = (f32x4){0.f, 0.f, 0.f, 0.f};
        cur = nxt; cA = nA; cB = nB; ++ui;
        if constexpr (ALIGN_EPI) { if (wr == 1) PG8_BAR; }
    }
    PG8_WAIT_V(0);
    if constexpr (!ALIGN_EPI) { if (wr == 0) PG8_BAR; }
    PG8_BAR;
    if constexpr (Epi::AFTER_DRAIN) { E.fused(acc, cur, wr, wc, fr, fq, lds, wid, lane); S.done(cur); }
#undef PG8_SA
#undef PG8_SB
#undef PG8_STAGE
#undef PG8_LDA
#undef PG8_LDB
#undef PG8_MMA
#undef PG8_WAIT_V
#undef PG8_WAIT_L
#undef PG8_BAR
#undef PG8_SCHED
}
}

#define LAS __attribute__((address_space(3)))
typedef unsigned short bf16;
typedef float f32x4 __attribute__((ext_vector_type(4)));
typedef float f32x2 __attribute__((ext_vector_type(2)));
typedef short bf16x8 __attribute__((ext_vector_type(8)));
typedef unsigned u32x4 __attribute__((ext_vector_type(4)));
typedef unsigned u32x2 __attribute__((ext_vector_type(2)));

constexpr int DM = 1024, NBP = 8, SEQ = 2048, MPR = NBP * SEQ, NBS = 128, MTOK = MPR + NBS, MPAD = 16640;
constexpr int DL = 512, NPROJ = 1536, NMOD = 6144, NBT = NBP + NBS, DFF = 2816;
constexpr int LCH = 64, NCH = SEQ / LCH;
constexpr int SCH = 16;
constexpr int SL = 16, SNCH = SEQ / SL, SROWS = NBP * SNCH;
constexpr float EPS = 1e-6f;
constexpr int NPHASE = 13;

constexpr size_t O_Y = 0, O_CONVP = (size_t)MTOK * DM, O_LRUP = O_CONVP + 8 * 3 * 512, O_S5RP = O_LRUP + 8 * 512, O_S5IP = O_S5RP + 8 * 32 * 64,
                 O_CONVS = O_S5IP + 8 * 32 * 64, O_LRUS = O_CONVS + 128 * 3 * 512, O_S5RS = O_LRUS + 128 * 512, O_S5IS = O_S5RS + 128 * 32 * 64, O_END = O_S5IS + 128 * 32 * 64;

constexpr size_t HM = 1u << 19;
constexpr size_t WS_WIN = 2 * HM, WS_WGLU = 8 * HM, WS_WOUT = 10 * HM, WS_WGU = 14 * HM, WS_WDN = 36 * HM  , WS_MOD = 48 * HM  ,
                 WS_TF = 56 * HM  , WS_E = 68 * HM  , WS_TAB = 72 * HM, WS_AGG = 74 * HM  ,
                 WS_XN = 80 * HM  , WS_LRUX = 146 * HM  , WS_GATE = 211 * HM  ,
                 WS_S5U = 244 * HM  , WS_HLOC = 277 * HM  , WS_CUM = 342 * HM, WS_GY = 407 * HM  ,
                 WS_SK = 440 * HM  , WS_HIN = 472 * HM  , WS_HB = 244 * HM  , WS_END = 512 * HM;
constexpr size_t T_ABAR = 0, T_A16 = 4096, T_BBR = 8192, T_BBI = 8192 + 32768;

struct KArgs { const float* in[36]; float* out; unsigned char* ws; int lo, hi; };

struct Ctx {
    const float* const* in; float* out; unsigned char* ws;
    __device__ __forceinline__ const float* I(int i) const { return in[i]; }
    __device__ __forceinline__ bf16* WIN() const { return (bf16*)(ws + WS_WIN); }
    __device__ __forceinline__ bf16* WGLU() const { return (bf16*)(ws + WS_WGLU); }
    __device__ __forceinline__ bf16* WOUT() const { return (bf16*)(ws + WS_WOUT); }
    __device__ __forceinline__ bf16* WGU() const { return (bf16*)(ws + WS_WGU); }
    __device__ __forceinline__ bf16* WDN() const { return (bf16*)(ws + WS_WDN); }
    __device__ __forceinline__ float* MOD() const { return (float*)(ws + WS_MOD); }
    __device__ __forceinline__ bf16* TF() const { return (bf16*)(ws + WS_TF); }
    __device__ __forceinline__ bf16* EM() const { return (bf16*)(ws + WS_E); }
    __device__ __forceinline__ float* TAB() const { return (float*)(ws + WS_TAB); }
    __device__ __forceinline__ f32x2* AGG() const { return (f32x2*)(ws + WS_AGG); }
    __device__ __forceinline__ bf16* XN() const { return (bf16*)(ws + WS_XN); }
    __device__ __forceinline__ bf16* MERGED() const { return (bf16*)(ws + WS_XN); }
    __device__ __forceinline__ float* LRUX() const { return (float*)(ws + WS_LRUX); }
    __device__ __forceinline__ bf16* XN2() const { return (bf16*)(ws + WS_LRUX); }
    __device__ __forceinline__ bf16* GATE() const { return (bf16*)(ws + WS_GATE); }
    __device__ __forceinline__ bf16* S5U() const { return (bf16*)(ws + WS_S5U); }
    __device__ __forceinline__ float* HLOC() const { return (float*)(ws + WS_HLOC); }
    __device__ __forceinline__ float* S5OUT() const { return (float*)(ws + WS_HLOC); }
    __device__ __forceinline__ float* CUM() const { return (float*)(ws + WS_CUM); }
    __device__ __forceinline__ bf16* GY() const { return (bf16*)(ws + WS_GY); }
    __device__ __forceinline__ float* SK() const { return (float*)(ws + WS_SK); }
    __device__ __forceinline__ bf16* HIN() const { return (bf16*)(ws + WS_HIN); }
    __device__ __forceinline__ bf16* HB() const { return (bf16*)(ws + WS_HB); }
};

#define LDS_WAIT() asm volatile("s_waitcnt lgkmcnt(0)" ::: "memory")
__device__ __forceinline__ unsigned pk2(float lo, float hi) { return pg8::cvt_pk_bf16(lo, hi); }
__device__ __forceinline__ float bf2f(unsigned b) { return __uint_as_float(b << 16); }
__device__ __forceinline__ float bflo(unsigned w) { return __uint_as_float(w << 16); }
__device__ __forceinline__ float bfhi(unsigned w) { return __uint_as_float(w & 0xffff0000u); }
__device__ __forceinline__ float wave_sum(float v) {
#pragma unroll
    for (int o = 1; o < 64; o <<= 1) v += __shfl_xor(v, o);
    return v;
}
__device__ __forceinline__ float sigm(float v) { return 1.f / (1.f + __expf(-v)); }
__device__ __forceinline__ float gelu_tanh(float x) { const float u = 1.5957691216f * (x + 0.044715f * x * x * x); return x / (1.f + __expf(-u)); }
__device__ __forceinline__ int mod_row(int row) { return row < MPR ? (row >> 11) : (NBP + row - MPR); }
__device__ __forceinline__ u32x4 pack8(f32x4 a, f32x4 b) { u32x4 w; w.x = pk2(a[0], a[1]); w.y = pk2(a[2], a[3]); w.z = pk2(b[0], b[1]); w.w = pk2(b[2], b[3]); return w; }

struct EpiProj {
    static constexpr bool PERM = true, AFTER_DRAIN = false; float* lrux; bf16* gate; bf16* s5u;
    __device__ __forceinline__ void operator()(const f32x4 (&acc)[2][2][4][2], const pg8::Unit& u, int wr, int wc, int fr, int fq) const {
        const int colt = u.pn * 256 + wc * 32 + 8 * fq;
#pragma unroll
        for (int ai = 0; ai < 2; ++ai)
#pragma unroll
            for (int m = 0; m < 4; ++m) { const int row = u.pm * 256 + ai * 128 + wr * 64 + m * 16 + fr; if (row >= MTOK) continue;
#pragma unroll
                for (int bj = 0; bj < 2; ++bj) { const int col = colt + bj * 128; const f32x4 v0 = acc[ai][bj][m][0], v1 = acc[ai][bj][m][1];
                    if (u.pn < 2) { float* p = lrux + (size_t)row * 512 + col; *(f32x4*)p = v0; *(f32x4*)(p + 4) = v1; }
                    else if (u.pn < 4) { *(u32x4*)(gate + (size_t)row * 512 + (col - 512)) = pack8(v0, v1); }
                    else { *(u32x4*)(s5u + (size_t)row * 512 + (col - 1024)) = pack8(v0, v1); } } }
    }
};
struct EpiGlu {
    static constexpr bool PERM = true, AFTER_DRAIN = false; float* o;
    __device__ __forceinline__ void operator()(const f32x4 (&acc)[2][2][4][2], const pg8::Unit& u, int wr, int wc, int fr, int fq) const {
        const int col = u.pn * 128 + wc * 32 + 8 * fq;
#pragma unroll
        for (int ai = 0; ai < 2; ++ai)
#pragma unroll
            for (int m = 0; m < 4; ++m) { const int row = u.pm * 256 + ai * 128 + wr * 64 + m * 16 + fr; if (row >= MTOK) continue;
#pragma unroll
                for (int n = 0; n < 2; ++n) { const f32x4 a = acc[ai][0][m][n], b = acc[ai][1][m][n]; f32x4 s;
#pragma unroll
                    for (int i = 0; i < 4; ++i) s[i] = a[i] * sigm(b[i]);
                    *(f32x4*)(o + (size_t)row * 512 + col + 4 * n) = s; } }
    }
};
template <int GOFF> struct EpiRes {
    static constexpr bool PERM = true, AFTER_DRAIN = false; const float* xp; const float* xs; const float* mod; float* out;
    __device__ __forceinline__ void operator()(const f32x4 (&acc)[2][2][4][2], const pg8::Unit& u, int wr, int wc, int fr, int fq) const {
        const int colt = u.pn * 256 + wc * 32 + 8 * fq;
#pragma unroll
        for (int ai = 0; ai < 2; ++ai)
#pragma unroll
            for (int m = 0; m < 4; ++m) { const int row = u.pm * 256 + ai * 128 + wr * 64 + m * 16 + fr; if (row >= MTOK) continue;
                const float* gp = mod + (size_t)mod_row(row) * NMOD + GOFF; float* op = out + (size_t)row * DM;
                const float* bp = xp ? (row < MPR ? xp + (size_t)row * DM : xs + (size_t)(row - MPR) * DM) : op;
#pragma unroll
                for (int bj = 0; bj < 2; ++bj)
#pragma unroll
                    for (int n = 0; n < 2; ++n) { const int c = colt + bj * 128 + 4 * n; const f32x4 x4 = *(const f32x4*)(bp + c), g4 = *(const f32x4*)(gp + c);
                        *(f32x4*)(op + c) = x4 + g4 * acc[ai][bj][m][n]; } }
    }
};
struct EpiSwiglu {
    static constexpr bool PERM = true, AFTER_DRAIN = false; bf16* h;
    __device__ __forceinline__ void operator()(const f32x4 (&acc)[2][2][4][2], const pg8::Unit& u, int wr, int wc, int fr, int fq) const {
        const int col = u.pn * 128 + wc * 32 + 8 * fq;
#pragma unroll
        for (int ai = 0; ai < 2; ++ai)
#pragma unroll
            for (int m = 0; m < 4; ++m) { const int row = u.pm * 256 + ai * 128 + wr * 64 + m * 16 + fr; if (row >= MTOK) continue;
                f32x4 s[2];
#pragma unroll
                for (int n = 0; n < 2; ++n) { const f32x4 a = acc[ai][0][m][n], b = acc[ai][1][m][n];
#pragma unroll
                    for (int i = 0; i < 4; ++i) s[n][i] = a[i] * sigm(a[i]) * b[i]; }
                *(u32x4*)(h + (size_t)row * DFF + col) = pack8(s[0], s[1]); }
    }
};

__device__ __forceinline__ void transpose_item(const float* W, int ldw, int k0, int n0, bf16* WT, int K, int drow0, LAS bf16* scr, int lane) {
    const int lr = lane >> 4, lc = lane & 15;
    f32x4 v[16];
#pragma unroll
    for (int i = 0; i < 16; ++i) v[i] = *(const f32x4*)(W + (size_t)(k0 + lr + 4 * i) * ldw + n0 + 4 * lc);
#pragma unroll
    for (int i = 0; i < 16; ++i) { u32x2 p; p.x = pk2(v[i].x, v[i].y); p.y = pk2(v[i].z, v[i].w); *(LAS u32x2*)(scr + (lr + 4 * i) * 68 + 4 * lc) = p; }
    LDS_WAIT();
    const int kc = lane & 7;
#pragma unroll
    for (int j = 0; j < 8; ++j) { const int n = (lane >> 3) + 8 * j; const LAS bf16* sp = scr + (8 * kc) * 68 + n;
        u32x4 o; o.x = (unsigned)sp[0] | ((unsigned)sp[68] << 16); o.y = (unsigned)sp[2 * 68] | ((unsigned)sp[3 * 68] << 16);
        o.z = (unsigned)sp[4 * 68] | ((unsigned)sp[5 * 68] << 16); o.w = (unsigned)sp[6 * 68] | ((unsigned)sp[7 * 68] << 16);
        *(u32x4*)(WT + (size_t)(drow0 + n) * K + k0 + 8 * kc) = o; }
    LDS_WAIT();
}
__device__ __forceinline__ void transpose_dispatch(const Ctx& cx, int it, LAS bf16* scr, int lane) {
    if (it < 384) { const int kb = it / 24, nb = it % 24; transpose_item(cx.I(11), NPROJ, 64 * kb, 64 * nb, cx.WIN(), DM, 64 * nb, scr, lane); return; } it -= 384;
    if (it < 128) { const int kb = it / 16, nb = it % 16, n0 = 64 * nb; const int dr = 256 * ((n0 & 511) >> 7) + 128 * (n0 >> 9) + (n0 & 127);
        transpose_item(cx.I(27), 1024, 64 * kb, n0, cx.WGLU(), 512, dr, scr, lane); return; } it -= 128;
    if (it < 256) { const int kb = it / 16, nb = it % 16; transpose_item(cx.I(30), DM, 64 * kb, 64 * nb, cx.WOUT(), DM, 64 * nb, scr, lane); return; } it -= 256;
    if (it < 704) { const int kb = it / 44, nb = it % 44, n0 = 64 * nb; transpose_item(cx.I(32), DFF, 64 * kb, n0, cx.WGU(), DM, 256 * (n0 >> 7) + (n0 & 127), scr, lane); return; } it -= 704;
    if (it < 704) { const int kb = it / 44, nb = it % 44, n0 = 64 * nb; transpose_item(cx.I(33), DFF, 64 * kb, n0, cx.WGU(), DM, 256 * (n0 >> 7) + 128 + (n0 & 127), scr, lane); return; } it -= 704;
    { const int kb = it / 16, nb = it % 16; transpose_item(cx.I(34), DM, 64 * kb, 64 * nb, cx.WDN(), DFF, 64 * nb, scr, lane); }
}
constexpr int N_TR_ITEMS = 384 + 128 + 256 + 704 + 704 + 704;

__device__ __forceinline__ void ada_block(const Ctx& cx, int item, LAS unsigned char* lds) {
    const int tid = threadIdx.x, w = __builtin_amdgcn_readfirstlane(tid >> 6), lane = tid & 63, fr = lane & 15, fq = lane >> 4, n0 = 32 * item;
    const float* W = cx.I(8); const float* cp = cx.I(6); const float* cs = cx.I(7);
    bf16x8 wf[4][2];
#pragma unroll
    for (int ks = 0; ks < 4; ++ks)
#pragma unroll
        for (int nt = 0; nt < 2; ++nt) { const float* src = W + (size_t)(128 * w + 32 * ks + 8 * fq) * NMOD + n0 + 16 * nt + fr;
            u32x4 o; o.x = pk2(src[0], src[NMOD]); o.y = pk2(src[2 * NMOD], src[3 * NMOD]); o.z = pk2(src[4 * NMOD], src[5 * NMOD]); o.w = pk2(src[6 * NMOD], src[7 * NMOD]); wf[ks][nt] = __builtin_bit_cast(bf16x8, o); }
    f32x4 acc[9][2];
#pragma unroll
    for (int i = 0; i < 9; ++i) { acc[i][0] = (f32x4){0.f, 0.f, 0.f, 0.f}; acc[i][1] = (f32x4){0.f, 0.f, 0.f, 0.f}; }
#pragma unroll
    for (int mt = 0; mt < 9; ++mt) { int row = 16 * mt + fr; row = row < NBT ? row : NBT - 1;
        const float* src = (row < NBP ? cp + (size_t)row * DM : cs + (size_t)(row - NBP) * DM) + 128 * w + 8 * fq;
#pragma unroll
        for (int ks = 0; ks < 4; ++ks) { f32x4 a0 = *(const f32x4*)(src + 32 * ks), a1 = *(const f32x4*)(src + 32 * ks + 4);
#pragma unroll
            for (int i = 0; i < 4; ++i) { a0[i] = a0[i] * sigm(a0[i]); a1[i] = a1[i] * sigm(a1[i]); }
            const bf16x8 af = __builtin_bit_cast(bf16x8, pack8(a0, a1));
            acc[mt][0] = __builtin_amdgcn_mfma_f32_16x16x32_bf16(wf[ks][0], af, acc[mt][0], 0, 0, 0);
            acc[mt][1] = __builtin_amdgcn_mfma_f32_16x16x32_bf16(wf[ks][1], af, acc[mt][1], 0, 0, 0); } }
    LAS f32x4* red = (LAS f32x4*)lds;
#pragma unroll
    for (int st = 4; st >= 1; st >>= 1) {
        if (w >= st && w < 2 * st) {
#pragma unroll
            for (int i = 0; i < 9; ++i) { red[((w - st) * 18 + 2 * i) * 64 + lane] = acc[i][0]; red[((w - st) * 18 + 2 * i + 1) * 64 + lane] = acc[i][1]; } }
        __syncthreads();
        if (w < st) {
#pragma unroll
            for (int i = 0; i < 9; ++i) { acc[i][0] += red[(w * 18 + 2 * i) * 64 + lane]; acc[i][1] += red[(w * 18 + 2 * i + 1) * 64 + lane]; } }
        __syncthreads();
    }
    if (w == 0) {
#pragma unroll
        for (int nt = 0; nt < 2; ++nt) { const f32x4 b4 = *(const f32x4*)(cx.I(9) + n0 + 16 * nt + 4 * fq);
#pragma unroll
            for (int mt = 0; mt < 9; ++mt) { const int row = 16 * mt + fr; if (row < NBT) *(f32x4*)(cx.MOD() + (size_t)row * NMOD + n0 + 16 * nt + 4 * fq) = acc[mt][nt] + b4; } } }
}

__device__ __forceinline__ void s5_tables(const Ctx& cx, int g, LAS unsigned char* lds) {
    LAS f32x2* Ap = (LAS f32x2*)lds;
    LAS f32x2* Bb = Ap + 17 * 64;
    LAS f32x2* Cc = Bb + 1024;
    LAS f32x2* Ff = Cc + 1024;
    LAS float* Kt = (LAS float*)(Ff + 64);
    const int tid = threadIdx.x;
    float* tab = cx.TAB();
    if (tid < 64) {
        const int n = tid; const float lr = cx.I(19)[g * 64 + n], li = cx.I(20)[g * 64 + n], dt = expf(cx.I(21)[g]);
        const float mag = expf(lr * dt);
        const double ang = (double)li * (double)dt; const double kq = rint(ang * 0.63661977236758134308); const double r = ang - kq * 1.57079632679489661923; const double r2 = r * r;
        const double sn = r * (1.0 + r2 * (-1.0 / 6 + r2 * (1.0 / 120 + r2 * (-1.0 / 5040 + r2 * (1.0 / 362880 + r2 * (-1.0 / 39916800 + r2 * (1.0 / 6227020800.0)))))));
        const double cn = 1.0 + r2 * (-0.5 + r2 * (1.0 / 24 + r2 * (-1.0 / 720 + r2 * (1.0 / 40320 + r2 * (-1.0 / 3628800 + r2 * (1.0 / 479001600.0))))));
        const int q = ((int)kq) & 3; const double cv = q == 0 ? cn : q == 1 ? -sn : q == 2 ? -cn : sn, sv = q == 0 ? sn : q == 1 ? cn : q == 2 ? -sn : -cn;
        const float abr = mag * (float)cv, abi = mag * (float)sv; const float den = lr * lr + li * li;
        const float frr = ((abr - 1.f) * lr + abi * li) / den, fii = (abi * lr - (abr - 1.f) * li) / den;
        f32x2 p = (f32x2){1.f, 0.f}; Ap[n] = p;
#pragma unroll 1
        for (int t = 1; t <= 16; ++t) { const float pr = p.x * abr - p.y * abi, pi = p.x * abi + p.y * abr; p = (f32x2){pr, pi}; Ap[t * 64 + n] = p; }
        Ff[n] = (f32x2){frr, fii};
        ((f32x2*)(tab + T_ABAR))[g * 64 + n] = (f32x2){abr, abi}; ((f32x2*)(tab + T_A16))[g * 64 + n] = p;
    }
    __syncthreads();
    for (int e = tid; e < 1024; e += 512) { const int n = e >> 4; const float br = cx.I(22)[g * 1024 + e], bi = cx.I(23)[g * 1024 + e]; const f32x2 f = Ff[n];
        const float bbr = f.x * br - f.y * bi, bbi = f.x * bi + f.y * br; Bb[e] = (f32x2){bbr, bbi}; tab[T_BBR + g * 1024 + e] = bbr; tab[T_BBI + g * 1024 + e] = bbi;
        Cc[e] = (f32x2){cx.I(24)[g * 1024 + e], cx.I(25)[g * 1024 + e]}; }
    __syncthreads();
    for (int e = tid; e < 4096; e += 512) { const int tau = e >> 8, c = (e >> 4) & 15, cp = e & 15; float sum = 0.f;
        for (int n = 0; n < 64; ++n) { const f32x2 a = Ap[tau * 64 + n], b = Bb[n * 16 + cp], cc = Cc[c * 64 + n];
            const float pr = a.x * b.x - a.y * b.y, pi = a.x * b.y + a.y * b.x; sum += cc.x * pr - cc.y * pi; }
        Kt[e] = sum; }
    __syncthreads();
    bf16* TFg = cx.TF() + (size_t)g * 256 * 384;
    for (int pc = tid; pc < 256 * 48; pc += 512) { const int row = pc / 48, k8 = (pc % 48) * 8, j = row >> 4, c = row & 15; float v[8];
#pragma unroll
        for (int q = 0; q < 8; ++q) { const int kk = k8 + q;
            if (kk < 256) { const int s = kk >> 4, cp = kk & 15; v[q] = (j >= s) ? Kt[((j - s) << 8) + (c << 4) + cp] : 0.f; }
            else { const int n = (kk - 256) & 63; const f32x2 p = Ap[(j + 1) * 64 + n], cc = Cc[c * 64 + n]; v[q] = (kk < 320) ? (cc.x * p.x - cc.y * p.y) : (-cc.x * p.y - cc.y * p.x); } }
        u32x4 o; o.x = pk2(v[0], v[1]); o.y = pk2(v[2], v[3]); o.z = pk2(v[4], v[5]); o.w = pk2(v[6], v[7]);
        *(u32x4*)(TFg + (size_t)row * 384 + k8) = o; }
    bf16* Eg = cx.EM() + (size_t)g * 128 * 256;
    for (int pc = tid; pc < 128 * 32; pc += 512) { const int np = pc >> 5, k8 = (pc & 31) * 8, n = np & 63, im = np >> 6; float v[8];
#pragma unroll
        for (int q = 0; q < 8; ++q) { const int kk = k8 + q, s = kk >> 4, cp = kk & 15; const f32x2 a = Ap[(15 - s) * 64 + n], b = Bb[n * 16 + cp];
            v[q] = im ? (a.x * b.y + a.y * b.x) : (a.x * b.x - a.y * b.y); }
        u32x4 o; o.x = pk2(v[0], v[1]); o.y = pk2(v[2], v[3]); o.z = pk2(v[4], v[5]); o.w = pk2(v[6], v[7]);
        *(u32x4*)(Eg + (size_t)np * 256 + k8) = o; }
    __syncthreads();
}

__device__ __forceinline__ void norm_mod_row(const float* xrow, const float* g, const float* sc, const float* sh, bf16* orow, int lane) {
    f32x4 v[4]; float ss = 0.f;
#pragma unroll
    for (int j = 0; j < 4; ++j) { v[j] = ((const f32x4*)xrow)[lane + 64 * j]; ss += (v[j].x * v[j].x + v[j].y * v[j].y) + (v[j].z * v[j].z + v[j].w * v[j].w); }
    const float rstd = rsqrtf(wave_sum(ss) * (1.f / DM) + EPS);
#pragma unroll
    for (int j = 0; j < 4; ++j) { const int col = 4 * (lane + 64 * j); const f32x4 gg = *(const f32x4*)(g + col), s1 = *(const f32x4*)(sc + col), s2 = *(const f32x4*)(sh + col);
        const f32x4 o = v[j] * rstd * gg * (1.f + s1) + s2; u32x2 w; w.x = pk2(o.x, o.y); w.y = pk2(o.z, o.w); *(u32x2*)(orow + col) = w; }
}

__device__ __forceinline__ void lru_local_unit(const Ctx& cx, int row0, int ntok, bool samp, int aggidx, LAS unsigned char* lds) {
    const int d = threadIdx.x, w = __builtin_amdgcn_readfirstlane(d >> 6), lane = d & 63, fr = lane & 15, fq = lane >> 4;
    LAS float* cf = (LAS float*)(lds + w * 8192);
    LAS bf16* cbf = (LAS bf16*)(lds + w * 8192 + 4608);
    bf16x8 wf[8][2];
#pragma unroll
    for (int nt = 0; nt < 8; ++nt)
#pragma unroll
        for (int ks = 0; ks < 2; ++ks) { const float* src = (nt < 4 ? cx.I(14) : cx.I(16)) + (size_t)w * 4096 + (32 * ks + 8 * fq) * 64 + 16 * (nt & 3) + fr;
            u32x4 o; o.x = pk2(src[0], src[64]); o.y = pk2(src[128], src[192]); o.z = pk2(src[256], src[320]); o.w = pk2(src[384], src[448]); wf[nt][ks] = __builtin_bit_cast(bf16x8, o); }
    const float cw0 = cx.I(12)[d], cw1 = cx.I(12)[512 + d], cw2 = cx.I(12)[1024 + d], cw3 = cx.I(12)[1536 + d], cb = cx.I(13)[d];
    float gba[4], gbx[4], gcd[4], hc[4], cc[4];
#pragma unroll
    for (int nt = 0; nt < 4; ++nt) { const int ch = 64 * w + 16 * nt + fr; gba[nt] = cx.I(15)[ch]; gbx[nt] = cx.I(17)[ch]; gcd[nt] = -8.f * log1pf(expf(-cx.I(18)[ch])); hc[nt] = 0.f; cc[nt] = 1.f; }
    const float* X = cx.LRUX(); float* HL = cx.HLOC(); float* CU = cx.CUM();
    float xm3 = 0.f, xm2 = 0.f, xm1 = 0.f;
    if (!samp) { const int t0 = row0 & (SEQ - 1); if (t0 >= 3) { xm3 = X[(size_t)(row0 - 3) * DL + d]; xm2 = X[(size_t)(row0 - 2) * DL + d]; xm1 = X[(size_t)(row0 - 1) * DL + d]; } }
    float xv[16];
#pragma unroll
    for (int i = 0; i < 16; ++i) xv[i] = X[(size_t)(row0 + i) * DL + d];
    for (int t0 = 0; t0 < ntok; t0 += 16) {
        if (samp) {
#pragma unroll
            for (int i = 0; i < 16; ++i) { const int row = row0 + t0 + i; const float* sc = cx.I(2) + (size_t)(row - MPR) * 1536 + d;
                const float cv = cb + cw0 * sc[0] + cw1 * sc[512] + cw2 * sc[1024] + cw3 * xv[i];
                cf[i * 68 + lane] = cv; cbf[i * 72 + lane] = (bf16)(pk2(cv, cv) & 0xffffu); }
        } else {
#pragma unroll
            for (int i = 0; i < 16; ++i) { const float x = xv[i]; const float cv = cb + cw0 * xm3 + cw1 * xm2 + cw2 * xm1 + cw3 * x; xm3 = xm2; xm2 = xm1; xm1 = x;
                cf[i * 68 + lane] = cv; cbf[i * 72 + lane] = (bf16)(pk2(cv, cv) & 0xffffu); }
        }
        if (t0 + 16 < ntok) {
#pragma unroll
            for (int i = 0; i < 16; ++i) xv[i] = X[(size_t)(row0 + t0 + 16 + i) * DL + d]; }
        LDS_WAIT();
        f32x4 acc[8];
#pragma unroll
        for (int nt = 0; nt < 8; ++nt) acc[nt] = (f32x4){0.f, 0.f, 0.f, 0.f};
#pragma unroll
        for (int ks = 0; ks < 2; ++ks) { const bf16x8 af = *(const LAS bf16x8*)(cbf + fr * 72 + 32 * ks + 8 * fq);
#pragma unroll
            for (int nt = 0; nt < 8; ++nt) acc[nt] = __builtin_amdgcn_mfma_f32_16x16x32_bf16(af, wf[nt][ks], acc[nt], 0, 0, 0); }
#pragma unroll
        for (int nt = 0; nt < 4; ++nt) { const int ch = 64 * w + 16 * nt + fr;
            float av[4], hv[4]; float P = 1.f, H = 0.f;
#pragma unroll
            for (int r = 0; r < 4; ++r) { const int tok = 4 * fq + r; const float cvv = cf[tok * 68 + 16 * nt + fr];
                const float rr = sigm(acc[nt][r] + gba[nt]), ig = sigm(acc[nt + 4][r] + gbx[nt]); const float la = gcd[nt] * rr; const float z = 2.f * la;
                const float em = z * (1.f + z * (0.5f + z * (1.f / 6 + z * (1.f / 24 + z * (1.f / 120 + z * (1.f / 720 + z * (1.f / 5040)))))));
                const float a = __expf(la); const float bb = sqrtf(-em) * ig * cvv;
                if (samp) { const float h0 = cx.I(3)[(size_t)(row0 + t0 + tok - MPR) * DL + ch]; hv[r] = a * h0 + bb; av[r] = 0.f; }
                else { H = a * H + bb; P = P * a; hv[r] = H; av[r] = P; } }
            if (!samp) {
                float Pp = __shfl_up(P, 16), Hp = __shfl_up(H, 16); if (fq >= 1) { H = P * Hp + H; P = P * Pp; }
                Pp = __shfl_up(P, 32); Hp = __shfl_up(H, 32); if (fq >= 2) { H = P * Hp + H; P = P * Pp; }
                float Pe = __shfl_up(P, 16), He = __shfl_up(H, 16); if (fq == 0) { Pe = 1.f; He = 0.f; }
                const float hstart = He + Pe * hc[nt], cstart = Pe * cc[nt];
#pragma unroll
                for (int r = 0; r < 4; ++r) { hv[r] = hv[r] + av[r] * hstart; av[r] = av[r] * cstart; }
                const float Pl = __shfl(P, 48 + fr), Hl = __shfl(H, 48 + fr); hc[nt] = Hl + Pl * hc[nt]; cc[nt] = Pl * cc[nt];
            }
#pragma unroll
            for (int r = 0; r < 4; ++r) { const size_t o = (size_t)(row0 + t0 + 4 * fq + r) * DL + ch; HL[o] = hv[r]; CU[o] = av[r]; }
        }
        LDS_WAIT();
    }
    if (!samp && fq == 0) {
#pragma unroll
        for (int nt = 0; nt < 4; ++nt) cx.AGG()[(size_t)aggidx * DL + 64 * w + 16 * nt + fr] = (f32x2){cc[nt], hc[nt]}; }
}

__device__ __forceinline__ void s5_gemm_e_item(const Ctx& cx, int item, int lane) {
    const int g = item >> 6, rb = item & 63, fr = lane & 15, fq = lane >> 4, cr = rb * 16 + fr;
    const bf16* U = cx.S5U() + (size_t)(16 * cr + (fq >> 1)) * 512 + 16 * g + 8 * (fq & 1); const bf16* Eg = cx.EM() + (size_t)g * 128 * 256 + (size_t)fr * 256 + 8 * fq;
    f32x4 acc[8];
#pragma unroll
    for (int n = 0; n < 8; ++n) acc[n] = (f32x4){0.f, 0.f, 0.f, 0.f};
#pragma unroll 4
    for (int ks = 0; ks < 8; ++ks) {
        const bf16x8 af = *(const bf16x8*)(U + (size_t)(2 * ks) * 512);
#pragma unroll
        for (int nt = 0; nt < 8; ++nt) { const bf16x8 wf = *(const bf16x8*)(Eg + (size_t)(16 * nt) * 256 + 32 * ks); acc[nt] = __builtin_amdgcn_mfma_f32_16x16x32_bf16(wf, af, acc[nt], 0, 0, 0); }
    }
    float* S = cx.SK() + ((size_t)cr * 32 + g) * 128 + 4 * fq;
#pragma unroll
    for (int nt = 0; nt < 8; ++nt) *(f32x4*)(S + 16 * nt) = acc[nt];
}

__device__ __forceinline__ void s5_chain_item(const Ctx& cx, int item, int lane) {
    const int idx = item * 64 + lane, b = idx >> 11, g = (idx >> 6) & 31, n = idx & 63;
    const f32x2 A = ((const f32x2*)(cx.TAB() + T_A16))[g * 64 + n];
    const float* S = cx.SK() + ((size_t)(b * SNCH) * 32 + g) * 128 + n; bf16* H = cx.HIN() + ((size_t)g * SROWS + b * SNCH) * 128 + n;
    float hr = 0.f, hi = 0.f; float s0r[8], s0i[8], s1r[8], s1i[8];
#define CH_LOAD(R, I, K0) do { _Pragma("unroll") for (int i = 0; i < 8; ++i) { R[i] = S[(size_t)((K0) + i) * 4096]; I[i] = S[(size_t)((K0) + i) * 4096 + 64]; } } while (0)
#define CH_STEP(R, I, K0) do { _Pragma("unroll") for (int i = 0; i < 8; ++i) { H[(size_t)((K0) + i) * 128] = (bf16)(pk2(hr, hr) & 0xffffu); H[(size_t)((K0) + i) * 128 + 64] = (bf16)(pk2(hi, hi) & 0xffffu); \
        const float nr = A.x * hr - A.y * hi + R[i], ni = A.x * hi + A.y * hr + I[i]; hr = nr; hi = ni; } } while (0)
    CH_LOAD(s0r, s0i, 0);
    for (int k0 = 0; k0 < SNCH; k0 += 16) { CH_LOAD(s1r, s1i, k0 + 8); CH_STEP(s0r, s0i, k0); if (k0 + 16 < SNCH) CH_LOAD(s0r, s0i, k0 + 16); CH_STEP(s1r, s1i, k0 + 8); }
#undef CH_LOAD
#undef CH_STEP
    cx.out[O_S5RP + (size_t)(b * 32 + g) * 64 + n] = hr; cx.out[O_S5IP + (size_t)(b * 32 + g) * 64 + n] = hi;
}

__device__ __forceinline__ void lru_fix_unit(const Ctx& cx, int row0, int ntok, bool samp, int b, int k, LAS unsigned char* lds) {
    const int d = threadIdx.x, w = d >> 6, lane = d & 63;
    LAS float* hs = (LAS float*)lds;
    float hin = 0.f;
    if (!samp) { const f32x2* ag = cx.AGG() + (size_t)(b * NCH) * DL + d; f32x2 pp[NCH - 1];
#pragma unroll
        for (int kk = 0; kk < NCH - 1; ++kk) pp[kk] = (kk < k) ? ag[(size_t)kk * DL] : (f32x2){1.f, 0.f};
#pragma unroll
        for (int kk = 0; kk < NCH - 1; ++kk) hin = pp[kk].x * hin + pp[kk].y; }
    hs[d] = hin;
    const float* X = cx.LRUX();
    if (!samp && k == NCH - 1) {
#pragma unroll
        for (int j = 0; j < 3; ++j) cx.out[O_CONVP + (size_t)(b * 3 + j) * DL + d] = X[(size_t)(row0 + LCH - 3 + j) * DL + d]; }
    if (samp) { for (int t = 0; t < ntok; ++t) { const int sb = row0 + t - MPR; const float* sc = cx.I(2) + (size_t)sb * 1536 + d; float* o = cx.out + O_CONVS + (size_t)sb * 1536 + d;
            o[0] = sc[512]; o[512] = sc[1024]; o[1024] = X[(size_t)(row0 + t) * DL + d]; } }
    __syncthreads();
    const float* HL = cx.HLOC(); const float* CU = cx.CUM(); const bf16* GT = cx.GATE(); bf16* MG = cx.MERGED(); const float* gl = cx.I(28);
    const f32x4 hi0 = *(const LAS f32x4*)(hs + 8 * lane), hi1 = *(const LAS f32x4*)(hs + 8 * lane + 4);
    const f32x4 g0 = *(const f32x4*)(gl + 8 * lane), g1 = *(const f32x4*)(gl + 8 * lane + 4);
#pragma unroll 4
    for (int t = w; t < ntok; t += 8) { const size_t ro = (size_t)(row0 + t) * DL + 8 * lane;
        const f32x4 a0 = *(const f32x4*)(HL + ro), a1 = *(const f32x4*)(HL + ro + 4), c0 = *(const f32x4*)(CU + ro), c1 = *(const f32x4*)(CU + ro + 4);
        const u32x4 gw = *(const u32x4*)(GT + ro);
        const f32x4 h0 = a0 + c0 * hi0, h1 = a1 + c1 * hi1;
        f32x4 l0, l1;
        l0[0] = h0[0] * gelu_tanh(bflo(gw.x)); l0[1] = h0[1] * gelu_tanh(bfhi(gw.x)); l0[2] = h0[2] * gelu_tanh(bflo(gw.y)); l0[3] = h0[3] * gelu_tanh(bfhi(gw.y));
        l1[0] = h1[0] * gelu_tanh(bflo(gw.z)); l1[1] = h1[1] * gelu_tanh(bfhi(gw.z)); l1[2] = h1[2] * gelu_tanh(bflo(gw.w)); l1[3] = h1[3] * gelu_tanh(bfhi(gw.w));
        float ss = (l0[0] * l0[0] + l0[1] * l0[1]) + (l0[2] * l0[2] + l0[3] * l0[3]) + (l1[0] * l1[0] + l1[1] * l1[1]) + (l1[2] * l1[2] + l1[3] * l1[3]);
        const float rstd = rsqrtf(wave_sum(ss) * (1.f / DL) + EPS);
        *(u32x4*)(MG + (size_t)(row0 + t) * DM + 8 * lane) = pack8(l0 * rstd * g0, l1 * rstd * g1);
        if (samp) { float* o = cx.out + O_LRUS + (size_t)(row0 + t - MPR) * DL + 8 * lane; *(f32x4*)o = h0; *(f32x4*)(o + 4) = h1; }
        else if (k == NCH - 1 && t == LCH - 1) { float* o = cx.out + O_LRUP + (size_t)b * DL + 8 * lane; *(f32x4*)o = h0; *(f32x4*)(o + 4) = h1; }
    }
    __syncthreads();
}

__device__ __forceinline__ void s5_gemm_tf_item(const Ctx& cx, int item, int lane) {
    const int half = item & 1, g = item >> 6, rb = (item >> 1) & 31, fr = lane & 15, fq = lane >> 4;
    const bf16* U = cx.S5U(); const bf16* TFg = cx.TF() + ((size_t)g * 256 + 128 * half) * 384; const bf16* Hg = cx.HIN() + (size_t)g * SROWS * 128;
    f32x4 acc[2][8];
#pragma unroll
    for (int a = 0; a < 2; ++a)
#pragma unroll
        for (int n = 0; n < 8; ++n) acc[a][n] = (f32x4){0.f, 0.f, 0.f, 0.f};
#pragma unroll 2
    for (int ks = 0; ks < 12; ++ks) {
        bf16x8 af[2];
#pragma unroll
        for (int mt = 0; mt < 2; ++mt) { const int cr = rb * 32 + 16 * mt + fr;
            af[mt] = (ks < 8) ? *(const bf16x8*)(U + ((size_t)(16 * cr + 2 * ks + (fq >> 1)) * 512 + 16 * g + 8 * (fq & 1))) : *(const bf16x8*)(Hg + (size_t)cr * 128 + 32 * (ks - 8) + 8 * fq); }
#pragma unroll
        for (int nt = 0; nt < 8; ++nt) { const bf16x8 wf = *(const bf16x8*)(TFg + (size_t)(16 * nt + fr) * 384 + 32 * ks + 8 * fq);
#pragma unroll
            for (int mt = 0; mt < 2; ++mt) acc[mt][nt] = __builtin_amdgcn_mfma_f32_16x16x32_bf16(wf, af[mt], acc[mt][nt], 0, 0, 0); }
    }
    const f32x4 d4 = *(const f32x4*)(cx.I(26) + 16 * g + 4 * fq); bf16* GY = cx.GY();
#pragma unroll
    for (int mt = 0; mt < 2; ++mt) { const int cr = rb * 32 + 16 * mt + fr;
#pragma unroll
        for (int nt = 0; nt < 8; ++nt) { const size_t off = (size_t)(16 * cr + 8 * half + nt) * 512 + 16 * g + 4 * fq; const u32x2 uw = *(const u32x2*)(U + off);
            const f32x4 y = acc[mt][nt] + d4 * (f32x4){bflo(uw.x), bfhi(uw.x), bflo(uw.y), bfhi(uw.y)};
            u32x2 o; o.x = pk2(gelu_tanh(y[0]), gelu_tanh(y[1])); o.y = pk2(gelu_tanh(y[2]), gelu_tanh(y[3])); *(u32x2*)(GY + off) = o; } }
}
__device__ __forceinline__ void s5_sample_item(const Ctx& cx, int item, int lane) {
    const int sb = item >> 5, g = item & 31, n = lane; const int row = MPR + sb;
    const float* tab = cx.TAB(); const f32x2 A = ((const f32x2*)(tab + T_ABAR))[g * 64 + n];
    const float h0r = cx.I(4)[((size_t)sb * 32 + g) * 64 + n], h0i = cx.I(5)[((size_t)sb * 32 + g) * 64 + n];
    const bf16* up = cx.S5U() + (size_t)row * 512 + 16 * g; const u32x4 u0 = *(const u32x4*)up, u1 = *(const u32x4*)(up + 8);
    float uu[16]; uu[0] = bflo(u0.x); uu[1] = bfhi(u0.x); uu[2] = bflo(u0.y); uu[3] = bfhi(u0.y); uu[4] = bflo(u0.z); uu[5] = bfhi(u0.z); uu[6] = bflo(u0.w); uu[7] = bfhi(u0.w);
    uu[8] = bflo(u1.x); uu[9] = bfhi(u1.x); uu[10] = bflo(u1.y); uu[11] = bfhi(u1.y); uu[12] = bflo(u1.z); uu[13] = bfhi(u1.z); uu[14] = bflo(u1.w); uu[15] = bfhi(u1.w);
    float bur = 0.f, bui = 0.f; const float* br = tab + T_BBR + (size_t)(g * 64 + n) * 16; const float* bi = tab + T_BBI + (size_t)(g * 64 + n) * 16;
#pragma unroll
    for (int c4 = 0; c4 < 4; ++c4) { const f32x4 r4 = *(const f32x4*)(br + 4 * c4), i4 = *(const f32x4*)(bi + 4 * c4);
#pragma unroll
        for (int i = 0; i < 4; ++i) { bur += r4[i] * uu[4 * c4 + i]; bui += i4[i] * uu[4 * c4 + i]; } }
    const float hr = A.x * h0r - A.y * h0i + bur, hi = A.x * h0i + A.y * h0r + bui;
    cx.out[O_S5RS + ((size_t)sb * 32 + g) * 64 + n] = hr; cx.out[O_S5IS + ((size_t)sb * 32 + g) * 64 + n] = hi;
    float my = 0.f, myu = 0.f;
#pragma unroll
    for (int c = 0; c < 16; ++c) { const float v = wave_sum(cx.I(24)[((size_t)g * 16 + c) * 64 + n] * hr - cx.I(25)[((size_t)g * 16 + c) * 64 + n] * hi); if (lane == c) { my = v; myu = uu[c]; } }
    if (lane < 16) { const float y = my + cx.I(26)[16 * g + lane] * myu; cx.GY()[(size_t)row * 512 + 16 * g + lane] = (bf16)(pk2(gelu_tanh(y), 0.f) & 0xffffu); }
}

__global__ void __launch_bounds__(512, 2) fwd_kernel(KArgs a) {
    extern __shared__ __attribute__((aligned(16))) unsigned char lds_raw[];
    LAS unsigned char* lds = (LAS unsigned char*)lds_raw;
    cg::grid_group grid = cg::this_grid();
    Ctx cx; cx.in = a.in; cx.out = a.out; cx.ws = a.ws;
    const int tid = threadIdx.x, lane = tid & 63, wave = __builtin_amdgcn_readfirstlane(tid >> 6);
    const int G = gridDim.x, bid = blockIdx.x, gw = bid * 8 + wave, NGW = G * 8;
#ifndef REPMASK
#define REPMASK 0
#endif
#ifndef PHMASK
#define PHMASK 0x1fff
#endif
#define IN(k) (((PHMASK >> (k)) & 1) && a.lo <= (k) && (k) < a.hi)
#define SEAM(k) do { if (IN(k) && IN((k) + 1)) grid.sync(); } while (0)

    if (IN(0)) for (int rep_ = 0; rep_ < 1 + ((REPMASK >> 0) & 1); ++rep_) {
        if (bid < 32 || G < 64) { for (int g = bid; g < 32; g += G) s5_tables(cx, g, lds); }
        const int nb2 = G >= 64 ? G - 32 : G, b2 = G >= 64 ? bid - 32 : bid;
        if (b2 >= 0) {
            for (int it = b2; it < 192; it += nb2) ada_block(cx, it, lds);
            LAS bf16* scr = (LAS bf16*)(lds + wave * 16384);
            for (int it = (nb2 - 1 - b2) * 8 + wave; it < N_TR_ITEMS; it += nb2 * 8) transpose_dispatch(cx, it, scr, lane);
        }
    }
    SEAM(0);
    if (IN(1)) for (int rep_ = 0; rep_ < 1 + ((REPMASK >> 1) & 1); ++rep_) {
        for (int r = gw; r < MTOK; r += NGW) { const float* xr = r < MPR ? cx.I(0) + (size_t)r * DM : cx.I(1) + (size_t)(r - MPR) * DM; const float* md = cx.MOD() + (size_t)mod_row(r) * NMOD;
            norm_mod_row(xr, cx.I(10), md + 1024, md, cx.XN() + (size_t)r * DM, lane); }
    }
    SEAM(1);
    if (IN(2)) for (int rep_ = 0; rep_ < 1 + ((REPMASK >> 2) & 1); ++rep_) {
        pg8::Gemm g{cx.XN(), cx.WIN(), MPAD, NPROJ, DM}; pg8::StaticOrder S; S.init(MPAD, NPROJ, G, bid);
        EpiProj E{cx.LRUX(), cx.GATE(), cx.S5U()};
        pg8::gemm_phase<EpiProj, pg8::StaticOrder, true, true>(lds, g, S, E);
    }
    SEAM(2);
    if (IN(3)) for (int rep_ = 0; rep_ < 1 + ((REPMASK >> 3) & 1); ++rep_) {
#ifndef NO_LRU
        for (int u = bid; u < 256 + NBS / SCH; u += G) {
            if (u < 256) lru_local_unit(cx, u * LCH, LCH, false, u, lds); else lru_local_unit(cx, MPR + (u - 256) * SCH, SCH, true, 0, lds);
        }
#endif
#ifndef NO_E
        for (int it = gw; it < 2048; it += NGW) s5_gemm_e_item(cx, it, lane);
#endif
    }
    SEAM(3);
    if (IN(4)) for (int rep_ = 0; rep_ < 1 + ((REPMASK >> 4) & 1); ++rep_) {
        if (wave == 0) { for (int it = bid; it < 256; it += G) s5_chain_item(cx, it, lane); }
        for (int u = bid; u < 256 + NBS / SCH; u += G) {
            if (u < 256) lru_fix_unit(cx, u * LCH, LCH, false, u >> 5, u & 31, lds); else lru_fix_unit(cx, MPR + (u - 256) * SCH, SCH, true, 0, 0, lds);
        }
    }
    SEAM(4);
    if (IN(5)) for (int rep_ = 0; rep_ < 1 + ((REPMASK >> 5) & 1); ++rep_) {
        for (int it = gw; it < 2048; it += NGW) s5_gemm_tf_item(cx, it, lane);
        for (int it = gw; it < NBS * 32; it += NGW) s5_sample_item(cx, it, lane);
    }
    SEAM(5);
    if (IN(6)) for (int rep_ = 0; rep_ < 1 + ((REPMASK >> 6) & 1); ++rep_) {
        pg8::Gemm g{cx.GY(), cx.WGLU(), MPAD, 1024, 512}; pg8::StaticOrder S; S.init(MPAD, 1024, G, bid);
        EpiGlu E{cx.S5OUT()};
        pg8::gemm_phase<EpiGlu, pg8::StaticOrder, true, true>(lds, g, S, E);
    }
    SEAM(6);
    if (IN(7)) for (int rep_ = 0; rep_ < 1 + ((REPMASK >> 7) & 1); ++rep_) {
        const float* gs = cx.I(29);
        for (int r = gw; r < MTOK; r += NGW) { const float* sr = cx.S5OUT() + (size_t)r * 512;
            const f32x4 v0 = ((const f32x4*)sr)[lane], v1 = ((const f32x4*)sr)[lane + 64];
            const float ss = (v0.x * v0.x + v0.y * v0.y) + (v0.z * v0.z + v0.w * v0.w) + (v1.x * v1.x + v1.y * v1.y) + (v1.z * v1.z + v1.w * v1.w);
            const float rstd = rsqrtf(wave_sum(ss) * (1.f / 512) + EPS);
            const f32x4 o0 = v0 * rstd * ((const f32x4*)gs)[lane], o1 = v1 * rstd * ((const f32x4*)gs)[lane + 64];
            bf16* mp = cx.MERGED() + (size_t)r * DM + 512; u32x2 w0, w1; w0.x = pk2(o0.x, o0.y); w0.y = pk2(o0.z, o0.w); w1.x = pk2(o1.x, o1.y); w1.y = pk2(o1.z, o1.w);
            *(u32x2*)(mp + 4 * lane) = w0; *(u32x2*)(mp + 256 + 4 * lane) = w1; }
    }
    SEAM(7);
    if (IN(8)) for (int rep_ = 0; rep_ < 1 + ((REPMASK >> 8) & 1); ++rep_) {
        pg8::Gemm g{cx.MERGED(), cx.WOUT(), MPAD, DM, DM}; pg8::StaticOrder S; S.init(MPAD, DM, G, bid);
        EpiRes<2048> E{cx.I(0), cx.I(1), cx.MOD(), cx.out};
        pg8::gemm_phase<EpiRes<2048>, pg8::StaticOrder, true, true>(lds, g, S, E);
    }
    SEAM(8);
    if (IN(9)) for (int rep_ = 0; rep_ < 1 + ((REPMASK >> 9) & 1); ++rep_) {
        for (int r = gw; r < MTOK; r += NGW) { const float* md = cx.MOD() + (size_t)mod_row(r) * NMOD;
            norm_mod_row(cx.out + (size_t)r * DM, cx.I(31), md + 4096, md + 3072, cx.XN2() + (size_t)r * DM, lane); }
    }
    SEAM(9);
    if (IN(10)) for (int rep_ = 0; rep_ < 1 + ((REPMASK >> 10) & 1); ++rep_) {
        pg8::Gemm g{cx.XN2(), cx.WGU(), MPAD, 2 * DFF, DM}; pg8::StaticOrder S; S.init(MPAD, 2 * DFF, G, bid);
        EpiSwiglu E{cx.HB()};
        pg8::gemm_phase<EpiSwiglu, pg8::StaticOrder, true, true>(lds, g, S, E);
    }
    SEAM(10);
    if (IN(11)) for (int rep_ = 0; rep_ < 1 + ((REPMASK >> 11) & 1); ++rep_) {
        pg8::Gemm g{cx.HB(), cx.WDN(), MPAD, DM, DFF}; pg8::StaticOrder S; S.init(MPAD, DM, G, bid);
        EpiRes<5120> E{nullptr, nullptr, cx.MOD(), cx.out};
        pg8::gemm_phase<EpiRes<5120>, pg8::StaticOrder, true, true>(lds, g, S, E);
    }
    SEAM(11);
    if (IN(12)) for (int rep_ = 0; rep_ < 1 + ((REPMASK >> 12) & 1); ++rep_) {
        const float* fg = cx.I(35);
        for (int r = gw; r < MTOK; r += NGW) { float* xr = cx.out + (size_t)r * DM; f32x4 v[4]; float ss = 0.f;
#pragma unroll
            for (int j = 0; j < 4; ++j) { v[j] = ((const f32x4*)xr)[lane + 64 * j]; ss += (v[j].x * v[j].x + v[j].y * v[j].y) + (v[j].z * v[j].z + v[j].w * v[j].w); }
            const float rstd = rsqrtf(wave_sum(ss) * (1.f / DM) + EPS);
#pragma unroll
            for (int j = 0; j < 4; ++j) ((f32x4*)xr)[lane + 64 * j] = v[j] * rstd * ((const f32x4*)fg)[lane + 64 * j]; }
    }
#undef IN
#undef SEAM
}

constexpr int LDS_BYTES = 131072;
#ifndef MK_SINGLE
#define MK_SINGLE 1
#endif
extern "C" void kernel_launch(void* const* d_in, const int* in_sizes, int n_in, void* d_out, int out_size, void* d_ws, size_t ws_size, hipStream_t stream) {
    static int grid = 0;
    if (grid == 0) {
        if (n_in != 36 || (size_t)out_size != O_END || ws_size < WS_END) { fprintf(stderr, "kernel_launch: unexpected shapes n_in %d out %d ws %zu\n", n_in, out_size, ws_size); grid = -1; return; }
        int dev = 0, cus = 0, per_cu = 0;
        hipGetDevice(&dev); hipDeviceGetAttribute(&cus, hipDeviceAttributeMultiprocessorCount, dev);
        hipFuncSetAttribute((const void*)fwd_kernel, hipFuncAttributeMaxDynamicSharedMemorySize, LDS_BYTES);
        hipOccupancyMaxActiveBlocksPerMultiprocessor(&per_cu, (const void*)fwd_kernel, 512, LDS_BYTES);
        if (per_cu < 1) { fprintf(stderr, "kernel_launch: occupancy query says %d blocks per CU\n", per_cu); grid = -1; return; }
        grid = cus;
    }
    if (grid < 0) return;
    KArgs a{};
    for (int i = 0; i < 36; ++i) a.in[i] = (const float*)d_in[i];
    a.out = (float*)d_out; a.ws = (unsigned char*)d_ws;
#if MK_SINGLE
    a.lo = 0; a.hi = NPHASE;
    void* args[] = {&a};
    hipError_t e = hipLaunchCooperativeKernel((const void*)fwd_kernel, dim3(grid), dim3(512), args, LDS_BYTES, stream);
    if (e != hipSuccess) fprintf(stderr, "cooperative launch failed: %s (grid %d)\n", hipGetErrorString(e), grid);
#else
    for (int p = 0; p < NPHASE; ++p) { a.lo = p; a.hi = p + 1; hipLaunchKernelGGL(fwd_kernel, dim3(grid), dim3(512), LDS_BYTES, stream, a); }
#endif
}
```

```cpp
#include <hip/hip_runtime.h>
#include <hip/hip_cooperative_groups.h>
#include <cstdio>
#include <cstdint>
namespace cg = cooperative_groups;
namespace pg8 {
#define PG8_LAS __attribute__((address_space(3)))
typedef unsigned short bf16_t;
typedef short bf16x8 __attribute__((ext_vector_type(8)));
typedef float f32x4 __attribute__((ext_vector_type(4)));
typedef unsigned u32x4 __attribute__((ext_vector_type(4)));
constexpr int BM = 256, BK = 64, HALF = 128, HTB = HALF * BK * 2  , STAGE_BYTES = 8 * HTB, NXCD = 8, WGM = 8;

__host__ __device__ __forceinline__ int lds_byte(int r, int c) { const int st = (r >> 4) * 2 + (c >> 5), rr = r & 15, cc = c & 31, ob = rr * 64 + cc * 2; return st * 1024 + (ob ^ (((ob >> 9) & 1) << 5)); }
__host__ __device__ __forceinline__ void stage_rc(int b, int& R, int& C) { const int st = b / 1024, sb = b % 1024, swz = sb ^ (((sb >> 9) & 1) << 5); R = (st >> 1) * 16 + swz / 64; C = (st & 1) * 32 + (swz % 64) / 2; }
__host__ __device__ __forceinline__ int perm32(int rho) { const int n = rho >> 4, i = rho & 15; return 8 * (i >> 2) + 4 * n + (i & 3); }

struct Unit { int pm, pn; };
struct Gemm { const bf16_t* A; const bf16_t* Bt; int M, N, K; };

struct StaticOrder {
    int nM, nN, nwg, G, c;
    __host__ __device__ void init(int M, int N, int G_, int c_) { nM = M / BM; nN = N / BM; nwg = nM * nN; G = G_; c = c_; }
    __host__ __device__ bool next(int i, Unit& u) const {
        const long L = (long)i * G + c; if (L >= nwg) return false;
        int wgid = (int)L; { const int q = nwg / NXCD, r = nwg % NXCD, xcd = wgid % NXCD, off = wgid / NXCD; wgid = (xcd < r ? xcd * (q + 1) : r * (q + 1) + (xcd - r) * q) + off; }
        const int nig = WGM * nN, gid = wgid / nig, fm = gid * WGM, gsz = (nM - fm) < WGM ? (nM - fm) : WGM;
        u.pm = fm + ((wgid % nig) % gsz); u.pn = (wgid % nig) / gsz; return true;
    }
    __device__ __forceinline__ void a_ready(const Unit&) const {}
    __device__ __forceinline__ void done(const Unit&) const {}
};

__device__ __forceinline__ unsigned cvt_pk_bf16(float lo, float hi) { unsigned r; asm volatile("v_cvt_pk_bf16_f32 %0, %1, %2" : "=v"(r) : "v"(lo), "v"(hi)); return r; }
typedef float f32x2 __attribute__((ext_vector_type(2)));
template <class Epi, class Sched, bool ALIGN_EPI = false, bool SP2 = false>
__device__ __forceinline__ void gemm_phase(PG8_LAS unsigned char* lds, const Gemm g, const Sched& S, const Epi& E) {
    const int tid = threadIdx.x, wid = __builtin_amdgcn_readfirstlane(tid >> 6), lane = tid & 63, wr = wid >> 2, wc = wid & 3, fr = lane & 15, fq = lane >> 4;
    const int K = g.K, nt = K / BK;
    unsigned voffA[2], voffB[2];
#pragma unroll
    for (int i = 0; i < 2; ++i) { int R, C; stage_rc(tid * 16 + i * 8192, R, C); const int Rb = Epi::PERM ? ((R & ~31) + perm32(R & 31)) : R;
        voffA[i] = (unsigned)(R * K + C) * 2u; voffB[i] = (unsigned)(Rb * K + C) * 2u; }
    const size_t kstep = (size_t)(BK * 2);
    const size_t hstep = (size_t)HALF * K * 2;
    const size_t tstep = 2 * hstep;
    const unsigned ldsw = (unsigned)wid * 1024u;
    const int aoff = lds_byte(wr * 64 + fr, fq * 8), boff = lds_byte(wc * 32 + fr, fq * 8);
#define PG8_SA(b, h) (((b) * 2 + (h)) * HTB)
#define PG8_SB(b, h) ((4 + (b) * 2 + (h)) * HTB)
#define PG8_STAGE(bufoff, gbase, voff) do { _Pragma("unroll") for (int _i = 0; _i < 2; ++_i) \
        __builtin_amdgcn_global_load_lds((const unsigned*)((const char*)(gbase) + (voff)[_i]), (PG8_LAS unsigned*)(lds + (bufoff) + ldsw + _i * 8192), 16, 0, 0); } while (0)
#define PG8_LDA(dst, b, h) do { _Pragma("unroll") for (int m = 0; m < 4; ++m) _Pragma("unroll") for (int k = 0; k < 2; ++k) dst[m][k] = *(const PG8_LAS bf16x8*)(lds + PG8_SA(b, h) + aoff + m * 2048 + k * 1024); } while (0)
#define PG8_LDB(dst, b, h) do { _Pragma("unroll") for (int n = 0; n < 2; ++n) _Pragma("unroll") for (int k = 0; k < 2; ++k) dst[n][k] = *(const PG8_LAS bf16x8*)(lds + PG8_SB(b, h) + boff + n * 2048 + k * 1024); } while (0)
#define PG8_MMA(ai, bj, At, Bt) do { __builtin_amdgcn_s_setprio(1); _Pragma("unroll") for (int m = 0; m < 4; ++m) _Pragma("unroll") for (int n = 0; n < 2; ++n) _Pragma("unroll") for (int k = 0; k < 2; ++k) \
        acc[ai][bj][m][n] = __builtin_amdgcn_mfma_f32_16x16x32_bf16(Bt[n][k], At[m][k], acc[ai][bj][m][n], 0, 0, 0); __builtin_amdgcn_s_setprio(0); } while (0)
#define PG8_WAIT_V(n) asm volatile("s_waitcnt vmcnt(" #n ")" ::: "memory")
#define PG8_WAIT_L(n) asm volatile("s_waitcnt lgkmcnt(" #n ")" ::: "memory")
#define PG8_BAR __builtin_amdgcn_s_barrier()
#define PG8_SCHED __builtin_amdgcn_sched_barrier(0)
    Unit cur, nxt; int ui = 0;
    if (!S.next(0, cur)) return;
    f32x4 acc[2][2][4][2];
#pragma unroll
    for (int a = 0; a < 2; ++a)
#pragma unroll
        for (int b = 0; b < 2; ++b)
#pragma unroll
            for (int m = 0; m < 4; ++m)
#pragma unroll
                for (int n = 0; n < 2; ++n) acc[a][b][m][n] = (f32x4){0.f, 0.f, 0.f, 0.f};
    bf16x8 At[4][2], B0[2][2], B1[2][2];
    const char* cA = (const char*)g.A + (size_t)cur.pm * tstep; const char* cB = (const char*)g.Bt + (size_t)cur.pn * tstep;
    S.a_ready(cur);
    if constexpr (SP2) {
        PG8_STAGE(PG8_SB(0, 0), cB, voffB); PG8_STAGE(PG8_SB(0, 1), cB + hstep, voffB); PG8_STAGE(PG8_SA(0, 0), cA, voffA); PG8_STAGE(PG8_SA(0, 1), cA + hstep, voffA);
        if (wr == 1) PG8_BAR;
        PG8_WAIT_V(2); PG8_BAR;
        PG8_STAGE(PG8_SB(1, 0), cB + kstep, voffB); PG8_STAGE(PG8_SA(1, 0), cA + kstep, voffA); PG8_STAGE(PG8_SB(1, 1), cB + hstep + kstep, voffB);
        PG8_WAIT_V(6); PG8_BAR;
    } else {
        PG8_STAGE(PG8_SB(0, 0), cB, voffB); PG8_STAGE(PG8_SA(0, 0), cA, voffA); PG8_STAGE(PG8_SB(0, 1), cB + hstep, voffB); PG8_STAGE(PG8_SA(0, 1), cA + hstep, voffA);
        if (wr == 1) PG8_BAR;
        PG8_WAIT_V(4); PG8_BAR;
        PG8_STAGE(PG8_SB(1, 0), cB + kstep, voffB); PG8_STAGE(PG8_SA(1, 0), cA + kstep, voffA); PG8_STAGE(PG8_SB(1, 1), cB + hstep + kstep, voffB);
        PG8_WAIT_V(6); PG8_BAR;
    }
    for (;;) {
        const bool has_next = S.next(ui + 1, nxt);
        const char* nA = has_next ? (const char*)g.A + (size_t)nxt.pm * tstep : cA; const char* nB = has_next ? (const char*)g.Bt + (size_t)nxt.pn * tstep : cB;
        for (int t = 0; t < nt; t += 2) {
            const bool last = (t == nt - 2);
            const char* a1 = cA + (size_t)(t + 1) * kstep;
            const char* a2 = last ? nA : cA + (size_t)(t + 2) * kstep; const char* b2 = last ? nB : cB + (size_t)(t + 2) * kstep;
            const char* a3 = a2 + kstep; const char* b3 = b2 + kstep;
            if (last && has_next) S.a_ready(nxt);
            if constexpr (SP2) {
            PG8_LDB(B0, 0, 0); PG8_LDB(B1, 0, 1); PG8_SCHED; PG8_LDA(At, 0, 0); PG8_STAGE(PG8_SA(1, 1), a1 + hstep, voffA);
            PG8_WAIT_V(8); PG8_WAIT_L(0); PG8_BAR; PG8_MMA(0, 0, At, B0); PG8_MMA(0, 1, At, B1); PG8_BAR; PG8_SCHED;
            PG8_LDA(At, 0, 1); PG8_STAGE(PG8_SB(0, 0), b2, voffB); PG8_STAGE(PG8_SB(0, 1), b2 + hstep, voffB); PG8_STAGE(PG8_SA(0, 0), a2, voffA);
            PG8_WAIT_V(8); PG8_WAIT_L(0); PG8_BAR; PG8_MMA(1, 0, At, B0); PG8_MMA(1, 1, At, B1); PG8_BAR; PG8_SCHED;
            PG8_LDB(B0, 1, 0); PG8_LDB(B1, 1, 1); PG8_SCHED; PG8_LDA(At, 1, 0); PG8_STAGE(PG8_SA(0, 1), a2 + hstep, voffA);
            PG8_WAIT_V(8); PG8_WAIT_L(0); PG8_BAR; PG8_MMA(0, 0, At, B0); PG8_MMA(0, 1, At, B1); PG8_BAR; PG8_SCHED;
            PG8_LDA(At, 1, 1); PG8_STAGE(PG8_SB(1, 0), b3, voffB); PG8_STAGE(PG8_SB(1, 1), b3 + hstep, voffB); PG8_STAGE(PG8_SA(1, 0), a3, voffA);
            PG8_WAIT_V(8); PG8_WAIT_L(0); PG8_BAR; PG8_MMA(1, 0, At, B0); PG8_MMA(1, 1, At, B1); PG8_BAR; PG8_SCHED;
            } else {
            PG8_LDB(B0, 0, 0); PG8_SCHED; PG8_LDA(At, 0, 0); PG8_STAGE(PG8_SA(1, 1), a1 + hstep, voffA);
            PG8_WAIT_L(8); PG8_BAR; PG8_WAIT_L(0); PG8_MMA(0, 0, At, B0); PG8_BAR; PG8_SCHED;
            PG8_LDB(B1, 0, 1); PG8_STAGE(PG8_SB(0, 0), b2, voffB);
            PG8_BAR; PG8_WAIT_L(0); PG8_MMA(0, 1, At, B1); PG8_BAR;
            PG8_LDA(At, 0, 1); PG8_STAGE(PG8_SA(0, 0), a2, voffA);
            PG8_BAR; PG8_WAIT_L(0); PG8_MMA(1, 0, At, B0); PG8_BAR; PG8_SCHED;
            PG8_STAGE(PG8_SB(0, 1), b2 + hstep, voffB);
            PG8_WAIT_V(6); PG8_BAR; PG8_MMA(1, 1, At, B1); PG8_BAR;
            PG8_LDB(B0, 1, 0); PG8_SCHED; PG8_LDA(At, 1, 0); PG8_STAGE(PG8_SA(0, 1), a2 + hstep, voffA);
            PG8_WAIT_L(8); PG8_BAR; PG8_WAIT_L(0); PG8_MMA(0, 0, At, B0); PG8_BAR; PG8_SCHED;
            PG8_LDB(B1, 1, 1); PG8_STAGE(PG8_SB(1, 0), b3, voffB);
            PG8_BAR; PG8_WAIT_L(0); PG8_MMA(0, 1, At, B1); PG8_BAR;
            PG8_LDA(At, 1, 1); PG8_STAGE(PG8_SA(1, 0), a3, voffA);
            PG8_BAR; PG8_WAIT_L(0); PG8_MMA(1, 0, At, B0); PG8_BAR; PG8_SCHED;
            PG8_STAGE(PG8_SB(1, 1), b3 + hstep, voffB);
            PG8_WAIT_V(6); PG8_BAR; PG8_MMA(1, 1, At, B1); PG8_BAR;
            }
        }
        if constexpr (ALIGN_EPI) { if (wr == 0) PG8_BAR; }
        if constexpr (!Epi::AFTER_DRAIN) { E(acc, cur, wr, wc, fr, fq); S.done(cur); }
        if (!has_next) break;
#pragma unroll
        for (int a = 0; a < 2; ++a)
#pragma unroll
            for (int b = 0; b < 2; ++b)
#pragma unroll
                for (int m = 0; m < 4; ++m)
#pragma unroll
                    for (int n = 0; n < 2; ++n) acc[a][b][m][n] = (f32x4){0.f, 0.f, 0.f, 0.f};
        cur = nxt; cA = nA; cB = nB; ++ui;
        if constexpr (ALIGN_EPI) { if (wr == 1) PG8_BAR; }
    }
    PG8_WAIT_V(0);
    if constexpr (!ALIGN_EPI) { if (wr == 0) PG8_BAR; }
    PG8_BAR;
    if constexpr (Epi::AFTER_DRAIN) { E.fused(acc, cur, wr, wc, fr, fq, lds, wid, lane); S.done(cur); }
#undef PG8_SA
#undef PG8_SB
#undef PG8_STAGE
#undef PG8_LDA
#undef PG8_LDB
#undef PG8_MMA
#undef PG8_WAIT_V
#undef PG8_WAIT_L
#undef PG8_BAR
#undef PG8_SCHED
}
}

#define LAS __attribute__((address_space(3)))
typedef unsigned short bf16;
typedef float f32x4 __attribute__((ext_vector_type(4)));
typedef float f32x2 __attribute__((ext_vector_type(2)));
typedef short bf16x8 __attribute__((ext_vector_type(8)));
typedef unsigned u32x4 __attribute__((ext_vector_type(4)));
typedef unsigned u32x2 __attribute__((ext_vector_type(2)));

constexpr int DM = 1024, NBP = 8, SEQ = 2048, MPR = NBP * SEQ, NBS = 128, MTOK = MPR + NBS, MPAD = 16640;
constexpr int DL = 512, NPROJ = 1536, NMOD = 6144, NBT = NBP + NBS, DFF = 2816;
constexpr int LCH = 64, NCH = SEQ / LCH;
constexpr int SCH = 16;
constexpr int SL = 16, SNCH = SEQ / SL, SROWS = NBP * SNCH;
constexpr float EPS = 1e-6f;
constexpr int NPHASE = 13;

constexpr size_t O_Y = 0, O_CONVP = (size_t)MTOK * DM, O_LRUP = O_CONVP + 8 * 3 * 512, O_S5RP = O_LRUP + 8 * 512, O_S5IP = O_S5RP + 8 * 32 * 64,
                 O_CONVS = O_S5IP + 8 * 32 * 64, O_LRUS = O_CONVS + 128 * 3 * 512, O_S5RS = O_LRUS + 128 * 512, O_S5IS = O_S5RS + 128 * 32 * 64, O_END = O_S5IS + 128 * 32 * 64;

constexpr size_t HM = 1u << 19;
constexpr size_t WS_WIN = 2 * HM, WS_WGLU = 8 * HM, WS_WOUT = 10 * HM, WS_WGU = 14 * HM, WS_WDN = 36 * HM  , WS_MOD = 48 * HM  ,
                 WS_TF = 56 * HM  , WS_E = 68 * HM  , WS_TAB = 72 * HM, WS_AGG = 74 * HM  ,
                 WS_XN = 80 * HM  , WS_LRUX = 146 * HM  , WS_GATE = 211 * HM  ,
                 WS_S5U = 244 * HM  , WS_HLOC = 277 * HM  , WS_CUM = 342 * HM, WS_GY = 407 * HM  ,
                 WS_SK = 440 * HM  , WS_HIN = 472 * HM  , WS_HB = 244 * HM  , WS_END = 512 * HM;
constexpr size_t T_ABAR = 0, T_A16 = 4096, T_BBR = 8192, T_BBI = 8192 + 32768;

struct KArgs { const float* in[36]; float* out; unsigned char* ws; int lo, hi; };

struct Ctx {
    const float* const* in; float* out; unsigned char* ws;
    __device__ __forceinline__ const float* I(int i) const { return in[i]; }
    __device__ __forceinline__ bf16* WIN() const { return (bf16*)(ws + WS_WIN); }
    __device__ __forceinline__ bf16* WGLU() const { return (bf16*)(ws + WS_WGLU); }
    __device__ __forceinline__ bf16* WOUT() const { return (bf16*)(ws + WS_WOUT); }
    __device__ __forceinline__ bf16* WGU() const { return (bf16*)(ws + WS_WGU); }
    __device__ __forceinline__ bf16* WDN() const { return (bf16*)(ws + WS_WDN); }
    __device__ __forceinline__ float* MOD() const { return (float*)(ws + WS_MOD); }
    __device__ __forceinline__ bf16* TF() const { return (bf16*)(ws + WS_TF); }
    __device__ __forceinline__ bf16* EM() const { return (bf16*)(ws + WS_E); }
    __device__ __forceinline__ float* TAB() const { return (float*)(ws + WS_TAB); }
    __device__ __forceinline__ f32x2* AGG() const { return (f32x2*)(ws + WS_AGG); }
    __device__ __forceinline__ bf16* XN() const { return (bf16*)(ws + WS_XN); }
    __device__ __forceinline__ bf16* MERGED() const { return (bf16*)(ws + WS_XN); }
    __device__ __forceinline__ float* LRUX() const { return (float*)(ws + WS_LRUX); }
    __device__ __forceinline__ bf16* XN2() const { return (bf16*)(ws + WS_LRUX); }
    __device__ __forceinline__ bf16* GATE() const { return (bf16*)(ws + WS_GATE); }
    __device__ __forceinline__ bf16* S5U() const { return (bf16*)(ws + WS_S5U); }
    __device__ __forceinline__ float* HLOC() const { return (float*)(ws + WS_HLOC); }
    __device__ __forceinline__ float* S5OUT() const { return (float*)(ws + WS_HLOC); }
    __device__ __forceinline__ float* CUM() const { return (float*)(ws + WS_CUM); }
    __device__ __forceinline__ bf16* GY() const { return (bf16*)(ws + WS_GY); }
    __device__ __forceinline__ float* SK() const { return (float*)(ws + WS_SK); }
    __device__ __forceinline__ bf16* HIN() const { return (bf16*)(ws + WS_HIN); }
    __device__ __forceinline__ bf16* HB() const { return (bf16*)(ws + WS_HB); }
};

#define LDS_WAIT() asm volatile("s_waitcnt lgkmcnt(0)" ::: "memory")
__device__ __forceinline__ unsigned pk2(float lo, float hi) { return pg8::cvt_pk_bf16(lo, hi); }
__device__ __forceinline__ float bf2f(unsigned b) { return __uint_as_float(b << 16); }
__device__ __forceinline__ float bflo(unsigned w) { return __uint_as_float(w << 16); }
__device__ __forceinline__ float bfhi(unsigned w) { return __uint_as_float(w & 0xffff0000u); }
__device__ __forceinline__ float wave_sum(float v) {
#pragma unroll
    for (int o = 1; o < 64; o <<= 1) v += __shfl_xor(v, o);
    return v;
}
__device__ __forceinline__ float sigm(float v) { return __builtin_amdgcn_rcpf(1.f + __builtin_amdgcn_exp2f(-1.44269504089f * v)); }
__device__ __forceinline__ float gelu_tanh(float x) { const float u = (-1.5957691216f * 1.44269504089f) * (x + 0.044715f * x * x * x); return x * __builtin_amdgcn_rcpf(1.f + __builtin_amdgcn_exp2f(u)); }
__device__ __forceinline__ int mod_row(int row) { return row < MPR ? (row >> 11) : (NBP + row - MPR); }
__device__ __forceinline__ u32x4 pack8(f32x4 a, f32x4 b) { u32x4 w; w.x = pk2(a[0], a[1]); w.y = pk2(a[2], a[3]); w.z = pk2(b[0], b[1]); w.w = pk2(b[2], b[3]); return w; }

struct EpiProj {
    static constexpr bool PERM = true, AFTER_DRAIN = false; float* lrux; bf16* gate; bf16* s5u;
    __device__ __forceinline__ void operator()(const f32x4 (&acc)[2][2][4][2], const pg8::Unit& u, int wr, int wc, int fr, int fq) const {
        const int colt = u.pn * 256 + wc * 32 + 8 * fq;
#pragma unroll
        for (int ai = 0; ai < 2; ++ai)
#pragma unroll
            for (int m = 0; m < 4; ++m) { const int row = u.pm * 256 + ai * 128 + wr * 64 + m * 16 + fr; if (row >= MTOK) continue;
#pragma unroll
                for (int bj = 0; bj < 2; ++bj) { const int col = colt + bj * 128; const f32x4 v0 = acc[ai][bj][m][0], v1 = acc[ai][bj][m][1];
                    if (u.pn < 2) { float* p = lrux + (size_t)row * 512 + col; *(f32x4*)p = v0; *(f32x4*)(p + 4) = v1; }
                    else if (u.pn < 4) { *(u32x4*)(gate + (size_t)row * 512 + (col - 512)) = pack8(v0, v1); }
                    else { *(u32x4*)(s5u + (size_t)row * 512 + (col - 1024)) = pack8(v0, v1); } } }
    }
};
struct EpiGlu {
    static constexpr bool PERM = true, AFTER_DRAIN = false; float* o;
    __device__ __forceinline__ void operator()(const f32x4 (&acc)[2][2][4][2], const pg8::Unit& u, int wr, int wc, int fr, int fq) const {
        const int col = u.pn * 128 + wc * 32 + 8 * fq;
#pragma unroll
        for (int ai = 0; ai < 2; ++ai)
#pragma unroll
            for (int m = 0; m < 4; ++m) { const int row = u.pm * 256 + ai * 128 + wr * 64 + m * 16 + fr; if (row >= MTOK) continue;
#pragma unroll
                for (int n = 0; n < 2; ++n) { const f32x4 a = acc[ai][0][m][n], b = acc[ai][1][m][n]; f32x4 s;
#pragma unroll
                    for (int i = 0; i < 4; ++i) s[i] = a[i] * sigm(b[i]);
                    *(f32x4*)(o + (size_t)row * 512 + col + 4 * n) = s; } }
    }
};
template <int GOFF> struct EpiRes {
    static constexpr bool PERM = true, AFTER_DRAIN = false; const float* xp; const float* xs; const float* mod; float* out;
    __device__ __forceinline__ void operator()(const f32x4 (&acc)[2][2][4][2], const pg8::Unit& u, int wr, int wc, int fr, int fq) const {
        const int colt = u.pn * 256 + wc * 32 + 8 * fq;
#pragma unroll
        for (int ai = 0; ai < 2; ++ai)
#pragma unroll
            for (int m = 0; m < 4; ++m) { const int row = u.pm * 256 + ai * 128 + wr * 64 + m * 16 + fr; if (row >= MTOK) continue;
                const float* gp = mod + (size_t)mod_row(row) * NMOD + GOFF; float* op = out + (size_t)row * DM;
                const float* bp = xp ? (row < MPR ? xp + (size_t)row * DM : xs + (size_t)(row - MPR) * DM) : op;
#pragma unroll
                for (int bj = 0; bj < 2; ++bj)
#pragma unroll
                    for (int n = 0; n < 2; ++n) { const int c = colt + bj * 128 + 4 * n; const f32x4 x4 = *(const f32x4*)(bp + c), g4 = *(const f32x4*)(gp + c);
                        *(f32x4*)(op + c) = x4 + g4 * acc[ai][bj][m][n]; } }
    }
};
struct EpiSwiglu {
    static constexpr bool PERM = true, AFTER_DRAIN = false; bf16* h;
    __device__ __forceinline__ void operator()(const f32x4 (&acc)[2][2][4][2], const pg8::Unit& u, int wr, int wc, int fr, int fq) const {
        const int col = u.pn * 128 + wc * 32 + 8 * fq;
#pragma unroll
        for (int ai = 0; ai < 2; ++ai)
#pragma unroll
            for (int m = 0; m < 4; ++m) { const int row = u.pm * 256 + ai * 128 + wr * 64 + m * 16 + fr; if (row >= MTOK) continue;
                f32x4 s[2];
#pragma unroll
                for (int n = 0; n < 2; ++n) { const f32x4 a = acc[ai][0][m][n], b = acc[ai][1][m][n];
#pragma unroll
                    for (int i = 0; i < 4; ++i) s[n][i] = a[i] * sigm(a[i]) * b[i]; }
                *(u32x4*)(h + (size_t)row * DFF + col) = pack8(s[0], s[1]); }
    }
};

__device__ __forceinline__ void transpose_item(const float* W, int ldw, int k0, int n0, bf16* WT, int K, int drow0, LAS bf16* scr, int lane) {
    const int lr = lane >> 4, lc = lane & 15;
    f32x4 v[16];
#pragma unroll
    for (int i = 0; i < 16; ++i) v[i] = *(const f32x4*)(W + (size_t)(k0 + lr + 4 * i) * ldw + n0 + 4 * lc);
#pragma unroll
    for (int i = 0; i < 16; ++i) { u32x2 p; p.x = pk2(v[i].x, v[i].y); p.y = pk2(v[i].z, v[i].w); *(LAS u32x2*)(scr + (lr + 4 * i) * 68 + 4 * lc) = p; }
    LDS_WAIT();
    const int kc = lane & 7;
#pragma unroll
    for (int j = 0; j < 8; ++j) { const int n = (lane >> 3) + 8 * j; const LAS bf16* sp = scr + (8 * kc) * 68 + n;
        u32x4 o; o.x = (unsigned)sp[0] | ((unsigned)sp[68] << 16); o.y = (unsigned)sp[2 * 68] | ((unsigned)sp[3 * 68] << 16);
        o.z = (unsigned)sp[4 * 68] | ((unsigned)sp[5 * 68] << 16); o.w = (unsigned)sp[6 * 68] | ((unsigned)sp[7 * 68] << 16);
        *(u32x4*)(WT + (size_t)(drow0 + n) * K + k0 + 8 * kc) = o; }
    LDS_WAIT();
}
__device__ __forceinline__ void transpose_dispatch(const Ctx& cx, int it, LAS bf16* scr, int lane) {
    if (it < 384) { const int kb = it / 24, nb = it % 24; transpose_item(cx.I(11), NPROJ, 64 * kb, 64 * nb, cx.WIN(), DM, 64 * nb, scr, lane); return; } it -= 384;
    if (it < 128) { const int kb = it / 16, nb = it % 16, n0 = 64 * nb; const int dr = 256 * ((n0 & 511) >> 7) + 128 * (n0 >> 9) + (n0 & 127);
        transpose_item(cx.I(27), 1024, 64 * kb, n0, cx.WGLU(), 512, dr, scr, lane); return; } it -= 128;
    if (it < 256) { const int kb = it / 16, nb = it % 16; transpose_item(cx.I(30), DM, 64 * kb, 64 * nb, cx.WOUT(), DM, 64 * nb, scr, lane); return; } it -= 256;
    if (it < 704) { const int kb = it / 44, nb = it % 44, n0 = 64 * nb; transpose_item(cx.I(32), DFF, 64 * kb, n0, cx.WGU(), DM, 256 * (n0 >> 7) + (n0 & 127), scr, lane); return; } it -= 704;
    if (it < 704) { const int kb = it / 44, nb = it % 44, n0 = 64 * nb; transpose_item(cx.I(33), DFF, 64 * kb, n0, cx.WGU(), DM, 256 * (n0 >> 7) + 128 + (n0 & 127), scr, lane); return; } it -= 704;
    { const int kb = it / 16, nb = it % 16; transpose_item(cx.I(34), DM, 64 * kb, 64 * nb, cx.WDN(), DFF, 64 * nb, scr, lane); }
}
constexpr int N_TR_ITEMS = 384 + 128 + 256 + 704 + 704 + 704;

__device__ __forceinline__ void ada_block(const Ctx& cx, int item, LAS unsigned char* lds) {
    const int tid = threadIdx.x, w = __builtin_amdgcn_readfirstlane(tid >> 6), lane = tid & 63, fr = lane & 15, fq = lane >> 4, n0 = 32 * item;
    const float* W = cx.I(8); const float* cp = cx.I(6); const float* cs = cx.I(7);
    bf16x8 wf[4][2];
#pragma unroll
    for (int ks = 0; ks < 4; ++ks)
#pragma unroll
        for (int nt = 0; nt < 2; ++nt) { const float* src = W + (size_t)(128 * w + 32 * ks + 8 * fq) * NMOD + n0 + 16 * nt + fr;
            u32x4 o; o.x = pk2(src[0], src[NMOD]); o.y = pk2(src[2 * NMOD], src[3 * NMOD]); o.z = pk2(src[4 * NMOD], src[5 * NMOD]); o.w = pk2(src[6 * NMOD], src[7 * NMOD]); wf[ks][nt] = __builtin_bit_cast(bf16x8, o); }
    f32x4 acc[9][2];
#pragma unroll
    for (int i = 0; i < 9; ++i) { acc[i][0] = (f32x4){0.f, 0.f, 0.f, 0.f}; acc[i][1] = (f32x4){0.f, 0.f, 0.f, 0.f}; }
#pragma unroll
    for (int mt = 0; mt < 9; ++mt) { int row = 16 * mt + fr; row = row < NBT ? row : NBT - 1;
        const float* src = (row < NBP ? cp + (size_t)row * DM : cs + (size_t)(row - NBP) * DM) + 128 * w + 8 * fq;
#pragma unroll
        for (int ks = 0; ks < 4; ++ks) { f32x4 a0 = *(const f32x4*)(src + 32 * ks), a1 = *(const f32x4*)(src + 32 * ks + 4);
#pragma unroll
            for (int i = 0; i < 4; ++i) { a0[i] = a0[i] * sigm(a0[i]); a1[i] = a1[i] * sigm(a1[i]); }
            const bf16x8 af = __builtin_bit_cast(bf16x8, pack8(a0, a1));
            acc[mt][0] = __builtin_amdgcn_mfma_f32_16x16x32_bf16(wf[ks][0], af, acc[mt][0], 0, 0, 0);
            acc[mt][1] = __builtin_amdgcn_mfma_f32_16x16x32_bf16(wf[ks][1], af, acc[mt][1], 0, 0, 0); } }
    LAS f32x4* red = (LAS f32x4*)lds;
#pragma unroll
    for (int st = 4; st >= 1; st >>= 1) {
        if (w >= st && w < 2 * st) {
#pragma unroll
            for (int i = 0; i < 9; ++i) { red[((w - st) * 18 + 2 * i) * 64 + lane] = acc[i][0]; red[((w - st) * 18 + 2 * i + 1) * 64 + lane] = acc[i][1]; } }
        __syncthreads();
        if (w < st) {
#pragma unroll
            for (int i = 0; i < 9; ++i) { acc[i][0] += red[(w * 18 + 2 * i) * 64 + lane]; acc[i][1] += red[(w * 18 + 2 * i + 1) * 64 + lane]; } }
        __syncthreads();
    }
    if (w == 0) {
#pragma unroll
        for (int nt = 0; nt < 2; ++nt) { const f32x4 b4 = *(const f32x4*)(cx.I(9) + n0 + 16 * nt + 4 * fq);
#pragma unroll
            for (int mt = 0; mt < 9; ++mt) { const int row = 16 * mt + fr; if (row < NBT) *(f32x4*)(cx.MOD() + (size_t)row * NMOD + n0 + 16 * nt + 4 * fq) = acc[mt][nt] + b4; } } }
}

__device__ __forceinline__ void s5_tables(const Ctx& cx, int g, LAS unsigned char* lds) {
    LAS f32x2* Ap = (LAS f32x2*)lds;
    LAS f32x2* Bb = Ap + 17 * 64;
    LAS f32x2* Cc = Bb + 1024;
    LAS f32x2* Ff = Cc + 1024;
    LAS float* Kt = (LAS float*)(Ff + 64);
    const int tid = threadIdx.x;
    float* tab = cx.TAB();
    if (tid < 64) {
        const int n = tid; const float lr = cx.I(19)[g * 64 + n], li = cx.I(20)[g * 64 + n], dt = expf(cx.I(21)[g]);
        const float mag = expf(lr * dt);
        const double ang = (double)li * (double)dt; const double kq = rint(ang * 0.63661977236758134308); const double r = ang - kq * 1.57079632679489661923; const double r2 = r * r;
        const double sn = r * (1.0 + r2 * (-1.0 / 6 + r2 * (1.0 / 120 + r2 * (-1.0 / 5040 + r2 * (1.0 / 362880 + r2 * (-1.0 / 39916800 + r2 * (1.0 / 6227020800.0)))))));
        const double cn = 1.0 + r2 * (-0.5 + r2 * (1.0 / 24 + r2 * (-1.0 / 720 + r2 * (1.0 / 40320 + r2 * (-1.0 / 3628800 + r2 * (1.0 / 479001600.0))))));
        const int q = ((int)kq) & 3; const double cv = q == 0 ? cn : q == 1 ? -sn : q == 2 ? -cn : sn, sv = q == 0 ? sn : q == 1 ? cn : q == 2 ? -sn : -cn;
        const float abr = mag * (float)cv, abi = mag * (float)sv; const float den = lr * lr + li * li;
        const float frr = ((abr - 1.f) * lr + abi * li) / den, fii = (abi * lr - (abr - 1.f) * li) / den;
        f32x2 p = (f32x2){1.f, 0.f}; Ap[n] = p;
#pragma unroll 1
        for (int t = 1; t <= 16; ++t) { const float pr = p.x * abr - p.y * abi, pi = p.x * abi + p.y * abr; p = (f32x2){pr, pi}; Ap[t * 64 + n] = p; }
        Ff[n] = (f32x2){frr, fii};
        ((f32x2*)(tab + T_ABAR))[g * 64 + n] = (f32x2){abr, abi}; ((f32x2*)(tab + T_A16))[g * 64 + n] = p;
    }
    __syncthreads();
    for (int e = tid; e < 1024; e += 512) { const int n = e >> 4; const float br = cx.I(22)[g * 1024 + e], bi = cx.I(23)[g * 1024 + e]; const f32x2 f = Ff[n];
        const float bbr = f.x * br - f.y * bi, bbi = f.x * bi + f.y * br; Bb[e] = (f32x2){bbr, bbi}; tab[T_BBR + g * 1024 + e] = bbr; tab[T_BBI + g * 1024 + e] = bbi;
        Cc[e] = (f32x2){cx.I(24)[g * 1024 + e], cx.I(25)[g * 1024 + e]}; }
    __syncthreads();
    for (int e = tid; e < 4096; e += 512) { const int tau = e >> 8, c = (e >> 4) & 15, cp = e & 15; float sum = 0.f;
        for (int n = 0; n < 64; ++n) { const f32x2 a = Ap[tau * 64 + n], b = Bb[n * 16 + cp], cc = Cc[c * 64 + n];
            const float pr = a.x * b.x - a.y * b.y, pi = a.x * b.y + a.y * b.x; sum += cc.x * pr - cc.y * pi; }
        Kt[e] = sum; }
    __syncthreads();
    bf16* TFg = cx.TF() + (size_t)g * 256 * 384;
    for (int pc = tid; pc < 256 * 48; pc += 512) { const int row = pc / 48, k8 = (pc % 48) * 8, j = row >> 4, c = row & 15; float v[8];
#pragma unroll
        for (int q = 0; q < 8; ++q) { const int kk = k8 + q;
            if (kk < 256) { const int s = kk >> 4, cp = kk & 15; v[q] = (j >= s) ? Kt[((j - s) << 8) + (c << 4) + cp] : 0.f; }
            else { const int n = (kk - 256) & 63; const f32x2 p = Ap[(j + 1) * 64 + n], cc = Cc[c * 64 + n]; v[q] = (kk < 320) ? (cc.x * p.x - cc.y * p.y) : (-cc.x * p.y - cc.y * p.x); } }
        u32x4 o; o.x = pk2(v[0], v[1]); o.y = pk2(v[2], v[3]); o.z = pk2(v[4], v[5]); o.w = pk2(v[6], v[7]);
        *(u32x4*)(TFg + (size_t)row * 384 + k8) = o; }
    bf16* Eg = cx.EM() + (size_t)g * 128 * 256;
    for (int pc = tid; pc < 128 * 32; pc += 512) { const int np = pc >> 5, k8 = (pc & 31) * 8, n = np & 63, im = np >> 6; float v[8];
#pragma unroll
        for (int q = 0; q < 8; ++q) { const int kk = k8 + q, s = kk >> 4, cp = kk & 15; const f32x2 a = Ap[(15 - s) * 64 + n], b = Bb[n * 16 + cp];
            v[q] = im ? (a.x * b.y + a.y * b.x) : (a.x * b.x - a.y * b.y); }
        u32x4 o; o.x = pk2(v[0], v[1]); o.y = pk2(v[2], v[3]); o.z = pk2(v[4], v[5]); o.w = pk2(v[6], v[7]);
        *(u32x4*)(Eg + (size_t)np * 256 + k8) = o; }
    __syncthreads();
}

__device__ __forceinline__ void norm_mod_row(const float* xrow, const float* g, const float* sc, const float* sh, bf16* orow, int lane) {
    f32x4 v[4]; float ss = 0.f;
#pragma unroll
    for (int j = 0; j < 4; ++j) { v[j] = ((const f32x4*)xrow)[lane + 64 * j]; ss += (v[j].x * v[j].x + v[j].y * v[j].y) + (v[j].z * v[j].z + v[j].w * v[j].w); }
    const float rstd = rsqrtf(wave_sum(ss) * (1.f / DM) + EPS);
#pragma unroll
    for (int j = 0; j < 4; ++j) { const int col = 4 * (lane + 64 * j); const f32x4 gg = *(const f32x4*)(g + col), s1 = *(const f32x4*)(sc + col), s2 = *(const f32x4*)(sh + col);
        const f32x4 o = v[j] * rstd * gg * (1.f + s1) + s2; u32x2 w; w.x = pk2(o.x, o.y); w.y = pk2(o.z, o.w); *(u32x2*)(orow + col) = w; }
}

__device__ __forceinline__ void lru_local_unit(const Ctx& cx, int row0, int ntok, bool samp, int aggidx, LAS unsigned char* lds) {
    const int d = threadIdx.x, w = __builtin_amdgcn_readfirstlane(d >> 6), lane = d & 63, fr = lane & 15, fq = lane >> 4;
    LAS float* cf = (LAS float*)(lds + w * 8192);
    LAS bf16* cbf = (LAS bf16*)(lds + w * 8192 + 4608);
    bf16x8 wf[8][2];
#pragma unroll
    for (int nt = 0; nt < 8; ++nt)
#pragma unroll
        for (int ks = 0; ks < 2; ++ks) { const float* src = (nt < 4 ? cx.I(14) : cx.I(16)) + (size_t)w * 4096 + (32 * ks + 8 * fq) * 64 + 16 * (nt & 3) + fr;
            u32x4 o; o.x = pk2(src[0], src[64]); o.y = pk2(src[128], src[192]); o.z = pk2(src[256], src[320]); o.w = pk2(src[384], src[448]); wf[nt][ks] = __builtin_bit_cast(bf16x8, o); }
    const float cw0 = cx.I(12)[d], cw1 = cx.I(12)[512 + d], cw2 = cx.I(12)[1024 + d], cw3 = cx.I(12)[1536 + d], cb = cx.I(13)[d];
    float gba[4], gbx[4], gcd[4], hc[4], cc[4];
#pragma unroll
    for (int nt = 0; nt < 4; ++nt) { const int ch = 64 * w + 16 * nt + fr; gba[nt] = cx.I(15)[ch]; gbx[nt] = cx.I(17)[ch]; gcd[nt] = -8.f * 1.44269504089f * log1pf(expf(-cx.I(18)[ch])); hc[nt] = 0.f; cc[nt] = 1.f; }
    const float* X = cx.LRUX(); float* HL = cx.HLOC(); float* CU = cx.CUM();
    float xm3 = 0.f, xm2 = 0.f, xm1 = 0.f;
    if (!samp) { const int t0 = row0 & (SEQ - 1); if (t0 >= 3) { xm3 = X[(size_t)(row0 - 3) * DL + d]; xm2 = X[(size_t)(row0 - 2) * DL + d]; xm1 = X[(size_t)(row0 - 1) * DL + d]; } }
    float xv[16];
#pragma unroll
    for (int i = 0; i < 16; ++i) xv[i] = X[(size_t)(row0 + i) * DL + d];
    for (int t0 = 0; t0 < ntok; t0 += 16) {
        if (samp) {
#pragma unroll
            for (int i = 0; i < 16; ++i) { const int row = row0 + t0 + i; const float* sc = cx.I(2) + (size_t)(row - MPR) * 1536 + d;
                const float cv = cb + cw0 * sc[0] + cw1 * sc[512] + cw2 * sc[1024] + cw3 * xv[i];
                cf[i * 68 + lane] = cv; cbf[i * 72 + lane] = (bf16)(pk2(cv, cv) & 0xffffu); }
        } else {
#pragma unroll
            for (int i = 0; i < 16; ++i) { const float x = xv[i]; const float cv = cb + cw0 * xm3 + cw1 * xm2 + cw2 * xm1 + cw3 * x; xm3 = xm2; xm2 = xm1; xm1 = x;
                cf[i * 68 + lane] = cv; cbf[i * 72 + lane] = (bf16)(pk2(cv, cv) & 0xffffu); }
        }
        if (t0 + 16 < ntok) {
#pragma unroll
            for (int i = 0; i < 16; ++i) xv[i] = X[(size_t)(row0 + t0 + 16 + i) * DL + d]; }
        LDS_WAIT();
        f32x4 acc[8];
#pragma unroll
        for (int nt = 0; nt < 8; ++nt) acc[nt] = (f32x4){0.f, 0.f, 0.f, 0.f};
#pragma unroll
        for (int ks = 0; ks < 2; ++ks) { const bf16x8 af = *(const LAS bf16x8*)(cbf + fr * 72 + 32 * ks + 8 * fq);
#pragma unroll
            for (int nt = 0; nt < 8; ++nt) acc[nt] = __builtin_amdgcn_mfma_f32_16x16x32_bf16(af, wf[nt][ks], acc[nt], 0, 0, 0); }
#pragma unroll
        for (int nt = 0; nt < 4; ++nt) { const int ch = 64 * w + 16 * nt + fr;
            float av[4], hv[4]; float P = 1.f, H = 0.f;
#pragma unroll
            for (int r = 0; r < 4; ++r) { const int tok = 4 * fq + r; const float cvv = cf[tok * 68 + 16 * nt + fr];
                const float rr = sigm(acc[nt][r] + gba[nt]), ig = sigm(acc[nt + 4][r] + gbx[nt]);
                const float a = __builtin_amdgcn_exp2f(gcd[nt] * rr);
                const float bb = __builtin_amdgcn_sqrtf(fmaf(-a, a, 1.f)) * ig * cvv;
                if (samp) { const float h0 = cx.I(3)[(size_t)(row0 + t0 + tok - MPR) * DL + ch]; hv[r] = a * h0 + bb; av[r] = 0.f; }
                else { H = a * H + bb; P = P * a; hv[r] = H; av[r] = P; } }
            if (!samp) {
                float Pp = __shfl_up(P, 16), Hp = __shfl_up(H, 16); if (fq >= 1) { H = P * Hp + H; P = P * Pp; }
                Pp = __shfl_up(P, 32); Hp = __shfl_up(H, 32); if (fq >= 2) { H = P * Hp + H; P = P * Pp; }
                float Pe = __shfl_up(P, 16), He = __shfl_up(H, 16); if (fq == 0) { Pe = 1.f; He = 0.f; }
                const float hstart = He + Pe * hc[nt], cstart = Pe * cc[nt];
#pragma unroll
                for (int r = 0; r < 4; ++r) { hv[r] = hv[r] + av[r] * hstart; av[r] = av[r] * cstart; }
                const float Pl = __shfl(P, 48 + fr), Hl = __shfl(H, 48 + fr); hc[nt] = Hl + Pl * hc[nt]; cc[nt] = Pl * cc[nt];
            }
#pragma unroll
            for (int r = 0; r < 4; ++r) { const size_t o = (size_t)(row0 + t0 + 4 * fq + r) * DL + ch; HL[o] = hv[r]; CU[o] = av[r]; }
            __builtin_amdgcn_sched_barrier(0);
        }
        LDS_WAIT();
    }
    if (!samp && fq == 0) {
#pragma unroll
        for (int nt = 0; nt < 4; ++nt) cx.AGG()[(size_t)aggidx * DL + 64 * w + 16 * nt + fr] = (f32x2){cc[nt], hc[nt]}; }
}

__device__ __forceinline__ void s5_gemm_e_item(const Ctx& cx, int item, int lane) {
    const int g = item >> 6, rb = item & 63, fr = lane & 15, fq = lane >> 4, cr = rb * 16 + fr;
    const bf16* U = cx.S5U() + (size_t)(16 * cr + (fq >> 1)) * 512 + 16 * g + 8 * (fq & 1); const bf16* Eg = cx.EM() + (size_t)g * 128 * 256 + (size_t)fr * 256 + 8 * fq;
    f32x4 acc[8];
#pragma unroll
    for (int n = 0; n < 8; ++n) acc[n] = (f32x4){0.f, 0.f, 0.f, 0.f};
#pragma unroll 4
    for (int ks = 0; ks < 8; ++ks) {
        const bf16x8 af = *(const bf16x8*)(U + (size_t)(2 * ks) * 512);
#pragma unroll
        for (int nt = 0; nt < 8; ++nt) { const bf16x8 wf = *(const bf16x8*)(Eg + (size_t)(16 * nt) * 256 + 32 * ks); acc[nt] = __builtin_amdgcn_mfma_f32_16x16x32_bf16(wf, af, acc[nt], 0, 0, 0); }
    }
    float* S = cx.SK() + ((size_t)cr * 32 + g) * 128 + 4 * fq;
#pragma unroll
    for (int nt = 0; nt < 8; ++nt) *(f32x4*)(S + 16 * nt) = acc[nt];
}

__device__ __forceinline__ void s5_chain_item(const Ctx& cx, int item, int lane) {
    const int idx = item * 64 + lane, b = idx >> 11, g = (idx >> 6) & 31, n = idx & 63;
    const f32x2 A = ((const f32x2*)(cx.TAB() + T_A16))[g * 64 + n];
    const float* S = cx.SK() + ((size_t)(b * SNCH) * 32 + g) * 128 + n; bf16* H = cx.HIN() + ((size_t)g * SROWS + b * SNCH) * 128 + n;
    float hr = 0.f, hi = 0.f; float s0r[8], s0i[8], s1r[8], s1i[8];
#define CH_LOAD(R, I, K0) do { _Pragma("unroll") for (int i = 0; i < 8; ++i) { R[i] = S[(size_t)((K0) + i) * 4096]; I[i] = S[(size_t)((K0) + i) * 4096 + 64]; } } while (0)
#define CH_STEP(R, I, K0) do { _Pragma("unroll") for (int i = 0; i < 8; ++i) { H[(size_t)((K0) + i) * 128] = (bf16)(pk2(hr, hr) & 0xffffu); H[(size_t)((K0) + i) * 128 + 64] = (bf16)(pk2(hi, hi) & 0xffffu); \
        const float nr = A.x * hr - A.y * hi + R[i], ni = A.x * hi + A.y * hr + I[i]; hr = nr; hi = ni; } } while (0)
    CH_LOAD(s0r, s0i, 0);
    for (int k0 = 0; k0 < SNCH; k0 += 16) { CH_LOAD(s1r, s1i, k0 + 8); CH_STEP(s0r, s0i, k0); if (k0 + 16 < SNCH) CH_LOAD(s0r, s0i, k0 + 16); CH_STEP(s1r, s1i, k0 + 8); }
#undef CH_LOAD
#undef CH_STEP
    cx.out[O_S5RP + (size_t)(b * 32 + g) * 64 + n] = hr; cx.out[O_S5IP + (size_t)(b * 32 + g) * 64 + n] = hi;
}

__device__ __forceinline__ void lru_fix_unit(const Ctx& cx, int row0, int ntok, bool samp, int b, int k, LAS unsigned char* lds) {
    const int d = threadIdx.x, w = d >> 6, lane = d & 63;
    LAS float* hs = (LAS float*)lds;
    float hin = 0.f;
    if (!samp) { const f32x2* ag = cx.AGG() + (size_t)(b * NCH) * DL + d; f32x2 pp[NCH - 1];
#pragma unroll
        for (int kk = 0; kk < NCH - 1; ++kk) pp[kk] = (kk < k) ? ag[(size_t)kk * DL] : (f32x2){1.f, 0.f};
#pragma unroll
        for (int kk = 0; kk < NCH - 1; ++kk) hin = pp[kk].x * hin + pp[kk].y; }
    hs[d] = hin;
    const float* X = cx.LRUX();
    if (!samp && k == NCH - 1) {
#pragma unroll
        for (int j = 0; j < 3; ++j) cx.out[O_CONVP + (size_t)(b * 3 + j) * DL + d] = X[(size_t)(row0 + LCH - 3 + j) * DL + d]; }
    if (samp) { for (int t = 0; t < ntok; ++t) { const int sb = row0 + t - MPR; const float* sc = cx.I(2) + (size_t)sb * 1536 + d; float* o = cx.out + O_CONVS + (size_t)sb * 1536 + d;
            o[0] = sc[512]; o[512] = sc[1024]; o[1024] = X[(size_t)(row0 + t) * DL + d]; } }
    __syncthreads();
    const float* HL = cx.HLOC(); const float* CU = cx.CUM(); const bf16* GT = cx.GATE(); bf16* MG = cx.MERGED(); const float* gl = cx.I(28);
    const f32x4 hi0 = *(const LAS f32x4*)(hs + 8 * lane), hi1 = *(const LAS f32x4*)(hs + 8 * lane + 4);
    const f32x4 g0 = *(const f32x4*)(gl + 8 * lane), g1 = *(const f32x4*)(gl + 8 * lane + 4);
#pragma unroll 4
    for (int t = w; t < ntok; t += 8) { const size_t ro = (size_t)(row0 + t) * DL + 8 * lane;
        const f32x4 a0 = *(const f32x4*)(HL + ro), a1 = *(const f32x4*)(HL + ro + 4), c0 = *(const f32x4*)(CU + ro), c1 = *(const f32x4*)(CU + ro + 4);
        const u32x4 gw = *(const u32x4*)(GT + ro);
        const f32x4 h0 = a0 + c0 * hi0, h1 = a1 + c1 * hi1;
        f32x4 l0, l1;
        l0[0] = h0[0] * gelu_tanh(bflo(gw.x)); l0[1] = h0[1] * gelu_tanh(bfhi(gw.x)); l0[2] = h0[2] * gelu_tanh(bflo(gw.y)); l0[3] = h0[3] * gelu_tanh(bfhi(gw.y));
        l1[0] = h1[0] * gelu_tanh(bflo(gw.z)); l1[1] = h1[1] * gelu_tanh(bfhi(gw.z)); l1[2] = h1[2] * gelu_tanh(bflo(gw.w)); l1[3] = h1[3] * gelu_tanh(bfhi(gw.w));
        float ss = (l0[0] * l0[0] + l0[1] * l0[1]) + (l0[2] * l0[2] + l0[3] * l0[3]) + (l1[0] * l1[0] + l1[1] * l1[1]) + (l1[2] * l1[2] + l1[3] * l1[3]);
        const float rstd = rsqrtf(wave_sum(ss) * (1.f / DL) + EPS);
        *(u32x4*)(MG + (size_t)(row0 + t) * DM + 8 * lane) = pack8(l0 * rstd * g0, l1 * rstd * g1);
        if (samp) { float* o = cx.out + O_LRUS + (size_t)(row0 + t - MPR) * DL + 8 * lane; *(f32x4*)o = h0; *(f32x4*)(o + 4) = h1; }
        else if (k == NCH - 1 && t == LCH - 1) { float* o = cx.out + O_LRUP + (size_t)b * DL + 8 * lane; *(f32x4*)o = h0; *(f32x4*)(o + 4) = h1; }
    }
    __syncthreads();
}

__device__ __forceinline__ void s5_gemm_tf_item(const Ctx& cx, int item, int lane) {
    const int half = item & 1, g = item >> 6, rb = (item >> 1) & 31, fr = lane & 15, fq = lane >> 4;
    const bf16* U = cx.S5U(); const bf16* TFg = cx.TF() + ((size_t)g * 256 + 128 * half) * 384; const bf16* Hg = cx.HIN() + (size_t)g * SROWS * 128;
    f32x4 acc[2][8];
#pragma unroll
    for (int a = 0; a < 2; ++a)
#pragma unroll
        for (int n = 0; n < 8; ++n) acc[a][n] = (f32x4){0.f, 0.f, 0.f, 0.f};
#pragma unroll 2
    for (int ks = 0; ks < 12; ++ks) {
        bf16x8 af[2];
#pragma unroll
        for (int mt = 0; mt < 2; ++mt) { const int cr = rb * 32 + 16 * mt + fr;
            af[mt] = (ks < 8) ? *(const bf16x8*)(U + ((size_t)(16 * cr + 2 * ks + (fq >> 1)) * 512 + 16 * g + 8 * (fq & 1))) : *(const bf16x8*)(Hg + (size_t)cr * 128 + 32 * (ks - 8) + 8 * fq); }
#pragma unroll
        for (int nt = 0; nt < 8; ++nt) { const bf16x8 wf = *(const bf16x8*)(TFg + (size_t)(16 * nt + fr) * 384 + 32 * ks + 8 * fq);
#pragma unroll
            for (int mt = 0; mt < 2; ++mt) acc[mt][nt] = __builtin_amdgcn_mfma_f32_16x16x32_bf16(wf, af[mt], acc[mt][nt], 0, 0, 0); }
    }
    const f32x4 d4 = *(const f32x4*)(cx.I(26) + 16 * g + 4 * fq); bf16* GY = cx.GY();
#pragma unroll
    for (int mt = 0; mt < 2; ++mt) { const int cr = rb * 32 + 16 * mt + fr;
#pragma unroll
        for (int nt = 0; nt < 8; ++nt) { const size_t off = (size_t)(16 * cr + 8 * half + nt) * 512 + 16 * g + 4 * fq; const u32x2 uw = *(const u32x2*)(U + off);
            const f32x4 y = acc[mt][nt] + d4 * (f32x4){bflo(uw.x), bfhi(uw.x), bflo(uw.y), bfhi(uw.y)};
            u32x2 o; o.x = pk2(gelu_tanh(y[0]), gelu_tanh(y[1])); o.y = pk2(gelu_tanh(y[2]), gelu_tanh(y[3])); *(u32x2*)(GY + off) = o; } }
}
__device__ __forceinline__ void s5_sample_item(const Ctx& cx, int item, int lane) {
    const int sb = item >> 5, g = item & 31, n = lane; const int row = MPR + sb;
    const float* tab = cx.TAB(); const f32x2 A = ((const f32x2*)(tab + T_ABAR))[g * 64 + n];
    const float h0r = cx.I(4)[((size_t)sb * 32 + g) * 64 + n], h0i = cx.I(5)[((size_t)sb * 32 + g) * 64 + n];
    const bf16* up = cx.S5U() + (size_t)row * 512 + 16 * g; const u32x4 u0 = *(const u32x4*)up, u1 = *(const u32x4*)(up + 8);
    float uu[16]; uu[0] = bflo(u0.x); uu[1] = bfhi(u0.x); uu[2] = bflo(u0.y); uu[3] = bfhi(u0.y); uu[4] = bflo(u0.z); uu[5] = bfhi(u0.z); uu[6] = bflo(u0.w); uu[7] = bfhi(u0.w);
    uu[8] = bflo(u1.x); uu[9] = bfhi(u1.x); uu[10] = bflo(u1.y); uu[11] = bfhi(u1.y); uu[12] = bflo(u1.z); uu[13] = bfhi(u1.z); uu[14] = bflo(u1.w); uu[15] = bfhi(u1.w);
    float bur = 0.f, bui = 0.f; const float* br = tab + T_BBR + (size_t)(g * 64 + n) * 16; const float* bi = tab + T_BBI + (size_t)(g * 64 + n) * 16;
#pragma unroll
    for (int c4 = 0; c4 < 4; ++c4) { const f32x4 r4 = *(const f32x4*)(br + 4 * c4), i4 = *(const f32x4*)(bi + 4 * c4);
#pragma unroll
        for (int i = 0; i < 4; ++i) { bur += r4[i] * uu[4 * c4 + i]; bui += i4[i] * uu[4 * c4 + i]; } }
    const float hr = A.x * h0r - A.y * h0i + bur, hi = A.x * h0i + A.y * h0r + bui;
    cx.out[O_S5RS + ((size_t)sb * 32 + g) * 64 + n] = hr; cx.out[O_S5IS + ((size_t)sb * 32 + g) * 64 + n] = hi;
    float my = 0.f, myu = 0.f;
#pragma unroll
    for (int c = 0; c < 16; ++c) { const float v = wave_sum(cx.I(24)[((size_t)g * 16 + c) * 64 + n] * hr - cx.I(25)[((size_t)g * 16 + c) * 64 + n] * hi); if (lane == c) { my = v; myu = uu[c]; } }
    if (lane < 16) { const float y = my + cx.I(26)[16 * g + lane] * myu; cx.GY()[(size_t)row * 512 + 16 * g + lane] = (bf16)(pk2(gelu_tanh(y), 0.f) & 0xffffu); }
}

__global__ void __launch_bounds__(512, 2) fwd_kernel(KArgs a) {
    extern __shared__ __attribute__((aligned(16))) unsigned char lds_raw[];
    LAS unsigned char* lds = (LAS unsigned char*)lds_raw;
    cg::grid_group grid = cg::this_grid();
    Ctx cx; cx.in = a.in; cx.out = a.out; cx.ws = a.ws;
    const int tid = threadIdx.x, lane = tid & 63, wave = __builtin_amdgcn_readfirstlane(tid >> 6);
    const int G = gridDim.x, bid = blockIdx.x, gw = bid * 8 + wave, NGW = G * 8;
#ifndef REPMASK
#define REPMASK 0
#endif
#ifndef PHMASK
#define PHMASK 0x1fff
#endif
#define IN(k) (((PHMASK >> (k)) & 1) && a.lo <= (k) && (k) < a.hi)
#define SEAM(k) do { if (IN(k) && IN((k) + 1)) grid.sync(); } while (0)

    if (IN(0)) for (int rep_ = 0; rep_ < 1 + ((REPMASK >> 0) & 1); ++rep_) {
        if (bid < 32 || G < 64) { for (int g = bid; g < 32; g += G) s5_tables(cx, g, lds); }
        const int nb2 = G >= 64 ? G - 32 : G, b2 = G >= 64 ? bid - 32 : bid;
        if (b2 >= 0) {
            for (int it = b2; it < 192; it += nb2) ada_block(cx, it, lds);
            LAS bf16* scr = (LAS bf16*)(lds + wave * 16384);
            for (int it = (nb2 - 1 - b2) * 8 + wave; it < N_TR_ITEMS; it += nb2 * 8) transpose_dispatch(cx, it, scr, lane);
        }
    }
    SEAM(0);
    if (IN(1)) for (int rep_ = 0; rep_ < 1 + ((REPMASK >> 1) & 1); ++rep_) {
        for (int r = gw; r < MTOK; r += NGW) { const float* xr = r < MPR ? cx.I(0) + (size_t)r * DM : cx.I(1) + (size_t)(r - MPR) * DM; const float* md = cx.MOD() + (size_t)mod_row(r) * NMOD;
            norm_mod_row(xr, cx.I(10), md + 1024, md, cx.XN() + (size_t)r * DM, lane); }
    }
    SEAM(1);
    if (IN(2)) for (int rep_ = 0; rep_ < 1 + ((REPMASK >> 2) & 1); ++rep_) {
        pg8::Gemm g{cx.XN(), cx.WIN(), MPAD, NPROJ, DM}; pg8::StaticOrder S; S.init(MPAD, NPROJ, G, bid);
        EpiProj E{cx.LRUX(), cx.GATE(), cx.S5U()};
        pg8::gemm_phase<EpiProj, pg8::StaticOrder, true, true>(lds, g, S, E);
    }
    SEAM(2);
    if (IN(3)) for (int rep_ = 0; rep_ < 1 + ((REPMASK >> 3) & 1); ++rep_) {
#ifndef NO_LRU
        for (int q_ = 0; q_ < 1 + ((REPMASK >> 13) & 1); ++q_)
        for (int u = bid; u < 256 + NBS / SCH; u += G) {
            if (u < 256) lru_local_unit(cx, u * LCH, LCH, false, u, lds); else lru_local_unit(cx, MPR + (u - 256) * SCH, SCH, true, 0, lds);
        }
#endif
#ifndef NO_E
        for (int q_ = 0; q_ < 1 + ((REPMASK >> 14) & 1); ++q_)
        for (int it = gw; it < 2048; it += NGW) s5_gemm_e_item(cx, it, lane);
#endif
    }
    SEAM(3);
    if (IN(4)) for (int rep_ = 0; rep_ < 1 + ((REPMASK >> 4) & 1); ++rep_) {
        if (wave == 0) { for (int it = bid; it < 256; it += G) s5_chain_item(cx, it, lane); }
        for (int u = bid; u < 256 + NBS / SCH; u += G) {
            if (u < 256) lru_fix_unit(cx, u * LCH, LCH, false, u >> 5, u & 31, lds); else lru_fix_unit(cx, MPR + (u - 256) * SCH, SCH, true, 0, 0, lds);
        }
    }
    SEAM(4);
    if (IN(5)) for (int rep_ = 0; rep_ < 1 + ((REPMASK >> 5) & 1); ++rep_) {
        for (int it = gw; it < 2048; it += NGW) s5_gemm_tf_item(cx, it, lane);
        for (int it = gw; it < NBS * 32; it += NGW) s5_sample_item(cx, it, lane);
    }
    SEAM(5);
    if (IN(6)) for (int rep_ = 0; rep_ < 1 + ((REPMASK >> 6) & 1); ++rep_) {
        pg8::Gemm g{cx.GY(), cx.WGLU(), MPAD, 1024, 512}; pg8::StaticOrder S; S.init(MPAD, 1024, G, bid);
        EpiGlu E{cx.S5OUT()};
        pg8::gemm_phase<EpiGlu, pg8::StaticOrder, true, true>(lds, g, S, E);
    }
    SEAM(6);
    if (IN(7)) for (int rep_ = 0; rep_ < 1 + ((REPMASK >> 7) & 1); ++rep_) {
        const float* gs = cx.I(29);
        for (int r = gw; r < MTOK; r += NGW) { const float* sr = cx.S5OUT() + (size_t)r * 512;
            const f32x4 v0 = ((const f32x4*)sr)[lane], v1 = ((const f32x4*)sr)[lane + 64];
            const float ss = (v0.x * v0.x + v0.y * v0.y) + (v0.z * v0.z + v0.w * v0.w) + (v1.x * v1.x + v1.y * v1.y) + (v1.z * v1.z + v1.w * v1.w);
            const float rstd = rsqrtf(wave_sum(ss) * (1.f / 512) + EPS);
            const f32x4 o0 = v0 * rstd * ((const f32x4*)gs)[lane], o1 = v1 * rstd * ((const f32x4*)gs)[lane + 64];
            bf16* mp = cx.MERGED() + (size_t)r * DM + 512; u32x2 w0, w1; w0.x = pk2(o0.x, o0.y); w0.y = pk2(o0.z, o0.w); w1.x = pk2(o1.x, o1.y); w1.y = pk2(o1.z, o1.w);
            *(u32x2*)(mp + 4 * lane) = w0; *(u32x2*)(mp + 256 + 4 * lane) = w1; }
    }
    SEAM(7);
    if (IN(8)) for (int rep_ = 0; rep_ < 1 + ((REPMASK >> 8) & 1); ++rep_) {
        pg8::Gemm g{cx.MERGED(), cx.WOUT(), MPAD, DM, DM}; pg8::StaticOrder S; S.init(MPAD, DM, G, bid);
        EpiRes<2048> E{cx.I(0), cx.I(1), cx.MOD(), cx.out};
        pg8::gemm_phase<EpiRes<2048>, pg8::StaticOrder, true, true>(lds, g, S, E);
    }
    SEAM(8);
    if (IN(9)) for (int rep_ = 0; rep_ < 1 + ((REPMASK >> 9) & 1); ++rep_) {
        for (int r = gw; r < MTOK; r += NGW) { const float* md = cx.MOD() + (size_t)mod_row(r) * NMOD;
            norm_mod_row(cx.out + (size_t)r * DM, cx.I(31), md + 4096, md + 3072, cx.XN2() + (size_t)r * DM, lane); }
    }
    SEAM(9);
    if (IN(10)) for (int rep_ = 0; rep_ < 1 + ((REPMASK >> 10) & 1); ++rep_) {
        pg8::Gemm g{cx.XN2(), cx.WGU(), MPAD, 2 * DFF, DM}; pg8::StaticOrder S; S.init(MPAD, 2 * DFF, G, bid);
        EpiSwiglu E{cx.HB()};
        pg8::gemm_phase<EpiSwiglu, pg8::StaticOrder, true, true>(lds, g, S, E);
    }
    SEAM(10);
    if (IN(11)) for (int rep_ = 0; rep_ < 1 + ((REPMASK >> 11) & 1); ++rep_) {
        pg8::Gemm g{cx.HB(), cx.WDN(), MPAD, DM, DFF}; pg8::StaticOrder S; S.init(MPAD, DM, G, bid);
        EpiRes<5120> E{nullptr, nullptr, cx.MOD(), cx.out};
        pg8::gemm_phase<EpiRes<5120>, pg8::StaticOrder, true, true>(lds, g, S, E);
    }
    SEAM(11);
    if (IN(12)) for (int rep_ = 0; rep_ < 1 + ((REPMASK >> 12) & 1); ++rep_) {
        const float* fg = cx.I(35);
        for (int r = gw; r < MTOK; r += NGW) { float* xr = cx.out + (size_t)r * DM; f32x4 v[4]; float ss = 0.f;
#pragma unroll
            for (int j = 0; j < 4; ++j) { v[j] = ((const f32x4*)xr)[lane + 64 * j]; ss += (v[j].x * v[j].x + v[j].y * v[j].y) + (v[j].z * v[j].z + v[j].w * v[j].w); }
            const float rstd = rsqrtf(wave_sum(ss) * (1.f / DM) + EPS);
#pragma unroll
            for (int j = 0; j < 4; ++j) ((f32x4*)xr)[lane + 64 * j] = v[j] * rstd * ((const f32x4*)fg)[lane + 64 * j]; }
    }
#undef IN
#undef SEAM
}

constexpr int LDS_BYTES = 131072;
#ifndef MK_SINGLE
#define MK_SINGLE 1
#endif
extern "C" void kernel_launch(void* const* d_in, const int* in_sizes, int n_in, void* d_out, int out_size, void* d_ws, size_t ws_size, hipStream_t stream) {
    static int grid = 0;
    if (grid == 0) {
        if (n_in != 36 || (size_t)out_size != O_END || ws_size < WS_END) { fprintf(stderr, "kernel_launch: unexpected shapes n_in %d out %d ws %zu\n", n_in, out_size, ws_size); grid = -1; return; }
        int dev = 0, cus = 0, per_cu = 0;
        hipGetDevice(&dev); hipDeviceGetAttribute(&cus, hipDeviceAttributeMultiprocessorCount, dev);
        hipFuncSetAttribute((const void*)fwd_kernel, hipFuncAttributeMaxDynamicSharedMemorySize, LDS_BYTES);
        hipOccupancyMaxActiveBlocksPerMultiprocessor(&per_cu, (const void*)fwd_kernel, 512, LDS_BYTES);
        if (per_cu < 1) { fprintf(stderr, "kernel_launch: occupancy query says %d blocks per CU\n", per_cu); grid = -1; return; }
        grid = cus;
    }
    if (grid < 0) return;
    KArgs a{};
    for (int i = 0; i < 36; ++i) a.in[i] = (const float*)d_in[i];
    a.out = (float*)d_out; a.ws = (unsigned char*)d_ws;
#if MK_SINGLE
    a.lo = 0; a.hi = NPHASE;
    void* args[] = {&a};
    hipError_t e = hipLaunchCooperativeKernel((const void*)fwd_kernel, dim3(grid), dim3(512), args, LDS_BYTES, stream);
    if (e != hipSuccess) fprintf(stderr, "cooperative launch failed: %s (grid %d)\n", hipGetErrorString(e), grid);
#else
    for (int p = 0; p < NPHASE; ++p) { a.lo = p; a.hi = p + 1; hipLaunchKernelGGL(fwd_kernel, dim3(grid), dim3(512), LDS_BYTES, stream, a); }
#endif
}
```

```cpp
#include <hip/hip_runtime.h>
#include <hip/hip_cooperative_groups.h>
#include <cstdio>
#include <cstdint>
namespace cg = cooperative_groups;
namespace pg8 {
#define PG8_LAS __attribute__((address_space(3)))
typedef unsigned short bf16_t;
typedef short bf16x8 __attribute__((ext_vector_type(8)));
typedef float f32x4 __attribute__((ext_vector_type(4)));
typedef unsigned u32x4 __attribute__((ext_vector_type(4)));
constexpr int BM = 256, BK = 64, HALF = 128, HTB = HALF * BK * 2  , STAGE_BYTES = 8 * HTB, NXCD = 8, WGM = 8;

__host__ __device__ __forceinline__ int lds_byte(int r, int c) { const int st = (r >> 4) * 2 + (c >> 5), rr = r & 15, cc = c & 31, ob = rr * 64 + cc * 2; return st * 1024 + (ob ^ (((ob >> 9) & 1) << 5)); }
__host__ __device__ __forceinline__ void stage_rc(int b, int& R, int& C) { const int st = b / 1024, sb = b % 1024, swz = sb ^ (((sb >> 9) & 1) << 5); R = (st >> 1) * 16 + swz / 64; C = (st & 1) * 32 + (swz % 64) / 2; }
__host__ __device__ __forceinline__ int perm32(int rho) { const int n = rho >> 4, i = rho & 15; return 8 * (i >> 2) + 4 * n + (i & 3); }

struct Unit { int pm, pn, kt0, nkt, kind, slice; };
struct Gemm { const bf16_t* A; const bf16_t* Bt; int M, N, K; };

struct StaticOrder {
    int nM, nN, nwg, G, c;
    __host__ __device__ __forceinline__ void init(int M, int N, int G_, int c_) { nM = M / BM; nN = N / BM; nwg = nM * nN; G = G_; c = c_; }
    __host__ __device__ __forceinline__ bool next(int i, Unit& u) const {
        const long L = (long)i * G + c; if (L >= nwg) return false;
        int wgid = (int)L; { const int q = nwg / NXCD, r = nwg % NXCD, xcd = wgid % NXCD, off = wgid / NXCD; wgid = (xcd < r ? xcd * (q + 1) : r * (q + 1) + (xcd - r) * q) + off; }
        const int nig = WGM * nN, gid = wgid / nig, fm = gid * WGM, gsz = (nM - fm) < WGM ? (nM - fm) : WGM;
        u.pm = fm + ((wgid % nig) % gsz); u.pn = (wgid % nig) / gsz; return true;
    }
    __device__ __forceinline__ void a_ready(const Unit&) const {}
    __device__ __forceinline__ void done(const Unit&) const {}
};

__device__ __forceinline__ unsigned cvt_pk_bf16(float lo, float hi) { unsigned r; asm volatile("v_cvt_pk_bf16_f32 %0, %1, %2" : "=v"(r) : "v"(lo), "v"(hi)); return r; }
typedef float f32x2 __attribute__((ext_vector_type(2)));
template <class Epi, class Sched, bool ALIGN_EPI = false, bool SP2 = false>
__device__ __forceinline__ void gemm_phase(PG8_LAS unsigned char* lds, const Gemm g, const Sched& S, const Epi& E) {
    const int tid = threadIdx.x, wid = __builtin_amdgcn_readfirstlane(tid >> 6), lane = tid & 63, wr = wid >> 2, wc = wid & 3, fr = lane & 15, fq = lane >> 4;
    const int K = g.K;
    unsigned voffA[2], voffB[2];
#pragma unroll
    for (int i = 0; i < 2; ++i) { int R, C; stage_rc(tid * 16 + i * 8192, R, C); const int Rb = Epi::PERM ? ((R & ~31) + perm32(R & 31)) : R;
        voffA[i] = (unsigned)(R * K + C) * 2u; voffB[i] = (unsigned)(Rb * K + C) * 2u; }
    const size_t kstep = (size_t)(BK * 2);
    const size_t hstep = (size_t)HALF * K * 2;
    const size_t tstep = 2 * hstep;
    const unsigned ldsw = (unsigned)wid * 1024u;
    const int aoff = lds_byte(wr * 64 + fr, fq * 8), boff = lds_byte(wc * 32 + fr, fq * 8);
#define PG8_SA(b, h) (((b) * 2 + (h)) * HTB)
#define PG8_SB(b, h) ((4 + (b) * 2 + (h)) * HTB)
#define PG8_STAGE(bufoff, gbase, voff) do { _Pragma("unroll") for (int _i = 0; _i < 2; ++_i) \
        __builtin_amdgcn_global_load_lds((const unsigned*)((const char*)(gbase) + (voff)[_i]), (PG8_LAS unsigned*)(lds + (bufoff) + ldsw + _i * 8192), 16, 0, 0); } while (0)
#define PG8_LDA(dst, b, h) do { _Pragma("unroll") for (int m = 0; m < 4; ++m) _Pragma("unroll") for (int k = 0; k < 2; ++k) dst[m][k] = *(const PG8_LAS bf16x8*)(lds + PG8_SA(b, h) + aoff + m * 2048 + k * 1024); } while (0)
#define PG8_LDB(dst, b, h) do { _Pragma("unroll") for (int n = 0; n < 2; ++n) _Pragma("unroll") for (int k = 0; k < 2; ++k) dst[n][k] = *(const PG8_LAS bf16x8*)(lds + PG8_SB(b, h) + boff + n * 2048 + k * 1024); } while (0)
#define PG8_MMA(ai, bj, At, Bt) do { __builtin_amdgcn_s_setprio(1); _Pragma("unroll") for (int m = 0; m < 4; ++m) _Pragma("unroll") for (int n = 0; n < 2; ++n) _Pragma("unroll") for (int k = 0; k < 2; ++k) \
        acc[ai][bj][m][n] = __builtin_amdgcn_mfma_f32_16x16x32_bf16(Bt[n][k], At[m][k], acc[ai][bj][m][n], 0, 0, 0); __builtin_amdgcn_s_setprio(0); } while (0)
#define PG8_WAIT_V(n) asm volatile("s_waitcnt vmcnt(" #n ")" ::: "memory")
#define PG8_WAIT_L(n) asm volatile("s_waitcnt lgkmcnt(" #n ")" ::: "memory")
#define PG8_BAR __builtin_amdgcn_s_barrier()
#define PG8_SCHED __builtin_amdgcn_sched_barrier(0)
    Unit cur = {0, 0, 0, 0, 0, 0}, nxt = {0, 0, 0, 0, 0, 0}; int ui = 0;
    if (!S.next(0, cur)) return;
    f32x4 acc[2][2][4][2];
#pragma unroll
    for (int a = 0; a < 2; ++a)
#pragma unroll
        for (int b = 0; b < 2; ++b)
#pragma unroll
            for (int m = 0; m < 4; ++m)
#pragma unroll
                for (int n = 0; n < 2; ++n) acc[a][b][m][n] = (f32x4){0.f, 0.f, 0.f, 0.f};
    bf16x8 At[4][2], B0[2][2], B1[2][2];
    const char* cA = (const char*)g.A + (size_t)cur.pm * tstep + (size_t)cur.kt0 * kstep; const char* cB = (const char*)g.Bt + (size_t)cur.pn * tstep + (size_t)cur.kt0 * kstep;
    S.a_ready(cur);
    if constexpr (SP2) {
        PG8_STAGE(PG8_SB(0, 0), cB, voffB); PG8_STAGE(PG8_SB(0, 1), cB + hstep, voffB); PG8_STAGE(PG8_SA(0, 0), cA, voffA); PG8_STAGE(PG8_SA(0, 1), cA + hstep, voffA);
        if (wr == 1) PG8_BAR;
        PG8_WAIT_V(2); PG8_BAR;
        PG8_STAGE(PG8_SB(1, 0), cB + kstep, voffB); PG8_STAGE(PG8_SA(1, 0), cA + kstep, voffA); PG8_STAGE(PG8_SB(1, 1), cB + hstep + kstep, voffB);
        PG8_WAIT_V(6); PG8_BAR;
    } else {
        PG8_STAGE(PG8_SB(0, 0), cB, voffB); PG8_STAGE(PG8_SA(0, 0), cA, voffA); PG8_STAGE(PG8_SB(0, 1), cB + hstep, voffB); PG8_STAGE(PG8_SA(0, 1), cA + hstep, voffA);
        if (wr == 1) PG8_BAR;
        PG8_WAIT_V(4); PG8_BAR;
        PG8_STAGE(PG8_SB(1, 0), cB + kstep, voffB); PG8_STAGE(PG8_SA(1, 0), cA + kstep, voffA); PG8_STAGE(PG8_SB(1, 1), cB + hstep + kstep, voffB);
        PG8_WAIT_V(6); PG8_BAR;
    }
    for (;;) {
        const bool has_next = S.next(ui + 1, nxt);
        const char* nA = has_next ? (const char*)g.A + (size_t)nxt.pm * tstep + (size_t)nxt.kt0 * kstep : cA; const char* nB = has_next ? (const char*)g.Bt + (size_t)nxt.pn * tstep + (size_t)nxt.kt0 * kstep : cB;
        const int nt = cur.nkt;
        for (int t = 0; t < nt; t += 2) {
            const bool last = (t == nt - 2);
            const char* a1 = cA + (size_t)(t + 1) * kstep;
            const char* a2 = last ? nA : cA + (size_t)(t + 2) * kstep; const char* b2 = last ? nB : cB + (size_t)(t + 2) * kstep;
            const char* a3 = a2 + kstep; const char* b3 = b2 + kstep;
            if (last && has_next) S.a_ready(nxt);
            if constexpr (SP2) {
            PG8_LDB(B0, 0, 0); PG8_LDB(B1, 0, 1); PG8_SCHED; PG8_LDA(At, 0, 0); PG8_STAGE(PG8_SA(1, 1), a1 + hstep, voffA);
            PG8_WAIT_V(8); PG8_WAIT_L(0); PG8_BAR; PG8_MMA(0, 0, At, B0); PG8_MMA(0, 1, At, B1); PG8_BAR; PG8_SCHED;
            PG8_LDA(At, 0, 1); PG8_STAGE(PG8_SB(0, 0), b2, voffB); PG8_STAGE(PG8_SB(0, 1), b2 + hstep, voffB); PG8_STAGE(PG8_SA(0, 0), a2, voffA);
            PG8_WAIT_V(8); PG8_WAIT_L(0); PG8_BAR; PG8_MMA(1, 0, At, B0); PG8_MMA(1, 1, At, B1); PG8_BAR; PG8_SCHED;
            PG8_LDB(B0, 1, 0); PG8_LDB(B1, 1, 1); PG8_SCHED; PG8_LDA(At, 1, 0); PG8_STAGE(PG8_SA(0, 1), a2 + hstep, voffA);
            PG8_WAIT_V(8); PG8_WAIT_L(0); PG8_BAR; PG8_MMA(0, 0, At, B0); PG8_MMA(0, 1, At, B1); PG8_BAR; PG8_SCHED;
            PG8_LDA(At, 1, 1); PG8_STAGE(PG8_SB(1, 0), b3, voffB); PG8_STAGE(PG8_SB(1, 1), b3 + hstep, voffB); PG8_STAGE(PG8_SA(1, 0), a3, voffA);
            PG8_WAIT_V(8); PG8_WAIT_L(0); PG8_BAR; PG8_MMA(1, 0, At, B0); PG8_MMA(1, 1, At, B1); PG8_BAR; PG8_SCHED;
            } else {
            PG8_LDB(B0, 0, 0); PG8_SCHED; PG8_LDA(At, 0, 0); PG8_STAGE(PG8_SA(1, 1), a1 + hstep, voffA);
            PG8_WAIT_L(8); PG8_BAR; PG8_WAIT_L(0); PG8_MMA(0, 0, At, B0); PG8_BAR; PG8_SCHED;
            PG8_LDB(B1, 0, 1); PG8_STAGE(PG8_SB(0, 0), b2, voffB);
            PG8_BAR; PG8_WAIT_L(0); PG8_MMA(0, 1, At, B1); PG8_BAR;
            PG8_LDA(At, 0, 1); PG8_STAGE(PG8_SA(0, 0), a2, voffA);
            PG8_BAR; PG8_WAIT_L(0); PG8_MMA(1, 0, At, B0); PG8_BAR; PG8_SCHED;
            PG8_STAGE(PG8_SB(0, 1), b2 + hstep, voffB);
            PG8_WAIT_V(6); PG8_BAR; PG8_MMA(1, 1, At, B1); PG8_BAR;
            PG8_LDB(B0, 1, 0); PG8_SCHED; PG8_LDA(At, 1, 0); PG8_STAGE(PG8_SA(0, 1), a2 + hstep, voffA);
            PG8_WAIT_L(8); PG8_BAR; PG8_WAIT_L(0); PG8_MMA(0, 0, At, B0); PG8_BAR; PG8_SCHED;
            PG8_LDB(B1, 1, 1); PG8_STAGE(PG8_SB(1, 0), b3, voffB);
            PG8_BAR; PG8_WAIT_L(0); PG8_MMA(0, 1, At, B1); PG8_BAR;
            PG8_LDA(At, 1, 1); PG8_STAGE(PG8_SA(1, 0), a3, voffA);
            PG8_BAR; PG8_WAIT_L(0); PG8_MMA(1, 0, At, B0); PG8_BAR; PG8_SCHED;
            PG8_STAGE(PG8_SB(1, 1), b3 + hstep, voffB);
            PG8_WAIT_V(6); PG8_BAR; PG8_MMA(1, 1, At, B1); PG8_BAR;
            }
        }
        if constexpr (ALIGN_EPI) { if (wr == 0) PG8_BAR; }
        if constexpr (!Epi::AFTER_DRAIN) { E(acc, cur, wr, wc, fr, fq); S.done(cur); }
        if (!has_next) break;
#pragma unroll
        for (int a = 0; a < 2; ++a)
#pragma unroll
            for (int b = 0; b < 2; ++b)
#pragma unroll
                for (int m = 0; m < 4; ++m)
#pragma unroll
                    for (int n = 0; n < 2; ++n) acc[a][b][m][n] = (f32x4){0.f, 0.f, 0.f, 0.f};
        cur = nxt; cA = nA; cB = nB; ++ui;
        if constexpr (ALIGN_EPI) { if (wr == 1) PG8_BAR; }
    }
    PG8_WAIT_V(0);
    if constexpr (!ALIGN_EPI) { if (wr == 0) PG8_BAR; }
    PG8_BAR;
    if constexpr (Epi::AFTER_DRAIN) { E.fused(acc, cur, wr, wc, fr, fq, lds, wid, lane); S.done(cur); }
#undef PG8_SA
#undef PG8_SB
#undef PG8_STAGE
#undef PG8_LDA
#undef PG8_LDB
#undef PG8_MMA
#undef PG8_WAIT_V
#undef PG8_WAIT_L
#undef PG8_BAR
#undef PG8_SCHED
}
}

#define LAS __attribute__((address_space(3)))
typedef unsigned short bf16;
typedef float f32x4 __attribute__((ext_vector_type(4)));
typedef float f32x2 __attribute__((ext_vector_type(2)));
typedef short bf16x8 __attribute__((ext_vector_type(8)));
typedef unsigned u32x4 __attribute__((ext_vector_type(4)));
typedef unsigned u32x2 __attribute__((ext_vector_type(2)));

constexpr int DM = 1024, NBP = 8, SEQ = 2048, MPR = NBP * SEQ, NBS = 128, MTOK = MPR + NBS, MPAD = 16640;
constexpr int DL = 512, NPROJ = 1536, NMOD = 6144, NBT = NBP + NBS, DFF = 2816;
constexpr int LCH = 64, NCH = SEQ / LCH;
constexpr int SCH = 16;
constexpr int SL = 16, SNCH = SEQ / SL, SROWS = NBP * SNCH;
constexpr float EPS = 1e-6f;
constexpr int NPHASE = 13;

constexpr size_t O_Y = 0, O_CONVP = (size_t)MTOK * DM, O_LRUP = O_CONVP + 8 * 3 * 512, O_S5RP = O_LRUP + 8 * 512, O_S5IP = O_S5RP + 8 * 32 * 64,
                 O_CONVS = O_S5IP + 8 * 32 * 64, O_LRUS = O_CONVS + 128 * 3 * 512, O_S5RS = O_LRUS + 128 * 512, O_S5IS = O_S5RS + 128 * 32 * 64, O_END = O_S5IS + 128 * 32 * 64;

constexpr size_t HM = 1u << 19;
constexpr size_t WS_WIN = 2 * HM, WS_WGLU = 8 * HM, WS_WOUT = 10 * HM, WS_WGU = 14 * HM, WS_WDN = 36 * HM  , WS_MOD = 48 * HM  ,
                 WS_TF = 56 * HM  , WS_E = 68 * HM  , WS_TAB = 72 * HM, WS_AGG = 74 * HM  ,
                 WS_XN = 80 * HM  , WS_LRUX = 146 * HM  , WS_GATE = 211 * HM  ,
                 WS_S5U = 244 * HM  , WS_HLOC = 277 * HM  , WS_CUM = 342 * HM, WS_GY = 407 * HM  ,
                 WS_SK = 440 * HM  , WS_HIN = 472 * HM  , WS_HB = 244 * HM  , WS_PART = 488 * HM  , WS_END = 512 * HM;
constexpr size_t T_ABAR = 0, T_A16 = 4096, T_BBR = 8192, T_BBI = 8192 + 32768;

struct KArgs { const float* in[36]; float* out; unsigned char* ws; int lo, hi; };

struct Ctx {
    const float* const* in; float* out; unsigned char* ws;
    __device__ __forceinline__ const float* I(int i) const { return in[i]; }
    __device__ __forceinline__ bf16* WIN() const { return (bf16*)(ws + WS_WIN); }
    __device__ __forceinline__ bf16* WGLU() const { return (bf16*)(ws + WS_WGLU); }
    __device__ __forceinline__ bf16* WOUT() const { return (bf16*)(ws + WS_WOUT); }
    __device__ __forceinline__ bf16* WGU() const { return (bf16*)(ws + WS_WGU); }
    __device__ __forceinline__ bf16* WDN() const { return (bf16*)(ws + WS_WDN); }
    __device__ __forceinline__ float* MOD() const { return (float*)(ws + WS_MOD); }
    __device__ __forceinline__ bf16* TF() const { return (bf16*)(ws + WS_TF); }
    __device__ __forceinline__ bf16* EM() const { return (bf16*)(ws + WS_E); }
    __device__ __forceinline__ float* TAB() const { return (float*)(ws + WS_TAB); }
    __device__ __forceinline__ f32x2* AGG() const { return (f32x2*)(ws + WS_AGG); }
    __device__ __forceinline__ bf16* XN() const { return (bf16*)(ws + WS_XN); }
    __device__ __forceinline__ bf16* MERGED() const { return (bf16*)(ws + WS_XN); }
    __device__ __forceinline__ float* LRUX() const { return (float*)(ws + WS_LRUX); }
    __device__ __forceinline__ bf16* XN2() const { return (bf16*)(ws + WS_LRUX); }
    __device__ __forceinline__ bf16* GATE() const { return (bf16*)(ws + WS_GATE); }
    __device__ __forceinline__ bf16* S5U() const { return (bf16*)(ws + WS_S5U); }
    __device__ __forceinline__ float* HLOC() const { return (float*)(ws + WS_HLOC); }
    __device__ __forceinline__ float* S5OUT() const { return (float*)(ws + WS_HLOC); }
    __device__ __forceinline__ float* CUM() const { return (float*)(ws + WS_CUM); }
    __device__ __forceinline__ bf16* GY() const { return (bf16*)(ws + WS_GY); }
    __device__ __forceinline__ float* SK() const { return (float*)(ws + WS_SK); }
    __device__ __forceinline__ bf16* HIN() const { return (bf16*)(ws + WS_HIN); }
    __device__ __forceinline__ bf16* HB() const { return (bf16*)(ws + WS_HB); }
    __device__ __forceinline__ float* PART() const { return (float*)(ws + WS_PART); }
};

#define LDS_WAIT() asm volatile("s_waitcnt lgkmcnt(0)" ::: "memory")
__device__ __forceinline__ unsigned pk2(float lo, float hi) { return pg8::cvt_pk_bf16(lo, hi); }
__device__ __forceinline__ float bf2f(unsigned b) { return __uint_as_float(b << 16); }
__device__ __forceinline__ float bflo(unsigned w) { return __uint_as_float(w << 16); }
__device__ __forceinline__ float bfhi(unsigned w) { return __uint_as_float(w & 0xffff0000u); }
__device__ __forceinline__ float wave_sum(float v) {
#pragma unroll
    for (int o = 1; o < 64; o <<= 1) v += __shfl_xor(v, o);
    return v;
}
__device__ __forceinline__ float sigm(float v) { return __builtin_amdgcn_rcpf(1.f + __builtin_amdgcn_exp2f(-1.44269504089f * v)); }
__device__ __forceinline__ float gelu_tanh(float x) { const float u = (-1.5957691216f * 1.44269504089f) * (x + 0.044715f * x * x * x); return x * __builtin_amdgcn_rcpf(1.f + __builtin_amdgcn_exp2f(u)); }
__device__ __forceinline__ int mod_row(int row) { return row < MPR ? (row >> 11) : (NBP + row - MPR); }
__device__ __forceinline__ u32x4 pack8(f32x4 a, f32x4 b) { u32x4 w; w.x = pk2(a[0], a[1]); w.y = pk2(a[2], a[3]); w.z = pk2(b[0], b[1]); w.w = pk2(b[2], b[3]); return w; }

struct Sched2 {
    pg8::StaticOrder so; int nkt_full, n_extra, ex_nn, ex_nkt;
    __device__ __forceinline__ void init(int N, int K, int G, int c, int ex_nkt_) { so.init(MPR, N, G, c); nkt_full = K / 64; ex_nn = N / 256; ex_nkt = ex_nkt_; n_extra = ex_nn * (nkt_full / ex_nkt_); }
    __device__ __forceinline__ bool next(int i, pg8::Unit& u) const {
        const long L = (long)i * so.G + so.c;
        const bool prompt = L < so.nwg; const int e = (int)(L - so.nwg);
        if (!prompt && e >= n_extra) return false;
        pg8::Unit t; t.pm = 0; t.pn = 0; t.kt0 = 0; t.nkt = 0; t.kind = 0; t.slice = 0;
        if (prompt) so.next(i, t);
        const int sl = prompt ? 0 : e / ex_nn;
        pg8::Unit r; r.pm = prompt ? t.pm : 64; r.pn = prompt ? t.pn : e % ex_nn; r.kt0 = sl * ex_nkt; r.nkt = prompt ? nkt_full : ex_nkt; r.kind = prompt ? 0 : ((ex_nkt == nkt_full) ? 1 : 2); r.slice = sl;
        u = r; return true;
    }
    __device__ __forceinline__ void a_ready(const pg8::Unit&) const {}
    __device__ __forceinline__ void done(const pg8::Unit&) const {}
};
__device__ __forceinline__ void store_partial(const f32x4 (&acc)[2][2][4][2], const pg8::Unit& u, int wr, int wc, int fr, int fq, float* part) {
    float* base = part + (size_t)u.slice * 128 * 1024 + u.pn * 256 + wc * 32 + 8 * fq;
#pragma unroll
    for (int m = 0; m < 4; ++m) { float* rp = base + (size_t)(wr * 64 + m * 16 + fr) * 1024;
#pragma unroll
        for (int bj = 0; bj < 2; ++bj)
#pragma unroll
            for (int n = 0; n < 2; ++n) *(f32x4*)(rp + bj * 128 + 4 * n) = acc[0][bj][m][n]; }
}

struct EpiProj {
    static constexpr bool PERM = true, AFTER_DRAIN = false; float* lrux; bf16* gate; bf16* s5u;
    __device__ __forceinline__ void operator()(const f32x4 (&acc)[2][2][4][2], const pg8::Unit& u, int wr, int wc, int fr, int fq) const {
        const int colt = u.pn * 256 + wc * 32 + 8 * fq;
#pragma unroll
        for (int ai = 0; ai < 2; ++ai)
#pragma unroll
            for (int m = 0; m < 4; ++m) { const int row = u.pm * 256 + ai * 128 + wr * 64 + m * 16 + fr; if (row >= MTOK) continue;
#pragma unroll
                for (int bj = 0; bj < 2; ++bj) { const int col = colt + bj * 128; const f32x4 v0 = acc[ai][bj][m][0], v1 = acc[ai][bj][m][1];
                    if (u.pn < 2) { float* p = lrux + (size_t)row * 512 + col; *(f32x4*)p = v0; *(f32x4*)(p + 4) = v1; }
                    else if (u.pn < 4) { *(u32x4*)(gate + (size_t)row * 512 + (col - 512)) = pack8(v0, v1); }
                    else { *(u32x4*)(s5u + (size_t)row * 512 + (col - 1024)) = pack8(v0, v1); } } }
    }
};
struct EpiGlu {
    static constexpr bool PERM = true, AFTER_DRAIN = false; float* o; float* part;
    __device__ __forceinline__ void operator()(const f32x4 (&acc)[2][2][4][2], const pg8::Unit& u, int wr, int wc, int fr, int fq) const {
        if (u.kind == 2) { store_partial(acc, u, wr, wc, fr, fq, part); return; }
        const int col = u.pn * 128 + wc * 32 + 8 * fq;
#pragma unroll
        for (int ai = 0; ai < 2; ++ai)
#pragma unroll
            for (int m = 0; m < 4; ++m) { const int row = u.pm * 256 + ai * 128 + wr * 64 + m * 16 + fr; if (row >= MTOK) continue;
#pragma unroll
                for (int n = 0; n < 2; ++n) { const f32x4 a = acc[ai][0][m][n], b = acc[ai][1][m][n]; f32x4 s;
#pragma unroll
                    for (int i = 0; i < 4; ++i) s[i] = a[i] * sigm(b[i]);
                    *(f32x4*)(o + (size_t)row * 512 + col + 4 * n) = s; } }
    }
};
template <int GOFF> struct EpiRes {
    static constexpr bool PERM = true, AFTER_DRAIN = false; const float* xp; const float* xs; const float* mod; float* out; float* part;
    __device__ __forceinline__ void operator()(const f32x4 (&acc)[2][2][4][2], const pg8::Unit& u, int wr, int wc, int fr, int fq) const {
        if (u.kind == 2) { store_partial(acc, u, wr, wc, fr, fq, part); return; }
        const int colt = u.pn * 256 + wc * 32 + 8 * fq;
#pragma unroll
        for (int ai = 0; ai < 2; ++ai)
#pragma unroll
            for (int m = 0; m < 4; ++m) { const int row = u.pm * 256 + ai * 128 + wr * 64 + m * 16 + fr; if (row >= MTOK) continue;
                const float* gp = mod + (size_t)mod_row(row) * NMOD + GOFF; float* op = out + (size_t)row * DM;
                const float* bp = xp ? (row < MPR ? xp + (size_t)row * DM : xs + (size_t)(row - MPR) * DM) : op;
#pragma unroll
                for (int bj = 0; bj < 2; ++bj)
#pragma unroll
                    for (int n = 0; n < 2; ++n) { const int c = colt + bj * 128 + 4 * n; const f32x4 x4 = *(const f32x4*)(bp + c), g4 = *(const f32x4*)(gp + c);
                        *(f32x4*)(op + c) = x4 + g4 * acc[ai][bj][m][n]; } }
    }
};
struct EpiSwiglu {
    static constexpr bool PERM = true, AFTER_DRAIN = false; bf16* h;
    __device__ __forceinline__ void operator()(const f32x4 (&acc)[2][2][4][2], const pg8::Unit& u, int wr, int wc, int fr, int fq) const {
        const int col = u.pn * 128 + wc * 32 + 8 * fq;
#pragma unroll
        for (int ai = 0; ai < 2; ++ai)
#pragma unroll
            for (int m = 0; m < 4; ++m) { const int row = u.pm * 256 + ai * 128 + wr * 64 + m * 16 + fr; if (row >= MTOK) continue;
                f32x4 s[2];
#pragma unroll
                for (int n = 0; n < 2; ++n) { const f32x4 a = acc[ai][0][m][n], b = acc[ai][1][m][n];
#pragma unroll
                    for (int i = 0; i < 4; ++i) s[n][i] = a[i] * sigm(a[i]) * b[i]; }
                *(u32x4*)(h + (size_t)row * DFF + col) = pack8(s[0], s[1]); }
    }
};

__device__ __forceinline__ void transpose_item(const float* W, int ldw, int k0, int n0, bf16* WT, int K, int drow0, LAS bf16* scr, int lane) {
    const int lr = lane >> 4, lc = lane & 15;
    f32x4 v[16];
#pragma unroll
    for (int i = 0; i < 16; ++i) v[i] = *(const f32x4*)(W + (size_t)(k0 + lr + 4 * i) * ldw + n0 + 4 * lc);
#pragma unroll
    for (int i = 0; i < 16; ++i) { u32x2 p; p.x = pk2(v[i].x, v[i].y); p.y = pk2(v[i].z, v[i].w); *(LAS u32x2*)(scr + (lr + 4 * i) * 68 + 4 * lc) = p; }
    LDS_WAIT();
    const int kc = lane & 7;
#pragma unroll
    for (int j = 0; j < 8; ++j) { const int n = (lane >> 3) + 8 * j; const LAS bf16* sp = scr + (8 * kc) * 68 + n;
        u32x4 o; o.x = (unsigned)sp[0] | ((unsigned)sp[68] << 16); o.y = (unsigned)sp[2 * 68] | ((unsigned)sp[3 * 68] << 16);
        o.z = (unsigned)sp[4 * 68] | ((unsigned)sp[5 * 68] << 16); o.w = (unsigned)sp[6 * 68] | ((unsigned)sp[7 * 68] << 16);
        *(u32x4*)(WT + (size_t)(drow0 + n) * K + k0 + 8 * kc) = o; }
    LDS_WAIT();
}
__device__ __forceinline__ void transpose_dispatch(const Ctx& cx, int it, LAS bf16* scr, int lane) {
    if (it < 384) { const int kb = it / 24, nb = it % 24; transpose_item(cx.I(11), NPROJ, 64 * kb, 64 * nb, cx.WIN(), DM, 64 * nb, scr, lane); return; } it -= 384;
    if (it < 128) { const int kb = it / 16, nb = it % 16, n0 = 64 * nb; const int dr = 256 * ((n0 & 511) >> 7) + 128 * (n0 >> 9) + (n0 & 127);
        transpose_item(cx.I(27), 1024, 64 * kb, n0, cx.WGLU(), 512, dr, scr, lane); return; } it -= 128;
    if (it < 256) { const int kb = it / 16, nb = it % 16; transpose_item(cx.I(30), DM, 64 * kb, 64 * nb, cx.WOUT(), DM, 64 * nb, scr, lane); return; } it -= 256;
    if (it < 704) { const int kb = it / 44, nb = it % 44, n0 = 64 * nb; transpose_item(cx.I(32), DFF, 64 * kb, n0, cx.WGU(), DM, 256 * (n0 >> 7) + (n0 & 127), scr, lane); return; } it -= 704;
    if (it < 704) { const int kb = it / 44, nb = it % 44, n0 = 64 * nb; transpose_item(cx.I(33), DFF, 64 * kb, n0, cx.WGU(), DM, 256 * (n0 >> 7) + 128 + (n0 & 127), scr, lane); return; } it -= 704;
    { const int kb = it / 16, nb = it % 16; transpose_item(cx.I(34), DM, 64 * kb, 64 * nb, cx.WDN(), DFF, 64 * nb, scr, lane); }
}
constexpr int N_TR_ITEMS = 384 + 128 + 256 + 704 + 704 + 704;

__device__ __forceinline__ void ada_block(const Ctx& cx, int item, LAS unsigned char* lds) {
    const int tid = threadIdx.x, w = __builtin_amdgcn_readfirstlane(tid >> 6), lane = tid & 63, fr = lane & 15, fq = lane >> 4, n0 = 32 * item;
    const float* W = cx.I(8); const float* cp = cx.I(6); const float* cs = cx.I(7);
    bf16x8 wf[4][2];
#pragma unroll
    for (int ks = 0; ks < 4; ++ks)
#pragma unroll
        for (int nt = 0; nt < 2; ++nt) { const float* src = W + (size_t)(128 * w + 32 * ks + 8 * fq) * NMOD + n0 + 16 * nt + fr;
            u32x4 o; o.x = pk2(src[0], src[NMOD]); o.y = pk2(src[2 * NMOD], src[3 * NMOD]); o.z = pk2(src[4 * NMOD], src[5 * NMOD]); o.w = pk2(src[6 * NMOD], src[7 * NMOD]); wf[ks][nt] = __builtin_bit_cast(bf16x8, o); }
    f32x4 acc[9][2];
#pragma unroll
    for (int i = 0; i < 9; ++i) { acc[i][0] = (f32x4){0.f, 0.f, 0.f, 0.f}; acc[i][1] = (f32x4){0.f, 0.f, 0.f, 0.f}; }
#pragma unroll
    for (int mt = 0; mt < 9; ++mt) { int row = 16 * mt + fr; row = row < NBT ? row : NBT - 1;
        const float* src = (row < NBP ? cp + (size_t)row * DM : cs + (size_t)(row - NBP) * DM) + 128 * w + 8 * fq;
#pragma unroll
        for (int ks = 0; ks < 4; ++ks) { f32x4 a0 = *(const f32x4*)(src + 32 * ks), a1 = *(const f32x4*)(src + 32 * ks + 4);
#pragma unroll
            for (int i = 0; i < 4; ++i) { a0[i] = a0[i] * sigm(a0[i]); a1[i] = a1[i] * sigm(a1[i]); }
            const bf16x8 af = __builtin_bit_cast(bf16x8, pack8(a0, a1));
            acc[mt][0] = __builtin_amdgcn_mfma_f32_16x16x32_bf16(wf[ks][0], af, acc[mt][0], 0, 0, 0);
            acc[mt][1] = __builtin_amdgcn_mfma_f32_16x16x32_bf16(wf[ks][1], af, acc[mt][1], 0, 0, 0); } }
    LAS f32x4* red = (LAS f32x4*)lds;
#pragma unroll
    for (int st = 4; st >= 1; st >>= 1) {
        if (w >= st && w < 2 * st) {
#pragma unroll
            for (int i = 0; i < 9; ++i) { red[((w - st) * 18 + 2 * i) * 64 + lane] = acc[i][0]; red[((w - st) * 18 + 2 * i + 1) * 64 + lane] = acc[i][1]; } }
        __syncthreads();
        if (w < st) {
#pragma unroll
            for (int i = 0; i < 9; ++i) { acc[i][0] += red[(w * 18 + 2 * i) * 64 + lane]; acc[i][1] += red[(w * 18 + 2 * i + 1) * 64 + lane]; } }
        __syncthreads();
    }
    if (w == 0) {
#pragma unroll
        for (int nt = 0; nt < 2; ++nt) { const f32x4 b4 = *(const f32x4*)(cx.I(9) + n0 + 16 * nt + 4 * fq);
#pragma unroll
            for (int mt = 0; mt < 9; ++mt) { const int row = 16 * mt + fr; if (row < NBT) *(f32x4*)(cx.MOD() + (size_t)row * NMOD + n0 + 16 * nt + 4 * fq) = acc[mt][nt] + b4; } } }
}

__device__ __forceinline__ void s5_tables(const Ctx& cx, int g, LAS unsigned char* lds) {
    LAS f32x2* Ap = (LAS f32x2*)lds;
    LAS f32x2* Bb = Ap + 17 * 64;
    LAS f32x2* Cc = Bb + 1024;
    LAS f32x2* Ff = Cc + 1024;
    LAS float* Kt = (LAS float*)(Ff + 64);
    const int tid = threadIdx.x;
    float* tab = cx.TAB();
    if (tid < 64) {
        const int n = tid; const float lr = cx.I(19)[g * 64 + n], li = cx.I(20)[g * 64 + n], dt = expf(cx.I(21)[g]);
        const float mag = expf(lr * dt);
        const double ang = (double)li * (double)dt; const double kq = rint(ang * 0.63661977236758134308); const double r = ang - kq * 1.57079632679489661923; const double r2 = r * r;
        const double sn = r * (1.0 + r2 * (-1.0 / 6 + r2 * (1.0 / 120 + r2 * (-1.0 / 5040 + r2 * (1.0 / 362880 + r2 * (-1.0 / 39916800 + r2 * (1.0 / 6227020800.0)))))));
        const double cn = 1.0 + r2 * (-0.5 + r2 * (1.0 / 24 + r2 * (-1.0 / 720 + r2 * (1.0 / 40320 + r2 * (-1.0 / 3628800 + r2 * (1.0 / 479001600.0))))));
        const int q = ((int)kq) & 3; const double cv = q == 0 ? cn : q == 1 ? -sn : q == 2 ? -cn : sn, sv = q == 0 ? sn : q == 1 ? cn : q == 2 ? -sn : -cn;
        const float abr = mag * (float)cv, abi = mag * (float)sv; const float den = lr * lr + li * li;
        const float frr = ((abr - 1.f) * lr + abi * li) / den, fii = (abi * lr - (abr - 1.f) * li) / den;
        f32x2 p = (f32x2){1.f, 0.f}; Ap[n] = p;
#pragma unroll 1
        for (int t = 1; t <= 16; ++t) { const float pr = p.x * abr - p.y * abi, pi = p.x * abi + p.y * abr; p = (f32x2){pr, pi}; Ap[t * 64 + n] = p; }
        Ff[n] = (f32x2){frr, fii};
        ((f32x2*)(tab + T_ABAR))[g * 64 + n] = (f32x2){abr, abi}; ((f32x2*)(tab + T_A16))[g * 64 + n] = p;
    }
    __syncthreads();
    for (int e = tid; e < 1024; e += 512) { const int n = e >> 4; const float br = cx.I(22)[g * 1024 + e], bi = cx.I(23)[g * 1024 + e]; const f32x2 f = Ff[n];
        const float bbr = f.x * br - f.y * bi, bbi = f.x * bi + f.y * br; Bb[e] = (f32x2){bbr, bbi}; tab[T_BBR + g * 1024 + e] = bbr; tab[T_BBI + g * 1024 + e] = bbi;
        Cc[e] = (f32x2){cx.I(24)[g * 1024 + e], cx.I(25)[g * 1024 + e]}; }
    __syncthreads();
    for (int e = tid; e < 4096; e += 512) { const int tau = e >> 8, c = (e >> 4) & 15, cp = e & 15; float sum = 0.f;
        for (int n = 0; n < 64; ++n) { const f32x2 a = Ap[tau * 64 + n], b = Bb[n * 16 + cp], cc = Cc[c * 64 + n];
            const float pr = a.x * b.x - a.y * b.y, pi = a.x * b.y + a.y * b.x; sum += cc.x * pr - cc.y * pi; }
        Kt[e] = sum; }
    __syncthreads();
    bf16* TFg = cx.TF() + (size_t)g * 256 * 384;
    for (int pc = tid; pc < 256 * 48; pc += 512) { const int row = pc / 48, k8 = (pc % 48) * 8, j = row >> 4, c = row & 15; float v[8];
#pragma unroll
        for (int q = 0; q < 8; ++q) { const int kk = k8 + q;
            if (kk < 256) { const int s = kk >> 4, cp = kk & 15; v[q] = (j >= s) ? Kt[((j - s) << 8) + (c << 4) + cp] : 0.f; }
            else { const int n = (kk - 256) & 63; const f32x2 p = Ap[(j + 1) * 64 + n], cc = Cc[c * 64 + n]; v[q] = (kk < 320) ? (cc.x * p.x - cc.y * p.y) : (-cc.x * p.y - cc.y * p.x); } }
        u32x4 o; o.x = pk2(v[0], v[1]); o.y = pk2(v[2], v[3]); o.z = pk2(v[4], v[5]); o.w = pk2(v[6], v[7]);
        *(u32x4*)(TFg + (size_t)row * 384 + k8) = o; }
    bf16* Eg = cx.EM() + (size_t)g * 128 * 256;
    for (int pc = tid; pc < 128 * 32; pc += 512) { const int np = pc >> 5, k8 = (pc & 31) * 8, n = np & 63, im = np >> 6; float v[8];
#pragma unroll
        for (int q = 0; q < 8; ++q) { const int kk = k8 + q, s = kk >> 4, cp = kk & 15; const f32x2 a = Ap[(15 - s) * 64 + n], b = Bb[n * 16 + cp];
            v[q] = im ? (a.x * b.y + a.y * b.x) : (a.x * b.x - a.y * b.y); }
        u32x4 o; o.x = pk2(v[0], v[1]); o.y = pk2(v[2], v[3]); o.z = pk2(v[4], v[5]); o.w = pk2(v[6], v[7]);
        *(u32x4*)(Eg + (size_t)np * 256 + k8) = o; }
    __syncthreads();
}

__device__ __forceinline__ void norm_mod_row(const float* xrow, const float* g, const float* sc, const float* sh, bf16* orow, int lane) {
    f32x4 v[4]; float ss = 0.f;
#pragma unroll
    for (int j = 0; j < 4; ++j) { v[j] = ((const f32x4*)xrow)[lane + 64 * j]; ss += (v[j].x * v[j].x + v[j].y * v[j].y) + (v[j].z * v[j].z + v[j].w * v[j].w); }
    const float rstd = rsqrtf(wave_sum(ss) * (1.f / DM) + EPS);
#pragma unroll
    for (int j = 0; j < 4; ++j) { const int col = 4 * (lane + 64 * j); const f32x4 gg = *(const f32x4*)(g + col), s1 = *(const f32x4*)(sc + col), s2 = *(const f32x4*)(sh + col);
        const f32x4 o = v[j] * rstd * gg * (1.f + s1) + s2; u32x2 w; w.x = pk2(o.x, o.y); w.y = pk2(o.z, o.w); *(u32x2*)(orow + col) = w; }
}

__device__ __forceinline__ void lru_local_unit(const Ctx& cx, int row0, int ntok, bool samp, int aggidx, LAS unsigned char* lds) {
    const int d = threadIdx.x, w = __builtin_amdgcn_readfirstlane(d >> 6), lane = d & 63, fr = lane & 15, fq = lane >> 4;
    LAS float* cf = (LAS float*)(lds + w * 8192);
    LAS bf16* cbf = (LAS bf16*)(lds + w * 8192 + 4608);
    bf16x8 wf[8][2];
#pragma unroll
    for (int nt = 0; nt < 8; ++nt)
#pragma unroll
        for (int ks = 0; ks < 2; ++ks) { const float* src = (nt < 4 ? cx.I(14) : cx.I(16)) + (size_t)w * 4096 + (32 * ks + 8 * fq) * 64 + 16 * (nt & 3) + fr;
            u32x4 o; o.x = pk2(src[0], src[64]); o.y = pk2(src[128], src[192]); o.z = pk2(src[256], src[320]); o.w = pk2(src[384], src[448]); wf[nt][ks] = __builtin_bit_cast(bf16x8, o); }
    const float cw0 = cx.I(12)[d], cw1 = cx.I(12)[512 + d], cw2 = cx.I(12)[1024 + d], cw3 = cx.I(12)[1536 + d], cb = cx.I(13)[d];
    float gba[4], gbx[4], gcd[4], hc[4], cc[4];
#pragma unroll
    for (int nt = 0; nt < 4; ++nt) { const int ch = 64 * w + 16 * nt + fr; gba[nt] = cx.I(15)[ch]; gbx[nt] = cx.I(17)[ch]; gcd[nt] = -8.f * 1.44269504089f * log1pf(expf(-cx.I(18)[ch])); hc[nt] = 0.f; cc[nt] = 1.f; }
    const float* X = cx.LRUX(); float* HL = cx.HLOC(); float* CU = cx.CUM();
    float xm3 = 0.f, xm2 = 0.f, xm1 = 0.f;
    if (!samp) { const int t0 = row0 & (SEQ - 1); if (t0 >= 3) { xm3 = X[(size_t)(row0 - 3) * DL + d]; xm2 = X[(size_t)(row0 - 2) * DL + d]; xm1 = X[(size_t)(row0 - 1) * DL + d]; } }
    float xv[16];
#pragma unroll
    for (int i = 0; i < 16; ++i) xv[i] = X[(size_t)(row0 + i) * DL + d];
    for (int t0 = 0; t0 < ntok; t0 += 16) {
        if (samp) {
#pragma unroll
            for (int i = 0; i < 16; ++i) { const int row = row0 + t0 + i; const float* sc = cx.I(2) + (size_t)(row - MPR) * 1536 + d;
                const float cv = cb + cw0 * sc[0] + cw1 * sc[512] + cw2 * sc[1024] + cw3 * xv[i];
                cf[i * 68 + lane] = cv; cbf[i * 72 + lane] = (bf16)(pk2(cv, cv) & 0xffffu); }
        } else {
#pragma unroll
            for (int i = 0; i < 16; ++i) { const float x = xv[i]; const float cv = cb + cw0 * xm3 + cw1 * xm2 + cw2 * xm1 + cw3 * x; xm3 = xm2; xm2 = xm1; xm1 = x;
                cf[i * 68 + lane] = cv; cbf[i * 72 + lane] = (bf16)(pk2(cv, cv) & 0xffffu); }
        }
        if (t0 + 16 < ntok) {
#pragma unroll
            for (int i = 0; i < 16; ++i) xv[i] = X[(size_t)(row0 + t0 + 16 + i) * DL + d]; }
        LDS_WAIT();
        f32x4 acc[8];
#pragma unroll
        for (int nt = 0; nt < 8; ++nt) acc[nt] = (f32x4){0.f, 0.f, 0.f, 0.f};
#pragma unroll
        for (int ks = 0; ks < 2; ++ks) { const bf16x8 af = *(const LAS bf16x8*)(cbf + fr * 72 + 32 * ks + 8 * fq);
#pragma unroll
            for (int nt = 0; nt < 8; ++nt) acc[nt] = __builtin_amdgcn_mfma_f32_16x16x32_bf16(af, wf[nt][ks], acc[nt], 0, 0, 0); }
#pragma unroll
        for (int nt = 0; nt < 4; ++nt) { const int ch = 64 * w + 16 * nt + fr;
            float av[4], hv[4]; float P = 1.f, H = 0.f;
#pragma unroll
            for (int r = 0; r < 4; ++r) { const int tok = 4 * fq + r; const float cvv = cf[tok * 68 + 16 * nt + fr];
                const float rr = sigm(acc[nt][r] + gba[nt]), ig = sigm(acc[nt + 4][r] + gbx[nt]);
                const float a = __builtin_amdgcn_exp2f(gcd[nt] * rr);
                const float bb = __builtin_amdgcn_sqrtf(fmaf(-a, a, 1.f)) * ig * cvv;
                if (samp) { const float h0 = cx.I(3)[(size_t)(row0 + t0 + tok - MPR) * DL + ch]; hv[r] = a * h0 + bb; av[r] = 0.f; }
                else { H = a * H + bb; P = P * a; hv[r] = H; av[r] = P; } }
            if (!samp) {
                float Pp = __shfl_up(P, 16), Hp = __shfl_up(H, 16); if (fq >= 1) { H = P * Hp + H; P = P * Pp; }
                Pp = __shfl_up(P, 32); Hp = __shfl_up(H, 32); if (fq >= 2) { H = P * Hp + H; P = P * Pp; }
                float Pe = __shfl_up(P, 16), He = __shfl_up(H, 16); if (fq == 0) { Pe = 1.f; He = 0.f; }
                const float hstart = He + Pe * hc[nt], cstart = Pe * cc[nt];
#pragma unroll
                for (int r = 0; r < 4; ++r) { hv[r] = hv[r] + av[r] * hstart; av[r] = av[r] * cstart; }
                const float Pl = __shfl(P, 48 + fr), Hl = __shfl(H, 48 + fr); hc[nt] = Hl + Pl * hc[nt]; cc[nt] = Pl * cc[nt];
            }
#pragma unroll
            for (int r = 0; r < 4; ++r) { const size_t o = (size_t)(row0 + t0 + 4 * fq + r) * DL + ch; HL[o] = hv[r]; CU[o] = av[r]; }
            __builtin_amdgcn_sched_barrier(0);
        }
        LDS_WAIT();
    }
    if (!samp && fq == 0) {
#pragma unroll
        for (int nt = 0; nt < 4; ++nt) cx.AGG()[(size_t)aggidx * DL + 64 * w + 16 * nt + fr] = (f32x2){cc[nt], hc[nt]}; }
}

__device__ __forceinline__ void s5_gemm_e_item(const Ctx& cx, int item, int lane) {
    const int g = item >> 6, rb = item & 63, fr = lane & 15, fq = lane >> 4, cr = rb * 16 + fr;
    const bf16* U = cx.S5U() + (size_t)(16 * cr + (fq >> 1)) * 512 + 16 * g + 8 * (fq & 1); const bf16* Eg = cx.EM() + (size_t)g * 128 * 256 + (size_t)fr * 256 + 8 * fq;
    f32x4 acc[8];
#pragma unroll
    for (int n = 0; n < 8; ++n) acc[n] = (f32x4){0.f, 0.f, 0.f, 0.f};
#pragma unroll 4
    for (int ks = 0; ks < 8; ++ks) {
        const bf16x8 af = *(const bf16x8*)(U + (size_t)(2 * ks) * 512);
#pragma unroll
        for (int nt = 0; nt < 8; ++nt) { const bf16x8 wf = *(const bf16x8*)(Eg + (size_t)(16 * nt) * 256 + 32 * ks); acc[nt] = __builtin_amdgcn_mfma_f32_16x16x32_bf16(wf, af, acc[nt], 0, 0, 0); }
    }
    float* S = cx.SK() + ((size_t)cr * 32 + g) * 128 + 4 * fq;
#pragma unroll
    for (int nt = 0; nt < 8; ++nt) *(f32x4*)(S + 16 * nt) = acc[nt];
}

__device__ __forceinline__ void s5_chain_item(const Ctx& cx, int item, int lane) {
    const int idx = item * 64 + lane, b = idx >> 11, g = (idx >> 6) & 31, n = idx & 63;
    const f32x2 A = ((const f32x2*)(cx.TAB() + T_A16))[g * 64 + n];
    const float* S = cx.SK() + ((size_t)(b * SNCH) * 32 + g) * 128 + n; bf16* H = cx.HIN() + ((size_t)g * SROWS + b * SNCH) * 128 + n;
    float hr = 0.f, hi = 0.f; float s0r[8], s0i[8], s1r[8], s1i[8];
#define CH_LOAD(R, I, K0) do { _Pragma("unroll") for (int i = 0; i < 8; ++i) { R[i] = S[(size_t)((K0) + i) * 4096]; I[i] = S[(size_t)((K0) + i) * 4096 + 64]; } } while (0)
#define CH_STEP(R, I, K0) do { _Pragma("unroll") for (int i = 0; i < 8; ++i) { H[(size_t)((K0) + i) * 128] = (bf16)(pk2(hr, hr) & 0xffffu); H[(size_t)((K0) + i) * 128 + 64] = (bf16)(pk2(hi, hi) & 0xffffu); \
        const float nr = A.x * hr - A.y * hi + R[i], ni = A.x * hi + A.y * hr + I[i]; hr = nr; hi = ni; } } while (0)
    CH_LOAD(s0r, s0i, 0);
    for (int k0 = 0; k0 < SNCH; k0 += 16) { CH_LOAD(s1r, s1i, k0 + 8); CH_STEP(s0r, s0i, k0); if (k0 + 16 < SNCH) CH_LOAD(s0r, s0i, k0 + 16); CH_STEP(s1r, s1i, k0 + 8); }
#undef CH_LOAD
#undef CH_STEP
    cx.out[O_S5RP + (size_t)(b * 32 + g) * 64 + n] = hr; cx.out[O_S5IP + (size_t)(b * 32 + g) * 64 + n] = hi;
}

__device__ __forceinline__ void lru_fix_unit(const Ctx& cx, int row0, int ntok, bool samp, int b, int k, LAS unsigned char* lds) {
    const int d = threadIdx.x, w = d >> 6, lane = d & 63;
    LAS float* hs = (LAS float*)lds;
    float hin = 0.f;
    if (!samp) { const f32x2* ag = cx.AGG() + (size_t)(b * NCH) * DL + d; f32x2 pp[NCH - 1];
#pragma unroll
        for (int kk = 0; kk < NCH - 1; ++kk) pp[kk] = (kk < k) ? ag[(size_t)kk * DL] : (f32x2){1.f, 0.f};
#pragma unroll
        for (int kk = 0; kk < NCH - 1; ++kk) hin = pp[kk].x * hin + pp[kk].y; }
    hs[d] = hin;
    const float* X = cx.LRUX();
    if (!samp && k == NCH - 1) {
#pragma unroll
        for (int j = 0; j < 3; ++j) cx.out[O_CONVP + (size_t)(b * 3 + j) * DL + d] = X[(size_t)(row0 + LCH - 3 + j) * DL + d]; }
    if (samp) { for (int t = 0; t < ntok; ++t) { const int sb = row0 + t - MPR; const float* sc = cx.I(2) + (size_t)sb * 1536 + d; float* o = cx.out + O_CONVS + (size_t)sb * 1536 + d;
            o[0] = sc[512]; o[512] = sc[1024]; o[1024] = X[(size_t)(row0 + t) * DL + d]; } }
    __syncthreads();
    const float* HL = cx.HLOC(); const float* CU = cx.CUM(); const bf16* GT = cx.GATE(); bf16* MG = cx.MERGED(); const float* gl = cx.I(28);
    const f32x4 hi0 = *(const LAS f32x4*)(hs + 8 * lane), hi1 = *(const LAS f32x4*)(hs + 8 * lane + 4);
    const f32x4 g0 = *(const f32x4*)(gl + 8 * lane), g1 = *(const f32x4*)(gl + 8 * lane + 4);
#pragma unroll 4
    for (int t = w; t < ntok; t += 8) { const size_t ro = (size_t)(row0 + t) * DL + 8 * lane;
        const f32x4 a0 = *(const f32x4*)(HL + ro), a1 = *(const f32x4*)(HL + ro + 4), c0 = *(const f32x4*)(CU + ro), c1 = *(const f32x4*)(CU + ro + 4);
        const u32x4 gw = *(const u32x4*)(GT + ro);
        const f32x4 h0 = a0 + c0 * hi0, h1 = a1 + c1 * hi1;
        f32x4 l0, l1;
        l0[0] = h0[0] * gelu_tanh(bflo(gw.x)); l0[1] = h0[1] * gelu_tanh(bfhi(gw.x)); l0[2] = h0[2] * gelu_tanh(bflo(gw.y)); l0[3] = h0[3] * gelu_tanh(bfhi(gw.y));
        l1[0] = h1[0] * gelu_tanh(bflo(gw.z)); l1[1] = h1[1] * gelu_tanh(bfhi(gw.z)); l1[2] = h1[2] * gelu_tanh(bflo(gw.w)); l1[3] = h1[3] * gelu_tanh(bfhi(gw.w));
        float ss = (l0[0] * l0[0] + l0[1] * l0[1]) + (l0[2] * l0[2] + l0[3] * l0[3]) + (l1[0] * l1[0] + l1[1] * l1[1]) + (l1[2] * l1[2] + l1[3] * l1[3]);
        const float rstd = rsqrtf(wave_sum(ss) * (1.f / DL) + EPS);
        *(u32x4*)(MG + (size_t)(row0 + t) * DM + 8 * lane) = pack8(l0 * rstd * g0, l1 * rstd * g1);
        if (samp) { float* o = cx.out + O_LRUS + (size_t)(row0 + t - MPR) * DL + 8 * lane; *(f32x4*)o = h0; *(f32x4*)(o + 4) = h1; }
        else if (k == NCH - 1 && t == LCH - 1) { float* o = cx.out + O_LRUP + (size_t)b * DL + 8 * lane; *(f32x4*)o = h0; *(f32x4*)(o + 4) = h1; }
    }
    __syncthreads();
}

__device__ __forceinline__ void s5_gemm_tf_item(const Ctx& cx, int item, int lane) {
    const int half = item & 1, g = item >> 6, rb = (item >> 1) & 31, fr = lane & 15, fq = lane >> 4;
    const bf16* U = cx.S5U(); const bf16* TFg = cx.TF() + ((size_t)g * 256 + 128 * half) * 384; const bf16* Hg = cx.HIN() + (size_t)g * SROWS * 128;
    f32x4 acc[2][8];
#pragma unroll
    for (int a = 0; a < 2; ++a)
#pragma unroll
        for (int n = 0; n < 8; ++n) acc[a][n] = (f32x4){0.f, 0.f, 0.f, 0.f};
#pragma unroll 2
    for (int ks = 0; ks < 12; ++ks) {
        bf16x8 af[2];
#pragma unroll
        for (int mt = 0; mt < 2; ++mt) { const int cr = rb * 32 + 16 * mt + fr;
            af[mt] = (ks < 8) ? *(const bf16x8*)(U + ((size_t)(16 * cr + 2 * ks + (fq >> 1)) * 512 + 16 * g + 8 * (fq & 1))) : *(const bf16x8*)(Hg + (size_t)cr * 128 + 32 * (ks - 8) + 8 * fq); }
#pragma unroll
        for (int nt = 0; nt < 8; ++nt) { const bf16x8 wf = *(const bf16x8*)(TFg + (size_t)(16 * nt + fr) * 384 + 32 * ks + 8 * fq);
#pragma unroll
            for (int mt = 0; mt < 2; ++mt) acc[mt][nt] = __builtin_amdgcn_mfma_f32_16x16x32_bf16(wf, af[mt], acc[mt][nt], 0, 0, 0); }
    }
    const f32x4 d4 = *(const f32x4*)(cx.I(26) + 16 * g + 4 * fq); bf16* GY = cx.GY();
#pragma unroll
    for (int mt = 0; mt < 2; ++mt) { const int cr = rb * 32 + 16 * mt + fr;
#pragma unroll
        for (int nt = 0; nt < 8; ++nt) { const size_t off = (size_t)(16 * cr + 8 * half + nt) * 512 + 16 * g + 4 * fq; const u32x2 uw = *(const u32x2*)(U + off);
            const f32x4 y = acc[mt][nt] + d4 * (f32x4){bflo(uw.x), bfhi(uw.x), bflo(uw.y), bfhi(uw.y)};
            u32x2 o; o.x = pk2(gelu_tanh(y[0]), gelu_tanh(y[1])); o.y = pk2(gelu_tanh(y[2]), gelu_tanh(y[3])); *(u32x2*)(GY + off) = o; } }
}
__device__ __forceinline__ void s5_sample_item(const Ctx& cx, int item, int lane) {
    const int sb = item >> 5, g = item & 31, n = lane; const int row = MPR + sb;
    const float* tab = cx.TAB(); const f32x2 A = ((const f32x2*)(tab + T_ABAR))[g * 64 + n];
    const float h0r = cx.I(4)[((size_t)sb * 32 + g) * 64 + n], h0i = cx.I(5)[((size_t)sb * 32 + g) * 64 + n];
    const bf16* up = cx.S5U() + (size_t)row * 512 + 16 * g; const u32x4 u0 = *(const u32x4*)up, u1 = *(const u32x4*)(up + 8);
    float uu[16]; uu[0] = bflo(u0.x); uu[1] = bfhi(u0.x); uu[2] = bflo(u0.y); uu[3] = bfhi(u0.y); uu[4] = bflo(u0.z); uu[5] = bfhi(u0.z); uu[6] = bflo(u0.w); uu[7] = bfhi(u0.w);
    uu[8] = bflo(u1.x); uu[9] = bfhi(u1.x); uu[10] = bflo(u1.y); uu[11] = bfhi(u1.y); uu[12] = bflo(u1.z); uu[13] = bfhi(u1.z); uu[14] = bflo(u1.w); uu[15] = bfhi(u1.w);
    float bur = 0.f, bui = 0.f; const float* br = tab + T_BBR + (size_t)(g * 64 + n) * 16; const float* bi = tab + T_BBI + (size_t)(g * 64 + n) * 16;
#pragma unroll
    for (int c4 = 0; c4 < 4; ++c4) { const f32x4 r4 = *(const f32x4*)(br + 4 * c4), i4 = *(const f32x4*)(bi + 4 * c4);
#pragma unroll
        for (int i = 0; i < 4; ++i) { bur += r4[i] * uu[4 * c4 + i]; bui += i4[i] * uu[4 * c4 + i]; } }
    const float hr = A.x * h0r - A.y * h0i + bur, hi = A.x * h0i + A.y * h0r + bui;
    cx.out[O_S5RS + ((size_t)sb * 32 + g) * 64 + n] = hr; cx.out[O_S5IS + ((size_t)sb * 32 + g) * 64 + n] = hi;
    float my = 0.f, myu = 0.f;
#pragma unroll
    for (int c = 0; c < 16; ++c) { const float v = wave_sum(cx.I(24)[((size_t)g * 16 + c) * 64 + n] * hr - cx.I(25)[((size_t)g * 16 + c) * 64 + n] * hi); if (lane == c) { my = v; myu = uu[c]; } }
    if (lane < 16) { const float y = my + cx.I(26)[16 * g + lane] * myu; cx.GY()[(size_t)row * 512 + 16 * g + lane] = (bf16)(pk2(gelu_tanh(y), 0.f) & 0xffffu); }
}

__global__ void __launch_bounds__(512, 2) fwd_kernel(KArgs a) {
    extern __shared__ __attribute__((aligned(16))) unsigned char lds_raw[];
    LAS unsigned char* lds = (LAS unsigned char*)lds_raw;
    cg::grid_group grid = cg::this_grid();
    Ctx cx; cx.in = a.in; cx.out = a.out; cx.ws = a.ws;
    const int tid = threadIdx.x, lane = tid & 63, wave = __builtin_amdgcn_readfirstlane(tid >> 6);
    const int G = gridDim.x, bid = blockIdx.x, gw = bid * 8 + wave, NGW = G * 8;
#ifndef REPMASK
#define REPMASK 0
#endif
#ifndef PHMASK
#define PHMASK 0x1fff
#endif
#define IN(k) (((PHMASK >> (k)) & 1) && a.lo <= (k) && (k) < a.hi)
#define SEAM(k) do { if (IN(k) && IN((k) + 1)) grid.sync(); } while (0)

    if (IN(0)) for (int rep_ = 0; rep_ < 1 + ((REPMASK >> 0) & 1); ++rep_) {
        if (bid < 32 || G < 64) { for (int g = bid; g < 32; g += G) s5_tables(cx, g, lds); }
        const int nb2 = G >= 64 ? G - 32 : G, b2 = G >= 64 ? bid - 32 : bid;
        if (b2 >= 0) {
            for (int it = b2; it < 192; it += nb2) ada_block(cx, it, lds);
            LAS bf16* scr = (LAS bf16*)(lds + wave * 16384);
            for (int it = (nb2 - 1 - b2) * 8 + wave; it < N_TR_ITEMS; it += nb2 * 8) transpose_dispatch(cx, it, scr, lane);
        }
    }
    SEAM(0);
    if (IN(1)) for (int rep_ = 0; rep_ < 1 + ((REPMASK >> 1) & 1); ++rep_) {
        for (int r = gw; r < MTOK; r += NGW) { const float* xr = r < MPR ? cx.I(0) + (size_t)r * DM : cx.I(1) + (size_t)(r - MPR) * DM; const float* md = cx.MOD() + (size_t)mod_row(r) * NMOD;
            norm_mod_row(xr, cx.I(10), md + 1024, md, cx.XN() + (size_t)r * DM, lane); }
    }
    SEAM(1);
    if (IN(2)) for (int rep_ = 0; rep_ < 1 + ((REPMASK >> 2) & 1); ++rep_) {
        pg8::Gemm g{cx.XN(), cx.WIN(), MPAD, NPROJ, DM}; Sched2 S; S.init(NPROJ, DM, G, bid, DM / 64);
        EpiProj E{cx.LRUX(), cx.GATE(), cx.S5U()};
        pg8::gemm_phase<EpiProj, Sched2, true, true>(lds, g, S, E);
    }
    SEAM(2);
    if (IN(3)) for (int rep_ = 0; rep_ < 1 + ((REPMASK >> 3) & 1); ++rep_) {
#ifndef NO_LRU
        for (int q_ = 0; q_ < 1 + ((REPMASK >> 13) & 1); ++q_)
        for (int u = bid; u < 256 + NBS / SCH; u += G) {
            if (u < 256) lru_local_unit(cx, u * LCH, LCH, false, u, lds); else lru_local_unit(cx, MPR + (u - 256) * SCH, SCH, true, 0, lds);
        }
#endif
#ifndef NO_E
        for (int q_ = 0; q_ < 1 + ((REPMASK >> 14) & 1); ++q_)
        for (int it = gw; it < 2048; it += NGW) s5_gemm_e_item(cx, it, lane);
#endif
    }
    SEAM(3);
    if (IN(4)) for (int rep_ = 0; rep_ < 1 + ((REPMASK >> 4) & 1); ++rep_) {
        if (wave == 0) { for (int it = bid; it < 256; it += G) s5_chain_item(cx, it, lane); }
        for (int u = bid; u < 256 + NBS / SCH; u += G) {
            if (u < 256) lru_fix_unit(cx, u * LCH, LCH, false, u >> 5, u & 31, lds); else lru_fix_unit(cx, MPR + (u - 256) * SCH, SCH, true, 0, 0, lds);
        }
    }
    SEAM(4);
    if (IN(5)) for (int rep_ = 0; rep_ < 1 + ((REPMASK >> 5) & 1); ++rep_) {
        for (int it = gw; it < 2048; it += NGW) s5_gemm_tf_item(cx, it, lane);
        for (int it = gw; it < NBS * 32; it += NGW) s5_sample_item(cx, it, lane);
    }
    SEAM(5);
    if (IN(6)) for (int rep_ = 0; rep_ < 1 + ((REPMASK >> 6) & 1); ++rep_) {
        pg8::Gemm g{cx.GY(), cx.WGLU(), MPAD, 1024, 512}; Sched2 S; S.init(1024, 512, G, bid, 2);
        EpiGlu E{cx.S5OUT(), cx.PART()};
        pg8::gemm_phase<EpiGlu, Sched2, true, true>(lds, g, S, E);
    }
    SEAM(6);
    if (IN(7)) for (int rep_ = 0; rep_ < 1 + ((REPMASK >> 7) & 1); ++rep_) {
        const float* gs = cx.I(29);
        for (int r = gw; r < MTOK; r += NGW) { const float* sr = cx.S5OUT() + (size_t)r * 512;
            f32x4 v0, v1;
            if (r < MPR) { v0 = ((const f32x4*)sr)[lane]; v1 = ((const f32x4*)sr)[lane + 64]; }
            else { const float* pp = cx.PART() + (size_t)(r - MPR) * 1024; const int c0 = 4 * lane, ca0 = 256 * (c0 >> 7) + (c0 & 127), ca1 = ca0 + 512;
                f32x4 a0 = (f32x4){0.f, 0.f, 0.f, 0.f}, b0 = a0, a1 = a0, b1 = a0;
#pragma unroll
                for (int sl = 0; sl < 4; ++sl) { const float* q = pp + (size_t)sl * 128 * 1024; a0 += *(const f32x4*)(q + ca0); b0 += *(const f32x4*)(q + ca0 + 128); a1 += *(const f32x4*)(q + ca1); b1 += *(const f32x4*)(q + ca1 + 128); }
#pragma unroll
                for (int i = 0; i < 4; ++i) { v0[i] = a0[i] * sigm(b0[i]); v1[i] = a1[i] * sigm(b1[i]); } }
            const float ss = (v0.x * v0.x + v0.y * v0.y) + (v0.z * v0.z + v0.w * v0.w) + (v1.x * v1.x + v1.y * v1.y) + (v1.z * v1.z + v1.w * v1.w);
            const float rstd = rsqrtf(wave_sum(ss) * (1.f / 512) + EPS);
            const f32x4 o0 = v0 * rstd * ((const f32x4*)gs)[lane], o1 = v1 * rstd * ((const f32x4*)gs)[lane + 64];
            bf16* mp = cx.MERGED() + (size_t)r * DM + 512; u32x2 w0, w1; w0.x = pk2(o0.x, o0.y); w0.y = pk2(o0.z, o0.w); w1.x = pk2(o1.x, o1.y); w1.y = pk2(o1.z, o1.w);
            *(u32x2*)(mp + 4 * lane) = w0; *(u32x2*)(mp + 256 + 4 * lane) = w1; }
    }
    SEAM(7);
    if (IN(8)) for (int rep_ = 0; rep_ < 1 + ((REPMASK >> 8) & 1); ++rep_) {
        pg8::Gemm g{cx.MERGED(), cx.WOUT(), MPAD, DM, DM}; Sched2 S; S.init(DM, DM, G, bid, 2);
        EpiRes<2048> E{cx.I(0), cx.I(1), cx.MOD(), cx.out, cx.PART()};
        pg8::gemm_phase<EpiRes<2048>, Sched2, true, true>(lds, g, S, E);
    }
    SEAM(8);
    if (IN(9)) for (int rep_ = 0; rep_ < 1 + ((REPMASK >> 9) & 1); ++rep_) {
        for (int r = gw; r < MTOK; r += NGW) { const float* md = cx.MOD() + (size_t)mod_row(r) * NMOD;
            if (r >= MPR) { const float* pp = cx.PART() + (size_t)(r - MPR) * 1024; const float* xr = cx.I(1) + (size_t)(r - MPR) * DM; float* orow = cx.out + (size_t)r * DM;
#pragma unroll
                for (int j = 0; j < 4; ++j) { const int col = 4 * (lane + 64 * j); f32x4 sm = (f32x4){0.f, 0.f, 0.f, 0.f};
#pragma unroll
                    for (int sl = 0; sl < 8; ++sl) sm += *(const f32x4*)(pp + (size_t)sl * 128 * 1024 + col);
                    *(f32x4*)(orow + col) = *(const f32x4*)(xr + col) + *(const f32x4*)(md + 2048 + col) * sm; } }
            norm_mod_row(cx.out + (size_t)r * DM, cx.I(31), md + 4096, md + 3072, cx.XN2() + (size_t)r * DM, lane); }
    }
    SEAM(9);
    if (IN(10)) for (int rep_ = 0; rep_ < 1 + ((REPMASK >> 10) & 1); ++rep_) {
        pg8::Gemm g{cx.XN2(), cx.WGU(), MPAD, 2 * DFF, DM}; Sched2 S; S.init(2 * DFF, DM, G, bid, DM / 64);
        EpiSwiglu E{cx.HB()};
        pg8::gemm_phase<EpiSwiglu, Sched2, true, true>(lds, g, S, E);
    }
    SEAM(10);
    if (IN(11)) for (int rep_ = 0; rep_ < 1 + ((REPMASK >> 11) & 1); ++rep_) {
        pg8::Gemm g{cx.HB(), cx.WDN(), MPAD, DM, DFF}; Sched2 S; S.init(DM, DFF, G, bid, 2);
        EpiRes<5120> E{nullptr, nullptr, cx.MOD(), cx.out, cx.PART()};
        pg8::gemm_phase<EpiRes<5120>, Sched2, true, true>(lds, g, S, E);
    }
    SEAM(11);
    if (IN(12)) for (int rep_ = 0; rep_ < 1 + ((REPMASK >> 12) & 1); ++rep_) {
        const float* fg = cx.I(35);
        for (int r = gw; r < MTOK; r += NGW) { float* xr = cx.out + (size_t)r * DM; f32x4 v[4]; float ss = 0.f;
#pragma unroll
            for (int j = 0; j < 4; ++j) { v[j] = ((const f32x4*)xr)[lane + 64 * j];
                if (r >= MPR) { const int col = 4 * (lane + 64 * j); const float* pp = cx.PART() + (size_t)(r - MPR) * 1024 + col; f32x4 sm = (f32x4){0.f, 0.f, 0.f, 0.f};
#pragma unroll 2
                    for (int sl = 0; sl < 22; ++sl) sm += *(const f32x4*)(pp + (size_t)sl * 128 * 1024);
                    v[j] += *(const f32x4*)(cx.MOD() + (size_t)mod_row(r) * NMOD + 5120 + col) * sm; }
                ss += (v[j].x * v[j].x + v[j].y * v[j].y) + (v[j].z * v[j].z + v[j].w * v[j].w); }
            const float rstd = rsqrtf(wave_sum(ss) * (1.f / DM) + EPS);
#pragma unroll
            for (int j = 0; j < 4; ++j) ((f32x4*)xr)[lane + 64 * j] = v[j] * rstd * ((const f32x4*)fg)[lane + 64 * j]; }
    }
#undef IN
#undef SEAM
}

constexpr int LDS_BYTES = 131072;
#ifndef MK_SINGLE
#define MK_SINGLE 1
#endif
extern "C" void kernel_launch(void* const* d_in, const int* in_sizes, int n_in, void* d_out, int out_size, void* d_ws, size_t ws_size, hipStream_t stream) {
    static int grid = 0;
    if (grid == 0) {
        if (n_in != 36 || (size_t)out_size != O_END || ws_size < WS_END) { fprintf(stderr, "kernel_launch: unexpected shapes n_in %d out %d ws %zu\n", n_in, out_size, ws_size); grid = -1; return; }
        int dev = 0, cus = 0, per_cu = 0;
        hipGetDevice(&dev); hipDeviceGetAttribute(&cus, hipDeviceAttributeMultiprocessorCount, dev);
        hipFuncSetAttribute((const void*)fwd_kernel, hipFuncAttributeMaxDynamicSharedMemorySize, LDS_BYTES);
        hipOccupancyMaxActiveBlocksPerMultiprocessor(&per_cu, (const void*)fwd_kernel, 512, LDS_BYTES);
        if (per_cu < 1) { fprintf(stderr, "kernel_launch: occupancy query says %d blocks per CU\n", per_cu); grid = -1; return; }
        grid = cus;
    }
    if (grid < 0) return;
    KArgs a{};
    for (int i = 0; i < 36; ++i) a.in[i] = (const float*)d_in[i];
    a.out = (float*)d_out; a.ws = (unsigned char*)d_ws;
#if MK_SINGLE
    a.lo = 0; a.hi = NPHASE;
    void* args[] = {&a};
    hipError_t e = hipLaunchCooperativeKernel((const void*)fwd_kernel, dim3(grid), dim3(512), args, LDS_BYTES, stream);
    if (e != hipSuccess) fprintf(stderr, "cooperative launch failed: %s (grid %d)\n", hipGetErrorString(e), grid);
#else
    for (int p = 0; p < NPHASE; ++p) { a.lo = p; a.hi = p + 1; hipLaunchKernelGGL(fwd_kernel, dim3(grid), dim3(512), LDS_BYTES, stream, a); }
#endif
}
```

```cpp
#include <hip/hip_runtime.h>
#include <hip/hip_cooperative_groups.h>
#include <cstdio>
#include <cstdint>
namespace cg = cooperative_groups;
namespace pg8 {
#define PG8_LAS __attribute__((address_space(3)))
typedef unsigned short bf16_t;
typedef short bf16x8 __attribute__((ext_vector_type(8)));
typedef float f32x4 __attribute__((ext_vector_type(4)));
typedef unsigned u32x4 __attribute__((ext_vector_type(4)));
constexpr int BM = 256, BK = 64, HALF = 128, HTB = HALF * BK * 2  , STAGE_BYTES = 8 * HTB, NXCD = 8, WGM = 8;

__host__ __device__ __forceinline__ int lds_byte(int r, int c) { const int st = (r >> 4) * 2 + (c >> 5), rr = r & 15, cc = c & 31, ob = rr * 64 + cc * 2; return st * 1024 + (ob ^ (((ob >> 9) & 1) << 5)); }
__host__ __device__ __forceinline__ void stage_rc(int b, int& R, int& C) { const int st = b / 1024, sb = b % 1024, swz = sb ^ (((sb >> 9) & 1) << 5); R = (st >> 1) * 16 + swz / 64; C = (st & 1) * 32 + (swz % 64) / 2; }
__host__ __device__ __forceinline__ int perm32(int rho) { const int n = rho >> 4, i = rho & 15; return 8 * (i >> 2) + 4 * n + (i & 3); }

struct Unit { int pm, pn, kt0, nkt, kind, slice; };
struct Gemm { const bf16_t* A; const bf16_t* Bt; int M, N, K; };

struct StaticOrder {
    int nM, nN, nwg, G, c;
    __host__ __device__ __forceinline__ void init(int M, int N, int G_, int c_) { nM = M / BM; nN = N / BM; nwg = nM * nN; G = G_; c = c_; }
    __host__ __device__ __forceinline__ bool next(int i, Unit& u) const {
        const long L = (long)i * G + c; if (L >= nwg) return false;
        int wgid = (int)L; { const int q = nwg / NXCD, r = nwg % NXCD, xcd = wgid % NXCD, off = wgid / NXCD; wgid = (xcd < r ? xcd * (q + 1) : r * (q + 1) + (xcd - r) * q) + off; }
        const int nig = WGM * nN, gid = wgid / nig, fm = gid * WGM, gsz = (nM - fm) < WGM ? (nM - fm) : WGM;
        u.pm = fm + ((wgid % nig) % gsz); u.pn = (wgid % nig) / gsz; return true;
    }
    __device__ __forceinline__ void a_ready(const Unit&) const {}
    __device__ __forceinline__ void done(const Unit&) const {}
};

__device__ __forceinline__ unsigned cvt_pk_bf16(float lo, float hi) { unsigned r; asm volatile("v_cvt_pk_bf16_f32 %0, %1, %2" : "=v"(r) : "v"(lo), "v"(hi)); return r; }
typedef float f32x2 __attribute__((ext_vector_type(2)));
template <class Epi, class Sched, bool ALIGN_EPI = false, bool SP2 = false>
__device__ __forceinline__ void gemm_phase(PG8_LAS unsigned char* lds, const Gemm g, const Sched& S, const Epi& E) {
    const int tid = threadIdx.x, wid = __builtin_amdgcn_readfirstlane(tid >> 6), lane = tid & 63, wr = wid >> 2, wc = wid & 3, fr = lane & 15, fq = lane >> 4;
    const int K = g.K;
    unsigned voffA[2], voffB[2];
#pragma unroll
    for (int i = 0; i < 2; ++i) { int R, C; stage_rc(tid * 16 + i * 8192, R, C); const int Rb = Epi::PERM ? ((R & ~31) + perm32(R & 31)) : R;
        voffA[i] = (unsigned)(R * K + C) * 2u; voffB[i] = (unsigned)(Rb * K + C) * 2u; }
    const size_t kstep = (size_t)(BK * 2);
    const size_t hstep = (size_t)HALF * K * 2;
    const size_t tstep = 2 * hstep;
    const unsigned ldsw = (unsigned)wid * 1024u;
    const int aoff = lds_byte(wr * 64 + fr, fq * 8), boff = lds_byte(wc * 32 + fr, fq * 8);
#define PG8_SA(b, h) (((b) * 2 + (h)) * HTB)
#define PG8_SB(b, h) ((4 + (b) * 2 + (h)) * HTB)
#define PG8_STAGE(bufoff, gbase, voff) do { _Pragma("unroll") for (int _i = 0; _i < 2; ++_i) \
        __builtin_amdgcn_global_load_lds((const unsigned*)((const char*)(gbase) + (voff)[_i]), (PG8_LAS unsigned*)(lds + (bufoff) + ldsw + _i * 8192), 16, 0, 0); } while (0)
#define PG8_LDA(dst, b, h) do { _Pragma("unroll") for (int m = 0; m < 4; ++m) _Pragma("unroll") for (int k = 0; k < 2; ++k) dst[m][k] = *(const PG8_LAS bf16x8*)(lds + PG8_SA(b, h) + aoff + m * 2048 + k * 1024); } while (0)
#define PG8_LDB(dst, b, h) do { _Pragma("unroll") for (int n = 0; n < 2; ++n) _Pragma("unroll") for (int k = 0; k < 2; ++k) dst[n][k] = *(const PG8_LAS bf16x8*)(lds + PG8_SB(b, h) + boff + n * 2048 + k * 1024); } while (0)
#define PG8_MMA(ai, bj, At, Bt) do { __builtin_amdgcn_s_setprio(1); _Pragma("unroll") for (int m = 0; m < 4; ++m) _Pragma("unroll") for (int n = 0; n < 2; ++n) _Pragma("unroll") for (int k = 0; k < 2; ++k) \
        acc[ai][bj][m][n] = __builtin_amdgcn_mfma_f32_16x16x32_bf16(Bt[n][k], At[m][k], acc[ai][bj][m][n], 0, 0, 0); __builtin_amdgcn_s_setprio(0); } while (0)
#define PG8_WAIT_V(n) asm volatile("s_waitcnt vmcnt(" #n ")" ::: "memory")
#define PG8_WAIT_L(n) asm volatile("s_waitcnt lgkmcnt(" #n ")" ::: "memory")
#define PG8_BAR __builtin_amdgcn_s_barrier()
#define PG8_SCHED __builtin_amdgcn_sched_barrier(0)
    Unit cur = {0, 0, 0, 0, 0, 0}, nxt = {0, 0, 0, 0, 0, 0}; int ui = 0;
    if (!S.next(0, cur)) return;
    f32x4 acc[2][2][4][2];
#pragma unroll
    for (int a = 0; a < 2; ++a)
#pragma unroll
        for (int b = 0; b < 2; ++b)
#pragma unroll
            for (int m = 0; m < 4; ++m)
#pragma unroll
                for (int n = 0; n < 2; ++n) acc[a][b][m][n] = (f32x4){0.f, 0.f, 0.f, 0.f};
    bf16x8 At[4][2], B0[2][2], B1[2][2];
    const char* cA = (const char*)g.A + (size_t)cur.pm * tstep + (size_t)cur.kt0 * kstep; const char* cB = (const char*)g.Bt + (size_t)cur.pn * tstep + (size_t)cur.kt0 * kstep;
    S.a_ready(cur);
    if constexpr (SP2) {
        PG8_STAGE(PG8_SB(0, 0), cB, voffB); PG8_STAGE(PG8_SB(0, 1), cB + hstep, voffB); PG8_STAGE(PG8_SA(0, 0), cA, voffA); PG8_STAGE(PG8_SA(0, 1), cA + hstep, voffA);
        if (wr == 1) PG8_BAR;
        PG8_WAIT_V(2); PG8_BAR;
        PG8_STAGE(PG8_SB(1, 0), cB + kstep, voffB); PG8_STAGE(PG8_SA(1, 0), cA + kstep, voffA); PG8_STAGE(PG8_SB(1, 1), cB + hstep + kstep, voffB);
        PG8_WAIT_V(6); PG8_BAR;
    } else {
        PG8_STAGE(PG8_SB(0, 0), cB, voffB); PG8_STAGE(PG8_SA(0, 0), cA, voffA); PG8_STAGE(PG8_SB(0, 1), cB + hstep, voffB); PG8_STAGE(PG8_SA(0, 1), cA + hstep, voffA);
        if (wr == 1) PG8_BAR;
        PG8_WAIT_V(4); PG8_BAR;
        PG8_STAGE(PG8_SB(1, 0), cB + kstep, voffB); PG8_STAGE(PG8_SA(1, 0), cA + kstep, voffA); PG8_STAGE(PG8_SB(1, 1), cB + hstep + kstep, voffB);
        PG8_WAIT_V(6); PG8_BAR;
    }
    for (;;) {
        const bool has_next = S.next(ui + 1, nxt);
        const char* nA = has_next ? (const char*)g.A + (size_t)nxt.pm * tstep + (size_t)nxt.kt0 * kstep : cA; const char* nB = has_next ? (const char*)g.Bt + (size_t)nxt.pn * tstep + (size_t)nxt.kt0 * kstep : cB;
        const int nt = cur.nkt;
        for (int t = 0; t < nt; t += 2) {
            const bool last = (t == nt - 2);
            const char* a1 = cA + (size_t)(t + 1) * kstep;
            const char* a2 = last ? nA : cA + (size_t)(t + 2) * kstep; const char* b2 = last ? nB : cB + (size_t)(t + 2) * kstep;
            const char* a3 = a2 + kstep; const char* b3 = b2 + kstep;
            if (last && has_next) S.a_ready(nxt);
            if constexpr (SP2) {
            PG8_LDB(B0, 0, 0); PG8_LDB(B1, 0, 1); PG8_SCHED; PG8_LDA(At, 0, 0); PG8_STAGE(PG8_SA(1, 1), a1 + hstep, voffA);
            PG8_WAIT_V(8); PG8_WAIT_L(0); PG8_BAR; PG8_MMA(0, 0, At, B0); PG8_MMA(0, 1, At, B1); PG8_BAR; PG8_SCHED;
            PG8_LDA(At, 0, 1); PG8_STAGE(PG8_SB(0, 0), b2, voffB); PG8_STAGE(PG8_SB(0, 1), b2 + hstep, voffB); PG8_STAGE(PG8_SA(0, 0), a2, voffA);
            PG8_WAIT_V(8); PG8_WAIT_L(0); PG8_BAR; PG8_MMA(1, 0, At, B0); PG8_MMA(1, 1, At, B1); PG8_BAR; PG8_SCHED;
            PG8_LDB(B0, 1, 0); PG8_LDB(B1, 1, 1); PG8_SCHED; PG8_LDA(At, 1, 0); PG8_STAGE(PG8_SA(0, 1), a2 + hstep, voffA);
            PG8_WAIT_V(8); PG8_WAIT_L(0); PG8_BAR; PG8_MMA(0, 0, At, B0); PG8_MMA(0, 1, At, B1); PG8_BAR; PG8_SCHED;
            PG8_LDA(At, 1, 1); PG8_STAGE(PG8_SB(1, 0), b3, voffB); PG8_STAGE(PG8_SB(1, 1), b3 + hstep, voffB); PG8_STAGE(PG8_SA(1, 0), a3, voffA);
            PG8_WAIT_V(8); PG8_WAIT_L(0); PG8_BAR; PG8_MMA(1, 0, At, B0); PG8_MMA(1, 1, At, B1); PG8_BAR; PG8_SCHED;
            } else {
            PG8_LDB(B0, 0, 0); PG8_SCHED; PG8_LDA(At, 0, 0); PG8_STAGE(PG8_SA(1, 1), a1 + hstep, voffA);
            PG8_WAIT_L(8); PG8_BAR; PG8_WAIT_L(0); PG8_MMA(0, 0, At, B0); PG8_BAR; PG8_SCHED;
            PG8_LDB(B1, 0, 1); PG8_STAGE(PG8_SB(0, 0), b2, voffB);
            PG8_BAR; PG8_WAIT_L(0); PG8_MMA(0, 1, At, B1); PG8_BAR;
            PG8_LDA(At, 0, 1); PG8_STAGE(PG8_SA(0, 0), a2, voffA);
            PG8_BAR; PG8_WAIT_L(0); PG8_MMA(1, 0, At, B0); PG8_BAR; PG8_SCHED;
            PG8_STAGE(PG8_SB(0, 1), b2 + hstep, voffB);
            PG8_WAIT_V(6); PG8_BAR; PG8_MMA(1, 1, At, B1); PG8_BAR;
            PG8_LDB(B0, 1, 0); PG8_SCHED; PG8_LDA(At, 1, 0); PG8_STAGE(PG8_SA(0, 1), a2 + hstep, voffA);
            PG8_WAIT_L(8); PG8_BAR; PG8_WAIT_L(0); PG8_MMA(0, 0, At, B0); PG8_BAR; PG8_SCHED;
            PG8_LDB(B1, 1, 1); PG8_STAGE(PG8_SB(1, 0), b3, voffB);
            PG8_BAR; PG8_WAIT_L(0); PG8_MMA(0, 1, At, B1); PG8_BAR;
            PG8_LDA(At, 1, 1); PG8_STAGE(PG8_SA(1, 0), a3, voffA);
            PG8_BAR; PG8_WAIT_L(0); PG8_MMA(1, 0, At, B0); PG8_BAR; PG8_SCHED;
            PG8_STAGE(PG8_SB(1, 1), b3 + hstep, voffB);
            PG8_WAIT_V(6); PG8_BAR; PG8_MMA(1, 1, At, B1); PG8_BAR;
            }
        }
        if constexpr (ALIGN_EPI) { if (wr == 0) PG8_BAR; }
        if constexpr (!Epi::AFTER_DRAIN) { E(acc, cur, wr, wc, fr, fq); S.done(cur); }
        if (!has_next) break;
#pragma unroll
        for (int a = 0; a < 2; ++a)
#pragma unroll
            for (int b = 0; b < 2; ++b)
#pragma unroll
                for (int m = 0; m < 4; ++m)
#pragma unroll
                    for (int n = 0; n < 2; ++n) acc[a][b][m][n] = (f32x4){0.f, 0.f, 0.f, 0.f};
        cur = nxt; cA = nA; cB = nB; ++ui;
        if constexpr (ALIGN_EPI) { if (wr == 1) PG8_BAR; }
    }
    PG8_WAIT_V(0);
    if constexpr (!ALIGN_EPI) { if (wr == 0) PG8_BAR; }
    PG8_BAR;
    if constexpr (Epi::AFTER_DRAIN) { E.fused(acc, cur, wr, wc, fr, fq, lds, wid, lane); S.done(cur); }
#undef PG8_SA
#undef PG8_SB
#undef PG8_STAGE
#undef PG8_LDA
#undef PG8_LDB
#undef PG8_MMA
#undef PG8_WAIT_V
#undef PG8_WAIT_L
#undef PG8_BAR
#undef PG8_SCHED
}
}

#define LAS __attribute__((address_space(3)))
typedef unsigned short bf16;
typedef float f32x4 __attribute__((ext_vector_type(4)));
typedef float f32x2 __attribute__((ext_vector_type(2)));
typedef short bf16x8 __attribute__((ext_vector_type(8)));
typedef unsigned u32x4 __attribute__((ext_vector_type(4)));
typedef unsigned u32x2 __attribute__((ext_vector_type(2)));

constexpr int DM = 1024, NBP = 8, SEQ = 2048, MPR = NBP * SEQ, NBS = 128, MTOK = MPR + NBS, MPAD = 16640;
constexpr int DL = 512, NPROJ = 1536, NMOD = 6144, NBT = NBP + NBS, DFF = 2816;
constexpr int LCH = 64, NCH = SEQ / LCH;
constexpr int SCH = 16;
constexpr int SL = 16, SNCH = SEQ / SL, SROWS = NBP * SNCH;
constexpr float EPS = 1e-6f;
constexpr int NPHASE = 13;

constexpr size_t O_Y = 0, O_CONVP = (size_t)MTOK * DM, O_LRUP = O_CONVP + 8 * 3 * 512, O_S5RP = O_LRUP + 8 * 512, O_S5IP = O_S5RP + 8 * 32 * 64,
                 O_CONVS = O_S5IP + 8 * 32 * 64, O_LRUS = O_CONVS + 128 * 3 * 512, O_S5RS = O_LRUS + 128 * 512, O_S5IS = O_S5RS + 128 * 32 * 64, O_END = O_S5IS + 128 * 32 * 64;

constexpr size_t HM = 1u << 19;
constexpr size_t WS_WIN = 2 * HM, WS_WGLU = 8 * HM, WS_WOUT = 10 * HM, WS_WGU = 14 * HM, WS_WDN = 36 * HM  , WS_MOD = 48 * HM  ,
                 WS_TF = 56 * HM  , WS_E = 68 * HM  , WS_TAB = 72 * HM, WS_AGG = 74 * HM  ,
                 WS_XN = 80 * HM  , WS_LRUX = 146 * HM  , WS_GATE = 211 * HM  ,
                 WS_S5U = 244 * HM  , WS_HLOC = 277 * HM  , WS_CUM = 342 * HM, WS_GY = 407 * HM  ,
                 WS_SK = 440 * HM  , WS_HIN = 472 * HM  , WS_HB = 244 * HM  , WS_PART = 488 * HM  , WS_END = 512 * HM;
constexpr size_t T_ABAR = 0, T_A16 = 4096, T_BBR = 8192, T_BBI = 8192 + 32768;

struct KArgs { const float* in[36]; float* out; unsigned char* ws; int lo, hi; };

struct Ctx {
    const float* const* in; float* out; unsigned char* ws;
    __device__ __forceinline__ const float* I(int i) const { return in[i]; }
    __device__ __forceinline__ bf16* WIN() const { return (bf16*)(ws + WS_WIN); }
    __device__ __forceinline__ bf16* WGLU() const { return (bf16*)(ws + WS_WGLU); }
    __device__ __forceinline__ bf16* WOUT() const { return (bf16*)(ws + WS_WOUT); }
    __device__ __forceinline__ bf16* WGU() const { return (bf16*)(ws + WS_WGU); }
    __device__ __forceinline__ bf16* WDN() const { return (bf16*)(ws + WS_WDN); }
    __device__ __forceinline__ float* MOD() const { return (float*)(ws + WS_MOD); }
    __device__ __forceinline__ bf16* TF() const { return (bf16*)(ws + WS_TF); }
    __device__ __forceinline__ bf16* EM() const { return (bf16*)(ws + WS_E); }
    __device__ __forceinline__ float* TAB() const { return (float*)(ws + WS_TAB); }
    __device__ __forceinline__ f32x2* AGG() const { return (f32x2*)(ws + WS_AGG); }
    __device__ __forceinline__ bf16* XN() const { return (bf16*)(ws + WS_XN); }
    __device__ __forceinline__ bf16* MERGED() const { return (bf16*)(ws + WS_XN); }
    __device__ __forceinline__ float* LRUX() const { return (float*)(ws + WS_LRUX); }
    __device__ __forceinline__ bf16* XN2() const { return (bf16*)(ws + WS_LRUX); }
    __device__ __forceinline__ bf16* GATE() const { return (bf16*)(ws + WS_GATE); }
    __device__ __forceinline__ bf16* S5U() const { return (bf16*)(ws + WS_S5U); }
    __device__ __forceinline__ float* HLOC() const { return (float*)(ws + WS_HLOC); }
    __device__ __forceinline__ float* S5OUT() const { return (float*)(ws + WS_HLOC); }
    __device__ __forceinline__ float* CUM() const { return (float*)(ws + WS_CUM); }
    __device__ __forceinline__ bf16* GY() const { return (bf16*)(ws + WS_GY); }
    __device__ __forceinline__ float* SK() const { return (float*)(ws + WS_SK); }
    __device__ __forceinline__ bf16* HIN() const { return (bf16*)(ws + WS_HIN); }
    __device__ __forceinline__ bf16* HB() const { return (bf16*)(ws + WS_HB); }
    __device__ __forceinline__ float* PART() const { return (float*)(ws + WS_PART); }
};

#define LDS_WAIT() asm volatile("s_waitcnt lgkmcnt(0)" ::: "memory")
__device__ __forceinline__ unsigned pk2(float lo, float hi) { return pg8::cvt_pk_bf16(lo, hi); }
__device__ __forceinline__ float bf2f(unsigned b) { return __uint_as_float(b << 16); }
__device__ __forceinline__ float bflo(unsigned w) { return __uint_as_float(w << 16); }
__device__ __forceinline__ float bfhi(unsigned w) { return __uint_as_float(w & 0xffff0000u); }
__device__ __forceinline__ float wave_sum(float v) {
#pragma unroll
    for (int o = 1; o < 64; o <<= 1) v += __shfl_xor(v, o);
    return v;
}
__device__ __forceinline__ float sigm(float v) { return __builtin_amdgcn_rcpf(1.f + __builtin_amdgcn_exp2f(-1.44269504089f * v)); }
__device__ __forceinline__ float gelu_tanh(float x) { const float u = (-1.5957691216f * 1.44269504089f) * (x + 0.044715f * x * x * x); return x * __builtin_amdgcn_rcpf(1.f + __builtin_amdgcn_exp2f(u)); }
__device__ __forceinline__ int mod_row(int row) { return row < MPR ? (row >> 11) : (NBP + row - MPR); }
__device__ __forceinline__ u32x4 pack8(f32x4 a, f32x4 b) { u32x4 w; w.x = pk2(a[0], a[1]); w.y = pk2(a[2], a[3]); w.z = pk2(b[0], b[1]); w.w = pk2(b[2], b[3]); return w; }

struct Sched2 {
    pg8::StaticOrder so; int nkt_full, n_extra, ex_nn, ex_nkt;
    __device__ __forceinline__ void init(int N, int K, int G, int c, int ex_nkt_) { so.init(MPR, N, G, c); nkt_full = K / 64; ex_nn = N / 256; ex_nkt = ex_nkt_; n_extra = ex_nn * (nkt_full / ex_nkt_); }
    __device__ __forceinline__ bool next(int i, pg8::Unit& u) const {
        const long L = (long)i * so.G + so.c;
        const bool prompt = L < so.nwg; const int e = (int)(L - so.nwg);
        if (!prompt && e >= n_extra) return false;
        pg8::Unit t; t.pm = 0; t.pn = 0; t.kt0 = 0; t.nkt = 0; t.kind = 0; t.slice = 0;
        if (prompt) so.next(i, t);
        const int sl = prompt ? 0 : e / ex_nn;
        pg8::Unit r; r.pm = prompt ? t.pm : 64; r.pn = prompt ? t.pn : e % ex_nn; r.kt0 = sl * ex_nkt; r.nkt = prompt ? nkt_full : ex_nkt; r.kind = prompt ? 0 : ((ex_nkt == nkt_full) ? 1 : 2); r.slice = sl;
        u = r; return true;
    }
    __device__ __forceinline__ void a_ready(const pg8::Unit&) const {}
    __device__ __forceinline__ void done(const pg8::Unit&) const {}
};
__device__ __forceinline__ void store_partial(const f32x4 (&acc)[2][2][4][2], const pg8::Unit& u, int wr, int wc, int fr, int fq, float* part) {
    float* base = part + (size_t)u.slice * 128 * 1024 + u.pn * 256 + wc * 32 + 8 * fq;
#pragma unroll
    for (int m = 0; m < 4; ++m) { float* rp = base + (size_t)(wr * 64 + m * 16 + fr) * 1024;
#pragma unroll
        for (int bj = 0; bj < 2; ++bj)
#pragma unroll
            for (int n = 0; n < 2; ++n) *(f32x4*)(rp + bj * 128 + 4 * n) = acc[0][bj][m][n]; }
}

struct EpiProj {
    static constexpr bool PERM = true, AFTER_DRAIN = false; float* lrux; bf16* gate; bf16* s5u;
    __device__ __forceinline__ void operator()(const f32x4 (&acc)[2][2][4][2], const pg8::Unit& u, int wr, int wc, int fr, int fq) const {
        const int colt = u.pn * 256 + wc * 32 + 8 * fq;
#pragma unroll
        for (int ai = 0; ai < 2; ++ai)
#pragma unroll
            for (int m = 0; m < 4; ++m) { const int row = u.pm * 256 + ai * 128 + wr * 64 + m * 16 + fr; if (row >= MTOK) continue;
#pragma unroll
                for (int bj = 0; bj < 2; ++bj) { const int col = colt + bj * 128; const f32x4 v0 = acc[ai][bj][m][0], v1 = acc[ai][bj][m][1];
                    if (u.pn < 2) { float* p = lrux + (size_t)row * 512 + col; *(f32x4*)p = v0; *(f32x4*)(p + 4) = v1; }
                    else if (u.pn < 4) { *(u32x4*)(gate + (size_t)row * 512 + (col - 512)) = pack8(v0, v1); }
                    else { *(u32x4*)(s5u + (size_t)row * 512 + (col - 1024)) = pack8(v0, v1); } } }
    }
};
struct EpiGlu {
    static constexpr bool PERM = true, AFTER_DRAIN = false; float* o; float* part;
    __device__ __forceinline__ void operator()(const f32x4 (&acc)[2][2][4][2], const pg8::Unit& u, int wr, int wc, int fr, int fq) const {
        if (u.kind == 2) { store_partial(acc, u, wr, wc, fr, fq, part); return; }
        const int col = u.pn * 128 + wc * 32 + 8 * fq;
#pragma unroll
        for (int ai = 0; ai < 2; ++ai)
#pragma unroll
            for (int m = 0; m < 4; ++m) { const int row = u.pm * 256 + ai * 128 + wr * 64 + m * 16 + fr; if (row >= MTOK) continue;
#pragma unroll
                for (int n = 0; n < 2; ++n) { const f32x4 a = acc[ai][0][m][n], b = acc[ai][1][m][n]; f32x4 s;
#pragma unroll
                    for (int i = 0; i < 4; ++i) s[i] = a[i] * sigm(b[i]);
                    *(f32x4*)(o + (size_t)row * 512 + col + 4 * n) = s; } }
    }
};
template <int GOFF> struct EpiRes {
    static constexpr bool PERM = true, AFTER_DRAIN = false; const float* xp; const float* xs; const float* mod; float* out; float* part;
    __device__ __forceinline__ void operator()(const f32x4 (&acc)[2][2][4][2], const pg8::Unit& u, int wr, int wc, int fr, int fq) const {
        if (u.kind == 2) { store_partial(acc, u, wr, wc, fr, fq, part); return; }
        const int colt = u.pn * 256 + wc * 32 + 8 * fq;
#pragma unroll
        for (int ai = 0; ai < 2; ++ai)
#pragma unroll
            for (int m = 0; m < 4; ++m) { const int row = u.pm * 256 + ai * 128 + wr * 64 + m * 16 + fr; if (row >= MTOK) continue;
                const float* gp = mod + (size_t)mod_row(row) * NMOD + GOFF; float* op = out + (size_t)row * DM;
                const float* bp = xp ? (row < MPR ? xp + (size_t)row * DM : xs + (size_t)(row - MPR) * DM) : op;
#pragma unroll
                for (int bj = 0; bj < 2; ++bj)
#pragma unroll
                    for (int n = 0; n < 2; ++n) { const int c = colt + bj * 128 + 4 * n; const f32x4 x4 = *(const f32x4*)(bp + c), g4 = *(const f32x4*)(gp + c);
                        *(f32x4*)(op + c) = x4 + g4 * acc[ai][bj][m][n]; } }
    }
};
struct EpiSwiglu {
    static constexpr bool PERM = true, AFTER_DRAIN = false; bf16* h;
    __device__ __forceinline__ void operator()(const f32x4 (&acc)[2][2][4][2], const pg8::Unit& u, int wr, int wc, int fr, int fq) const {
        const int col = u.pn * 128 + wc * 32 + 8 * fq;
#pragma unroll
        for (int ai = 0; ai < 2; ++ai)
#pragma unroll
            for (int m = 0; m < 4; ++m) { const int row = u.pm * 256 + ai * 128 + wr * 64 + m * 16 + fr; if (row >= MTOK) continue;
                f32x4 s[2];
#pragma unroll
                for (int n = 0; n < 2; ++n) { const f32x4 a = acc[ai][0][m][n], b = acc[ai][1][m][n];
#pragma unroll
                    for (int i = 0; i < 4; ++i) s[n][i] = a[i] * sigm(a[i]) * b[i]; }
                *(u32x4*)(h + (size_t)row * DFF + col) = pack8(s[0], s[1]); }
    }
};

__device__ __forceinline__ void transpose_item(const float* W, int ldw, int k0, int n0, bf16* WT, int K, int drow0, LAS bf16* scr, int lane) {
    const int lr = lane >> 4, lc = lane & 15;
    f32x4 v[16];
#pragma unroll
    for (int i = 0; i < 16; ++i) v[i] = *(const f32x4*)(W + (size_t)(k0 + lr + 4 * i) * ldw + n0 + 4 * lc);
#pragma unroll
    for (int i = 0; i < 16; ++i) { u32x2 p; p.x = pk2(v[i].x, v[i].y); p.y = pk2(v[i].z, v[i].w); *(LAS u32x2*)(scr + (lr + 4 * i) * 68 + 4 * lc) = p; }
    LDS_WAIT();
    const int kc = lane & 7;
#pragma unroll
    for (int j = 0; j < 8; ++j) { const int n = (lane >> 3) + 8 * j; const LAS bf16* sp = scr + (8 * kc) * 68 + n;
        u32x4 o; o.x = (unsigned)sp[0] | ((unsigned)sp[68] << 16); o.y = (unsigned)sp[2 * 68] | ((unsigned)sp[3 * 68] << 16);
        o.z = (unsigned)sp[4 * 68] | ((unsigned)sp[5 * 68] << 16); o.w = (unsigned)sp[6 * 68] | ((unsigned)sp[7 * 68] << 16);
        *(u32x4*)(WT + (size_t)(drow0 + n) * K + k0 + 8 * kc) = o; }
    LDS_WAIT();
}
__device__ __forceinline__ void transpose_dispatch(const Ctx& cx, int it, LAS bf16* scr, int lane) {
    if (it < 384) { const int kb = it / 24, nb = it % 24; transpose_item(cx.I(11), NPROJ, 64 * kb, 64 * nb, cx.WIN(), DM, 64 * nb, scr, lane); return; } it -= 384;
    if (it < 128) { const int kb = it / 16, nb = it % 16, n0 = 64 * nb; const int dr = 256 * ((n0 & 511) >> 7) + 128 * (n0 >> 9) + (n0 & 127);
        transpose_item(cx.I(27), 1024, 64 * kb, n0, cx.WGLU(), 512, dr, scr, lane); return; } it -= 128;
    if (it < 256) { const int kb = it / 16, nb = it % 16; transpose_item(cx.I(30), DM, 64 * kb, 64 * nb, cx.WOUT(), DM, 64 * nb, scr, lane); return; } it -= 256;
    if (it < 704) { const int kb = it / 44, nb = it % 44, n0 = 64 * nb; transpose_item(cx.I(32), DFF, 64 * kb, n0, cx.WGU(), DM, 256 * (n0 >> 7) + (n0 & 127), scr, lane); return; } it -= 704;
    if (it < 704) { const int kb = it / 44, nb = it % 44, n0 = 64 * nb; transpose_item(cx.I(33), DFF, 64 * kb, n0, cx.WGU(), DM, 256 * (n0 >> 7) + 128 + (n0 & 127), scr, lane); return; } it -= 704;
    { const int kb = it / 16, nb = it % 16; transpose_item(cx.I(34), DM, 64 * kb, 64 * nb, cx.WDN(), DFF, 64 * nb, scr, lane); }
}
constexpr int N_TR_ITEMS = 384 + 128 + 256 + 704 + 704 + 704;

__device__ __forceinline__ void ada_block(const Ctx& cx, int item, LAS unsigned char* lds) {
    const int tid = threadIdx.x, w = __builtin_amdgcn_readfirstlane(tid >> 6), lane = tid & 63, fr = lane & 15, fq = lane >> 4, n0 = 32 * item;
    const float* W = cx.I(8); const float* cp = cx.I(6); const float* cs = cx.I(7);
    bf16x8 wf[4][2];
#pragma unroll
    for (int ks = 0; ks < 4; ++ks)
#pragma unroll
        for (int nt = 0; nt < 2; ++nt) { const float* src = W + (size_t)(128 * w + 32 * ks + 8 * fq) * NMOD + n0 + 16 * nt + fr;
            u32x4 o; o.x = pk2(src[0], src[NMOD]); o.y = pk2(src[2 * NMOD], src[3 * NMOD]); o.z = pk2(src[4 * NMOD], src[5 * NMOD]); o.w = pk2(src[6 * NMOD], src[7 * NMOD]); wf[ks][nt] = __builtin_bit_cast(bf16x8, o); }
    f32x4 acc[9][2];
#pragma unroll
    for (int i = 0; i < 9; ++i) { acc[i][0] = (f32x4){0.f, 0.f, 0.f, 0.f}; acc[i][1] = (f32x4){0.f, 0.f, 0.f, 0.f}; }
#pragma unroll
    for (int mt = 0; mt < 9; ++mt) { int row = 16 * mt + fr; row = row < NBT ? row : NBT - 1;
        const float* src = (row < NBP ? cp + (size_t)row * DM : cs + (size_t)(row - NBP) * DM) + 128 * w + 8 * fq;
#pragma unroll
        for (int ks = 0; ks < 4; ++ks) { f32x4 a0 = *(const f32x4*)(src + 32 * ks), a1 = *(const f32x4*)(src + 32 * ks + 4);
#pragma unroll
            for (int i = 0; i < 4; ++i) { a0[i] = a0[i] * sigm(a0[i]); a1[i] = a1[i] * sigm(a1[i]); }
            const bf16x8 af = __builtin_bit_cast(bf16x8, pack8(a0, a1));
            acc[mt][0] = __builtin_amdgcn_mfma_f32_16x16x32_bf16(wf[ks][0], af, acc[mt][0], 0, 0, 0);
            acc[mt][1] = __builtin_amdgcn_mfma_f32_16x16x32_bf16(wf[ks][1], af, acc[mt][1], 0, 0, 0); } }
    LAS f32x4* red = (LAS f32x4*)lds;
#pragma unroll
    for (int st = 4; st >= 1; st >>= 1) {
        if (w >= st && w < 2 * st) {
#pragma unroll
            for (int i = 0; i < 9; ++i) { red[((w - st) * 18 + 2 * i) * 64 + lane] = acc[i][0]; red[((w - st) * 18 + 2 * i + 1) * 64 + lane] = acc[i][1]; } }
        __syncthreads();
        if (w < st) {
#pragma unroll
            for (int i = 0; i < 9; ++i) { acc[i][0] += red[(w * 18 + 2 * i) * 64 + lane]; acc[i][1] += red[(w * 18 + 2 * i + 1) * 64 + lane]; } }
        __syncthreads();
    }
    if (w == 0) {
#pragma unroll
        for (int nt = 0; nt < 2; ++nt) { const f32x4 b4 = *(const f32x4*)(cx.I(9) + n0 + 16 * nt + 4 * fq);
#pragma unroll
            for (int mt = 0; mt < 9; ++mt) { const int row = 16 * mt + fr; if (row < NBT) *(f32x4*)(cx.MOD() + (size_t)row * NMOD + n0 + 16 * nt + 4 * fq) = acc[mt][nt] + b4; } } }
}

__device__ __forceinline__ void s5_tables(const Ctx& cx, int g, LAS unsigned char* lds) {
    LAS f32x2* Ap = (LAS f32x2*)lds;
    LAS f32x2* Bb = Ap + 17 * 64;
    LAS f32x2* Cc = Bb + 1024;
    LAS f32x2* Ff = Cc + 1024;
    LAS float* Kt = (LAS float*)(Ff + 64);
    const int tid = threadIdx.x;
    float* tab = cx.TAB();
    if (tid < 64) {
        const int n = tid; const float lr = cx.I(19)[g * 64 + n], li = cx.I(20)[g * 64 + n], dt = expf(cx.I(21)[g]);
        const float mag = expf(lr * dt);
        const double ang = (double)li * (double)dt; const double kq = rint(ang * 0.63661977236758134308); const double r = ang - kq * 1.57079632679489661923; const double r2 = r * r;
        const double sn = r * (1.0 + r2 * (-1.0 / 6 + r2 * (1.0 / 120 + r2 * (-1.0 / 5040 + r2 * (1.0 / 362880 + r2 * (-1.0 / 39916800 + r2 * (1.0 / 6227020800.0)))))));
        const double cn = 1.0 + r2 * (-0.5 + r2 * (1.0 / 24 + r2 * (-1.0 / 720 + r2 * (1.0 / 40320 + r2 * (-1.0 / 3628800 + r2 * (1.0 / 479001600.0))))));
        const int q = ((int)kq) & 3; const double cv = q == 0 ? cn : q == 1 ? -sn : q == 2 ? -cn : sn, sv = q == 0 ? sn : q == 1 ? cn : q == 2 ? -sn : -cn;
        const float abr = mag * (float)cv, abi = mag * (float)sv; const float den = lr * lr + li * li;
        const float frr = ((abr - 1.f) * lr + abi * li) / den, fii = (abi * lr - (abr - 1.f) * li) / den;
        f32x2 p = (f32x2){1.f, 0.f}; Ap[n] = p;
#pragma unroll 1
        for (int t = 1; t <= 16; ++t) { const float pr = p.x * abr - p.y * abi, pi = p.x * abi + p.y * abr; p = (f32x2){pr, pi}; Ap[t * 64 + n] = p; }
        Ff[n] = (f32x2){frr, fii};
        ((f32x2*)(tab + T_ABAR))[g * 64 + n] = (f32x2){abr, abi}; ((f32x2*)(tab + T_A16))[g * 64 + n] = p;
    }
    __syncthreads();
    for (int e = tid; e < 1024; e += 512) { const int n = e >> 4; const float br = cx.I(22)[g * 1024 + e], bi = cx.I(23)[g * 1024 + e]; const f32x2 f = Ff[n];
        const float bbr = f.x * br - f.y * bi, bbi = f.x * bi + f.y * br; Bb[e] = (f32x2){bbr, bbi}; tab[T_BBR + g * 1024 + e] = bbr; tab[T_BBI + g * 1024 + e] = bbi;
        Cc[e] = (f32x2){cx.I(24)[g * 1024 + e], cx.I(25)[g * 1024 + e]}; }
    __syncthreads();
    for (int e = tid; e < 4096; e += 512) { const int tau = e >> 8, c = (e >> 4) & 15, cp = e & 15; float sum = 0.f;
        for (int n = 0; n < 64; ++n) { const f32x2 a = Ap[tau * 64 + n], b = Bb[n * 16 + cp], cc = Cc[c * 64 + n];
            const float pr = a.x * b.x - a.y * b.y, pi = a.x * b.y + a.y * b.x; sum += cc.x * pr - cc.y * pi; }
        Kt[e] = sum; }
    __syncthreads();
    bf16* TFg = cx.TF() + (size_t)g * 256 * 384;
    for (int pc = tid; pc < 256 * 48; pc += 512) { const int row = pc / 48, k8 = (pc % 48) * 8, j = row >> 4, c = row & 15; float v[8];
#pragma unroll
        for (int q = 0; q < 8; ++q) { const int kk = k8 + q;
            if (kk < 256) { const int s = kk >> 4, cp = kk & 15; v[q] = (j >= s) ? Kt[((j - s) << 8) + (c << 4) + cp] : 0.f; }
            else { const int n = (kk - 256) & 63; const f32x2 p = Ap[(j + 1) * 64 + n], cc = Cc[c * 64 + n]; v[q] = (kk < 320) ? (cc.x * p.x - cc.y * p.y) : (-cc.x * p.y - cc.y * p.x); } }
        u32x4 o; o.x = pk2(v[0], v[1]); o.y = pk2(v[2], v[3]); o.z = pk2(v[4], v[5]); o.w = pk2(v[6], v[7]);
        *(u32x4*)(TFg + (size_t)row * 384 + k8) = o; }
    bf16* Eg = cx.EM() + (size_t)g * 128 * 256;
    for (int pc = tid; pc < 128 * 32; pc += 512) { const int np = pc >> 5, k8 = (pc & 31) * 8, n = np & 63, im = np >> 6; float v[8];
#pragma unroll
        for (int q = 0; q < 8; ++q) { const int kk = k8 + q, s = kk >> 4, cp = kk & 15; const f32x2 a = Ap[(15 - s) * 64 + n], b = Bb[n * 16 + cp];
            v[q] = im ? (a.x * b.y + a.y * b.x) : (a.x * b.x - a.y * b.y); }
        u32x4 o; o.x = pk2(v[0], v[1]); o.y = pk2(v[2], v[3]); o.z = pk2(v[4], v[5]); o.w = pk2(v[6], v[7]);
        *(u32x4*)(Eg + (size_t)np * 256 + k8) = o; }
    __syncthreads();
}

__device__ __forceinline__ void norm_mod_row(const float* xrow, const float* g, const float* sc, const float* sh, bf16* orow, int lane) {
    f32x4 v[4]; float ss = 0.f;
#pragma unroll
    for (int j = 0; j < 4; ++j) { v[j] = ((const f32x4*)xrow)[lane + 64 * j]; ss += (v[j].x * v[j].x + v[j].y * v[j].y) + (v[j].z * v[j].z + v[j].w * v[j].w); }
    const float rstd = rsqrtf(wave_sum(ss) * (1.f / DM) + EPS);
#pragma unroll
    for (int j = 0; j < 4; ++j) { const int col = 4 * (lane + 64 * j); const f32x4 gg = *(const f32x4*)(g + col), s1 = *(const f32x4*)(sc + col), s2 = *(const f32x4*)(sh + col);
        const f32x4 o = v[j] * rstd * gg * (1.f + s1) + s2; u32x2 w; w.x = pk2(o.x, o.y); w.y = pk2(o.z, o.w); *(u32x2*)(orow + col) = w; }
}

__device__ __forceinline__ void lru_local_unit(const Ctx& cx, int row0, int ntok, bool samp, int aggidx, LAS unsigned char* lds) {
    const int d = threadIdx.x, w = __builtin_amdgcn_readfirstlane(d >> 6), lane = d & 63, fr = lane & 15, fq = lane >> 4;
    LAS float* cf = (LAS float*)(lds + w * 8192);
    LAS bf16* cbf = (LAS bf16*)(lds + w * 8192 + 4608);
    bf16x8 wf[8][2];
#pragma unroll
    for (int nt = 0; nt < 8; ++nt)
#pragma unroll
        for (int ks = 0; ks < 2; ++ks) { const float* src = (nt < 4 ? cx.I(14) : cx.I(16)) + (size_t)w * 4096 + (32 * ks + 8 * fq) * 64 + 16 * (nt & 3) + fr;
            u32x4 o; o.x = pk2(src[0], src[64]); o.y = pk2(src[128], src[192]); o.z = pk2(src[256], src[320]); o.w = pk2(src[384], src[448]); wf[nt][ks] = __builtin_bit_cast(bf16x8, o); }
    const float cw0 = cx.I(12)[d], cw1 = cx.I(12)[512 + d], cw2 = cx.I(12)[1024 + d], cw3 = cx.I(12)[1536 + d], cb = cx.I(13)[d];
    float gba[4], gbx[4], gcd[4], hc[4], cc[4];
#pragma unroll
    for (int nt = 0; nt < 4; ++nt) { const int ch = 64 * w + 16 * nt + fr; gba[nt] = cx.I(15)[ch]; gbx[nt] = cx.I(17)[ch]; gcd[nt] = -8.f * 1.44269504089f * log1pf(expf(-cx.I(18)[ch])); hc[nt] = 0.f; cc[nt] = 1.f; }
    const float* X = cx.LRUX(); float* HL = cx.HLOC(); float* CU = cx.CUM();
    float xm3 = 0.f, xm2 = 0.f, xm1 = 0.f;
    if (!samp) { const int t0 = row0 & (SEQ - 1); if (t0 >= 3) { xm3 = X[(size_t)(row0 - 3) * DL + d]; xm2 = X[(size_t)(row0 - 2) * DL + d]; xm1 = X[(size_t)(row0 - 1) * DL + d]; } }
    float xv[16];
#pragma unroll
    for (int i = 0; i < 16; ++i) xv[i] = X[(size_t)(row0 + i) * DL + d];
    for (int t0 = 0; t0 < ntok; t0 += 16) {
        if (samp) {
#pragma unroll
            for (int i = 0; i < 16; ++i) { const int row = row0 + t0 + i; const float* sc = cx.I(2) + (size_t)(row - MPR) * 1536 + d;
                const float cv = cb + cw0 * sc[0] + cw1 * sc[512] + cw2 * sc[1024] + cw3 * xv[i];
                cf[i * 68 + lane] = cv; cbf[i * 72 + lane] = (bf16)(pk2(cv, cv) & 0xffffu); }
        } else {
#pragma unroll
            for (int i = 0; i < 16; ++i) { const float x = xv[i]; const float cv = cb + cw0 * xm3 + cw1 * xm2 + cw2 * xm1 + cw3 * x; xm3 = xm2; xm2 = xm1; xm1 = x;
                cf[i * 68 + lane] = cv; cbf[i * 72 + lane] = (bf16)(pk2(cv, cv) & 0xffffu); }
        }
        if (t0 + 16 < ntok) {
#pragma unroll
            for (int i = 0; i < 16; ++i) xv[i] = X[(size_t)(row0 + t0 + 16 + i) * DL + d]; }
        LDS_WAIT();
        f32x4 acc[8];
#pragma unroll
        for (int nt = 0; nt < 8; ++nt) acc[nt] = (f32x4){0.f, 0.f, 0.f, 0.f};
#pragma unroll
        for (int ks = 0; ks < 2; ++ks) { const bf16x8 af = *(const LAS bf16x8*)(cbf + fr * 72 + 32 * ks + 8 * fq);
#pragma unroll
            for (int nt = 0; nt < 8; ++nt) acc[nt] = __builtin_amdgcn_mfma_f32_16x16x32_bf16(af, wf[nt][ks], acc[nt], 0, 0, 0); }
#pragma unroll
        for (int nt = 0; nt < 4; ++nt) { const int ch = 64 * w + 16 * nt + fr;
            float av[4], hv[4]; float P = 1.f, H = 0.f;
#pragma unroll
            for (int r = 0; r < 4; ++r) { const int tok = 4 * fq + r; const float cvv = cf[tok * 68 + 16 * nt + fr];
                const float rr = sigm(acc[nt][r] + gba[nt]), ig = sigm(acc[nt + 4][r] + gbx[nt]);
                const float a = __builtin_amdgcn_exp2f(gcd[nt] * rr);
                const float bb = __builtin_amdgcn_sqrtf(fmaf(-a, a, 1.f)) * ig * cvv;
                if (samp) { const float h0 = cx.I(3)[(size_t)(row0 + t0 + tok - MPR) * DL + ch]; hv[r] = a * h0 + bb; av[r] = 0.f; }
                else { H = a * H + bb; P = P * a; hv[r] = H; av[r] = P; } }
            if (!samp) {
                float Pp = __shfl_up(P, 16), Hp = __shfl_up(H, 16); if (fq >= 1) { H = P * Hp + H; P = P * Pp; }
                Pp = __shfl_up(P, 32); Hp = __shfl_up(H, 32); if (fq >= 2) { H = P * Hp + H; P = P * Pp; }
                float Pe = __shfl_up(P, 16), He = __shfl_up(H, 16); if (fq == 0) { Pe = 1.f; He = 0.f; }
                const float hstart = He + Pe * hc[nt], cstart = Pe * cc[nt];
#pragma unroll
                for (int r = 0; r < 4; ++r) { hv[r] = hv[r] + av[r] * hstart; av[r] = av[r] * cstart; }
                const float Pl = __shfl(P, 48 + fr), Hl = __shfl(H, 48 + fr); hc[nt] = Hl + Pl * hc[nt]; cc[nt] = Pl * cc[nt];
            }
#pragma unroll
            for (int r = 0; r < 4; ++r) { const size_t o = (size_t)(row0 + t0 + 4 * fq + r) * DL + ch; HL[o] = hv[r]; CU[o] = av[r]; }
            __builtin_amdgcn_sched_barrier(0);
        }
        LDS_WAIT();
    }
    if (!samp && fq == 0) {
#pragma unroll
        for (int nt = 0; nt < 4; ++nt) cx.AGG()[(size_t)aggidx * DL + 64 * w + 16 * nt + fr] = (f32x2){cc[nt], hc[nt]}; }
}

__device__ __forceinline__ void s5_gemm_e_item(const Ctx& cx, int item, int lane) {
    const int g = item >> 6, rb = item & 63, fr = lane & 15, fq = lane >> 4, cr = rb * 16 + fr;
    const bf16* U = cx.S5U() + (size_t)(16 * cr + (fq >> 1)) * 512 + 16 * g + 8 * (fq & 1); const bf16* Eg = cx.EM() + (size_t)g * 128 * 256 + (size_t)fr * 256 + 8 * fq;
    f32x4 acc[8];
#pragma unroll
    for (int n = 0; n < 8; ++n) acc[n] = (f32x4){0.f, 0.f, 0.f, 0.f};
#pragma unroll 4
    for (int ks = 0; ks < 8; ++ks) {
        const bf16x8 af = *(const bf16x8*)(U + (size_t)(2 * ks) * 512);
#pragma unroll
        for (int nt = 0; nt < 8; ++nt) { const bf16x8 wf = *(const bf16x8*)(Eg + (size_t)(16 * nt) * 256 + 32 * ks); acc[nt] = __builtin_amdgcn_mfma_f32_16x16x32_bf16(wf, af, acc[nt], 0, 0, 0); }
    }
    float* S = cx.SK() + ((size_t)cr * 32 + g) * 128 + 4 * fq;
#pragma unroll
    for (int nt = 0; nt < 8; ++nt) *(f32x4*)(S + 16 * nt) = acc[nt];
}

__device__ __forceinline__ void s5_chain_item(const Ctx& cx, int item, int lane) {
    const int idx = item * 64 + lane, b = idx >> 11, g = (idx >> 6) & 31, n = idx & 63;
    const f32x2 A = ((const f32x2*)(cx.TAB() + T_A16))[g * 64 + n];
    const float* S = cx.SK() + ((size_t)(b * SNCH) * 32 + g) * 128 + n; bf16* H = cx.HIN() + ((size_t)g * SROWS + b * SNCH) * 128 + n;
    float hr = 0.f, hi = 0.f; float s0r[8], s0i[8], s1r[8], s1i[8];
#define CH_LOAD(R, I, K0) do { _Pragma("unroll") for (int i = 0; i < 8; ++i) { R[i] = S[(size_t)((K0) + i) * 4096]; I[i] = S[(size_t)((K0) + i) * 4096 + 64]; } } while (0)
#define CH_STEP(R, I, K0) do { _Pragma("unroll") for (int i = 0; i < 8; ++i) { H[(size_t)((K0) + i) * 128] = (bf16)(pk2(hr, hr) & 0xffffu); H[(size_t)((K0) + i) * 128 + 64] = (bf16)(pk2(hi, hi) & 0xffffu); \
        const float nr = A.x * hr - A.y * hi + R[i], ni = A.x * hi + A.y * hr + I[i]; hr = nr; hi = ni; } } while (0)
    CH_LOAD(s0r, s0i, 0);
    for (int k0 = 0; k0 < SNCH; k0 += 16) { CH_LOAD(s1r, s1i, k0 + 8); CH_STEP(s0r, s0i, k0); if (k0 + 16 < SNCH) CH_LOAD(s0r, s0i, k0 + 16); CH_STEP(s1r, s1i, k0 + 8); }
#undef CH_LOAD
#undef CH_STEP
    cx.out[O_S5RP + (size_t)(b * 32 + g) * 64 + n] = hr; cx.out[O_S5IP + (size_t)(b * 32 + g) * 64 + n] = hi;
}

__device__ __forceinline__ void lru_fix_unit(const Ctx& cx, int row0, int ntok, bool samp, int b, int k, LAS unsigned char* lds) {
    const int d = threadIdx.x, w = d >> 6, lane = d & 63;
    LAS float* hs = (LAS float*)lds;
    float hin = 0.f;
    if (!samp) { const f32x2* ag = cx.AGG() + (size_t)(b * NCH) * DL + d; f32x2 pp[NCH - 1];
#pragma unroll
        for (int kk = 0; kk < NCH - 1; ++kk) pp[kk] = (kk < k) ? ag[(size_t)kk * DL] : (f32x2){1.f, 0.f};
#pragma unroll
        for (int kk = 0; kk < NCH - 1; ++kk) hin = pp[kk].x * hin + pp[kk].y; }
    hs[d] = hin;
    const float* X = cx.LRUX();
    if (!samp && k == NCH - 1) {
#pragma unroll
        for (int j = 0; j < 3; ++j) cx.out[O_CONVP + (size_t)(b * 3 + j) * DL + d] = X[(size_t)(row0 + LCH - 3 + j) * DL + d]; }
    if (samp) { for (int t = 0; t < ntok; ++t) { const int sb = row0 + t - MPR; const float* sc = cx.I(2) + (size_t)sb * 1536 + d; float* o = cx.out + O_CONVS + (size_t)sb * 1536 + d;
            o[0] = sc[512]; o[512] = sc[1024]; o[1024] = X[(size_t)(row0 + t) * DL + d]; } }
    __syncthreads();
    const float* HL = cx.HLOC(); const float* CU = cx.CUM(); const bf16* GT = cx.GATE(); bf16* MG = cx.MERGED(); const float* gl = cx.I(28);
    const f32x4 hi0 = *(const LAS f32x4*)(hs + 8 * lane), hi1 = *(const LAS f32x4*)(hs + 8 * lane + 4);
    const f32x4 g0 = *(const f32x4*)(gl + 8 * lane), g1 = *(const f32x4*)(gl + 8 * lane + 4);
#pragma unroll 4
    for (int t = w; t < ntok; t += 8) { const size_t ro = (size_t)(row0 + t) * DL + 8 * lane;
        const f32x4 a0 = *(const f32x4*)(HL + ro), a1 = *(const f32x4*)(HL + ro + 4), c0 = *(const f32x4*)(CU + ro), c1 = *(const f32x4*)(CU + ro + 4);
        const u32x4 gw = *(const u32x4*)(GT + ro);
        const f32x4 h0 = a0 + c0 * hi0, h1 = a1 + c1 * hi1;
        f32x4 l0, l1;
        l0[0] = h0[0] * gelu_tanh(bflo(gw.x)); l0[1] = h0[1] * gelu_tanh(bfhi(gw.x)); l0[2] = h0[2] * gelu_tanh(bflo(gw.y)); l0[3] = h0[3] * gelu_tanh(bfhi(gw.y));
        l1[0] = h1[0] * gelu_tanh(bflo(gw.z)); l1[1] = h1[1] * gelu_tanh(bfhi(gw.z)); l1[2] = h1[2] * gelu_tanh(bflo(gw.w)); l1[3] = h1[3] * gelu_tanh(bfhi(gw.w));
        float ss = (l0[0] * l0[0] + l0[1] * l0[1]) + (l0[2] * l0[2] + l0[3] * l0[3]) + (l1[0] * l1[0] + l1[1] * l1[1]) + (l1[2] * l1[2] + l1[3] * l1[3]);
        const float rstd = rsqrtf(wave_sum(ss) * (1.f / DL) + EPS);
        *(u32x4*)(MG + (size_t)(row0 + t) * DM + 8 * lane) = pack8(l0 * rstd * g0, l1 * rstd * g1);
        if (samp) { float* o = cx.out + O_LRUS + (size_t)(row0 + t - MPR) * DL + 8 * lane; *(f32x4*)o = h0; *(f32x4*)(o + 4) = h1; }
        else if (k == NCH - 1 && t == LCH - 1) { float* o = cx.out + O_LRUP + (size_t)b * DL + 8 * lane; *(f32x4*)o = h0; *(f32x4*)(o + 4) = h1; }
    }
    __syncthreads();
}

__device__ __forceinline__ void s5_gemm_tf_item(const Ctx& cx, int item, int lane) {
    const int half = item & 1, g = item >> 6, rb = (item >> 1) & 31, fr = lane & 15, fq = lane >> 4;
    const bf16* U = cx.S5U(); const bf16* TFg = cx.TF() + ((size_t)g * 256 + 128 * half) * 384; const bf16* Hg = cx.HIN() + (size_t)g * SROWS * 128;
    f32x4 acc[2][8];
#pragma unroll
    for (int a = 0; a < 2; ++a)
#pragma unroll
        for (int n = 0; n < 8; ++n) acc[a][n] = (f32x4){0.f, 0.f, 0.f, 0.f};
#pragma unroll 2
    for (int ks = 0; ks < 12; ++ks) {
        bf16x8 af[2];
#pragma unroll
        for (int mt = 0; mt < 2; ++mt) { const int cr = rb * 32 + 16 * mt + fr;
            af[mt] = (ks < 8) ? *(const bf16x8*)(U + ((size_t)(16 * cr + 2 * ks + (fq >> 1)) * 512 + 16 * g + 8 * (fq & 1))) : *(const bf16x8*)(Hg + (size_t)cr * 128 + 32 * (ks - 8) + 8 * fq); }
#pragma unroll
        for (int nt = 0; nt < 8; ++nt) { const bf16x8 wf = *(const bf16x8*)(TFg + (size_t)(16 * nt + fr) * 384 + 32 * ks + 8 * fq);
#pragma unroll
            for (int mt = 0; mt < 2; ++mt) acc[mt][nt] = __builtin_amdgcn_mfma_f32_16x16x32_bf16(wf, af[mt], acc[mt][nt], 0, 0, 0); }
    }
    const f32x4 d4 = *(const f32x4*)(cx.I(26) + 16 * g + 4 * fq); bf16* GY = cx.GY();
#pragma unroll
    for (int mt = 0; mt < 2; ++mt) { const int cr = rb * 32 + 16 * mt + fr;
#pragma unroll
        for (int nt = 0; nt < 8; ++nt) { const size_t off = (size_t)(16 * cr + 8 * half + nt) * 512 + 16 * g + 4 * fq; const u32x2 uw = *(const u32x2*)(U + off);
            const f32x4 y = acc[mt][nt] + d4 * (f32x4){bflo(uw.x), bfhi(uw.x), bflo(uw.y), bfhi(uw.y)};
            u32x2 o; o.x = pk2(gelu_tanh(y[0]), gelu_tanh(y[1])); o.y = pk2(gelu_tanh(y[2]), gelu_tanh(y[3])); *(u32x2*)(GY + off) = o; } }
}
__device__ __forceinline__ void s5_sample_item(const Ctx& cx, int item, int lane) {
    const int sb = item >> 5, g = item & 31, n = lane; const int row = MPR + sb;
    const float* tab = cx.TAB(); const f32x2 A = ((const f32x2*)(tab + T_ABAR))[g * 64 + n];
    const float h0r = cx.I(4)[((size_t)sb * 32 + g) * 64 + n], h0i = cx.I(5)[((size_t)sb * 32 + g) * 64 + n];
    const bf16* up = cx.S5U() + (size_t)row * 512 + 16 * g; const u32x4 u0 = *(const u32x4*)up, u1 = *(const u32x4*)(up + 8);
    float uu[16]; uu[0] = bflo(u0.x); uu[1] = bfhi(u0.x); uu[2] = bflo(u0.y); uu[3] = bfhi(u0.y); uu[4] = bflo(u0.z); uu[5] = bfhi(u0.z); uu[6] = bflo(u0.w); uu[7] = bfhi(u0.w);
    uu[8] = bflo(u1.x); uu[9] = bfhi(u1.x); uu[10] = bflo(u1.y); uu[11] = bfhi(u1.y); uu[12] = bflo(u1.z); uu[13] = bfhi(u1.z); uu[14] = bflo(u1.w); uu[15] = bfhi(u1.w);
    float bur = 0.f, bui = 0.f; const float* br = tab + T_BBR + (size_t)(g * 64 + n) * 16; const float* bi = tab + T_BBI + (size_t)(g * 64 + n) * 16;
#pragma unroll
    for (int c4 = 0; c4 < 4; ++c4) { const f32x4 r4 = *(const f32x4*)(br + 4 * c4), i4 = *(const f32x4*)(bi + 4 * c4);
#pragma unroll
        for (int i = 0; i < 4; ++i) { bur += r4[i] * uu[4 * c4 + i]; bui += i4[i] * uu[4 * c4 + i]; } }
    const float hr = A.x * h0r - A.y * h0i + bur, hi = A.x * h0i + A.y * h0r + bui;
    cx.out[O_S5RS + ((size_t)sb * 32 + g) * 64 + n] = hr; cx.out[O_S5IS + ((size_t)sb * 32 + g) * 64 + n] = hi;
    float my = 0.f, myu = 0.f;
#pragma unroll
    for (int c = 0; c < 16; ++c) { const float v = wave_sum(cx.I(24)[((size_t)g * 16 + c) * 64 + n] * hr - cx.I(25)[((size_t)g * 16 + c) * 64 + n] * hi); if (lane == c) { my = v; myu = uu[c]; } }
    if (lane < 16) { const float y = my + cx.I(26)[16 * g + lane] * myu; cx.GY()[(size_t)row * 512 + 16 * g + lane] = (bf16)(pk2(gelu_tanh(y), 0.f) & 0xffffu); }
}

#define XB_TMO      128
#define XB_XCNT(j)  (256  + 64 * (j))
#define XB_XSUB(j)  (1280 + 64 * (j))
#define XB_XGEN(j)  (2304 + 64 * (j))
#define XB_TOP      3328
#define XB_TOPGEN   3392
#define XCD_BAR_WORDS 3456
#define XB_SPIN_CAP (1u << 18)

__device__ __forceinline__ unsigned xb_ld(unsigned* p)              { return __hip_atomic_load(p, __ATOMIC_RELAXED, __HIP_MEMORY_SCOPE_AGENT); }
__device__ __forceinline__ unsigned xb_add(unsigned* p, unsigned v) { return __hip_atomic_fetch_add(p, v, __ATOMIC_RELAXED, __HIP_MEMORY_SCOPE_AGENT); }
__device__ __forceinline__ unsigned xb_xcc_id() { return (unsigned)__builtin_amdgcn_s_getreg((3 << 11) | 20) & 0xFu; }
#define XB_SPIN(cond, bar) do { unsigned _sp = 0; while (cond) { __builtin_amdgcn_s_sleep(1); \
    if ((++_sp & 255u) == 0u) { if (xb_ld(&(bar)[XB_TMO])) break; if (_sp > XB_SPIN_CAP) { atomicAdd(&(bar)[XB_TMO], 1u); break; } } } } while (0)

struct XcdBarrier {
    unsigned* bar; unsigned x;
    volatile LAS unsigned* st;
};

__device__ __forceinline__ XcdBarrier xcd_barrier_post(unsigned* bar, volatile LAS unsigned* st) {
    XcdBarrier b; b.bar = bar; b.x = xb_xcc_id(); b.st = st;
    if (threadIdx.x == 0) (void)xb_add(&bar[XB_XCNT(b.x)], 1u);
    return b;
}
__device__ __forceinline__ void xcd_barrier_complete(unsigned* bar, unsigned x, unsigned& nloc, unsigned& nx) {
    const unsigned G = gridDim.x * gridDim.y * gridDim.z;
    unsigned sum, cnt, mine, sp = 0u;
    for (;;) {
        sum = 0u; cnt = 0u; mine = 0u;
#pragma unroll
        for (unsigned j = 0; j < 16; ++j) { const unsigned c = xb_ld(&bar[XB_XCNT(j)]); sum += c; cnt += (c > 0u) ? 1u : 0u; mine = (j == x) ? c : mine; }
        if (sum == G) break;
        __builtin_amdgcn_s_sleep(1);
        if ((++sp & 255u) == 0u) { if (xb_ld(&bar[XB_TMO])) break; if (sp > XB_SPIN_CAP) { atomicAdd(&bar[XB_TMO], 1u); break; } }
    }
    nloc = mine > 0u ? mine : 1u; nx = cnt > 0u ? cnt : 1u;
}

__device__ __forceinline__ void xcd_barrier(const XcdBarrier& b) {
    asm volatile("s_waitcnt vmcnt(0)" ::: "memory");
    __syncthreads();
    if (threadIdx.x == 0) {
        unsigned* bar = b.bar;
        __builtin_amdgcn_s_waitcnt(0);
        unsigned nloc = b.st[0], nx = b.st[1];
        if (nloc == 0u) { xcd_barrier_complete(bar, b.x, nloc, nx); b.st[0] = nloc; b.st[1] = nx; }
        const unsigned old = xb_add(&bar[XB_XSUB(b.x)], 1u);
        const unsigned gen = old / nloc;
        if (old + 1u == (gen + 1u) * nloc) {
            __builtin_amdgcn_fence(__ATOMIC_RELEASE, "agent");
            asm volatile("s_waitcnt vmcnt(0)" ::: "memory");
            const unsigned og = xb_add(&bar[XB_TOP], 1u);
            const unsigned tg = og / nx;
            if (og + 1u == (tg + 1u) * nx) xb_add(&bar[XB_TOPGEN], 1u);
            else XB_SPIN(xb_ld(&bar[XB_TOPGEN]) == tg, bar);
            __builtin_amdgcn_fence(__ATOMIC_ACQUIRE, "agent");
            xb_add(&bar[XB_XGEN(b.x)], 1u);
            asm volatile("s_waitcnt vmcnt(0)" ::: "memory");
        } else {
            XB_SPIN(xb_ld(&bar[XB_XGEN(b.x)]) == gen, bar);
            __builtin_amdgcn_fence(__ATOMIC_ACQUIRE, "agent");
            asm volatile("s_waitcnt vmcnt(0)" ::: "memory");
        }
    }
    __syncthreads();
}

__global__ void __launch_bounds__(512, 2) fwd_kernel(KArgs a) {
    extern __shared__ __attribute__((aligned(16))) unsigned char lds_raw[];
    LAS unsigned char* lds = (LAS unsigned char*)lds_raw;
    cg::grid_group grid = cg::this_grid();
    Ctx cx; cx.in = a.in; cx.out = a.out; cx.ws = a.ws;
    const int tid = threadIdx.x, lane = tid & 63, wave = __builtin_amdgcn_readfirstlane(tid >> 6);
    const int G = gridDim.x, bid = blockIdx.x, gw = bid * 8 + wave, NGW = G * 8;
    volatile LAS unsigned* bst = (volatile LAS unsigned*)(lds + 131072);
    if (tid < 16) bst[tid] = 0u;
    __syncthreads();
    XcdBarrier xbar = xcd_barrier_post((unsigned*)a.ws, bst);
    if (a.hi - a.lo > 1) grid.sync();
#ifndef REPMASK
#define REPMASK 0
#endif
#ifndef PHMASK
#define PHMASK 0x1fff
#endif
#define IN(k) (((PHMASK >> (k)) & 1) && a.lo <= (k) && (k) < a.hi)
#define SEAM(k) do { if (IN(k) && IN((k) + 1)) xcd_barrier(xbar); } while (0)

    if (IN(0)) for (int rep_ = 0; rep_ < 1 + ((REPMASK >> 0) & 1); ++rep_) {
        if (bid < 32 || G < 64) { for (int g = bid; g < 32; g += G) s5_tables(cx, g, lds); }
        const int nb2 = G >= 64 ? G - 32 : G, b2 = G >= 64 ? bid - 32 : bid;
        if (b2 >= 0) {
            for (int it = b2; it < 192; it += nb2) ada_block(cx, it, lds);
            LAS bf16* scr = (LAS bf16*)(lds + wave * 16384);
            for (int it = (nb2 - 1 - b2) * 8 + wave; it < N_TR_ITEMS; it += nb2 * 8) transpose_dispatch(cx, it, scr, lane);
        }
    }
    SEAM(0);
    if (IN(1)) for (int rep_ = 0; rep_ < 1 + ((REPMASK >> 1) & 1); ++rep_) {
        for (int r = gw; r < MTOK; r += NGW) { const float* xr = r < MPR ? cx.I(0) + (size_t)r * DM : cx.I(1) + (size_t)(r - MPR) * DM; const float* md = cx.MOD() + (size_t)mod_row(r) * NMOD;
            norm_mod_row(xr, cx.I(10), md + 1024, md, cx.XN() + (size_t)r * DM, lane); }
    }
    SEAM(1);
    if (IN(2)) for (int rep_ = 0; rep_ < 1 + ((REPMASK >> 2) & 1); ++rep_) {
        pg8::Gemm g{cx.XN(), cx.WIN(), MPAD, NPROJ, DM}; Sched2 S; S.init(NPROJ, DM, G, bid, DM / 64);
        EpiProj E{cx.LRUX(), cx.GATE(), cx.S5U()};
        pg8::gemm_phase<EpiProj, Sched2, true, true>(lds, g, S, E);
    }
    SEAM(2);
    if (IN(3)) for (int rep_ = 0; rep_ < 1 + ((REPMASK >> 3) & 1); ++rep_) {
#ifndef NO_LRU
        for (int q_ = 0; q_ < 1 + ((REPMASK >> 13) & 1); ++q_)
        for (int u = bid; u < 256 + NBS / SCH; u += G) {
            if (u < 256) lru_local_unit(cx, u * LCH, LCH, false, u, lds); else lru_local_unit(cx, MPR + (u - 256) * SCH, SCH, true, 0, lds);
        }
#endif
#ifndef NO_E
        for (int q_ = 0; q_ < 1 + ((REPMASK >> 14) & 1); ++q_)
        for (int it = gw; it < 2048; it += NGW) s5_gemm_e_item(cx, it, lane);
#endif
    }
    SEAM(3);
    if (IN(4)) for (int rep_ = 0; rep_ < 1 + ((REPMASK >> 4) & 1); ++rep_) {
        if (wave == 0) { for (int it = bid; it < 256; it += G) s5_chain_item(cx, it, lane); }
        for (int u = bid; u < 256 + NBS / SCH; u += G) {
            if (u < 256) lru_fix_unit(cx, u * LCH, LCH, false, u >> 5, u & 31, lds); else lru_fix_unit(cx, MPR + (u - 256) * SCH, SCH, true, 0, 0, lds);
        }
    }
    SEAM(4);
    if (IN(5)) for (int rep_ = 0; rep_ < 1 + ((REPMASK >> 5) & 1); ++rep_) {
        for (int it = gw; it < 2048; it += NGW) s5_gemm_tf_item(cx, it, lane);
        for (int it = gw; it < NBS * 32; it += NGW) s5_sample_item(cx, it, lane);
    }
    SEAM(5);
    if (IN(6)) for (int rep_ = 0; rep_ < 1 + ((REPMASK >> 6) & 1); ++rep_) {
        pg8::Gemm g{cx.GY(), cx.WGLU(), MPAD, 1024, 512}; Sched2 S; S.init(1024, 512, G, bid, 2);
        EpiGlu E{cx.S5OUT(), cx.PART()};
        pg8::gemm_phase<EpiGlu, Sched2, true, true>(lds, g, S, E);
    }
    SEAM(6);
    if (IN(7)) for (int rep_ = 0; rep_ < 1 + ((REPMASK >> 7) & 1); ++rep_) {
        const float* gs = cx.I(29);
        for (int r = gw; r < MTOK; r += NGW) { const float* sr = cx.S5OUT() + (size_t)r * 512;
            f32x4 v0, v1;
            if (r < MPR) { v0 = ((const f32x4*)sr)[lane]; v1 = ((const f32x4*)sr)[lane + 64]; }
            else { const float* pp = cx.PART() + (size_t)(r - MPR) * 1024; const int c0 = 4 * lane, ca0 = 256 * (c0 >> 7) + (c0 & 127), ca1 = ca0 + 512;
                f32x4 a0 = (f32x4){0.f, 0.f, 0.f, 0.f}, b0 = a0, a1 = a0, b1 = a0;
#pragma unroll
                for (int sl = 0; sl < 4; ++sl) { const float* q = pp + (size_t)sl * 128 * 1024; a0 += *(const f32x4*)(q + ca0); b0 += *(const f32x4*)(q + ca0 + 128); a1 += *(const f32x4*)(q + ca1); b1 += *(const f32x4*)(q + ca1 + 128); }
#pragma unroll
                for (int i = 0; i < 4; ++i) { v0[i] = a0[i] * sigm(b0[i]); v1[i] = a1[i] * sigm(b1[i]); } }
            const float ss = (v0.x * v0.x + v0.y * v0.y) + (v0.z * v0.z + v0.w * v0.w) + (v1.x * v1.x + v1.y * v1.y) + (v1.z * v1.z + v1.w * v1.w);
            const float rstd = rsqrtf(wave_sum(ss) * (1.f / 512) + EPS);
            const f32x4 o0 = v0 * rstd * ((const f32x4*)gs)[lane], o1 = v1 * rstd * ((const f32x4*)gs)[lane + 64];
            bf16* mp = cx.MERGED() + (size_t)r * DM + 512; u32x2 w0, w1; w0.x = pk2(o0.x, o0.y); w0.y = pk2(o0.z, o0.w); w1.x = pk2(o1.x, o1.y); w1.y = pk2(o1.z, o1.w);
            *(u32x2*)(mp + 4 * lane) = w0; *(u32x2*)(mp + 256 + 4 * lane) = w1; }
    }
    SEAM(7);
    if (IN(8)) for (int rep_ = 0; rep_ < 1 + ((REPMASK >> 8) & 1); ++rep_) {
        pg8::Gemm g{cx.MERGED(), cx.WOUT(), MPAD, DM, DM}; Sched2 S; S.init(DM, DM, G, bid, 2);
        EpiRes<2048> E{cx.I(0), cx.I(1), cx.MOD(), cx.out, cx.PART()};
        pg8::gemm_phase<EpiRes<2048>, Sched2, true, true>(lds, g, S, E);
    }
    SEAM(8);
    if (IN(9)) for (int rep_ = 0; rep_ < 1 + ((REPMASK >> 9) & 1); ++rep_) {
        for (int r = gw; r < MTOK; r += NGW) { const float* md = cx.MOD() + (size_t)mod_row(r) * NMOD;
            if (r >= MPR) { const float* pp = cx.PART() + (size_t)(r - MPR) * 1024; const float* xr = cx.I(1) + (size_t)(r - MPR) * DM; float* orow = cx.out + (size_t)r * DM;
#pragma unroll
                for (int j = 0; j < 4; ++j) { const int col = 4 * (lane + 64 * j); f32x4 sm = (f32x4){0.f, 0.f, 0.f, 0.f};
#pragma unroll
                    for (int sl = 0; sl < 8; ++sl) sm += *(const f32x4*)(pp + (size_t)sl * 128 * 1024 + col);
                    *(f32x4*)(orow + col) = *(const f32x4*)(xr + col) + *(const f32x4*)(md + 2048 + col) * sm; } }
            norm_mod_row(cx.out + (size_t)r * DM, cx.I(31), md + 4096, md + 3072, cx.XN2() + (size_t)r * DM, lane); }
    }
    SEAM(9);
    if (IN(10)) for (int rep_ = 0; rep_ < 1 + ((REPMASK >> 10) & 1); ++rep_) {
        pg8::Gemm g{cx.XN2(), cx.WGU(), MPAD, 2 * DFF, DM}; Sched2 S; S.init(2 * DFF, DM, G, bid, DM / 64);
        EpiSwiglu E{cx.HB()};
        pg8::gemm_phase<EpiSwiglu, Sched2, true, true>(lds, g, S, E);
    }
    SEAM(10);
    if (IN(11)) for (int rep_ = 0; rep_ < 1 + ((REPMASK >> 11) & 1); ++rep_) {
        pg8::Gemm g{cx.HB(), cx.WDN(), MPAD, DM, DFF}; Sched2 S; S.init(DM, DFF, G, bid, 2);
        EpiRes<5120> E{nullptr, nullptr, cx.MOD(), cx.out, cx.PART()};
        pg8::gemm_phase<EpiRes<5120>, Sched2, true, true>(lds, g, S, E);
    }
    SEAM(11);
    if (IN(12)) for (int rep_ = 0; rep_ < 1 + ((REPMASK >> 12) & 1); ++rep_) {
        const float* fg = cx.I(35);
        for (int r = gw; r < MTOK; r += NGW) { float* xr = cx.out + (size_t)r * DM; f32x4 v[4]; float ss = 0.f;
#pragma unroll
            for (int j = 0; j < 4; ++j) { v[j] = ((const f32x4*)xr)[lane + 64 * j];
                if (r >= MPR) { const int col = 4 * (lane + 64 * j); const float* pp = cx.PART() + (size_t)(r - MPR) * 1024 + col; f32x4 sm = (f32x4){0.f, 0.f, 0.f, 0.f};
#pragma unroll 2
                    for (int sl = 0; sl < 22; ++sl) sm += *(const f32x4*)(pp + (size_t)sl * 128 * 1024);
                    v[j] += *(const f32x4*)(cx.MOD() + (size_t)mod_row(r) * NMOD + 5120 + col) * sm; }
                ss += (v[j].x * v[j].x + v[j].y * v[j].y) + (v[j].z * v[j].z + v[j].w * v[j].w); }
            const float rstd = rsqrtf(wave_sum(ss) * (1.f / DM) + EPS);
#pragma unroll
            for (int j = 0; j < 4; ++j) ((f32x4*)xr)[lane + 64 * j] = v[j] * rstd * ((const f32x4*)fg)[lane + 64 * j]; }
    }
#undef IN
#undef SEAM
}

constexpr int LDS_BYTES = 131072 + 256;
#ifndef MK_SINGLE
#define MK_SINGLE 1
#endif
extern "C" void kernel_launch(void* const* d_in, const int* in_sizes, int n_in, void* d_out, int out_size, void* d_ws, size_t ws_size, hipStream_t stream) {
    static int grid = 0;
    if (grid == 0) {
        if (n_in != 36 || (size_t)out_size != O_END || ws_size < WS_END) { fprintf(stderr, "kernel_launch: unexpected shapes n_in %d out %d ws %zu\n", n_in, out_size, ws_size); grid = -1; return; }
        int dev = 0, cus = 0, per_cu = 0;
        hipGetDevice(&dev); hipDeviceGetAttribute(&cus, hipDeviceAttributeMultiprocessorCount, dev);
        hipFuncSetAttribute((const void*)fwd_kernel, hipFuncAttributeMaxDynamicSharedMemorySize, LDS_BYTES);
        hipOccupancyMaxActiveBlocksPerMultiprocessor(&per_cu, (const void*)fwd_kernel, 512, LDS_BYTES);
        if (per_cu < 1) { fprintf(stderr, "kernel_launch: occupancy query says %d blocks per CU\n", per_cu); grid = -1; return; }
        grid = cus;
    }
    if (grid < 0) return;
    if (hipMemsetAsync(d_ws, 0, 65536, stream) != hipSuccess) { fprintf(stderr, "kernel_launch: memset of the barrier words failed\n"); return; }
    KArgs a{};
    for (int i = 0; i < 36; ++i) a.in[i] = (const float*)d_in[i];
    a.out = (float*)d_out; a.ws = (unsigned char*)d_ws;
#if MK_SINGLE
    a.lo = 0; a.hi = NPHASE;
    void* args[] = {&a};
    hipError_t e = hipLaunchCooperativeKernel((const void*)fwd_kernel, dim3(grid), dim3(512), args, LDS_BYTES, stream);
    if (e != hipSuccess) fprintf(stderr, "cooperative launch failed: %s (grid %d)\n", hipGetErrorString(e), grid);
#else
    for (int p = 0; p < NPHASE; ++p) { a.lo = p; a.hi = p + 1; hipLaunchKernelGGL(fwd_kernel, dim3(grid), dim3(512), LDS_BYTES, stream, a); }
#endif
}
```

```cpp
#include <hip/hip_runtime.h>
#include <hip/hip_cooperative_groups.h>
#include <cstdio>
#include <cstdint>
namespace cg = cooperative_groups;
namespace pg8 {
#define PG8_LAS __attribute__((address_space(3)))
typedef unsigned short bf16_t;
typedef short bf16x8 __attribute__((ext_vector_type(8)));
typedef float f32x4 __attribute__((ext_vector_type(4)));
typedef unsigned u32x4 __attribute__((ext_vector_type(4)));
constexpr int BM = 256, BK = 64, HALF = 128, HTB = HALF * BK * 2  , STAGE_BYTES = 8 * HTB, NXCD = 8, WGM = 8;

__host__ __device__ __forceinline__ int lds_byte(int r, int c) { const int st = (r >> 4) * 2 + (c >> 5), rr = r & 15, cc = c & 31, ob = rr * 64 + cc * 2; return st * 1024 + (ob ^ (((ob >> 9) & 1) << 5)); }
__host__ __device__ __forceinline__ void stage_rc(int b, int& R, int& C) { const int st = b / 1024, sb = b % 1024, swz = sb ^ (((sb >> 9) & 1) << 5); R = (st >> 1) * 16 + swz / 64; C = (st & 1) * 32 + (swz % 64) / 2; }
__host__ __device__ __forceinline__ int perm32(int rho) { const int n = rho >> 4, i = rho & 15; return 8 * (i >> 2) + 4 * n + (i & 3); }

struct Unit { int pm, pn, kt0, nkt, kind, slice; };
struct Gemm { const bf16_t* A; const bf16_t* Bt; int M, N, K; };

struct StaticOrder {
    int nM, nN, nwg, G, c;
    __host__ __device__ __forceinline__ void init(int M, int N, int G_, int c_) { nM = M / BM; nN = N / BM; nwg = nM * nN; G = G_; c = c_; }
    __host__ __device__ __forceinline__ bool next(int i, Unit& u) const {
        const long L = (long)i * G + c; if (L >= nwg) return false;
        int wgid = (int)L; { const int q = nwg / NXCD, r = nwg % NXCD, xcd = wgid % NXCD, off = wgid / NXCD; wgid = (xcd < r ? xcd * (q + 1) : r * (q + 1) + (xcd - r) * q) + off; }
        const int nig = WGM * nN, gid = wgid / nig, fm = gid * WGM, gsz = (nM - fm) < WGM ? (nM - fm) : WGM;
        u.pm = fm + ((wgid % nig) % gsz); u.pn = (wgid % nig) / gsz; return true;
    }
    __device__ __forceinline__ void a_ready(const Unit&) const {}
    __device__ __forceinline__ void done(const Unit&) const {}
};

__device__ __forceinline__ unsigned cvt_pk_bf16(float lo, float hi) { unsigned r; asm volatile("v_cvt_pk_bf16_f32 %0, %1, %2" : "=v"(r) : "v"(lo), "v"(hi)); return r; }
typedef float f32x2 __attribute__((ext_vector_type(2)));
template <class Epi, class Sched, bool ALIGN_EPI = false, bool SP2 = false>
__device__ __forceinline__ void gemm_phase(PG8_LAS unsigned char* lds, const Gemm g, const Sched& S, const Epi& E) {
    const int tid = threadIdx.x, wid = __builtin_amdgcn_readfirstlane(tid >> 6), lane = tid & 63, wr = wid >> 2, wc = wid & 3, fr = lane & 15, fq = lane >> 4;
    const int K = g.K;
    unsigned voffA[2], voffB[2];
#pragma unroll
    for (int i = 0; i < 2; ++i) { int R, C; stage_rc(tid * 16 + i * 8192, R, C); const int Rb = Epi::PERM ? ((R & ~31) + perm32(R & 31)) : R;
        voffA[i] = (unsigned)(R * K + C) * 2u; voffB[i] = (unsigned)(Rb * K + C) * 2u; }
    const size_t kstep = (size_t)(BK * 2);
    const size_t hstep = (size_t)HALF * K * 2;
    const size_t tstep = 2 * hstep;
    const unsigned ldsw = (unsigned)wid * 1024u;
    const int aoff = lds_byte(wr * 64 + fr, fq * 8), boff = lds_byte(wc * 32 + fr, fq * 8);
#define PG8_SA(b, h) (((b) * 2 + (h)) * HTB)
#define PG8_SB(b, h) ((4 + (b) * 2 + (h)) * HTB)
#define PG8_STAGE(bufoff, gbase, voff) do { _Pragma("unroll") for (int _i = 0; _i < 2; ++_i) \
        __builtin_amdgcn_global_load_lds((const unsigned*)((const char*)(gbase) + (voff)[_i]), (PG8_LAS unsigned*)(lds + (bufoff) + ldsw + _i * 8192), 16, 0, 0); } while (0)
#define PG8_LDA(dst, b, h) do { _Pragma("unroll") for (int m = 0; m < 4; ++m) _Pragma("unroll") for (int k = 0; k < 2; ++k) dst[m][k] = *(const PG8_LAS bf16x8*)(lds + PG8_SA(b, h) + aoff + m * 2048 + k * 1024); } while (0)
#define PG8_LDB(dst, b, h) do { _Pragma("unroll") for (int n = 0; n < 2; ++n) _Pragma("unroll") for (int k = 0; k < 2; ++k) dst[n][k] = *(const PG8_LAS bf16x8*)(lds + PG8_SB(b, h) + boff + n * 2048 + k * 1024); } while (0)
#define PG8_MMA(ai, bj, At, Bt) do { __builtin_amdgcn_s_setprio(1); _Pragma("unroll") for (int m = 0; m < 4; ++m) _Pragma("unroll") for (int n = 0; n < 2; ++n) _Pragma("unroll") for (int k = 0; k < 2; ++k) \
        acc[ai][bj][m][n] = __builtin_amdgcn_mfma_f32_16x16x32_bf16(Bt[n][k], At[m][k], acc[ai][bj][m][n], 0, 0, 0); __builtin_amdgcn_s_setprio(0); } while (0)
#define PG8_WAIT_V(n) asm volatile("s_waitcnt vmcnt(" #n ")" ::: "memory")
#define PG8_WAIT_L(n) asm volatile("s_waitcnt lgkmcnt(" #n ")" ::: "memory")
#define PG8_BAR __builtin_amdgcn_s_barrier()
#define PG8_SCHED __builtin_amdgcn_sched_barrier(0)
    Unit cur = {0, 0, 0, 0, 0, 0}, nxt = {0, 0, 0, 0, 0, 0}; int ui = 0;
    if (!S.next(0, cur)) return;
    f32x4 acc[2][2][4][2];
#pragma unroll
    for (int a = 0; a < 2; ++a)
#pragma unroll
        for (int b = 0; b < 2; ++b)
#pragma unroll
            for (int m = 0; m < 4; ++m)
#pragma unroll
                for (int n = 0; n < 2; ++n) acc[a][b][m][n] = (f32x4){0.f, 0.f, 0.f, 0.f};
    bf16x8 At[4][2], B0[2][2], B1[2][2];
    const char* cA = (const char*)g.A + (size_t)cur.pm * tstep + (size_t)cur.kt0 * kstep; const char* cB = (const char*)g.Bt + (size_t)cur.pn * tstep + (size_t)cur.kt0 * kstep;
    S.a_ready(cur);
    if constexpr (SP2) {
        PG8_STAGE(PG8_SB(0, 0), cB, voffB); PG8_STAGE(PG8_SB(0, 1), cB + hstep, voffB); PG8_STAGE(PG8_SA(0, 0), cA, voffA); PG8_STAGE(PG8_SA(0, 1), cA + hstep, voffA);
        if (wr == 1) PG8_BAR;
        PG8_WAIT_V(2); PG8_BAR;
        PG8_STAGE(PG8_SB(1, 0), cB + kstep, voffB); PG8_STAGE(PG8_SA(1, 0), cA + kstep, voffA); PG8_STAGE(PG8_SB(1, 1), cB + hstep + kstep, voffB);
        PG8_WAIT_V(6); PG8_BAR;
    } else {
        PG8_STAGE(PG8_SB(0, 0), cB, voffB); PG8_STAGE(PG8_SA(0, 0), cA, voffA); PG8_STAGE(PG8_SB(0, 1), cB + hstep, voffB); PG8_STAGE(PG8_SA(0, 1), cA + hstep, voffA);
        if (wr == 1) PG8_BAR;
        PG8_WAIT_V(4); PG8_BAR;
        PG8_STAGE(PG8_SB(1, 0), cB + kstep, voffB); PG8_STAGE(PG8_SA(1, 0), cA + kstep, voffA); PG8_STAGE(PG8_SB(1, 1), cB + hstep + kstep, voffB);
        PG8_WAIT_V(6); PG8_BAR;
    }
    for (;;) {
        const bool has_next = S.next(ui + 1, nxt);
        const char* nA = has_next ? (const char*)g.A + (size_t)nxt.pm * tstep + (size_t)nxt.kt0 * kstep : cA; const char* nB = has_next ? (const char*)g.Bt + (size_t)nxt.pn * tstep + (size_t)nxt.kt0 * kstep : cB;
        const int nt = cur.nkt;
        for (int t = 0; t < nt; t += 2) {
            const bool last = (t == nt - 2);
            const char* a1 = cA + (size_t)(t + 1) * kstep;
            const char* a2 = last ? nA : cA + (size_t)(t + 2) * kstep; const char* b2 = last ? nB : cB + (size_t)(t + 2) * kstep;
            const char* a3 = a2 + kstep; const char* b3 = b2 + kstep;
            if (last && has_next) S.a_ready(nxt);
            if constexpr (SP2) {
            PG8_LDB(B0, 0, 0); PG8_LDB(B1, 0, 1); PG8_SCHED; PG8_LDA(At, 0, 0); PG8_STAGE(PG8_SA(1, 1), a1 + hstep, voffA);
            PG8_WAIT_V(8); PG8_WAIT_L(0); PG8_BAR; PG8_MMA(0, 0, At, B0); PG8_MMA(0, 1, At, B1); PG8_BAR; PG8_SCHED;
            PG8_LDA(At, 0, 1); PG8_STAGE(PG8_SB(0, 0), b2, voffB); PG8_STAGE(PG8_SB(0, 1), b2 + hstep, voffB); PG8_STAGE(PG8_SA(0, 0), a2, voffA);
            PG8_WAIT_V(8); PG8_WAIT_L(0); PG8_BAR; PG8_MMA(1, 0, At, B0); PG8_MMA(1, 1, At, B1); PG8_BAR; PG8_SCHED;
            PG8_LDB(B0, 1, 0); PG8_LDB(B1, 1, 1); PG8_SCHED; PG8_LDA(At, 1, 0); PG8_STAGE(PG8_SA(0, 1), a2 + hstep, voffA);
            PG8_WAIT_V(8); PG8_WAIT_L(0); PG8_BAR; PG8_MMA(0, 0, At, B0); PG8_MMA(0, 1, At, B1); PG8_BAR; PG8_SCHED;
            PG8_LDA(At, 1, 1); PG8_STAGE(PG8_SB(1, 0), b3, voffB); PG8_STAGE(PG8_SB(1, 1), b3 + hstep, voffB); PG8_STAGE(PG8_SA(1, 0), a3, voffA);
            PG8_WAIT_V(8); PG8_WAIT_L(0); PG8_BAR; PG8_MMA(1, 0, At, B0); PG8_MMA(1, 1, At, B1); PG8_BAR; PG8_SCHED;
            } else {
            PG8_LDB(B0, 0, 0); PG8_SCHED; PG8_LDA(At, 0, 0); PG8_STAGE(PG8_SA(1, 1), a1 + hstep, voffA);
            PG8_WAIT_L(8); PG8_BAR; PG8_WAIT_L(0); PG8_MMA(0, 0, At, B0); PG8_BAR; PG8_SCHED;
            PG8_LDB(B1, 0, 1); PG8_STAGE(PG8_SB(0, 0), b2, voffB);
            PG8_BAR; PG8_WAIT_L(0); PG8_MMA(0, 1, At, B1); PG8_BAR;
            PG8_LDA(At, 0, 1); PG8_STAGE(PG8_SA(0, 0), a2, voffA);
            PG8_BAR; PG8_WAIT_L(0); PG8_MMA(1, 0, At, B0); PG8_BAR; PG8_SCHED;
            PG8_STAGE(PG8_SB(0, 1), b2 + hstep, voffB);
            PG8_WAIT_V(6); PG8_BAR; PG8_MMA(1, 1, At, B1); PG8_BAR;
            PG8_LDB(B0, 1, 0); PG8_SCHED; PG8_LDA(At, 1, 0); PG8_STAGE(PG8_SA(0, 1), a2 + hstep, voffA);
            PG8_WAIT_L(8); PG8_BAR; PG8_WAIT_L(0); PG8_MMA(0, 0, At, B0); PG8_BAR; PG8_SCHED;
            PG8_LDB(B1, 1, 1); PG8_STAGE(PG8_SB(1, 0), b3, voffB);
            PG8_BAR; PG8_WAIT_L(0); PG8_MMA(0, 1, At, B1); PG8_BAR;
            PG8_LDA(At, 1, 1); PG8_STAGE(PG8_SA(1, 0), a3, voffA);
            PG8_BAR; PG8_WAIT_L(0); PG8_MMA(1, 0, At, B0); PG8_BAR; PG8_SCHED;
            PG8_STAGE(PG8_SB(1, 1), b3 + hstep, voffB);
            PG8_WAIT_V(6); PG8_BAR; PG8_MMA(1, 1, At, B1); PG8_BAR;
            }
        }
        if constexpr (ALIGN_EPI) { if (wr == 0) PG8_BAR; }
        if constexpr (!Epi::AFTER_DRAIN) { E(acc, cur, wr, wc, fr, fq); S.done(cur); }
        if (!has_next) break;
#pragma unroll
        for (int a = 0; a < 2; ++a)
#pragma unroll
            for (int b = 0; b < 2; ++b)
#pragma unroll
                for (int m = 0; m < 4; ++m)
#pragma unroll
                    for (int n = 0; n < 2; ++n) acc[a][b][m][n] = (f32x4){0.f, 0.f, 0.f, 0.f};
        cur = nxt; cA = nA; cB = nB; ++ui;
        if constexpr (ALIGN_EPI) { if (wr == 1) PG8_BAR; }
    }
    PG8_WAIT_V(0);
    if constexpr (!ALIGN_EPI) { if (wr == 0) PG8_BAR; }
    PG8_BAR;
    if constexpr (Epi::AFTER_DRAIN) { E.fused(acc, cur, wr, wc, fr, fq, lds, wid, lane); S.done(cur); }
#undef PG8_SA
#undef PG8_SB
#undef PG8_STAGE
#undef PG8_LDA
#undef PG8_LDB
#undef PG8_MMA
#undef PG8_WAIT_V
#undef PG8_WAIT_L
#undef PG8_BAR
#undef PG8_SCHED
}
}

#define LAS __attribute__((address_space(3)))
typedef unsigned short bf16;
typedef float f32x4 __attribute__((ext_vector_type(4)));
typedef float f32x2 __attribute__((ext_vector_type(2)));
typedef short bf16x8 __attribute__((ext_vector_type(8)));
typedef unsigned u32x4 __attribute__((ext_vector_type(4)));
typedef unsigned u32x2 __attribute__((ext_vector_type(2)));

constexpr int DM = 1024, NBP = 8, SEQ = 2048, MPR = NBP * SEQ, NBS = 128, MTOK = MPR + NBS, MPAD = 16640;
constexpr int DL = 512, NPROJ = 1536, NMOD = 6144, NBT = NBP + NBS, DFF = 2816;
constexpr int LCH = 64, NCH = SEQ / LCH;
constexpr int SCH = 16;
constexpr int SL = 16, SNCH = SEQ / SL, SROWS = NBP * SNCH;
constexpr float EPS = 1e-6f;
constexpr int NPHASE = 13;

constexpr size_t O_Y = 0, O_CONVP = (size_t)MTOK * DM, O_LRUP = O_CONVP + 8 * 3 * 512, O_S5RP = O_LRUP + 8 * 512, O_S5IP = O_S5RP + 8 * 32 * 64,
                 O_CONVS = O_S5IP + 8 * 32 * 64, O_LRUS = O_CONVS + 128 * 3 * 512, O_S5RS = O_LRUS + 128 * 512, O_S5IS = O_S5RS + 128 * 32 * 64, O_END = O_S5IS + 128 * 32 * 64;

constexpr size_t HM = 1u << 19;
constexpr size_t WS_WIN = 2 * HM, WS_WGLU = 8 * HM, WS_WOUT = 10 * HM, WS_WGU = 14 * HM, WS_WDN = 36 * HM  , WS_MOD = 48 * HM  ,
                 WS_TF = 56 * HM  , WS_E = 68 * HM  , WS_TAB = 72 * HM, WS_AGG = 74 * HM  ,
                 WS_XN = 80 * HM  , WS_LRUX = 146 * HM  , WS_GATE = 211 * HM  ,
                 WS_S5U = 244 * HM  , WS_HLOC = 277 * HM  , WS_CUM = 342 * HM, WS_GY = 407 * HM  ,
                 WS_SK = 440 * HM  , WS_HIN = 472 * HM  , WS_HB = 244 * HM  , WS_PART = 488 * HM  , WS_END = 512 * HM;
constexpr size_t T_ABAR = 0, T_A16 = 4096, T_BBR = 8192, T_BBI = 8192 + 32768;

struct KArgs { const float* in[36]; float* out; unsigned char* ws; int lo, hi; };

struct Ctx {
    const float* const* in; float* out; unsigned char* ws;
    __device__ __forceinline__ const float* I(int i) const { return in[i]; }
    __device__ __forceinline__ bf16* WIN() const { return (bf16*)(ws + WS_WIN); }
    __device__ __forceinline__ bf16* WGLU() const { return (bf16*)(ws + WS_WGLU); }
    __device__ __forceinline__ bf16* WOUT() const { return (bf16*)(ws + WS_WOUT); }
    __device__ __forceinline__ bf16* WGU() const { return (bf16*)(ws + WS_WGU); }
    __device__ __forceinline__ bf16* WDN() const { return (bf16*)(ws + WS_WDN); }
    __device__ __forceinline__ float* MOD() const { return (float*)(ws + WS_MOD); }
    __device__ __forceinline__ bf16* TF() const { return (bf16*)(ws + WS_TF); }
    __device__ __forceinline__ bf16* EM() const { return (bf16*)(ws + WS_E); }
    __device__ __forceinline__ float* TAB() const { return (float*)(ws + WS_TAB); }
    __device__ __forceinline__ f32x2* AGG() const { return (f32x2*)(ws + WS_AGG); }
    __device__ __forceinline__ bf16* XN() const { return (bf16*)(ws + WS_XN); }
    __device__ __forceinline__ bf16* MERGED() const { return (bf16*)(ws + WS_XN); }
    __device__ __forceinline__ float* LRUX() const { return (float*)(ws + WS_LRUX); }
    __device__ __forceinline__ bf16* XN2() const { return (bf16*)(ws + WS_LRUX); }
    __device__ __forceinline__ bf16* GATE() const { return (bf16*)(ws + WS_GATE); }
    __device__ __forceinline__ bf16* S5U() const { return (bf16*)(ws + WS_S5U); }
    __device__ __forceinline__ float* HLOC() const { return (float*)(ws + WS_HLOC); }
    __device__ __forceinline__ float* S5OUT() const { return (float*)(ws + WS_HLOC); }
    __device__ __forceinline__ float* CUM() const { return (float*)(ws + WS_CUM); }
    __device__ __forceinline__ bf16* GY() const { return (bf16*)(ws + WS_GY); }
    __device__ __forceinline__ float* SK() const { return (float*)(ws + WS_SK); }
    __device__ __forceinline__ bf16* HIN() const { return (bf16*)(ws + WS_HIN); }
    __device__ __forceinline__ bf16* HB() const { return (bf16*)(ws + WS_HB); }
    __device__ __forceinline__ float* PART() const { return (float*)(ws + WS_PART); }
};

#define LDS_WAIT() asm volatile("s_waitcnt lgkmcnt(0)" ::: "memory")
__device__ __forceinline__ unsigned pk2(float lo, float hi) { return pg8::cvt_pk_bf16(lo, hi); }
__device__ __forceinline__ float bf2f(unsigned b) { return __uint_as_float(b << 16); }
__device__ __forceinline__ float bflo(unsigned w) { return __uint_as_float(w << 16); }
__device__ __forceinline__ float bfhi(unsigned w) { return __uint_as_float(w & 0xffff0000u); }
__device__ __forceinline__ float wave_sum(float v) {
#pragma unroll
    for (int o = 1; o < 64; o <<= 1) v += __shfl_xor(v, o);
    return v;
}
__device__ __forceinline__ float sigm(float v) { return __builtin_amdgcn_rcpf(1.f + __builtin_amdgcn_exp2f(-1.44269504089f * v)); }
__device__ __forceinline__ float gelu_tanh(float x) { const float u = (-1.5957691216f * 1.44269504089f) * (x + 0.044715f * x * x * x); return x * __builtin_amdgcn_rcpf(1.f + __builtin_amdgcn_exp2f(u)); }
__device__ __forceinline__ int mod_row(int row) { return row < MPR ? (row >> 11) : (NBP + row - MPR); }
__device__ __forceinline__ u32x4 pack8(f32x4 a, f32x4 b) { u32x4 w; w.x = pk2(a[0], a[1]); w.y = pk2(a[2], a[3]); w.z = pk2(b[0], b[1]); w.w = pk2(b[2], b[3]); return w; }

struct Sched2 {
    pg8::StaticOrder so; int nkt_full, n_extra, ex_nn, ex_nkt;
    __device__ __forceinline__ void init(int N, int K, int G, int c, int ex_nkt_) { so.init(MPR, N, G, c); nkt_full = K / 64; ex_nn = N / 256; ex_nkt = ex_nkt_; n_extra = ex_nn * (nkt_full / ex_nkt_); }
    __device__ __forceinline__ bool next(int i, pg8::Unit& u) const {
        const long L = (long)i * so.G + so.c;
        const bool prompt = L < so.nwg; const int e = (int)(L - so.nwg);
        if (!prompt && e >= n_extra) return false;
        pg8::Unit t; t.pm = 0; t.pn = 0; t.kt0 = 0; t.nkt = 0; t.kind = 0; t.slice = 0;
        if (prompt) so.next(i, t);
        const int sl = prompt ? 0 : e / ex_nn;
        pg8::Unit r; r.pm = prompt ? t.pm : 64; r.pn = prompt ? t.pn : e % ex_nn; r.kt0 = sl * ex_nkt; r.nkt = prompt ? nkt_full : ex_nkt; r.kind = prompt ? 0 : ((ex_nkt == nkt_full) ? 1 : 2); r.slice = sl;
        u = r; return true;
    }
    __device__ __forceinline__ void a_ready(const pg8::Unit&) const {}
    __device__ __forceinline__ void done(const pg8::Unit&) const {}
};
__device__ __forceinline__ void store_partial(const f32x4 (&acc)[2][2][4][2], const pg8::Unit& u, int wr, int wc, int fr, int fq, float* part) {
    float* base = part + (size_t)u.slice * 128 * 1024 + u.pn * 256 + wc * 32 + 8 * fq;
#pragma unroll
    for (int m = 0; m < 4; ++m) { float* rp = base + (size_t)(wr * 64 + m * 16 + fr) * 1024;
#pragma unroll
        for (int bj = 0; bj < 2; ++bj)
#pragma unroll
            for (int n = 0; n < 2; ++n) *(f32x4*)(rp + bj * 128 + 4 * n) = acc[0][bj][m][n]; }
}

struct EpiProj {
    static constexpr bool PERM = true, AFTER_DRAIN = false; float* lrux; bf16* gate; bf16* s5u;
    __device__ __forceinline__ void operator()(const f32x4 (&acc)[2][2][4][2], const pg8::Unit& u, int wr, int wc, int fr, int fq) const {
        const int colt = u.pn * 256 + wc * 32 + 8 * fq;
#pragma unroll
        for (int ai = 0; ai < 2; ++ai)
#pragma unroll
            for (int m = 0; m < 4; ++m) { const int row = u.pm * 256 + ai * 128 + wr * 64 + m * 16 + fr; if (row >= MTOK) continue;
#pragma unroll
                for (int bj = 0; bj < 2; ++bj) { const int col = colt + bj * 128; const f32x4 v0 = acc[ai][bj][m][0], v1 = acc[ai][bj][m][1];
                    if (u.pn < 2) { float* p = lrux + (size_t)row * 512 + col; *(f32x4*)p = v0; *(f32x4*)(p + 4) = v1; }
                    else if (u.pn < 4) { *(u32x4*)(gate + (size_t)row * 512 + (col - 512)) = pack8(v0, v1); }
                    else { *(u32x4*)(s5u + (size_t)row * 512 + (col - 1024)) = pack8(v0, v1); } } }
    }
};
struct EpiGlu {
    static constexpr bool PERM = true, AFTER_DRAIN = false; float* o; float* part;
    __device__ __forceinline__ void operator()(const f32x4 (&acc)[2][2][4][2], const pg8::Unit& u, int wr, int wc, int fr, int fq) const {
        if (u.kind == 2) { store_partial(acc, u, wr, wc, fr, fq, part); return; }
        const int col = u.pn * 128 + wc * 32 + 8 * fq;
#pragma unroll
        for (int ai = 0; ai < 2; ++ai)
#pragma unroll
            for (int m = 0; m < 4; ++m) { const int row = u.pm * 256 + ai * 128 + wr * 64 + m * 16 + fr; if (row >= MTOK) continue;
#pragma unroll
                for (int n = 0; n < 2; ++n) { const f32x4 a = acc[ai][0][m][n], b = acc[ai][1][m][n]; f32x4 s;
#pragma unroll
                    for (int i = 0; i < 4; ++i) s[i] = a[i] * sigm(b[i]);
                    *(f32x4*)(o + (size_t)row * 512 + col + 4 * n) = s; } }
    }
};
template <int GOFF> struct EpiRes {
    static constexpr bool PERM = true, AFTER_DRAIN = false; const float* xp; const float* xs; const float* mod; float* out; float* part;
    __device__ __forceinline__ void operator()(const f32x4 (&acc)[2][2][4][2], const pg8::Unit& u, int wr, int wc, int fr, int fq) const {
        if (u.kind == 2) { store_partial(acc, u, wr, wc, fr, fq, part); return; }
        const int colt = u.pn * 256 + wc * 32 + 8 * fq;
#pragma unroll
        for (int ai = 0; ai < 2; ++ai)
#pragma unroll
            for (int m = 0; m < 4; ++m) { const int row = u.pm * 256 + ai * 128 + wr * 64 + m * 16 + fr; if (row >= MTOK) continue;
                const float* gp = mod + (size_t)mod_row(row) * NMOD + GOFF; float* op = out + (size_t)row * DM;
                const float* bp = xp ? (row < MPR ? xp + (size_t)row * DM : xs + (size_t)(row - MPR) * DM) : op;
#pragma unroll
                for (int bj = 0; bj < 2; ++bj)
#pragma unroll
                    for (int n = 0; n < 2; ++n) { const int c = colt + bj * 128 + 4 * n; const f32x4 x4 = *(const f32x4*)(bp + c), g4 = *(const f32x4*)(gp + c);
                        *(f32x4*)(op + c) = x4 + g4 * acc[ai][bj][m][n]; } }
    }
};
struct EpiSwiglu {
    static constexpr bool PERM = true, AFTER_DRAIN = false; bf16* h;
    __device__ __forceinline__ void operator()(const f32x4 (&acc)[2][2][4][2], const pg8::Unit& u, int wr, int wc, int fr, int fq) const {
        const int col = u.pn * 128 + wc * 32 + 8 * fq;
#pragma unroll
        for (int ai = 0; ai < 2; ++ai)
#pragma unroll
            for (int m = 0; m < 4; ++m) { const int row = u.pm * 256 + ai * 128 + wr * 64 + m * 16 + fr; if (row >= MTOK) continue;
                f32x4 s[2];
#pragma unroll
                for (int n = 0; n < 2; ++n) { const f32x4 a = acc[ai][0][m][n], b = acc[ai][1][m][n];
#pragma unroll
                    for (int i = 0; i < 4; ++i) s[n][i] = a[i] * sigm(a[i]) * b[i]; }
                *(u32x4*)(h + (size_t)row * DFF + col) = pack8(s[0], s[1]); }
    }
};

__device__ __forceinline__ void transpose_item(const float* W, int ldw, int k0, int n0, bf16* WT, int K, int drow0, LAS bf16* scr, int lane) {
    const int lr = lane >> 4, lc = lane & 15;
    f32x4 v[16];
#pragma unroll
    for (int i = 0; i < 16; ++i) v[i] = *(const f32x4*)(W + (size_t)(k0 + lr + 4 * i) * ldw + n0 + 4 * lc);
#pragma unroll
    for (int i = 0; i < 16; ++i) { u32x2 p; p.x = pk2(v[i].x, v[i].y); p.y = pk2(v[i].z, v[i].w); *(LAS u32x2*)(scr + (lr + 4 * i) * 68 + 4 * lc) = p; }
    LDS_WAIT();
    const int kc = lane & 7;
#pragma unroll
    for (int j = 0; j < 8; ++j) { const int n = (lane >> 3) + 8 * j; const LAS bf16* sp = scr + (8 * kc) * 68 + n;
        u32x4 o; o.x = (unsigned)sp[0] | ((unsigned)sp[68] << 16); o.y = (unsigned)sp[2 * 68] | ((unsigned)sp[3 * 68] << 16);
        o.z = (unsigned)sp[4 * 68] | ((unsigned)sp[5 * 68] << 16); o.w = (unsigned)sp[6 * 68] | ((unsigned)sp[7 * 68] << 16);
        *(u32x4*)(WT + (size_t)(drow0 + n) * K + k0 + 8 * kc) = o; }
    LDS_WAIT();
}
__device__ __forceinline__ void transpose_dispatch(const Ctx& cx, int it, LAS bf16* scr, int lane) {
    if (it < 384) { const int kb = it / 24, nb = it % 24; transpose_item(cx.I(11), NPROJ, 64 * kb, 64 * nb, cx.WIN(), DM, 64 * nb, scr, lane); return; } it -= 384;
    if (it < 128) { const int kb = it / 16, nb = it % 16, n0 = 64 * nb; const int dr = 256 * ((n0 & 511) >> 7) + 128 * (n0 >> 9) + (n0 & 127);
        transpose_item(cx.I(27), 1024, 64 * kb, n0, cx.WGLU(), 512, dr, scr, lane); return; } it -= 128;
    if (it < 256) { const int kb = it / 16, nb = it % 16; transpose_item(cx.I(30), DM, 64 * kb, 64 * nb, cx.WOUT(), DM, 64 * nb, scr, lane); return; } it -= 256;
    if (it < 704) { const int kb = it / 44, nb = it % 44, n0 = 64 * nb; transpose_item(cx.I(32), DFF, 64 * kb, n0, cx.WGU(), DM, 256 * (n0 >> 7) + (n0 & 127), scr, lane); return; } it -= 704;
    if (it < 704) { const int kb = it / 44, nb = it % 44, n0 = 64 * nb; transpose_item(cx.I(33), DFF, 64 * kb, n0, cx.WGU(), DM, 256 * (n0 >> 7) + 128 + (n0 & 127), scr, lane); return; } it -= 704;
    { const int kb = it / 16, nb = it % 16; transpose_item(cx.I(34), DM, 64 * kb, 64 * nb, cx.WDN(), DFF, 64 * nb, scr, lane); }
}
constexpr int N_TR_ITEMS = 384 + 128 + 256 + 704 + 704 + 704;

__device__ __forceinline__ void ada_block(const Ctx& cx, int item, LAS unsigned char* lds) {
    const int tid = threadIdx.x, w = __builtin_amdgcn_readfirstlane(tid >> 6), lane = tid & 63, fr = lane & 15, fq = lane >> 4, n0 = 32 * item;
    const float* W = cx.I(8); const float* cp = cx.I(6); const float* cs = cx.I(7);
    bf16x8 wf[4][2];
#pragma unroll
    for (int ks = 0; ks < 4; ++ks)
#pragma unroll
        for (int nt = 0; nt < 2; ++nt) { const float* src = W + (size_t)(128 * w + 32 * ks + 8 * fq) * NMOD + n0 + 16 * nt + fr;
            u32x4 o; o.x = pk2(src[0], src[NMOD]); o.y = pk2(src[2 * NMOD], src[3 * NMOD]); o.z = pk2(src[4 * NMOD], src[5 * NMOD]); o.w = pk2(src[6 * NMOD], src[7 * NMOD]); wf[ks][nt] = __builtin_bit_cast(bf16x8, o); }
    f32x4 acc[9][2];
#pragma unroll
    for (int i = 0; i < 9; ++i) { acc[i][0] = (f32x4){0.f, 0.f, 0.f, 0.f}; acc[i][1] = (f32x4){0.f, 0.f, 0.f, 0.f}; }
#pragma unroll
    for (int mt = 0; mt < 9; ++mt) { int row = 16 * mt + fr; row = row < NBT ? row : NBT - 1;
        const float* src = (row < NBP ? cp + (size_t)row * DM : cs + (size_t)(row - NBP) * DM) + 128 * w + 8 * fq;
#pragma unroll
        for (int ks = 0; ks < 4; ++ks) { f32x4 a0 = *(const f32x4*)(src + 32 * ks), a1 = *(const f32x4*)(src + 32 * ks + 4);
#pragma unroll
            for (int i = 0; i < 4; ++i) { a0[i] = a0[i] * sigm(a0[i]); a1[i] = a1[i] * sigm(a1[i]); }
            const bf16x8 af = __builtin_bit_cast(bf16x8, pack8(a0, a1));
            acc[mt][0] = __builtin_amdgcn_mfma_f32_16x16x32_bf16(wf[ks][0], af, acc[mt][0], 0, 0, 0);
            acc[mt][1] = __builtin_amdgcn_mfma_f32_16x16x32_bf16(wf[ks][1], af, acc[mt][1], 0, 0, 0); } }
    LAS f32x4* red = (LAS f32x4*)lds;
#pragma unroll
    for (int st = 4; st >= 1; st >>= 1) {
        if (w >= st && w < 2 * st) {
#pragma unroll
            for (int i = 0; i < 9; ++i) { red[((w - st) * 18 + 2 * i) * 64 + lane] = acc[i][0]; red[((w - st) * 18 + 2 * i + 1) * 64 + lane] = acc[i][1]; } }
        __syncthreads();
        if (w < st) {
#pragma unroll
            for (int i = 0; i < 9; ++i) { acc[i][0] += red[(w * 18 + 2 * i) * 64 + lane]; acc[i][1] += red[(w * 18 + 2 * i + 1) * 64 + lane]; } }
        __syncthreads();
    }
    if (w == 0) {
#pragma unroll
        for (int nt = 0; nt < 2; ++nt) { const f32x4 b4 = *(const f32x4*)(cx.I(9) + n0 + 16 * nt + 4 * fq);
#pragma unroll
            for (int mt = 0; mt < 9; ++mt) { const int row = 16 * mt + fr; if (row < NBT) *(f32x4*)(cx.MOD() + (size_t)row * NMOD + n0 + 16 * nt + 4 * fq) = acc[mt][nt] + b4; } } }
}

__device__ __forceinline__ void s5_tables(const Ctx& cx, int g, LAS unsigned char* lds) {
    LAS f32x2* Ap = (LAS f32x2*)lds;
    LAS f32x2* Bb = Ap + 17 * 64;
    LAS f32x2* Cc = Bb + 1024;
    LAS f32x2* Ff = Cc + 1024;
    LAS float* Kt = (LAS float*)(Ff + 64);
    const int tid = threadIdx.x;
    float* tab = cx.TAB();
    if (tid < 64) {
        const int n = tid; const float lr = cx.I(19)[g * 64 + n], li = cx.I(20)[g * 64 + n], dt = expf(cx.I(21)[g]);
        const float mag = expf(lr * dt);
        const double ang = (double)li * (double)dt; const double kq = rint(ang * 0.63661977236758134308); const double r = ang - kq * 1.57079632679489661923; const double r2 = r * r;
        const double sn = r * (1.0 + r2 * (-1.0 / 6 + r2 * (1.0 / 120 + r2 * (-1.0 / 5040 + r2 * (1.0 / 362880 + r2 * (-1.0 / 39916800 + r2 * (1.0 / 6227020800.0)))))));
        const double cn = 1.0 + r2 * (-0.5 + r2 * (1.0 / 24 + r2 * (-1.0 / 720 + r2 * (1.0 / 40320 + r2 * (-1.0 / 3628800 + r2 * (1.0 / 479001600.0))))));
        const int q = ((int)kq) & 3; const double cv = q == 0 ? cn : q == 1 ? -sn : q == 2 ? -cn : sn, sv = q == 0 ? sn : q == 1 ? cn : q == 2 ? -sn : -cn;
        const float abr = mag * (float)cv, abi = mag * (float)sv; const float den = lr * lr + li * li;
        const float frr = ((abr - 1.f) * lr + abi * li) / den, fii = (abi * lr - (abr - 1.f) * li) / den;
        f32x2 p = (f32x2){1.f, 0.f}; Ap[n] = p;
#pragma unroll 1
        for (int t = 1; t <= 16; ++t) { const float pr = p.x * abr - p.y * abi, pi = p.x * abi + p.y * abr; p = (f32x2){pr, pi}; Ap[t * 64 + n] = p; }
        Ff[n] = (f32x2){frr, fii};
        ((f32x2*)(tab + T_ABAR))[g * 64 + n] = (f32x2){abr, abi}; ((f32x2*)(tab + T_A16))[g * 64 + n] = p;
    }
    __syncthreads();
    for (int e = tid; e < 1024; e += 512) { const int n = e >> 4; const float br = cx.I(22)[g * 1024 + e], bi = cx.I(23)[g * 1024 + e]; const f32x2 f = Ff[n];
        const float bbr = f.x * br - f.y * bi, bbi = f.x * bi + f.y * br; Bb[e] = (f32x2){bbr, bbi}; tab[T_BBR + g * 1024 + e] = bbr; tab[T_BBI + g * 1024 + e] = bbi;
        Cc[e] = (f32x2){cx.I(24)[g * 1024 + e], cx.I(25)[g * 1024 + e]}; }
    __syncthreads();
    for (int e = tid; e < 4096; e += 512) { const int tau = e >> 8, c = (e >> 4) & 15, cp = e & 15; float sum = 0.f;
        for (int n = 0; n < 64; ++n) { const f32x2 a = Ap[tau * 64 + n], b = Bb[n * 16 + cp], cc = Cc[c * 64 + n];
            const float pr = a.x * b.x - a.y * b.y, pi = a.x * b.y + a.y * b.x; sum += cc.x * pr - cc.y * pi; }
        Kt[e] = sum; }
    __syncthreads();
    bf16* TFg = cx.TF() + (size_t)g * 256 * 384;
    for (int pc = tid; pc < 256 * 48; pc += 512) { const int row = pc / 48, k8 = (pc % 48) * 8, j = row >> 4, c = row & 15; float v[8];
#pragma unroll
        for (int q = 0; q < 8; ++q) { const int kk = k8 + q;
            if (kk < 256) { const int s = kk >> 4, cp = kk & 15; v[q] = (j >= s) ? Kt[((j - s) << 8) + (c << 4) + cp] : 0.f; }
            else { const int n = (kk - 256) & 63; const f32x2 p = Ap[(j + 1) * 64 + n], cc = Cc[c * 64 + n]; v[q] = (kk < 320) ? (cc.x * p.x - cc.y * p.y) : (-cc.x * p.y - cc.y * p.x); } }
        u32x4 o; o.x = pk2(v[0], v[1]); o.y = pk2(v[2], v[3]); o.z = pk2(v[4], v[5]); o.w = pk2(v[6], v[7]);
        *(u32x4*)(TFg + (size_t)row * 384 + k8) = o; }
    bf16* Eg = cx.EM() + (size_t)g * 128 * 256;
    for (int pc = tid; pc < 128 * 32; pc += 512) { const int np = pc >> 5, k8 = (pc & 31) * 8, n = np & 63, im = np >> 6; float v[8];
#pragma unroll
        for (int q = 0; q < 8; ++q) { const int kk = k8 + q, s = kk >> 4, cp = kk & 15; const f32x2 a = Ap[(15 - s) * 64 + n], b = Bb[n * 16 + cp];
            v[q] = im ? (a.x * b.y + a.y * b.x) : (a.x * b.x - a.y * b.y); }
        u32x4 o; o.x = pk2(v[0], v[1]); o.y = pk2(v[2], v[3]); o.z = pk2(v[4], v[5]); o.w = pk2(v[6], v[7]);
        *(u32x4*)(Eg + (size_t)np * 256 + k8) = o; }
    __syncthreads();
}

__device__ __forceinline__ void norm_mod_row(const float* xrow, const float* g, const float* sc, const float* sh, bf16* orow, int lane) {
    f32x4 v[4]; float ss = 0.f;
#pragma unroll
    for (int j = 0; j < 4; ++j) { v[j] = ((const f32x4*)xrow)[lane + 64 * j]; ss += (v[j].x * v[j].x + v[j].y * v[j].y) + (v[j].z * v[j].z + v[j].w * v[j].w); }
    const float rstd = rsqrtf(wave_sum(ss) * (1.f / DM) + EPS);
#pragma unroll
    for (int j = 0; j < 4; ++j) { const int col = 4 * (lane + 64 * j); const f32x4 gg = *(const f32x4*)(g + col), s1 = *(const f32x4*)(sc + col), s2 = *(const f32x4*)(sh + col);
        const f32x4 o = v[j] * rstd * gg * (1.f + s1) + s2; u32x2 w; w.x = pk2(o.x, o.y); w.y = pk2(o.z, o.w); *(u32x2*)(orow + col) = w; }
}

__device__ __forceinline__ void lru_local_unit(const Ctx& cx, int row0, int ntok, bool samp, int aggidx, LAS unsigned char* lds) {
    const int d = threadIdx.x, w = __builtin_amdgcn_readfirstlane(d >> 6), lane = d & 63, fr = lane & 15, fq = lane >> 4;
    LAS float* cf = (LAS float*)(lds + w * 8192);
    LAS bf16* cbf = (LAS bf16*)(lds + w * 8192 + 4608);
    bf16x8 wf[8][2];
#pragma unroll
    for (int nt = 0; nt < 8; ++nt)
#pragma unroll
        for (int ks = 0; ks < 2; ++ks) { const float* src = (nt < 4 ? cx.I(14) : cx.I(16)) + (size_t)w * 4096 + (32 * ks + 8 * fq) * 64 + 16 * (nt & 3) + fr;
            u32x4 o; o.x = pk2(src[0], src[64]); o.y = pk2(src[128], src[192]); o.z = pk2(src[256], src[320]); o.w = pk2(src[384], src[448]); wf[nt][ks] = __builtin_bit_cast(bf16x8, o); }
    const float cw0 = cx.I(12)[d], cw1 = cx.I(12)[512 + d], cw2 = cx.I(12)[1024 + d], cw3 = cx.I(12)[1536 + d], cb = cx.I(13)[d];
    float gba[4], gbx[4], gcd[4], hc[4], cc[4];
#pragma unroll
    for (int nt = 0; nt < 4; ++nt) { const int ch = 64 * w + 16 * nt + fr; gba[nt] = cx.I(15)[ch]; gbx[nt] = cx.I(17)[ch]; gcd[nt] = -8.f * 1.44269504089f * log1pf(expf(-cx.I(18)[ch])); hc[nt] = 0.f; cc[nt] = 1.f; }
    const float* X = cx.LRUX(); float* HL = cx.HLOC(); float* CU = cx.CUM();
    float xm3 = 0.f, xm2 = 0.f, xm1 = 0.f;
    if (!samp) { const int t0 = row0 & (SEQ - 1); if (t0 >= 3) { xm3 = X[(size_t)(row0 - 3) * DL + d]; xm2 = X[(size_t)(row0 - 2) * DL + d]; xm1 = X[(size_t)(row0 - 1) * DL + d]; } }
    float xv[16];
#pragma unroll
    for (int i = 0; i < 16; ++i) xv[i] = X[(size_t)(row0 + i) * DL + d];
    for (int t0 = 0; t0 < ntok; t0 += 16) {
        if (samp) {
#pragma unroll
            for (int i = 0; i < 16; ++i) { const int row = row0 + t0 + i; const float* sc = cx.I(2) + (size_t)(row - MPR) * 1536 + d;
                const float cv = cb + cw0 * sc[0] + cw1 * sc[512] + cw2 * sc[1024] + cw3 * xv[i];
                cf[i * 68 + lane] = cv; cbf[i * 72 + lane] = (bf16)(pk2(cv, cv) & 0xffffu); }
        } else {
#pragma unroll
            for (int i = 0; i < 16; ++i) { const float x = xv[i]; const float cv = cb + cw0 * xm3 + cw1 * xm2 + cw2 * xm1 + cw3 * x; xm3 = xm2; xm2 = xm1; xm1 = x;
                cf[i * 68 + lane] = cv; cbf[i * 72 + lane] = (bf16)(pk2(cv, cv) & 0xffffu); }
        }
        if (t0 + 16 < ntok) {
#pragma unroll
            for (int i = 0; i < 16; ++i) xv[i] = X[(size_t)(row0 + t0 + 16 + i) * DL + d]; }
        LDS_WAIT();
        f32x4 acc[8];
#pragma unroll
        for (int nt = 0; nt < 8; ++nt) acc[nt] = (f32x4){0.f, 0.f, 0.f, 0.f};
#pragma unroll
        for (int ks = 0; ks < 2; ++ks) { const bf16x8 af = *(const LAS bf16x8*)(cbf + fr * 72 + 32 * ks + 8 * fq);
#pragma unroll
            for (int nt = 0; nt < 8; ++nt) acc[nt] = __builtin_amdgcn_mfma_f32_16x16x32_bf16(af, wf[nt][ks], acc[nt], 0, 0, 0); }
#pragma unroll
        for (int nt = 0; nt < 4; ++nt) { const int ch = 64 * w + 16 * nt + fr;
            float av[4], hv[4]; float P = 1.f, H = 0.f;
#pragma unroll
            for (int r = 0; r < 4; ++r) { const int tok = 4 * fq + r; const float cvv = cf[tok * 68 + 16 * nt + fr];
                const float rr = sigm(acc[nt][r] + gba[nt]), ig = sigm(acc[nt + 4][r] + gbx[nt]);
                const float a = __builtin_amdgcn_exp2f(gcd[nt] * rr);
                const float bb = __builtin_amdgcn_sqrtf(fmaf(-a, a, 1.f)) * ig * cvv;
                if (samp) { const float h0 = cx.I(3)[(size_t)(row0 + t0 + tok - MPR) * DL + ch]; hv[r] = a * h0 + bb; av[r] = 0.f; }
                else { H = a * H + bb; P = P * a; hv[r] = H; av[r] = P; } }
            if (!samp) {
                float Pp = __shfl_up(P, 16), Hp = __shfl_up(H, 16); if (fq >= 1) { H = P * Hp + H; P = P * Pp; }
                Pp = __shfl_up(P, 32); Hp = __shfl_up(H, 32); if (fq >= 2) { H = P * Hp + H; P = P * Pp; }
                float Pe = __shfl_up(P, 16), He = __shfl_up(H, 16); if (fq == 0) { Pe = 1.f; He = 0.f; }
                const float hstart = He + Pe * hc[nt], cstart = Pe * cc[nt];
#pragma unroll
                for (int r = 0; r < 4; ++r) { hv[r] = hv[r] + av[r] * hstart; av[r] = av[r] * cstart; }
                const float Pl = __shfl(P, 48 + fr), Hl = __shfl(H, 48 + fr); hc[nt] = Hl + Pl * hc[nt]; cc[nt] = Pl * cc[nt];
            }
#pragma unroll
            for (int r = 0; r < 4; ++r) { const size_t o = (size_t)(row0 + t0 + 4 * fq + r) * DL + ch; HL[o] = hv[r]; CU[o] = av[r]; }
            __builtin_amdgcn_sched_barrier(0);
        }
        LDS_WAIT();
    }
    if (!samp && fq == 0) {
#pragma unroll
        for (int nt = 0; nt < 4; ++nt) cx.AGG()[(size_t)aggidx * DL + 64 * w + 16 * nt + fr] = (f32x2){cc[nt], hc[nt]}; }
}

__device__ __forceinline__ void s5_gemm_e_item(const Ctx& cx, int item, int lane) {
    const int g = item >> 6, rb = item & 63, fr = lane & 15, fq = lane >> 4, cr = rb * 16 + fr;
    const bf16* U = cx.S5U() + (size_t)(16 * cr + (fq >> 1)) * 512 + 16 * g + 8 * (fq & 1); const bf16* Eg = cx.EM() + (size_t)g * 128 * 256 + (size_t)fr * 256 + 8 * fq;
    f32x4 acc[8];
#pragma unroll
    for (int n = 0; n < 8; ++n) acc[n] = (f32x4){0.f, 0.f, 0.f, 0.f};
#pragma unroll 4
    for (int ks = 0; ks < 8; ++ks) {
        const bf16x8 af = *(const bf16x8*)(U + (size_t)(2 * ks) * 512);
#pragma unroll
        for (int nt = 0; nt < 8; ++nt) { const bf16x8 wf = *(const bf16x8*)(Eg + (size_t)(16 * nt) * 256 + 32 * ks); acc[nt] = __builtin_amdgcn_mfma_f32_16x16x32_bf16(wf, af, acc[nt], 0, 0, 0); }
    }
    float* S = cx.SK() + ((size_t)cr * 32 + g) * 128 + 4 * fq;
#pragma unroll
    for (int nt = 0; nt < 8; ++nt) *(f32x4*)(S + 16 * nt) = acc[nt];
}

__device__ __forceinline__ void s5_chain_item(const Ctx& cx, int item, int lane) {
    const int idx = item * 64 + lane, b = idx >> 11, g = (idx >> 6) & 31, n = idx & 63;
    const f32x2 A = ((const f32x2*)(cx.TAB() + T_A16))[g * 64 + n];
    const float* S = cx.SK() + ((size_t)(b * SNCH) * 32 + g) * 128 + n; bf16* H = cx.HIN() + ((size_t)g * SROWS + b * SNCH) * 128 + n;
    float hr = 0.f, hi = 0.f; float s0r[8], s0i[8], s1r[8], s1i[8];
#define CH_LOAD(R, I, K0) do { _Pragma("unroll") for (int i = 0; i < 8; ++i) { R[i] = S[(size_t)((K0) + i) * 4096]; I[i] = S[(size_t)((K0) + i) * 4096 + 64]; } } while (0)
#define CH_STEP(R, I, K0) do { _Pragma("unroll") for (int i = 0; i < 8; ++i) { H[(size_t)((K0) + i) * 128] = (bf16)(pk2(hr, hr) & 0xffffu); H[(size_t)((K0) + i) * 128 + 64] = (bf16)(pk2(hi, hi) & 0xffffu); \
        const float nr = A.x * hr - A.y * hi + R[i], ni = A.x * hi + A.y * hr + I[i]; hr = nr; hi = ni; } } while (0)
    CH_LOAD(s0r, s0i, 0);
    for (int k0 = 0; k0 < SNCH; k0 += 16) { CH_LOAD(s1r, s1i, k0 + 8); CH_STEP(s0r, s0i, k0); if (k0 + 16 < SNCH) CH_LOAD(s0r, s0i, k0 + 16); CH_STEP(s1r, s1i, k0 + 8); }
#undef CH_LOAD
#undef CH_STEP
    cx.out[O_S5RP + (size_t)(b * 32 + g) * 64 + n] = hr; cx.out[O_S5IP + (size_t)(b * 32 + g) * 64 + n] = hi;
}

__device__ __forceinline__ void lru_fix_unit(const Ctx& cx, int row0, int ntok, bool samp, int b, int k, LAS unsigned char* lds) {
    const int d = threadIdx.x, w = d >> 6, lane = d & 63;
    LAS float* hs = (LAS float*)lds;
    float hin = 0.f;
    if (!samp) { const f32x2* ag = cx.AGG() + (size_t)(b * NCH) * DL + d; f32x2 pp[NCH - 1];
#pragma unroll
        for (int kk = 0; kk < NCH - 1; ++kk) pp[kk] = (kk < k) ? ag[(size_t)kk * DL] : (f32x2){1.f, 0.f};
#pragma unroll
        for (int kk = 0; kk < NCH - 1; ++kk) hin = pp[kk].x * hin + pp[kk].y; }
    hs[d] = hin;
    const float* X = cx.LRUX();
    if (!samp && k == NCH - 1) {
#pragma unroll
        for (int j = 0; j < 3; ++j) cx.out[O_CONVP + (size_t)(b * 3 + j) * DL + d] = X[(size_t)(row0 + LCH - 3 + j) * DL + d]; }
    if (samp) { for (int t = 0; t < ntok; ++t) { const int sb = row0 + t - MPR; const float* sc = cx.I(2) + (size_t)sb * 1536 + d; float* o = cx.out + O_CONVS + (size_t)sb * 1536 + d;
            o[0] = sc[512]; o[512] = sc[1024]; o[1024] = X[(size_t)(row0 + t) * DL + d]; } }
    __syncthreads();
    const float* HL = cx.HLOC(); const float* CU = cx.CUM(); const bf16* GT = cx.GATE(); bf16* MG = cx.MERGED(); const float* gl = cx.I(28);
    const f32x4 hi0 = *(const LAS f32x4*)(hs + 8 * lane), hi1 = *(const LAS f32x4*)(hs + 8 * lane + 4);
    const f32x4 g0 = *(const f32x4*)(gl + 8 * lane), g1 = *(const f32x4*)(gl + 8 * lane + 4);
#pragma unroll 4
    for (int t = w; t < ntok; t += 8) { const size_t ro = (size_t)(row0 + t) * DL + 8 * lane;
        const f32x4 a0 = *(const f32x4*)(HL + ro), a1 = *(const f32x4*)(HL + ro + 4), c0 = *(const f32x4*)(CU + ro), c1 = *(const f32x4*)(CU + ro + 4);
        const u32x4 gw = *(const u32x4*)(GT + ro);
        const f32x4 h0 = a0 + c0 * hi0, h1 = a1 + c1 * hi1;
        f32x4 l0, l1;
        l0[0] = h0[0] * gelu_tanh(bflo(gw.x)); l0[1] = h0[1] * gelu_tanh(bfhi(gw.x)); l0[2] = h0[2] * gelu_tanh(bflo(gw.y)); l0[3] = h0[3] * gelu_tanh(bfhi(gw.y));
        l1[0] = h1[0] * gelu_tanh(bflo(gw.z)); l1[1] = h1[1] * gelu_tanh(bfhi(gw.z)); l1[2] = h1[2] * gelu_tanh(bflo(gw.w)); l1[3] = h1[3] * gelu_tanh(bfhi(gw.w));
        float ss = (l0[0] * l0[0] + l0[1] * l0[1]) + (l0[2] * l0[2] + l0[3] * l0[3]) + (l1[0] * l1[0] + l1[1] * l1[1]) + (l1[2] * l1[2] + l1[3] * l1[3]);
        const float rstd = rsqrtf(wave_sum(ss) * (1.f / DL) + EPS);
        *(u32x4*)(MG + (size_t)(row0 + t) * DM + 8 * lane) = pack8(l0 * rstd * g0, l1 * rstd * g1);
        if (samp) { float* o = cx.out + O_LRUS + (size_t)(row0 + t - MPR) * DL + 8 * lane; *(f32x4*)o = h0; *(f32x4*)(o + 4) = h1; }
        else if (k == NCH - 1 && t == LCH - 1) { float* o = cx.out + O_LRUP + (size_t)b * DL + 8 * lane; *(f32x4*)o = h0; *(f32x4*)(o + 4) = h1; }
    }
    __syncthreads();
}

__device__ __forceinline__ void s5_gemm_tf_item(const Ctx& cx, int item, int lane) {
    const int half = item & 1, g = item >> 6, rb = (item >> 1) & 31, fr = lane & 15, fq = lane >> 4;
    const bf16* U = cx.S5U(); const bf16* TFg = cx.TF() + ((size_t)g * 256 + 128 * half) * 384; const bf16* Hg = cx.HIN() + (size_t)g * SROWS * 128;
    f32x4 acc[2][8];
#pragma unroll
    for (int a = 0; a < 2; ++a)
#pragma unroll
        for (int n = 0; n < 8; ++n) acc[a][n] = (f32x4){0.f, 0.f, 0.f, 0.f};
#pragma unroll 2
    for (int ks = 0; ks < 12; ++ks) {
        bf16x8 af[2];
#pragma unroll
        for (int mt = 0; mt < 2; ++mt) { const int cr = rb * 32 + 16 * mt + fr;
            af[mt] = (ks < 8) ? *(const bf16x8*)(U + ((size_t)(16 * cr + 2 * ks + (fq >> 1)) * 512 + 16 * g + 8 * (fq & 1))) : *(const bf16x8*)(Hg + (size_t)cr * 128 + 32 * (ks - 8) + 8 * fq); }
#pragma unroll
        for (int nt = 0; nt < 8; ++nt) { const bf16x8 wf = *(const bf16x8*)(TFg + (size_t)(16 * nt + fr) * 384 + 32 * ks + 8 * fq);
#pragma unroll
            for (int mt = 0; mt < 2; ++mt) acc[mt][nt] = __builtin_amdgcn_mfma_f32_16x16x32_bf16(wf, af[mt], acc[mt][nt], 0, 0, 0); }
    }
    const f32x4 d4 = *(const f32x4*)(cx.I(26) + 16 * g + 4 * fq); bf16* GY = cx.GY();
#pragma unroll
    for (int mt = 0; mt < 2; ++mt) { const int cr = rb * 32 + 16 * mt + fr;
#pragma unroll
        for (int nt = 0; nt < 8; ++nt) { const size_t off = (size_t)(16 * cr + 8 * half + nt) * 512 + 16 * g + 4 * fq; const u32x2 uw = *(const u32x2*)(U + off);
            const f32x4 y = acc[mt][nt] + d4 * (f32x4){bflo(uw.x), bfhi(uw.x), bflo(uw.y), bfhi(uw.y)};
            u32x2 o; o.x = pk2(gelu_tanh(y[0]), gelu_tanh(y[1])); o.y = pk2(gelu_tanh(y[2]), gelu_tanh(y[3])); *(u32x2*)(GY + off) = o; } }
}
__device__ __forceinline__ void s5_sample_item(const Ctx& cx, int item, int lane) {
    const int sb = item >> 5, g = item & 31, n = lane; const int row = MPR + sb;
    const float* tab = cx.TAB(); const f32x2 A = ((const f32x2*)(tab + T_ABAR))[g * 64 + n];
    const float h0r = cx.I(4)[((size_t)sb * 32 + g) * 64 + n], h0i = cx.I(5)[((size_t)sb * 32 + g) * 64 + n];
    const bf16* up = cx.S5U() + (size_t)row * 512 + 16 * g; const u32x4 u0 = *(const u32x4*)up, u1 = *(const u32x4*)(up + 8);
    float uu[16]; uu[0] = bflo(u0.x); uu[1] = bfhi(u0.x); uu[2] = bflo(u0.y); uu[3] = bfhi(u0.y); uu[4] = bflo(u0.z); uu[5] = bfhi(u0.z); uu[6] = bflo(u0.w); uu[7] = bfhi(u0.w);
    uu[8] = bflo(u1.x); uu[9] = bfhi(u1.x); uu[10] = bflo(u1.y); uu[11] = bfhi(u1.y); uu[12] = bflo(u1.z); uu[13] = bfhi(u1.z); uu[14] = bflo(u1.w); uu[15] = bfhi(u1.w);
    float bur = 0.f, bui = 0.f; const float* br = tab + T_BBR + (size_t)(g * 64 + n) * 16; const float* bi = tab + T_BBI + (size_t)(g * 64 + n) * 16;
#pragma unroll
    for (int c4 = 0; c4 < 4; ++c4) { const f32x4 r4 = *(const f32x4*)(br + 4 * c4), i4 = *(const f32x4*)(bi + 4 * c4);
#pragma unroll
        for (int i = 0; i < 4; ++i) { bur += r4[i] * uu[4 * c4 + i]; bui += i4[i] * uu[4 * c4 + i]; } }
    const float hr = A.x * h0r - A.y * h0i + bur, hi = A.x * h0i + A.y * h0r + bui;
    cx.out[O_S5RS + ((size_t)sb * 32 + g) * 64 + n] = hr; cx.out[O_S5IS + ((size_t)sb * 32 + g) * 64 + n] = hi;
    float my = 0.f, myu = 0.f;
#pragma unroll
    for (int c = 0; c < 16; ++c) { const float v = wave_sum(cx.I(24)[((size_t)g * 16 + c) * 64 + n] * hr - cx.I(25)[((size_t)g * 16 + c) * 64 + n] * hi); if (lane == c) { my = v; myu = uu[c]; } }
    if (lane < 16) { const float y = my + cx.I(26)[16 * g + lane] * myu; cx.GY()[(size_t)row * 512 + 16 * g + lane] = (bf16)(pk2(gelu_tanh(y), 0.f) & 0xffffu); }
}

#define XB_TMO      128
#define XB_XCNT(j)  (256  + 64 * (j))
#define XB_XSUB(j)  (1280 + 64 * (j))
#define XB_XGEN(j)  (2304 + 64 * (j))
#define XB_TOP      3328
#define XB_TOPGEN   3392
#define XCD_BAR_WORDS 3456
#define XB_SPIN_CAP (1u << 18)

__device__ __forceinline__ unsigned xb_ld(unsigned* p)              { return __hip_atomic_load(p, __ATOMIC_RELAXED, __HIP_MEMORY_SCOPE_AGENT); }
__device__ __forceinline__ unsigned xb_add(unsigned* p, unsigned v) { return __hip_atomic_fetch_add(p, v, __ATOMIC_RELAXED, __HIP_MEMORY_SCOPE_AGENT); }
__device__ __forceinline__ unsigned xb_xcc_id() { return (unsigned)__builtin_amdgcn_s_getreg((3 << 11) | 20) & 0xFu; }
#define XB_SPIN(cond, bar) do { unsigned _sp = 0; while (cond) { __builtin_amdgcn_s_sleep(1); \
    if ((++_sp & 255u) == 0u) { if (xb_ld(&(bar)[XB_TMO])) break; if (_sp > XB_SPIN_CAP) { atomicAdd(&(bar)[XB_TMO], 1u); break; } } } } while (0)

struct XcdBarrier {
    unsigned* bar; unsigned x;
    volatile LAS unsigned* st;
};

__device__ __forceinline__ XcdBarrier xcd_barrier_post(unsigned* bar, volatile LAS unsigned* st) {
    XcdBarrier b; b.bar = bar; b.x = xb_xcc_id(); b.st = st;
    if (threadIdx.x == 0) (void)xb_add(&bar[XB_XCNT(b.x)], 1u);
    return b;
}
__device__ __forceinline__ void xcd_barrier_complete(unsigned* bar, unsigned x, unsigned& nloc, unsigned& nx) {
    const unsigned G = gridDim.x * gridDim.y * gridDim.z;
    unsigned sum, cnt, mine, sp = 0u;
    for (;;) {
        sum = 0u; cnt = 0u; mine = 0u;
#pragma unroll
        for (unsigned j = 0; j < 16; ++j) { const unsigned c = xb_ld(&bar[XB_XCNT(j)]); sum += c; cnt += (c > 0u) ? 1u : 0u; mine = (j == x) ? c : mine; }
        if (sum == G) break;
        __builtin_amdgcn_s_sleep(1);
        if ((++sp & 255u) == 0u) { if (xb_ld(&bar[XB_TMO])) break; if (sp > XB_SPIN_CAP) { atomicAdd(&bar[XB_TMO], 1u); break; } }
    }
    nloc = mine > 0u ? mine : 1u; nx = cnt > 0u ? cnt : 1u;
}

__device__ __forceinline__ void xcd_barrier(const XcdBarrier& b) {
    asm volatile("s_waitcnt vmcnt(0)" ::: "memory");
    __syncthreads();
    if (threadIdx.x == 0) {
        unsigned* bar = b.bar;
        __builtin_amdgcn_s_waitcnt(0);
        unsigned nloc = b.st[0], nx = b.st[1];
        if (nloc == 0u) { xcd_barrier_complete(bar, b.x, nloc, nx); b.st[0] = nloc; b.st[1] = nx; }
        const unsigned old = xb_add(&bar[XB_XSUB(b.x)], 1u);
        const unsigned gen = old / nloc;
        if (old + 1u == (gen + 1u) * nloc) {
            __builtin_amdgcn_fence(__ATOMIC_RELEASE, "agent");
            asm volatile("s_waitcnt vmcnt(0)" ::: "memory");
            const unsigned og = xb_add(&bar[XB_TOP], 1u);
            const unsigned tg = og / nx;
            if (og + 1u == (tg + 1u) * nx) xb_add(&bar[XB_TOPGEN], 1u);
            else XB_SPIN(xb_ld(&bar[XB_TOPGEN]) == tg, bar);
            __builtin_amdgcn_fence(__ATOMIC_ACQUIRE, "agent");
            xb_add(&bar[XB_XGEN(b.x)], 1u);
            asm volatile("s_waitcnt vmcnt(0)" ::: "memory");
        } else {
            XB_SPIN(xb_ld(&bar[XB_XGEN(b.x)]) == gen, bar);
            __builtin_amdgcn_fence(__ATOMIC_ACQUIRE, "agent");
            asm volatile("s_waitcnt vmcnt(0)" ::: "memory");
        }
    }
    __syncthreads();
}

__global__ void __launch_bounds__(512, 2) fwd_kernel(KArgs a) {
    extern __shared__ __attribute__((aligned(16))) unsigned char lds_raw[];
    LAS unsigned char* lds = (LAS unsigned char*)lds_raw;
    Ctx cx; cx.in = a.in; cx.out = a.out; cx.ws = a.ws;
    const int tid = threadIdx.x, lane = tid & 63, wave = __builtin_amdgcn_readfirstlane(tid >> 6);
    const int G = gridDim.x, bid = blockIdx.x, gw = bid * 8 + wave, NGW = G * 8;
    volatile LAS unsigned* bst = (volatile LAS unsigned*)(lds + 131072);
    if (tid < 16) bst[tid] = 0u;
    __syncthreads();
    XcdBarrier xbar = xcd_barrier_post((unsigned*)a.ws, bst);
#ifndef REPMASK
#define REPMASK 0
#endif
#ifndef PHMASK
#define PHMASK 0x1fff
#endif
#define IN(k) (((PHMASK >> (k)) & 1) && a.lo <= (k) && (k) < a.hi)
#define SEAM(k) do { if (IN(k) && IN((k) + 1)) xcd_barrier(xbar); } while (0)

    if (IN(0)) for (int rep_ = 0; rep_ < 1 + ((REPMASK >> 0) & 1); ++rep_) {
        if (bid < 32 || G < 64) { for (int g = bid; g < 32; g += G) s5_tables(cx, g, lds); }
        const int nb2 = G >= 64 ? G - 32 : G, b2 = G >= 64 ? bid - 32 : bid;
        if (b2 >= 0) {
            for (int it = b2; it < 192; it += nb2) ada_block(cx, it, lds);
            LAS bf16* scr = (LAS bf16*)(lds + wave * 16384);
            for (int it = (nb2 - 1 - b2) * 8 + wave; it < N_TR_ITEMS; it += nb2 * 8) transpose_dispatch(cx, it, scr, lane);
        }
    }
    SEAM(0);
    if (IN(1)) for (int rep_ = 0; rep_ < 1 + ((REPMASK >> 1) & 1); ++rep_) {
        for (int r = gw; r < MTOK; r += NGW) { const float* xr = r < MPR ? cx.I(0) + (size_t)r * DM : cx.I(1) + (size_t)(r - MPR) * DM; const float* md = cx.MOD() + (size_t)mod_row(r) * NMOD;
            norm_mod_row(xr, cx.I(10), md + 1024, md, cx.XN() + (size_t)r * DM, lane); }
    }
    SEAM(1);
    if (IN(2)) for (int rep_ = 0; rep_ < 1 + ((REPMASK >> 2) & 1); ++rep_) {
        pg8::Gemm g{cx.XN(), cx.WIN(), MPAD, NPROJ, DM}; Sched2 S; S.init(NPROJ, DM, G, bid, DM / 64);
        EpiProj E{cx.LRUX(), cx.GATE(), cx.S5U()};
        pg8::gemm_phase<EpiProj, Sched2, true, true>(lds, g, S, E);
    }
    SEAM(2);
    if (IN(3)) for (int rep_ = 0; rep_ < 1 + ((REPMASK >> 3) & 1); ++rep_) {
#ifndef NO_LRU
        for (int q_ = 0; q_ < 1 + ((REPMASK >> 13) & 1); ++q_)
        for (int u = bid; u < 256 + NBS / SCH; u += G) {
            if (u < 256) lru_local_unit(cx, u * LCH, LCH, false, u, lds); else lru_local_unit(cx, MPR + (u - 256) * SCH, SCH, true, 0, lds);
        }
#endif
#ifndef NO_E
        for (int q_ = 0; q_ < 1 + ((REPMASK >> 14) & 1); ++q_)
        for (int it = gw; it < 2048; it += NGW) s5_gemm_e_item(cx, it, lane);
#endif
    }
    SEAM(3);
    if (IN(4)) for (int rep_ = 0; rep_ < 1 + ((REPMASK >> 4) & 1); ++rep_) {
        if (wave == 0) { for (int it = bid; it < 256; it += G) s5_chain_item(cx, it, lane); }
        for (int u = bid; u < 256 + NBS / SCH; u += G) {
            if (u < 256) lru_fix_unit(cx, u * LCH, LCH, false, u >> 5, u & 31, lds); else lru_fix_unit(cx, MPR + (u - 256) * SCH, SCH, true, 0, 0, lds);
        }
    }
    SEAM(4);
    if (IN(5)) for (int rep_ = 0; rep_ < 1 + ((REPMASK >> 5) & 1); ++rep_) {
        for (int it = gw; it < 2048; it += NGW) s5_gemm_tf_item(cx, it, lane);
        for (int it = gw; it < NBS * 32; it += NGW) s5_sample_item(cx, it, lane);
    }
    SEAM(5);
    if (IN(6)) for (int rep_ = 0; rep_ < 1 + ((REPMASK >> 6) & 1); ++rep_) {
        pg8::Gemm g{cx.GY(), cx.WGLU(), MPAD, 1024, 512}; Sched2 S; S.init(1024, 512, G, bid, 2);
        EpiGlu E{cx.S5OUT(), cx.PART()};
        pg8::gemm_phase<EpiGlu, Sched2, true, true>(lds, g, S, E);
    }
    SEAM(6);
    if (IN(7)) for (int rep_ = 0; rep_ < 1 + ((REPMASK >> 7) & 1); ++rep_) {
        const float* gs = cx.I(29);
        for (int r = gw; r < MTOK; r += NGW) { const float* sr = cx.S5OUT() + (size_t)r * 512;
            f32x4 v0, v1;
            if (r < MPR) { v0 = ((const f32x4*)sr)[lane]; v1 = ((const f32x4*)sr)[lane + 64]; }
            else { const float* pp = cx.PART() + (size_t)(r - MPR) * 1024; const int c0 = 4 * lane, ca0 = 256 * (c0 >> 7) + (c0 & 127), ca1 = ca0 + 512;
                f32x4 a0 = (f32x4){0.f, 0.f, 0.f, 0.f}, b0 = a0, a1 = a0, b1 = a0;
#pragma unroll
                for (int sl = 0; sl < 4; ++sl) { const float* q = pp + (size_t)sl * 128 * 1024; a0 += *(const f32x4*)(q + ca0); b0 += *(const f32x4*)(q + ca0 + 128); a1 += *(const f32x4*)(q + ca1); b1 += *(const f32x4*)(q + ca1 + 128); }
#pragma unroll
                for (int i = 0; i < 4; ++i) { v0[i] = a0[i] * sigm(b0[i]); v1[i] = a1[i] * sigm(b1[i]); } }
            const float ss = (v0.x * v0.x + v0.y * v0.y) + (v0.z * v0.z + v0.w * v0.w) + (v1.x * v1.x + v1.y * v1.y) + (v1.z * v1.z + v1.w * v1.w);
            const float rstd = rsqrtf(wave_sum(ss) * (1.f / 512) + EPS);
            const f32x4 o0 = v0 * rstd * ((const f32x4*)gs)[lane], o1 = v1 * rstd * ((const f32x4*)gs)[lane + 64];
            bf16* mp = cx.MERGED() + (size_t)r * DM + 512; u32x2 w0, w1; w0.x = pk2(o0.x, o0.y); w0.y = pk2(o0.z, o0.w); w1.x = pk2(o1.x, o1.y); w1.y = pk2(o1.z, o1.w);
            *(u32x2*)(mp + 4 * lane) = w0; *(u32x2*)(mp + 256 + 4 * lane) = w1; }
    }
    SEAM(7);
    if (IN(8)) for (int rep_ = 0; rep_ < 1 + ((REPMASK >> 8) & 1); ++rep_) {
        pg8::Gemm g{cx.MERGED(), cx.WOUT(), MPAD, DM, DM}; Sched2 S; S.init(DM, DM, G, bid, 2);
        EpiRes<2048> E{cx.I(0), cx.I(1), cx.MOD(), cx.out, cx.PART()};
        pg8::gemm_phase<EpiRes<2048>, Sched2, true, true>(lds, g, S, E);
    }
    SEAM(8);
    if (IN(9)) for (int rep_ = 0; rep_ < 1 + ((REPMASK >> 9) & 1); ++rep_) {
        for (int r = gw; r < MTOK; r += NGW) { const float* md = cx.MOD() + (size_t)mod_row(r) * NMOD;
            if (r >= MPR) { const float* pp = cx.PART() + (size_t)(r - MPR) * 1024; const float* xr = cx.I(1) + (size_t)(r - MPR) * DM; float* orow = cx.out + (size_t)r * DM;
#pragma unroll
                for (int j = 0; j < 4; ++j) { const int col = 4 * (lane + 64 * j); f32x4 sm = (f32x4){0.f, 0.f, 0.f, 0.f};
#pragma unroll
                    for (int sl = 0; sl < 8; ++sl) sm += *(const f32x4*)(pp + (size_t)sl * 128 * 1024 + col);
                    *(f32x4*)(orow + col) = *(const f32x4*)(xr + col) + *(const f32x4*)(md + 2048 + col) * sm; } }
            norm_mod_row(cx.out + (size_t)r * DM, cx.I(31), md + 4096, md + 3072, cx.XN2() + (size_t)r * DM, lane); }
    }
    SEAM(9);
    if (IN(10)) for (int rep_ = 0; rep_ < 1 + ((REPMASK >> 10) & 1); ++rep_) {
        pg8::Gemm g{cx.XN2(), cx.WGU(), MPAD, 2 * DFF, DM}; Sched2 S; S.init(2 * DFF, DM, G, bid, DM / 64);
        EpiSwiglu E{cx.HB()};
        pg8::gemm_phase<EpiSwiglu, Sched2, true, true>(lds, g, S, E);
    }
    SEAM(10);
    if (IN(11)) for (int rep_ = 0; rep_ < 1 + ((REPMASK >> 11) & 1); ++rep_) {
        pg8::Gemm g{cx.HB(), cx.WDN(), MPAD, DM, DFF}; Sched2 S; S.init(DM, DFF, G, bid, 2);
        EpiRes<5120> E{nullptr, nullptr, cx.MOD(), cx.out, cx.PART()};
        pg8::gemm_phase<EpiRes<5120>, Sched2, true, true>(lds, g, S, E);
    }
    SEAM(11);
    if (IN(12)) for (int rep_ = 0; rep_ < 1 + ((REPMASK >> 12) & 1); ++rep_) {
        const float* fg = cx.I(35);
        for (int r = gw; r < MTOK; r += NGW) { float* xr = cx.out + (size_t)r * DM; f32x4 v[4]; float ss = 0.f;
#pragma unroll
            for (int j = 0; j < 4; ++j) { v[j] = ((const f32x4*)xr)[lane + 64 * j];
                if (r >= MPR) { const int col = 4 * (lane + 64 * j); const float* pp = cx.PART() + (size_t)(r - MPR) * 1024 + col; f32x4 sm = (f32x4){0.f, 0.f, 0.f, 0.f};
#pragma unroll 2
                    for (int sl = 0; sl < 22; ++sl) sm += *(const f32x4*)(pp + (size_t)sl * 128 * 1024);
                    v[j] += *(const f32x4*)(cx.MOD() + (size_t)mod_row(r) * NMOD + 5120 + col) * sm; }
                ss += (v[j].x * v[j].x + v[j].y * v[j].y) + (v[j].z * v[j].z + v[j].w * v[j].w); }
            const float rstd = rsqrtf(wave_sum(ss) * (1.f / DM) + EPS);
#pragma unroll
            for (int j = 0; j < 4; ++j) ((f32x4*)xr)[lane + 64 * j] = v[j] * rstd * ((const f32x4*)fg)[lane + 64 * j]; }
    }
#undef IN
#undef SEAM
}

constexpr int LDS_BYTES = 131072 + 256;
#ifndef MK_SINGLE
#define MK_SINGLE 1
#endif
extern "C" void kernel_launch(void* const* d_in, const int* in_sizes, int n_in, void* d_out, int out_size, void* d_ws, size_t ws_size, hipStream_t stream) {
    static int grid = 0;
    if (grid == 0) {
        if (n_in != 36 || (size_t)out_size != O_END || ws_size < WS_END) { fprintf(stderr, "kernel_launch: unexpected shapes n_in %d out %d ws %zu\n", n_in, out_size, ws_size); grid = -1; return; }
        int dev = 0, cus = 0, per_cu = 0;
        hipGetDevice(&dev); hipDeviceGetAttribute(&cus, hipDeviceAttributeMultiprocessorCount, dev);
        hipFuncSetAttribute((const void*)fwd_kernel, hipFuncAttributeMaxDynamicSharedMemorySize, LDS_BYTES);
        hipOccupancyMaxActiveBlocksPerMultiprocessor(&per_cu, (const void*)fwd_kernel, 512, LDS_BYTES);
        if (per_cu < 1) { fprintf(stderr, "kernel_launch: occupancy query says %d blocks per CU\n", per_cu); grid = -1; return; }
        grid = cus;
    }
    if (grid < 0) return;
    if (hipMemsetAsync(d_ws, 0, 65536, stream) != hipSuccess) { fprintf(stderr, "kernel_launch: memset of the barrier words failed\n"); return; }
    KArgs a{};
    for (int i = 0; i < 36; ++i) a.in[i] = (const float*)d_in[i];
    a.out = (float*)d_out; a.ws = (unsigned char*)d_ws;
#if MK_SINGLE
    a.lo = 0; a.hi = NPHASE;
    void* args[] = {&a};
    hipError_t e = hipLaunchCooperativeKernel((const void*)fwd_kernel, dim3(grid), dim3(512), args, LDS_BYTES, stream);
    if (e != hipSuccess) fprintf(stderr, "cooperative launch failed: %s (grid %d)\n", hipGetErrorString(e), grid);
#else
    for (int p = 0; p < NPHASE; ++p) { a.lo = p; a.hi = p + 1; hipLaunchKernelGGL(fwd_kernel, dim3(grid), dim3(512), LDS_BYTES, stream, a); }
#endif
}
```

```cpp
#include <hip/hip_runtime.h>
#include <hip/hip_cooperative_groups.h>
#include <cstdio>
#include <cstdint>
namespace cg = cooperative_groups;
namespace pg8 {
#define PG8_LAS __attribute__((address_space(3)))
typedef unsigned short bf16_t;
typedef short bf16x8 __attribute__((ext_vector_type(8)));
typedef float f32x4 __attribute__((ext_vector_type(4)));
typedef unsigned u32x4 __attribute__((ext_vector_type(4)));
constexpr int BM = 256, BK = 64, HALF = 128, HTB = HALF * BK * 2  , STAGE_BYTES = 8 * HTB, NXCD = 8, WGM = 8;

__host__ __device__ __forceinline__ int lds_byte(int r, int c) { const int st = (r >> 4) * 2 + (c >> 5), rr = r & 15, cc = c & 31, ob = rr * 64 + cc * 2; return st * 1024 + (ob ^ (((ob >> 9) & 1) << 5)); }
__host__ __device__ __forceinline__ void stage_rc(int b, int& R, int& C) { const int st = b / 1024, sb = b % 1024, swz = sb ^ (((sb >> 9) & 1) << 5); R = (st >> 1) * 16 + swz / 64; C = (st & 1) * 32 + (swz % 64) / 2; }
__host__ __device__ __forceinline__ int perm32(int rho) { const int n = rho >> 4, i = rho & 15; return 8 * (i >> 2) + 4 * n + (i & 3); }

struct Unit { int pm, pn, kt0, nkt, kind, slice; };
struct Gemm { const bf16_t* A; const bf16_t* Bt; int M, N, K; };

struct StaticOrder {
    int nM, nN, nwg, G, c;
    __host__ __device__ __forceinline__ void init(int M, int N, int G_, int c_) { nM = M / BM; nN = N / BM; nwg = nM * nN; G = G_; c = c_; }
    __host__ __device__ __forceinline__ bool next(int i, Unit& u) const {
        const long L = (long)i * G + c; if (L >= nwg) return false;
        int wgid = (int)L; { const int q = nwg / NXCD, r = nwg % NXCD, xcd = wgid % NXCD, off = wgid / NXCD; wgid = (xcd < r ? xcd * (q + 1) : r * (q + 1) + (xcd - r) * q) + off; }
        const int nig = WGM * nN, gid = wgid / nig, fm = gid * WGM, gsz = (nM - fm) < WGM ? (nM - fm) : WGM;
        u.pm = fm + ((wgid % nig) % gsz); u.pn = (wgid % nig) / gsz; return true;
    }
    __device__ __forceinline__ void a_ready(const Unit&) const {}
    __device__ __forceinline__ void done(const Unit&) const {}
};

__device__ __forceinline__ unsigned cvt_pk_bf16(float lo, float hi) { unsigned r; asm volatile("v_cvt_pk_bf16_f32 %0, %1, %2" : "=v"(r) : "v"(lo), "v"(hi)); return r; }
typedef float f32x2 __attribute__((ext_vector_type(2)));
template <class Epi, class Sched, bool ALIGN_EPI = false, bool SP2 = false>
__device__ __forceinline__ void gemm_phase(PG8_LAS unsigned char* lds, const Gemm g, const Sched& S, const Epi& E) {
    const int tid = threadIdx.x, wid = __builtin_amdgcn_readfirstlane(tid >> 6), lane = tid & 63, wr = wid >> 2, wc = wid & 3, fr = lane & 15, fq = lane >> 4;
    const int K = g.K;
    unsigned voffA[2], voffB[2];
#pragma unroll
    for (int i = 0; i < 2; ++i) { int R, C; stage_rc(tid * 16 + i * 8192, R, C); const int Rb = Epi::PERM ? ((R & ~31) + perm32(R & 31)) : R;
        voffA[i] = (unsigned)(R * K + C) * 2u; voffB[i] = (unsigned)(Rb * K + C) * 2u; }
    const size_t kstep = (size_t)(BK * 2);
    const size_t hstep = (size_t)HALF * K * 2;
    const size_t tstep = 2 * hstep;
    const unsigned ldsw = (unsigned)wid * 1024u;
    const int aoff = lds_byte(wr * 64 + fr, fq * 8), boff = lds_byte(wc * 32 + fr, fq * 8);
#define PG8_SA(b, h) (((b) * 2 + (h)) * HTB)
#define PG8_SB(b, h) ((4 + (b) * 2 + (h)) * HTB)
#define PG8_STAGE(bufoff, gbase, voff) do { _Pragma("unroll") for (int _i = 0; _i < 2; ++_i) \
        __builtin_amdgcn_global_load_lds((const unsigned*)((const char*)(gbase) + (voff)[_i]), (PG8_LAS unsigned*)(lds + (bufoff) + ldsw + _i * 8192), 16, 0, 0); } while (0)
#define PG8_LDA(dst, b, h) do { _Pragma("unroll") for (int m = 0; m < 4; ++m) _Pragma("unroll") for (int k = 0; k < 2; ++k) dst[m][k] = *(const PG8_LAS bf16x8*)(lds + PG8_SA(b, h) + aoff + m * 2048 + k * 1024); } while (0)
#define PG8_LDB(dst, b, h) do { _Pragma("unroll") for (int n = 0; n < 2; ++n) _Pragma("unroll") for (int k = 0; k < 2; ++k) dst[n][k] = *(const PG8_LAS bf16x8*)(lds + PG8_SB(b, h) + boff + n * 2048 + k * 1024); } while (0)
#define PG8_MMA(ai, bj, At, Bt) do { __builtin_amdgcn_s_setprio(1); _Pragma("unroll") for (int m = 0; m < 4; ++m) _Pragma("unroll") for (int n = 0; n < 2; ++n) _Pragma("unroll") for (int k = 0; k < 2; ++k) \
        acc[ai][bj][m][n] = __builtin_amdgcn_mfma_f32_16x16x32_bf16(Bt[n][k], At[m][k], acc[ai][bj][m][n], 0, 0, 0); __builtin_amdgcn_s_setprio(0); } while (0)
#define PG8_WAIT_V(n) asm volatile("s_waitcnt vmcnt(" #n ")" ::: "memory")
#define PG8_WAIT_L(n) asm volatile("s_waitcnt lgkmcnt(" #n ")" ::: "memory")
#define PG8_BAR __builtin_amdgcn_s_barrier()
#define PG8_SCHED __builtin_amdgcn_sched_barrier(0)
    Unit cur = {0, 0, 0, 0, 0, 0}, nxt = {0, 0, 0, 0, 0, 0}; int ui = 0;
    if (!S.next(0, cur)) return;
    f32x4 acc[2][2][4][2];
#pragma unroll
    for (int a = 0; a < 2; ++a)
#pragma unroll
        for (int b = 0; b < 2; ++b)
#pragma unroll
            for (int m = 0; m < 4; ++m)
#pragma unroll
                for (int n = 0; n < 2; ++n) acc[a][b][m][n] = (f32x4){0.f, 0.f, 0.f, 0.f};
    bf16x8 At[4][2], B0[2][2], B1[2][2];
    const char* cA = (const char*)g.A + (size_t)cur.pm * tstep + (size_t)cur.kt0 * kstep; const char* cB = (const char*)g.Bt + (size_t)cur.pn * tstep + (size_t)cur.kt0 * kstep;
    S.a_ready(cur);
    if constexpr (SP2) {
        PG8_STAGE(PG8_SB(0, 0), cB, voffB); PG8_STAGE(PG8_SB(0, 1), cB + hstep, voffB); PG8_STAGE(PG8_SA(0, 0), cA, voffA); PG8_STAGE(PG8_SA(0, 1), cA + hstep, voffA);
        if (wr == 1) PG8_BAR;
        PG8_WAIT_V(2); PG8_BAR;
        PG8_STAGE(PG8_SB(1, 0), cB + kstep, voffB); PG8_STAGE(PG8_SA(1, 0), cA + kstep, voffA); PG8_STAGE(PG8_SB(1, 1), cB + hstep + kstep, voffB);
        PG8_WAIT_V(6); PG8_BAR;
    } else {
        PG8_STAGE(PG8_SB(0, 0), cB, voffB); PG8_STAGE(PG8_SA(0, 0), cA, voffA); PG8_STAGE(PG8_SB(0, 1), cB + hstep, voffB); PG8_STAGE(PG8_SA(0, 1), cA + hstep, voffA);
        if (wr == 1) PG8_BAR;
        PG8_WAIT_V(4); PG8_BAR;
        PG8_STAGE(PG8_SB(1, 0), cB + kstep, voffB); PG8_STAGE(PG8_SA(1, 0), cA + kstep, voffA); PG8_STAGE(PG8_SB(1, 1), cB + hstep + kstep, voffB);
        PG8_WAIT_V(6); PG8_BAR;
    }
    for (;;) {
        const bool has_next = S.next(ui + 1, nxt);
        const char* nA = has_next ? (const char*)g.A + (size_t)nxt.pm * tstep + (size_t)nxt.kt0 * kstep : cA; const char* nB = has_next ? (const char*)g.Bt + (size_t)nxt.pn * tstep + (size_t)nxt.kt0 * kstep : cB;
        const int nt = cur.nkt;
        for (int t = 0; t < nt; t += 2) {
            const bool last = (t == nt - 2);
            const char* a1 = cA + (size_t)(t + 1) * kstep;
            const char* a2 = last ? nA : cA + (size_t)(t + 2) * kstep; const char* b2 = last ? nB : cB + (size_t)(t + 2) * kstep;
            const char* a3 = a2 + kstep; const char* b3 = b2 + kstep;
            if (last && has_next) S.a_ready(nxt);
            if constexpr (SP2) {
            PG8_LDB(B0, 0, 0); PG8_LDB(B1, 0, 1); PG8_SCHED; PG8_LDA(At, 0, 0); PG8_STAGE(PG8_SA(1, 1), a1 + hstep, voffA);
            PG8_WAIT_V(8); PG8_WAIT_L(0); PG8_BAR; PG8_MMA(0, 0, At, B0); PG8_MMA(0, 1, At, B1); PG8_BAR; PG8_SCHED;
            PG8_LDA(At, 0, 1); PG8_STAGE(PG8_SB(0, 0), b2, voffB); PG8_STAGE(PG8_SB(0, 1), b2 + hstep, voffB); PG8_STAGE(PG8_SA(0, 0), a2, voffA);
            PG8_WAIT_V(8); PG8_WAIT_L(0); PG8_BAR; PG8_MMA(1, 0, At, B0); PG8_MMA(1, 1, At, B1); PG8_BAR; PG8_SCHED;
            PG8_LDB(B0, 1, 0); PG8_LDB(B1, 1, 1); PG8_SCHED; PG8_LDA(At, 1, 0); PG8_STAGE(PG8_SA(0, 1), a2 + hstep, voffA);
            PG8_WAIT_V(8); PG8_WAIT_L(0); PG8_BAR; PG8_MMA(0, 0, At, B0); PG8_MMA(0, 1, At, B1); PG8_BAR; PG8_SCHED;
            PG8_LDA(At, 1, 1); PG8_STAGE(PG8_SB(1, 0), b3, voffB); PG8_STAGE(PG8_SB(1, 1), b3 + hstep, voffB); PG8_STAGE(PG8_SA(1, 0), a3, voffA);
            PG8_WAIT_V(8); PG8_WAIT_L(0); PG8_BAR; PG8_MMA(1, 0, At, B0); PG8_MMA(1, 1, At, B1); PG8_BAR; PG8_SCHED;
            } else {
            PG8_LDB(B0, 0, 0); PG8_SCHED; PG8_LDA(At, 0, 0); PG8_STAGE(PG8_SA(1, 1), a1 + hstep, voffA);
            PG8_WAIT_L(8); PG8_BAR; PG8_WAIT_L(0); PG8_MMA(0, 0, At, B0); PG8_BAR; PG8_SCHED;
            PG8_LDB(B1, 0, 1); PG8_STAGE(PG8_SB(0, 0), b2, voffB);
            PG8_BAR; PG8_WAIT_L(0); PG8_MMA(0, 1, At, B1); PG8_BAR;
            PG8_LDA(At, 0, 1); PG8_STAGE(PG8_SA(0, 0), a2, voffA);
            PG8_BAR; PG8_WAIT_L(0); PG8_MMA(1, 0, At, B0); PG8_BAR; PG8_SCHED;
            PG8_STAGE(PG8_SB(0, 1), b2 + hstep, voffB);
            PG8_WAIT_V(6); PG8_BAR; PG8_MMA(1, 1, At, B1); PG8_BAR;
            PG8_LDB(B0, 1, 0); PG8_SCHED; PG8_LDA(At, 1, 0); PG8_STAGE(PG8_SA(0, 1), a2 + hstep, voffA);
            PG8_WAIT_L(8); PG8_BAR; PG8_WAIT_L(0); PG8_MMA(0, 0, At, B0); PG8_BAR; PG8_SCHED;
            PG8_LDB(B1, 1, 1); PG8_STAGE(PG8_SB(1, 0), b3, voffB);
            PG8_BAR; PG8_WAIT_L(0); PG8_MMA(0, 1, At, B1); PG8_BAR;
            PG8_LDA(At, 1, 1); PG8_STAGE(PG8_SA(1, 0), a3, voffA);
            PG8_BAR; PG8_WAIT_L(0); PG8_MMA(1, 0, At, B0); PG8_BAR; PG8_SCHED;
            PG8_STAGE(PG8_SB(1, 1), b3 + hstep, voffB);
            PG8_WAIT_V(6); PG8_BAR; PG8_MMA(1, 1, At, B1); PG8_BAR;
            }
        }
        if constexpr (ALIGN_EPI) { if (wr == 0) PG8_BAR; }
        if constexpr (!Epi::AFTER_DRAIN) { E(acc, cur, wr, wc, fr, fq); S.done(cur); } else { if (has_next) E(acc, cur, wr, wc, fr, fq); }
        if (!has_next) break;
#pragma unroll
        for (int a = 0; a < 2; ++a)
#pragma unroll
            for (int b = 0; b < 2; ++b)
#pragma unroll
                for (int m = 0; m < 4; ++m)
#pragma unroll
                    for (int n = 0; n < 2; ++n) acc[a][b][m][n] = (f32x4){0.f, 0.f, 0.f, 0.f};
        cur = nxt; cA = nA; cB = nB; ++ui;
        if constexpr (ALIGN_EPI) { if (wr == 1) PG8_BAR; }
    }
    PG8_WAIT_V(0);
    if constexpr (!ALIGN_EPI) { if (wr == 0) PG8_BAR; }
    PG8_BAR;
    if constexpr (Epi::AFTER_DRAIN) { E.fused(acc, cur, wr, wc, fr, fq, lds, wid, lane); S.done(cur); }
#undef PG8_SA
#undef PG8_SB
#undef PG8_STAGE
#undef PG8_LDA
#undef PG8_LDB
#undef PG8_MMA
#undef PG8_WAIT_V
#undef PG8_WAIT_L
#undef PG8_BAR
#undef PG8_SCHED
}
}

#define LAS __attribute__((address_space(3)))
typedef unsigned short bf16;
typedef float f32x4 __attribute__((ext_vector_type(4)));
typedef float f32x2 __attribute__((ext_vector_type(2)));
typedef short bf16x8 __attribute__((ext_vector_type(8)));
typedef unsigned u32x4 __attribute__((ext_vector_type(4)));
typedef unsigned u32x2 __attribute__((ext_vector_type(2)));

constexpr int DM = 1024, NBP = 8, SEQ = 2048, MPR = NBP * SEQ, NBS = 128, MTOK = MPR + NBS, MPAD = 16640;
constexpr int DL = 512, NPROJ = 1536, NMOD = 6144, NBT = NBP + NBS, DFF = 2816;
constexpr int LCH = 64, NCH = SEQ / LCH;
constexpr int SCH = 16;
constexpr int SL = 16, SNCH = SEQ / SL, SROWS = NBP * SNCH;
constexpr float EPS = 1e-6f;
constexpr int NPHASE = 13;

constexpr size_t O_Y = 0, O_CONVP = (size_t)MTOK * DM, O_LRUP = O_CONVP + 8 * 3 * 512, O_S5RP = O_LRUP + 8 * 512, O_S5IP = O_S5RP + 8 * 32 * 64,
                 O_CONVS = O_S5IP + 8 * 32 * 64, O_LRUS = O_CONVS + 128 * 3 * 512, O_S5RS = O_LRUS + 128 * 512, O_S5IS = O_S5RS + 128 * 32 * 64, O_END = O_S5IS + 128 * 32 * 64;

constexpr size_t HM = 1u << 19;
constexpr size_t WS_WIN = 2 * HM, WS_WGLU = 8 * HM, WS_WOUT = 10 * HM, WS_WGU = 14 * HM, WS_WDN = 36 * HM  , WS_MOD = 48 * HM  ,
                 WS_TF = 56 * HM  , WS_E = 68 * HM  , WS_TAB = 72 * HM, WS_AGG = 74 * HM  ,
                 WS_XN = 80 * HM  , WS_LRUX = 146 * HM  , WS_GATE = 211 * HM  ,
                 WS_S5U = 244 * HM  , WS_HLOC = 277 * HM  , WS_CUM = 342 * HM, WS_GY = 407 * HM  ,
                 WS_SK = 440 * HM  , WS_HIN = 472 * HM  , WS_HB = 244 * HM  , WS_PART = 488 * HM  , WS_END = 512 * HM;
constexpr size_t WS_XSLOT = 65536;
constexpr size_t T_ABAR = 0, T_A16 = 4096, T_BBR = 8192, T_BBI = 8192 + 32768;

struct KArgs { const float* in[36]; float* out; unsigned char* ws; int lo, hi; };

struct Ctx {
    const float* const* in; float* out; unsigned char* ws;
    __device__ __forceinline__ const float* I(int i) const { return in[i]; }
    __device__ __forceinline__ bf16* WIN() const { return (bf16*)(ws + WS_WIN); }
    __device__ __forceinline__ bf16* WGLU() const { return (bf16*)(ws + WS_WGLU); }
    __device__ __forceinline__ bf16* WOUT() const { return (bf16*)(ws + WS_WOUT); }
    __device__ __forceinline__ bf16* WGU() const { return (bf16*)(ws + WS_WGU); }
    __device__ __forceinline__ bf16* WDN() const { return (bf16*)(ws + WS_WDN); }
    __device__ __forceinline__ float* MOD() const { return (float*)(ws + WS_MOD); }
    __device__ __forceinline__ bf16* TF() const { return (bf16*)(ws + WS_TF); }
    __device__ __forceinline__ bf16* EM() const { return (bf16*)(ws + WS_E); }
    __device__ __forceinline__ float* TAB() const { return (float*)(ws + WS_TAB); }
    __device__ __forceinline__ f32x2* AGG() const { return (f32x2*)(ws + WS_AGG); }
    __device__ __forceinline__ bf16* XN() const { return (bf16*)(ws + WS_XN); }
    __device__ __forceinline__ bf16* MERGED() const { return (bf16*)(ws + WS_XN); }
    __device__ __forceinline__ float* LRUX() const { return (float*)(ws + WS_LRUX); }
    __device__ __forceinline__ bf16* XN2() const { return (bf16*)(ws + WS_LRUX); }
    __device__ __forceinline__ bf16* GATE() const { return (bf16*)(ws + WS_GATE); }
    __device__ __forceinline__ bf16* S5U() const { return (bf16*)(ws + WS_S5U); }
    __device__ __forceinline__ float* HLOC() const { return (float*)(ws + WS_HLOC); }
    __device__ __forceinline__ float* S5OUT() const { return (float*)(ws + WS_HLOC); }
    __device__ __forceinline__ float* CUM() const { return (float*)(ws + WS_CUM); }
    __device__ __forceinline__ bf16* GY() const { return (bf16*)(ws + WS_GY); }
    __device__ __forceinline__ float* SK() const { return (float*)(ws + WS_SK); }
    __device__ __forceinline__ bf16* HIN() const { return (bf16*)(ws + WS_HIN); }
    __device__ __forceinline__ bf16* HB() const { return (bf16*)(ws + WS_HB); }
    __device__ __forceinline__ float* PART() const { return (float*)(ws + WS_PART); }
};

#define LDS_WAIT() asm volatile("s_waitcnt lgkmcnt(0)" ::: "memory")
__device__ __forceinline__ unsigned pk2(float lo, float hi) { return pg8::cvt_pk_bf16(lo, hi); }
__device__ __forceinline__ float bf2f(unsigned b) { return __uint_as_float(b << 16); }
__device__ __forceinline__ float bflo(unsigned w) { return __uint_as_float(w << 16); }
__device__ __forceinline__ float bfhi(unsigned w) { return __uint_as_float(w & 0xffff0000u); }
__device__ __forceinline__ float wave_sum(float v) {
#pragma unroll
    for (int o = 1; o < 64; o <<= 1) v += __shfl_xor(v, o);
    return v;
}
__device__ __forceinline__ float sigm(float v) { return __builtin_amdgcn_rcpf(1.f + __builtin_amdgcn_exp2f(-1.44269504089f * v)); }
__device__ __forceinline__ float gelu_tanh(float x) { const float u = (-1.5957691216f * 1.44269504089f) * (x + 0.044715f * x * x * x); return x * __builtin_amdgcn_rcpf(1.f + __builtin_amdgcn_exp2f(u)); }
__device__ __forceinline__ int mod_row(int row) { return row < MPR ? (row >> 11) : (NBP + row - MPR); }
__device__ __forceinline__ u32x4 pack8(f32x4 a, f32x4 b) { u32x4 w; w.x = pk2(a[0], a[1]); w.y = pk2(a[2], a[3]); w.z = pk2(b[0], b[1]); w.w = pk2(b[2], b[3]); return w; }

struct Sched2 {
    pg8::StaticOrder so; int nkt_full, n_extra, ex_nn, ex_nkt;
    __device__ __forceinline__ void init(int N, int K, int G, int c, int ex_nkt_) { so.init(MPR, N, G, c); nkt_full = K / 64; ex_nn = N / 256; ex_nkt = ex_nkt_; n_extra = ex_nn * (nkt_full / ex_nkt_); }
    __device__ __forceinline__ bool next(int i, pg8::Unit& u) const {
        const long L = (long)i * so.G + so.c;
        const bool prompt = L < so.nwg; const int e = (int)(L - so.nwg);
        if (!prompt && e >= n_extra) return false;
        pg8::Unit t; t.pm = 0; t.pn = 0; t.kt0 = 0; t.nkt = 0; t.kind = 0; t.slice = 0;
        if (prompt) so.next(i, t);
        const int sl = prompt ? 0 : e / ex_nn;
        pg8::Unit r; r.pm = prompt ? t.pm : 64; r.pn = prompt ? t.pn : e % ex_nn; r.kt0 = sl * ex_nkt; r.nkt = prompt ? nkt_full : ex_nkt; r.kind = prompt ? 0 : ((ex_nkt == nkt_full) ? 1 : 2); r.slice = sl;
        u = r; return true;
    }
    __device__ __forceinline__ void a_ready(const pg8::Unit&) const {}
    __device__ __forceinline__ void done(const pg8::Unit&) const {}
};
__device__ __forceinline__ void store_partial(const f32x4 (&acc)[2][2][4][2], const pg8::Unit& u, int wr, int wc, int fr, int fq, float* part) {
    float* base = part + (size_t)u.slice * 128 * 1024 + u.pn * 256 + wc * 32 + 8 * fq;
#pragma unroll
    for (int m = 0; m < 4; ++m) { float* rp = base + (size_t)(wr * 64 + m * 16 + fr) * 1024;
#pragma unroll
        for (int bj = 0; bj < 2; ++bj)
#pragma unroll
            for (int n = 0; n < 2; ++n) *(f32x4*)(rp + bj * 128 + 4 * n) = acc[0][bj][m][n]; }
}

struct EpiProj {
    static constexpr bool PERM = true, AFTER_DRAIN = false; float* lrux; bf16* gate; bf16* s5u;
    __device__ __forceinline__ void operator()(const f32x4 (&acc)[2][2][4][2], const pg8::Unit& u, int wr, int wc, int fr, int fq) const {
        const int colt = u.pn * 256 + wc * 32 + 8 * fq;
#pragma unroll
        for (int ai = 0; ai < 2; ++ai)
#pragma unroll
            for (int m = 0; m < 4; ++m) { const int row = u.pm * 256 + ai * 128 + wr * 64 + m * 16 + fr; if (row >= MTOK) continue;
#pragma unroll
                for (int bj = 0; bj < 2; ++bj) { const int col = colt + bj * 128; const f32x4 v0 = acc[ai][bj][m][0], v1 = acc[ai][bj][m][1];
                    if (u.pn < 2) { float* p = lrux + (size_t)row * 512 + col; *(f32x4*)p = v0; *(f32x4*)(p + 4) = v1; }
                    else if (u.pn < 4) { *(u32x4*)(gate + (size_t)row * 512 + (col - 512)) = pack8(v0, v1); }
                    else { *(u32x4*)(s5u + (size_t)row * 512 + (col - 1024)) = pack8(v0, v1); } } }
    }
};
struct EpiGlu {
    static constexpr bool PERM = true, AFTER_DRAIN = false; float* o; float* part;
    __device__ __forceinline__ void operator()(const f32x4 (&acc)[2][2][4][2], const pg8::Unit& u, int wr, int wc, int fr, int fq) const {
        if (u.kind == 2) { store_partial(acc, u, wr, wc, fr, fq, part); return; }
        const int col = u.pn * 128 + wc * 32 + 8 * fq;
#pragma unroll
        for (int ai = 0; ai < 2; ++ai)
#pragma unroll
            for (int m = 0; m < 4; ++m) { const int row = u.pm * 256 + ai * 128 + wr * 64 + m * 16 + fr; if (row >= MTOK) continue;
#pragma unroll
                for (int n = 0; n < 2; ++n) { const f32x4 a = acc[ai][0][m][n], b = acc[ai][1][m][n]; f32x4 s;
#pragma unroll
                    for (int i = 0; i < 4; ++i) s[i] = a[i] * sigm(b[i]);
                    *(f32x4*)(o + (size_t)row * 512 + col + 4 * n) = s; } }
    }
};
template <int GOFF> struct EpiRes {
    static constexpr bool PERM = true, AFTER_DRAIN = false; const float* xp; const float* xs; const float* mod; float* out; float* part;
    __device__ __forceinline__ void operator()(const f32x4 (&acc)[2][2][4][2], const pg8::Unit& u, int wr, int wc, int fr, int fq) const {
        if (u.kind == 2) { store_partial(acc, u, wr, wc, fr, fq, part); return; }
        const int colt = u.pn * 256 + wc * 32 + 8 * fq;
#pragma unroll
        for (int ai = 0; ai < 2; ++ai)
#pragma unroll
            for (int m = 0; m < 4; ++m) { const int row = u.pm * 256 + ai * 128 + wr * 64 + m * 16 + fr; if (row >= MTOK) continue;
                const float* gp = mod + (size_t)mod_row(row) * NMOD + GOFF; float* op = out + (size_t)row * DM;
                const float* bp = xp ? (row < MPR ? xp + (size_t)row * DM : xs + (size_t)(row - MPR) * DM) : op;
#pragma unroll
                for (int bj = 0; bj < 2; ++bj)
#pragma unroll
                    for (int n = 0; n < 2; ++n) { const int c = colt + bj * 128 + 4 * n; const f32x4 x4 = *(const f32x4*)(bp + c), g4 = *(const f32x4*)(gp + c);
                        *(f32x4*)(op + c) = x4 + g4 * acc[ai][bj][m][n]; } }
    }
};
struct EpiSwiglu {
    static constexpr bool PERM = true, AFTER_DRAIN = false; bf16* h;
    __device__ __forceinline__ void operator()(const f32x4 (&acc)[2][2][4][2], const pg8::Unit& u, int wr, int wc, int fr, int fq) const {
        const int col = u.pn * 128 + wc * 32 + 8 * fq;
#pragma unroll
        for (int ai = 0; ai < 2; ++ai)
#pragma unroll
            for (int m = 0; m < 4; ++m) { const int row = u.pm * 256 + ai * 128 + wr * 64 + m * 16 + fr; if (row >= MTOK) continue;
                f32x4 s[2];
#pragma unroll
                for (int n = 0; n < 2; ++n) { const f32x4 a = acc[ai][0][m][n], b = acc[ai][1][m][n];
#pragma unroll
                    for (int i = 0; i < 4; ++i) s[n][i] = a[i] * sigm(a[i]) * b[i]; }
                *(u32x4*)(h + (size_t)row * DFF + col) = pack8(s[0], s[1]); }
    }
};

struct Sched3 {
    pg8::StaticOrder so; int nkt_full, n_extra, ex_nn, ex_nkt;
    __device__ __forceinline__ void init(int N, int K, int G, int c, int ex_nkt_) { so.init(MPR, N, G, c); nkt_full = K / 64; ex_nn = N / 256; ex_nkt = ex_nkt_; n_extra = ex_nn * (nkt_full / ex_nkt_); }
    __device__ __forceinline__ bool next(int i, pg8::Unit& u) const {
        const bool has_ex = so.c < n_extra; const int j = has_ex ? i : i + 1;
        if (j > 1) return false;
        const bool prompt = (j == 1); const int e = so.c;
        pg8::Unit t; t.pm = 0; t.pn = 0; t.kt0 = 0; t.nkt = 0; t.kind = 0; t.slice = 0;
        if (prompt) so.next(0, t);
        const int sl = prompt ? 0 : e / ex_nn;
        pg8::Unit r; r.pm = prompt ? t.pm : 64; r.pn = prompt ? t.pn : e % ex_nn; r.kt0 = sl * ex_nkt; r.nkt = prompt ? nkt_full : ex_nkt; r.kind = prompt ? 0 : 2; r.slice = sl;
        u = r; return true;
    }
    __device__ __forceinline__ void a_ready(const pg8::Unit&) const {}
    __device__ __forceinline__ void done(const pg8::Unit&) const {}
};
struct RmsPanel {
    float* xbuf;
    unsigned* cnt;
    float inv_n, eps;
    __device__ __forceinline__ void put(float t, int r, int wc, int fq, LAS unsigned char* lds) const { t += __shfl_xor(t, 16); t += __shfl_xor(t, 32); if (fq == 0) ((LAS float*)lds)[r * 4 + wc] = t; }
    __device__ __forceinline__ void finish(const pg8::Unit& u, LAS unsigned char* lds, int wid, int lane) const {
        LAS float* P = (LAS float*)lds; LAS float* S = (LAS float*)(lds + 4096);
        asm volatile("s_waitcnt lgkmcnt(0)" ::: "memory"); __builtin_amdgcn_s_barrier(); asm volatile("" ::: "memory");
        const int row = wid * 32 + (lane & 31);
        if (lane < 32) { const f32x4 p = *(const LAS f32x4*)(P + row * 4); const float t = (p.x + p.y) + (p.z + p.w);
            __hip_atomic_store(xbuf + ((size_t)(u.pm * 256 + row) * 4 + u.pn), t, __ATOMIC_RELAXED, __HIP_MEMORY_SCOPE_AGENT); }
        asm volatile("s_waitcnt vmcnt(0)" ::: "memory");
        if (lane == 0) __hip_atomic_fetch_add(cnt + 64 * u.pm, 1u, __ATOMIC_RELAXED, __HIP_MEMORY_SCOPE_AGENT);
        if (wid == 0) { unsigned sp = 0;
            while ((unsigned)__builtin_amdgcn_readfirstlane(__hip_atomic_load(cnt + 64 * u.pm, __ATOMIC_RELAXED, __HIP_MEMORY_SCOPE_AGENT)) < 32u) { __builtin_amdgcn_s_sleep(2); if (++sp > (1u << 22)) break; }
            __builtin_amdgcn_fence(__ATOMIC_ACQUIRE, "agent"); }
        asm volatile("s_waitcnt vmcnt(0) lgkmcnt(0)" ::: "memory"); __builtin_amdgcn_s_barrier(); asm volatile("" ::: "memory");
        if (lane < 32) { const float* slot = xbuf + (size_t)(u.pm * 256 + row) * 4; float t = 0.f;
#pragma unroll
            for (int q = 0; q < 4; ++q) t += __hip_atomic_load(slot + q, __ATOMIC_RELAXED, __HIP_MEMORY_SCOPE_AGENT);
            S[row] = rsqrtf(t * inv_n + eps); }
        asm volatile("s_waitcnt lgkmcnt(0)" ::: "memory"); __builtin_amdgcn_s_barrier(); asm volatile("" ::: "memory");
    }
};
struct EpiGluNorm {
    static constexpr bool PERM = true, AFTER_DRAIN = true; bf16* merged; const float* gs; float* part; RmsPanel st;
    __device__ __forceinline__ void operator()(const f32x4 (&acc)[2][2][4][2], const pg8::Unit& u, int wr, int wc, int fr, int fq) const { if (u.kind == 2) store_partial(acc, u, wr, wc, fr, fq, part); }
    __device__ __forceinline__ void fused(f32x4 (&acc)[2][2][4][2], const pg8::Unit& u, int wr, int wc, int fr, int fq, LAS unsigned char* lds, int wid, int lane) const {
#pragma unroll
        for (int ai = 0; ai < 2; ++ai)
#pragma unroll
            for (int m = 0; m < 4; ++m) { float ss = 0.f;
#pragma unroll
                for (int n = 0; n < 2; ++n) { const f32x4 a = acc[ai][0][m][n], b = acc[ai][1][m][n]; f32x4 sv;
#pragma unroll
                    for (int i = 0; i < 4; ++i) { sv[i] = a[i] * sigm(b[i]); ss += sv[i] * sv[i]; }
                    acc[ai][0][m][n] = sv; }
                st.put(ss, ai * 128 + wr * 64 + m * 16 + fr, wc, fq, lds); }
        st.finish(u, lds, wid, lane);
        const LAS float* S = (const LAS float*)(lds + 4096);
        const int col = u.pn * 128 + wc * 32 + 8 * fq; const f32x4 g0 = *(const f32x4*)(gs + col), g1 = *(const f32x4*)(gs + col + 4);
#pragma unroll
        for (int ai = 0; ai < 2; ++ai)
#pragma unroll
            for (int m = 0; m < 4; ++m) { const int r = ai * 128 + wr * 64 + m * 16 + fr; const float rstd = S[r];
                *(u32x4*)(merged + (size_t)(u.pm * 256 + r) * DM + 512 + col) = pack8(acc[ai][0][m][0] * rstd * g0, acc[ai][0][m][1] * rstd * g1); }
    }
};
template <int MODE> struct EpiResNorm {
    static constexpr bool PERM = true, AFTER_DRAIN = true; const float* xp; const float* mod; const float* gn; float* out; bf16* xn; float* part; RmsPanel st;
    __device__ __forceinline__ void operator()(const f32x4 (&acc)[2][2][4][2], const pg8::Unit& u, int wr, int wc, int fr, int fq) const { if (u.kind == 2) store_partial(acc, u, wr, wc, fr, fq, part); }
    __device__ __forceinline__ void fused(f32x4 (&acc)[2][2][4][2], const pg8::Unit& u, int wr, int wc, int fr, int fq, LAS unsigned char* lds, int wid, int lane) const {
        const int colt = u.pn * 256 + wc * 32 + 8 * fq; const float* mrow = mod + (size_t)(u.pm >> 3) * NMOD;
        constexpr int GOFF = MODE == 1 ? 2048 : 5120;
        f32x4 gv[2][2];
#pragma unroll
        for (int bj = 0; bj < 2; ++bj)
#pragma unroll
            for (int n = 0; n < 2; ++n) gv[bj][n] = *(const f32x4*)(mrow + GOFF + colt + bj * 128 + 4 * n);
#pragma unroll
        for (int ai = 0; ai < 2; ++ai)
#pragma unroll
            for (int m = 0; m < 4; ++m) { const size_t ro = (size_t)(u.pm * 256 + ai * 128 + wr * 64 + m * 16 + fr) * DM + colt; const float* bp = (MODE == 1 ? xp : out) + ro; float ss = 0.f;
#pragma unroll
                for (int bj = 0; bj < 2; ++bj)
#pragma unroll
                    for (int n = 0; n < 2; ++n) { const f32x4 v = *(const f32x4*)(bp + bj * 128 + 4 * n) + gv[bj][n] * acc[ai][bj][m][n]; acc[ai][bj][m][n] = v;
                        if (MODE == 1) *(f32x4*)(out + ro + bj * 128 + 4 * n) = v;
                        ss += (v.x * v.x + v.y * v.y) + (v.z * v.z + v.w * v.w); }
                st.put(ss, ai * 128 + wr * 64 + m * 16 + fr, wc, fq, lds);
                asm volatile("" : "+v"(acc[ai][0][m][0]), "+v"(acc[ai][0][m][1]), "+v"(acc[ai][1][m][0]), "+v"(acc[ai][1][m][1]));
                asm volatile("" ::: "memory"); }
        st.finish(u, lds, wid, lane);
        const LAS float* S = (const LAS float*)(lds + 4096);
#pragma unroll
        for (int bj = 0; bj < 2; ++bj) { const int c = colt + bj * 128;
            f32x4 w0 = *(const f32x4*)(gn + c), w1 = *(const f32x4*)(gn + c + 4), s0 = (f32x4){0.f, 0.f, 0.f, 0.f}, s1 = s0;
            if (MODE == 1) { w0 = w0 * (1.f + *(const f32x4*)(mrow + 4096 + c)); w1 = w1 * (1.f + *(const f32x4*)(mrow + 4096 + c + 4)); s0 = *(const f32x4*)(mrow + 3072 + c); s1 = *(const f32x4*)(mrow + 3072 + c + 4); }
#pragma unroll
            for (int ai = 0; ai < 2; ++ai)
#pragma unroll
                for (int m = 0; m < 4; ++m) { const int r = ai * 128 + wr * 64 + m * 16 + fr; const float rstd = S[r]; const size_t ro = (size_t)(u.pm * 256 + r) * DM + c;
                    const f32x4 o0 = acc[ai][bj][m][0] * rstd * w0 + s0, o1 = acc[ai][bj][m][1] * rstd * w1 + s1;
                    if (MODE == 1) *(u32x4*)(xn + ro) = pack8(o0, o1); else { *(f32x4*)(out + ro) = o0; *(f32x4*)(out + ro + 4) = o1; } } }
    }
};

__device__ __forceinline__ void transpose_item(const float* W, int ldw, int k0, int n0, bf16* WT, int K, int drow0, LAS bf16* scr, int lane) {
    const int lr = lane >> 4, lc = lane & 15;
    f32x4 v[16];
#pragma unroll
    for (int i = 0; i < 16; ++i) v[i] = *(const f32x4*)(W + (size_t)(k0 + lr + 4 * i) * ldw + n0 + 4 * lc);
#pragma unroll
    for (int i = 0; i < 16; ++i) { u32x2 p; p.x = pk2(v[i].x, v[i].y); p.y = pk2(v[i].z, v[i].w); *(LAS u32x2*)(scr + (lr + 4 * i) * 68 + 4 * lc) = p; }
    LDS_WAIT();
    const int kc = lane & 7;
#pragma unroll
    for (int j = 0; j < 8; ++j) { const int n = (lane >> 3) + 8 * j; const LAS bf16* sp = scr + (8 * kc) * 68 + n;
        u32x4 o; o.x = (unsigned)sp[0] | ((unsigned)sp[68] << 16); o.y = (unsigned)sp[2 * 68] | ((unsigned)sp[3 * 68] << 16);
        o.z = (unsigned)sp[4 * 68] | ((unsigned)sp[5 * 68] << 16); o.w = (unsigned)sp[6 * 68] | ((unsigned)sp[7 * 68] << 16);
        *(u32x4*)(WT + (size_t)(drow0 + n) * K + k0 + 8 * kc) = o; }
    LDS_WAIT();
}
__device__ __forceinline__ void transpose_dispatch(const Ctx& cx, int it, LAS bf16* scr, int lane) {
    if (it < 384) { const int kb = it / 24, nb = it % 24; transpose_item(cx.I(11), NPROJ, 64 * kb, 64 * nb, cx.WIN(), DM, 64 * nb, scr, lane); return; } it -= 384;
    if (it < 128) { const int kb = it / 16, nb = it % 16, n0 = 64 * nb; const int dr = 256 * ((n0 & 511) >> 7) + 128 * (n0 >> 9) + (n0 & 127);
        transpose_item(cx.I(27), 1024, 64 * kb, n0, cx.WGLU(), 512, dr, scr, lane); return; } it -= 128;
    if (it < 256) { const int kb = it / 16, nb = it % 16; transpose_item(cx.I(30), DM, 64 * kb, 64 * nb, cx.WOUT(), DM, 64 * nb, scr, lane); return; } it -= 256;
    if (it < 704) { const int kb = it / 44, nb = it % 44, n0 = 64 * nb; transpose_item(cx.I(32), DFF, 64 * kb, n0, cx.WGU(), DM, 256 * (n0 >> 7) + (n0 & 127), scr, lane); return; } it -= 704;
    if (it < 704) { const int kb = it / 44, nb = it % 44, n0 = 64 * nb; transpose_item(cx.I(33), DFF, 64 * kb, n0, cx.WGU(), DM, 256 * (n0 >> 7) + 128 + (n0 & 127), scr, lane); return; } it -= 704;
    { const int kb = it / 16, nb = it % 16; transpose_item(cx.I(34), DM, 64 * kb, 64 * nb, cx.WDN(), DFF, 64 * nb, scr, lane); }
}
constexpr int N_TR_ITEMS = 384 + 128 + 256 + 704 + 704 + 704;

__device__ __forceinline__ void ada_block(const Ctx& cx, int item, LAS unsigned char* lds) {
    const int tid = threadIdx.x, w = __builtin_amdgcn_readfirstlane(tid >> 6), lane = tid & 63, fr = lane & 15, fq = lane >> 4, n0 = 32 * item;
    const float* W = cx.I(8); const float* cp = cx.I(6); const float* cs = cx.I(7);
    bf16x8 wf[4][2];
#pragma unroll
    for (int ks = 0; ks < 4; ++ks)
#pragma unroll
        for (int nt = 0; nt < 2; ++nt) { const float* src = W + (size_t)(128 * w + 32 * ks + 8 * fq) * NMOD + n0 + 16 * nt + fr;
            u32x4 o; o.x = pk2(src[0], src[NMOD]); o.y = pk2(src[2 * NMOD], src[3 * NMOD]); o.z = pk2(src[4 * NMOD], src[5 * NMOD]); o.w = pk2(src[6 * NMOD], src[7 * NMOD]); wf[ks][nt] = __builtin_bit_cast(bf16x8, o); }
    f32x4 acc[9][2];
#pragma unroll
    for (int i = 0; i < 9; ++i) { acc[i][0] = (f32x4){0.f, 0.f, 0.f, 0.f}; acc[i][1] = (f32x4){0.f, 0.f, 0.f, 0.f}; }
#pragma unroll
    for (int mt = 0; mt < 9; ++mt) { int row = 16 * mt + fr; row = row < NBT ? row : NBT - 1;
        const float* src = (row < NBP ? cp + (size_t)row * DM : cs + (size_t)(row - NBP) * DM) + 128 * w + 8 * fq;
#pragma unroll
        for (int ks = 0; ks < 4; ++ks) { f32x4 a0 = *(const f32x4*)(src + 32 * ks), a1 = *(const f32x4*)(src + 32 * ks + 4);
#pragma unroll
            for (int i = 0; i < 4; ++i) { a0[i] = a0[i] * sigm(a0[i]); a1[i] = a1[i] * sigm(a1[i]); }
            const bf16x8 af = __builtin_bit_cast(bf16x8, pack8(a0, a1));
            acc[mt][0] = __builtin_amdgcn_mfma_f32_16x16x32_bf16(wf[ks][0], af, acc[mt][0], 0, 0, 0);
            acc[mt][1] = __builtin_amdgcn_mfma_f32_16x16x32_bf16(wf[ks][1], af, acc[mt][1], 0, 0, 0); } }
    LAS f32x4* red = (LAS f32x4*)lds;
#pragma unroll
    for (int st = 4; st >= 1; st >>= 1) {
        if (w >= st && w < 2 * st) {
#pragma unroll
            for (int i = 0; i < 9; ++i) { red[((w - st) * 18 + 2 * i) * 64 + lane] = acc[i][0]; red[((w - st) * 18 + 2 * i + 1) * 64 + lane] = acc[i][1]; } }
        __syncthreads();
        if (w < st) {
#pragma unroll
            for (int i = 0; i < 9; ++i) { acc[i][0] += red[(w * 18 + 2 * i) * 64 + lane]; acc[i][1] += red[(w * 18 + 2 * i + 1) * 64 + lane]; } }
        __syncthreads();
    }
    if (w == 0) {
#pragma unroll
        for (int nt = 0; nt < 2; ++nt) { const f32x4 b4 = *(const f32x4*)(cx.I(9) + n0 + 16 * nt + 4 * fq);
#pragma unroll
            for (int mt = 0; mt < 9; ++mt) { const int row = 16 * mt + fr; if (row < NBT) *(f32x4*)(cx.MOD() + (size_t)row * NMOD + n0 + 16 * nt + 4 * fq) = acc[mt][nt] + b4; } } }
}

__device__ __forceinline__ void s5_tables(const Ctx& cx, int g, LAS unsigned char* lds) {
    LAS f32x2* Ap = (LAS f32x2*)lds;
    LAS f32x2* Bb = Ap + 17 * 64;
    LAS f32x2* Cc = Bb + 1024;
    LAS f32x2* Ff = Cc + 1024;
    LAS float* Kt = (LAS float*)(Ff + 64);
    const int tid = threadIdx.x;
    float* tab = cx.TAB();
    if (tid < 64) {
        const int n = tid; const float lr = cx.I(19)[g * 64 + n], li = cx.I(20)[g * 64 + n], dt = expf(cx.I(21)[g]);
        const float mag = expf(lr * dt);
        const double ang = (double)li * (double)dt; const double kq = rint(ang * 0.63661977236758134308); const double r = ang - kq * 1.57079632679489661923; const double r2 = r * r;
        const double sn = r * (1.0 + r2 * (-1.0 / 6 + r2 * (1.0 / 120 + r2 * (-1.0 / 5040 + r2 * (1.0 / 362880 + r2 * (-1.0 / 39916800 + r2 * (1.0 / 6227020800.0)))))));
        const double cn = 1.0 + r2 * (-0.5 + r2 * (1.0 / 24 + r2 * (-1.0 / 720 + r2 * (1.0 / 40320 + r2 * (-1.0 / 3628800 + r2 * (1.0 / 479001600.0))))));
        const int q = ((int)kq) & 3; const double cv = q == 0 ? cn : q == 1 ? -sn : q == 2 ? -cn : sn, sv = q == 0 ? sn : q == 1 ? cn : q == 2 ? -sn : -cn;
        const float abr = mag * (float)cv, abi = mag * (float)sv; const float den = lr * lr + li * li;
        const float frr = ((abr - 1.f) * lr + abi * li) / den, fii = (abi * lr - (abr - 1.f) * li) / den;
        f32x2 p = (f32x2){1.f, 0.f}; Ap[n] = p;
#pragma unroll 1
        for (int t = 1; t <= 16; ++t) { const float pr = p.x * abr - p.y * abi, pi = p.x * abi + p.y * abr; p = (f32x2){pr, pi}; Ap[t * 64 + n] = p; }
        Ff[n] = (f32x2){frr, fii};
        ((f32x2*)(tab + T_ABAR))[g * 64 + n] = (f32x2){abr, abi}; ((f32x2*)(tab + T_A16))[g * 64 + n] = p;
    }
    __syncthreads();
    for (int e = tid; e < 1024; e += 512) { const int n = e >> 4; const float br = cx.I(22)[g * 1024 + e], bi = cx.I(23)[g * 1024 + e]; const f32x2 f = Ff[n];
        const float bbr = f.x * br - f.y * bi, bbi = f.x * bi + f.y * br; Bb[e] = (f32x2){bbr, bbi}; tab[T_BBR + g * 1024 + e] = bbr; tab[T_BBI + g * 1024 + e] = bbi;
        Cc[e] = (f32x2){cx.I(24)[g * 1024 + e], cx.I(25)[g * 1024 + e]}; }
    __syncthreads();
    for (int e = tid; e < 4096; e += 512) { const int tau = e >> 8, c = (e >> 4) & 15, cp = e & 15; float sum = 0.f;
        for (int n = 0; n < 64; ++n) { const f32x2 a = Ap[tau * 64 + n], b = Bb[n * 16 + cp], cc = Cc[c * 64 + n];
            const float pr = a.x * b.x - a.y * b.y, pi = a.x * b.y + a.y * b.x; sum += cc.x * pr - cc.y * pi; }
        Kt[e] = sum; }
    __syncthreads();
    bf16* TFg = cx.TF() + (size_t)g * 256 * 384;
    for (int pc = tid; pc < 256 * 48; pc += 512) { const int row = pc / 48, k8 = (pc % 48) * 8, j = row >> 4, c = row & 15; float v[8];
#pragma unroll
        for (int q = 0; q < 8; ++q) { const int kk = k8 + q;
            if (kk < 256) { const int s = kk >> 4, cp = kk & 15; v[q] = (j >= s) ? Kt[((j - s) << 8) + (c << 4) + cp] : 0.f; }
            else { const int n = (kk - 256) & 63; const f32x2 p = Ap[(j + 1) * 64 + n], cc = Cc[c * 64 + n]; v[q] = (kk < 320) ? (cc.x * p.x - cc.y * p.y) : (-cc.x * p.y - cc.y * p.x); } }
        u32x4 o; o.x = pk2(v[0], v[1]); o.y = pk2(v[2], v[3]); o.z = pk2(v[4], v[5]); o.w = pk2(v[6], v[7]);
        *(u32x4*)(TFg + (size_t)row * 384 + k8) = o; }
    bf16* Eg = cx.EM() + (size_t)g * 128 * 256;
    for (int pc = tid; pc < 128 * 32; pc += 512) { const int np = pc >> 5, k8 = (pc & 31) * 8, n = np & 63, im = np >> 6; float v[8];
#pragma unroll
        for (int q = 0; q < 8; ++q) { const int kk = k8 + q, s = kk >> 4, cp = kk & 15; const f32x2 a = Ap[(15 - s) * 64 + n], b = Bb[n * 16 + cp];
            v[q] = im ? (a.x * b.y + a.y * b.x) : (a.x * b.x - a.y * b.y); }
        u32x4 o; o.x = pk2(v[0], v[1]); o.y = pk2(v[2], v[3]); o.z = pk2(v[4], v[5]); o.w = pk2(v[6], v[7]);
        *(u32x4*)(Eg + (size_t)np * 256 + k8) = o; }
    __syncthreads();
}

__device__ __forceinline__ void norm_mod_row(const float* xrow, const float* g, const float* sc, const float* sh, bf16* orow, int lane) {
    f32x4 v[4]; float ss = 0.f;
#pragma unroll
    for (int j = 0; j < 4; ++j) { v[j] = ((const f32x4*)xrow)[lane + 64 * j]; ss += (v[j].x * v[j].x + v[j].y * v[j].y) + (v[j].z * v[j].z + v[j].w * v[j].w); }
    const float rstd = rsqrtf(wave_sum(ss) * (1.f / DM) + EPS);
#pragma unroll
    for (int j = 0; j < 4; ++j) { const int col = 4 * (lane + 64 * j); const f32x4 gg = *(const f32x4*)(g + col), s1 = *(const f32x4*)(sc + col), s2 = *(const f32x4*)(sh + col);
        const f32x4 o = v[j] * rstd * gg * (1.f + s1) + s2; u32x2 w; w.x = pk2(o.x, o.y); w.y = pk2(o.z, o.w); *(u32x2*)(orow + col) = w; }
}

__device__ __forceinline__ void lru_local_unit(const Ctx& cx, int row0, int ntok, bool samp, int aggidx, LAS unsigned char* lds) {
    const int d = threadIdx.x, w = __builtin_amdgcn_readfirstlane(d >> 6), lane = d & 63, fr = lane & 15, fq = lane >> 4;
    LAS float* cf = (LAS float*)(lds + w * 8192);
    LAS bf16* cbf = (LAS bf16*)(lds + w * 8192 + 4608);
    bf16x8 wf[8][2];
#pragma unroll
    for (int nt = 0; nt < 8; ++nt)
#pragma unroll
        for (int ks = 0; ks < 2; ++ks) { const float* src = (nt < 4 ? cx.I(14) : cx.I(16)) + (size_t)w * 4096 + (32 * ks + 8 * fq) * 64 + 16 * (nt & 3) + fr;
            u32x4 o; o.x = pk2(src[0], src[64]); o.y = pk2(src[128], src[192]); o.z = pk2(src[256], src[320]); o.w = pk2(src[384], src[448]); wf[nt][ks] = __builtin_bit_cast(bf16x8, o); }
    const float cw0 = cx.I(12)[d], cw1 = cx.I(12)[512 + d], cw2 = cx.I(12)[1024 + d], cw3 = cx.I(12)[1536 + d], cb = cx.I(13)[d];
    float gba[4], gbx[4], gcd[4], hc[4], cc[4];
#pragma unroll
    for (int nt = 0; nt < 4; ++nt) { const int ch = 64 * w + 16 * nt + fr; gba[nt] = cx.I(15)[ch]; gbx[nt] = cx.I(17)[ch]; gcd[nt] = -8.f * 1.44269504089f * log1pf(expf(-cx.I(18)[ch])); hc[nt] = 0.f; cc[nt] = 1.f; }
    const float* X = cx.LRUX(); float* HL = cx.HLOC(); float* CU = cx.CUM();
    float xm3 = 0.f, xm2 = 0.f, xm1 = 0.f;
    if (!samp) { const int t0 = row0 & (SEQ - 1); if (t0 >= 3) { xm3 = X[(size_t)(row0 - 3) * DL + d]; xm2 = X[(size_t)(row0 - 2) * DL + d]; xm1 = X[(size_t)(row0 - 1) * DL + d]; } }
    float xv[16];
#pragma unroll
    for (int i = 0; i < 16; ++i) xv[i] = X[(size_t)(row0 + i) * DL + d];
    for (int t0 = 0; t0 < ntok; t0 += 16) {
        if (samp) {
#pragma unroll
            for (int i = 0; i < 16; ++i) { const int row = row0 + t0 + i; const float* sc = cx.I(2) + (size_t)(row - MPR) * 1536 + d;
                const float cv = cb + cw0 * sc[0] + cw1 * sc[512] + cw2 * sc[1024] + cw3 * xv[i];
                cf[i * 68 + lane] = cv; cbf[i * 72 + lane] = (bf16)(pk2(cv, cv) & 0xffffu); }
        } else {
#pragma unroll
            for (int i = 0; i < 16; ++i) { const float x = xv[i]; const float cv = cb + cw0 * xm3 + cw1 * xm2 + cw2 * xm1 + cw3 * x; xm3 = xm2; xm2 = xm1; xm1 = x;
                cf[i * 68 + lane] = cv; cbf[i * 72 + lane] = (bf16)(pk2(cv, cv) & 0xffffu); }
        }
        if (t0 + 16 < ntok) {
#pragma unroll
            for (int i = 0; i < 16; ++i) xv[i] = X[(size_t)(row0 + t0 + 16 + i) * DL + d]; }
        LDS_WAIT();
        f32x4 acc[8];
#pragma unroll
        for (int nt = 0; nt < 8; ++nt) acc[nt] = (f32x4){0.f, 0.f, 0.f, 0.f};
#pragma unroll
        for (int ks = 0; ks < 2; ++ks) { const bf16x8 af = *(const LAS bf16x8*)(cbf + fr * 72 + 32 * ks + 8 * fq);
#pragma unroll
            for (int nt = 0; nt < 8; ++nt) acc[nt] = __builtin_amdgcn_mfma_f32_16x16x32_bf16(af, wf[nt][ks], acc[nt], 0, 0, 0); }
#pragma unroll
        for (int nt = 0; nt < 4; ++nt) { const int ch = 64 * w + 16 * nt + fr;
            float av[4], hv[4]; float P = 1.f, H = 0.f;
#pragma unroll
            for (int r = 0; r < 4; ++r) { const int tok = 4 * fq + r; const float cvv = cf[tok * 68 + 16 * nt + fr];
                const float rr = sigm(acc[nt][r] + gba[nt]), ig = sigm(acc[nt + 4][r] + gbx[nt]);
                const float a = __builtin_amdgcn_exp2f(gcd[nt] * rr);
                const float bb = __builtin_amdgcn_sqrtf(fmaf(-a, a, 1.f)) * ig * cvv;
                if (samp) { const float h0 = cx.I(3)[(size_t)(row0 + t0 + tok - MPR) * DL + ch]; hv[r] = a * h0 + bb; av[r] = 0.f; }
                else { H = a * H + bb; P = P * a; hv[r] = H; av[r] = P; } }
            if (!samp) {
                float Pp = __shfl_up(P, 16), Hp = __shfl_up(H, 16); if (fq >= 1) { H = P * Hp + H; P = P * Pp; }
                Pp = __shfl_up(P, 32); Hp = __shfl_up(H, 32); if (fq >= 2) { H = P * Hp + H; P = P * Pp; }
                float Pe = __shfl_up(P, 16), He = __shfl_up(H, 16); if (fq == 0) { Pe = 1.f; He = 0.f; }
                const float hstart = He + Pe * hc[nt], cstart = Pe * cc[nt];
#pragma unroll
                for (int r = 0; r < 4; ++r) { hv[r] = hv[r] + av[r] * hstart; av[r] = av[r] * cstart; }
                const float Pl = __shfl(P, 48 + fr), Hl = __shfl(H, 48 + fr); hc[nt] = Hl + Pl * hc[nt]; cc[nt] = Pl * cc[nt];
            }
#pragma unroll
            for (int r = 0; r < 4; ++r) { const size_t o = (size_t)(row0 + t0 + 4 * fq + r) * DL + ch; HL[o] = hv[r]; CU[o] = av[r]; }
            __builtin_amdgcn_sched_barrier(0);
        }
        LDS_WAIT();
    }
    if (!samp && fq == 0) {
#pragma unroll
        for (int nt = 0; nt < 4; ++nt) cx.AGG()[(size_t)aggidx * DL + 64 * w + 16 * nt + fr] = (f32x2){cc[nt], hc[nt]}; }
}

__device__ __forceinline__ void s5_gemm_e_item(const Ctx& cx, int item, int lane) {
    const int g = item >> 6, rb = item & 63, fr = lane & 15, fq = lane >> 4, cr = rb * 16 + fr;
    const bf16* U = cx.S5U() + (size_t)(16 * cr + (fq >> 1)) * 512 + 16 * g + 8 * (fq & 1); const bf16* Eg = cx.EM() + (size_t)g * 128 * 256 + (size_t)fr * 256 + 8 * fq;
    f32x4 acc[8];
#pragma unroll
    for (int n = 0; n < 8; ++n) acc[n] = (f32x4){0.f, 0.f, 0.f, 0.f};
#pragma unroll 4
    for (int ks = 0; ks < 8; ++ks) {
        const bf16x8 af = *(const bf16x8*)(U + (size_t)(2 * ks) * 512);
#pragma unroll
        for (int nt = 0; nt < 8; ++nt) { const bf16x8 wf = *(const bf16x8*)(Eg + (size_t)(16 * nt) * 256 + 32 * ks); acc[nt] = __builtin_amdgcn_mfma_f32_16x16x32_bf16(wf, af, acc[nt], 0, 0, 0); }
    }
    float* S = cx.SK() + ((size_t)cr * 32 + g) * 128 + 4 * fq;
#pragma unroll
    for (int nt = 0; nt < 8; ++nt) *(f32x4*)(S + 16 * nt) = acc[nt];
}

__device__ __forceinline__ void s5_chain_item(const Ctx& cx, int item, int lane) {
    const int idx = item * 64 + lane, b = idx >> 11, g = (idx >> 6) & 31, n = idx & 63;
    const f32x2 A = ((const f32x2*)(cx.TAB() + T_A16))[g * 64 + n];
    const float* S = cx.SK() + ((size_t)(b * SNCH) * 32 + g) * 128 + n; bf16* H = cx.HIN() + ((size_t)g * SROWS + b * SNCH) * 128 + n;
    float hr = 0.f, hi = 0.f; float s0r[8], s0i[8], s1r[8], s1i[8];
#define CH_LOAD(R, I, K0) do { _Pragma("unroll") for (int i = 0; i < 8; ++i) { R[i] = S[(size_t)((K0) + i) * 4096]; I[i] = S[(size_t)((K0) + i) * 4096 + 64]; } } while (0)
#define CH_STEP(R, I, K0) do { _Pragma("unroll") for (int i = 0; i < 8; ++i) { H[(size_t)((K0) + i) * 128] = (bf16)(pk2(hr, hr) & 0xffffu); H[(size_t)((K0) + i) * 128 + 64] = (bf16)(pk2(hi, hi) & 0xffffu); \
        const float nr = A.x * hr - A.y * hi + R[i], ni = A.x * hi + A.y * hr + I[i]; hr = nr; hi = ni; } } while (0)
    CH_LOAD(s0r, s0i, 0);
    for (int k0 = 0; k0 < SNCH; k0 += 16) { CH_LOAD(s1r, s1i, k0 + 8); CH_STEP(s0r, s0i, k0); if (k0 + 16 < SNCH) CH_LOAD(s0r, s0i, k0 + 16); CH_STEP(s1r, s1i, k0 + 8); }
#undef CH_LOAD
#undef CH_STEP
    cx.out[O_S5RP + (size_t)(b * 32 + g) * 64 + n] = hr; cx.out[O_S5IP + (size_t)(b * 32 + g) * 64 + n] = hi;
}

__device__ __forceinline__ void lru_fix_unit(const Ctx& cx, int row0, int ntok, bool samp, int b, int k, LAS unsigned char* lds) {
    const int d = threadIdx.x, w = d >> 6, lane = d & 63;
    LAS float* hs = (LAS float*)lds;
    float hin = 0.f;
    if (!samp) { const f32x2* ag = cx.AGG() + (size_t)(b * NCH) * DL + d; f32x2 pp[NCH - 1];
#pragma unroll
        for (int kk = 0; kk < NCH - 1; ++kk) pp[kk] = (kk < k) ? ag[(size_t)kk * DL] : (f32x2){1.f, 0.f};
#pragma unroll
        for (int kk = 0; kk < NCH - 1; ++kk) hin = pp[kk].x * hin + pp[kk].y; }
    hs[d] = hin;
    const float* X = cx.LRUX();
    if (!samp && k == NCH - 1) {
#pragma unroll
        for (int j = 0; j < 3; ++j) cx.out[O_CONVP + (size_t)(b * 3 + j) * DL + d] = X[(size_t)(row0 + LCH - 3 + j) * DL + d]; }
    if (samp) { for (int t = 0; t < ntok; ++t) { const int sb = row0 + t - MPR; const float* sc = cx.I(2) + (size_t)sb * 1536 + d; float* o = cx.out + O_CONVS + (size_t)sb * 1536 + d;
            o[0] = sc[512]; o[512] = sc[1024]; o[1024] = X[(size_t)(row0 + t) * DL + d]; } }
    __syncthreads();
    const float* HL = cx.HLOC(); const float* CU = cx.CUM(); const bf16* GT = cx.GATE(); bf16* MG = cx.MERGED(); const float* gl = cx.I(28);
    const f32x4 hi0 = *(const LAS f32x4*)(hs + 8 * lane), hi1 = *(const LAS f32x4*)(hs + 8 * lane + 4);
    const f32x4 g0 = *(const f32x4*)(gl + 8 * lane), g1 = *(const f32x4*)(gl + 8 * lane + 4);
#pragma unroll 4
    for (int t = w; t < ntok; t += 8) { const size_t ro = (size_t)(row0 + t) * DL + 8 * lane;
        const f32x4 a0 = *(const f32x4*)(HL + ro), a1 = *(const f32x4*)(HL + ro + 4), c0 = *(const f32x4*)(CU + ro), c1 = *(const f32x4*)(CU + ro + 4);
        const u32x4 gw = *(const u32x4*)(GT + ro);
        const f32x4 h0 = a0 + c0 * hi0, h1 = a1 + c1 * hi1;
        f32x4 l0, l1;
        l0[0] = h0[0] * gelu_tanh(bflo(gw.x)); l0[1] = h0[1] * gelu_tanh(bfhi(gw.x)); l0[2] = h0[2] * gelu_tanh(bflo(gw.y)); l0[3] = h0[3] * gelu_tanh(bfhi(gw.y));
        l1[0] = h1[0] * gelu_tanh(bflo(gw.z)); l1[1] = h1[1] * gelu_tanh(bfhi(gw.z)); l1[2] = h1[2] * gelu_tanh(bflo(gw.w)); l1[3] = h1[3] * gelu_tanh(bfhi(gw.w));
        float ss = (l0[0] * l0[0] + l0[1] * l0[1]) + (l0[2] * l0[2] + l0[3] * l0[3]) + (l1[0] * l1[0] + l1[1] * l1[1]) + (l1[2] * l1[2] + l1[3] * l1[3]);
        const float rstd = rsqrtf(wave_sum(ss) * (1.f / DL) + EPS);
        *(u32x4*)(MG + (size_t)(row0 + t) * DM + 8 * lane) = pack8(l0 * rstd * g0, l1 * rstd * g1);
        if (samp) { float* o = cx.out + O_LRUS + (size_t)(row0 + t - MPR) * DL + 8 * lane; *(f32x4*)o = h0; *(f32x4*)(o + 4) = h1; }
        else if (k == NCH - 1 && t == LCH - 1) { float* o = cx.out + O_LRUP + (size_t)b * DL + 8 * lane; *(f32x4*)o = h0; *(f32x4*)(o + 4) = h1; }
    }
    __syncthreads();
}

__device__ __forceinline__ void s5_gemm_tf_item(const Ctx& cx, int item, int lane) {
    const int half = item & 1, g = item >> 6, rb = (item >> 1) & 31, fr = lane & 15, fq = lane >> 4;
    const bf16* U = cx.S5U(); const bf16* TFg = cx.TF() + ((size_t)g * 256 + 128 * half) * 384; const bf16* Hg = cx.HIN() + (size_t)g * SROWS * 128;
    f32x4 acc[2][8];
#pragma unroll
    for (int a = 0; a < 2; ++a)
#pragma unroll
        for (int n = 0; n < 8; ++n) acc[a][n] = (f32x4){0.f, 0.f, 0.f, 0.f};
#pragma unroll 2
    for (int ks = 0; ks < 12; ++ks) {
        bf16x8 af[2];
#pragma unroll
        for (int mt = 0; mt < 2; ++mt) { const int cr = rb * 32 + 16 * mt + fr;
            af[mt] = (ks < 8) ? *(const bf16x8*)(U + ((size_t)(16 * cr + 2 * ks + (fq >> 1)) * 512 + 16 * g + 8 * (fq & 1))) : *(const bf16x8*)(Hg + (size_t)cr * 128 + 32 * (ks - 8) + 8 * fq); }
#pragma unroll
        for (int nt = 0; nt < 8; ++nt) { const bf16x8 wf = *(const bf16x8*)(TFg + (size_t)(16 * nt + fr) * 384 + 32 * ks + 8 * fq);
#pragma unroll
            for (int mt = 0; mt < 2; ++mt) acc[mt][nt] = __builtin_amdgcn_mfma_f32_16x16x32_bf16(wf, af[mt], acc[mt][nt], 0, 0, 0); }
    }
    const f32x4 d4 = *(const f32x4*)(cx.I(26) + 16 * g + 4 * fq); bf16* GY = cx.GY();
#pragma unroll
    for (int mt = 0; mt < 2; ++mt) { const int cr = rb * 32 + 16 * mt + fr;
#pragma unroll
        for (int nt = 0; nt < 8; ++nt) { const size_t off = (size_t)(16 * cr + 8 * half + nt) * 512 + 16 * g + 4 * fq; const u32x2 uw = *(const u32x2*)(U + off);
            const f32x4 y = acc[mt][nt] + d4 * (f32x4){bflo(uw.x), bfhi(uw.x), bflo(uw.y), bfhi(uw.y)};
            u32x2 o; o.x = pk2(gelu_tanh(y[0]), gelu_tanh(y[1])); o.y = pk2(gelu_tanh(y[2]), gelu_tanh(y[3])); *(u32x2*)(GY + off) = o; } }
}
__device__ __forceinline__ void s5_sample_item(const Ctx& cx, int item, int lane) {
    const int sb = item >> 5, g = item & 31, n = lane; const int row = MPR + sb;
    const float* tab = cx.TAB(); const f32x2 A = ((const f32x2*)(tab + T_ABAR))[g * 64 + n];
    const float h0r = cx.I(4)[((size_t)sb * 32 + g) * 64 + n], h0i = cx.I(5)[((size_t)sb * 32 + g) * 64 + n];
    const bf16* up = cx.S5U() + (size_t)row * 512 + 16 * g; const u32x4 u0 = *(const u32x4*)up, u1 = *(const u32x4*)(up + 8);
    float uu[16]; uu[0] = bflo(u0.x); uu[1] = bfhi(u0.x); uu[2] = bflo(u0.y); uu[3] = bfhi(u0.y); uu[4] = bflo(u0.z); uu[5] = bfhi(u0.z); uu[6] = bflo(u0.w); uu[7] = bfhi(u0.w);
    uu[8] = bflo(u1.x); uu[9] = bfhi(u1.x); uu[10] = bflo(u1.y); uu[11] = bfhi(u1.y); uu[12] = bflo(u1.z); uu[13] = bfhi(u1.z); uu[14] = bflo(u1.w); uu[15] = bfhi(u1.w);
    float bur = 0.f, bui = 0.f; const float* br = tab + T_BBR + (size_t)(g * 64 + n) * 16; const float* bi = tab + T_BBI + (size_t)(g * 64 + n) * 16;
#pragma unroll
    for (int c4 = 0; c4 < 4; ++c4) { const f32x4 r4 = *(const f32x4*)(br + 4 * c4), i4 = *(const f32x4*)(bi + 4 * c4);
#pragma unroll
        for (int i = 0; i < 4; ++i) { bur += r4[i] * uu[4 * c4 + i]; bui += i4[i] * uu[4 * c4 + i]; } }
    const float hr = A.x * h0r - A.y * h0i + bur, hi = A.x * h0i + A.y * h0r + bui;
    cx.out[O_S5RS + ((size_t)sb * 32 + g) * 64 + n] = hr; cx.out[O_S5IS + ((size_t)sb * 32 + g) * 64 + n] = hi;
    float my = 0.f, myu = 0.f;
#pragma unroll
    for (int c = 0; c < 16; ++c) { const float v = wave_sum(cx.I(24)[((size_t)g * 16 + c) * 64 + n] * hr - cx.I(25)[((size_t)g * 16 + c) * 64 + n] * hi); if (lane == c) { my = v; myu = uu[c]; } }
    if (lane < 16) { const float y = my + cx.I(26)[16 * g + lane] * myu; cx.GY()[(size_t)row * 512 + 16 * g + lane] = (bf16)(pk2(gelu_tanh(y), 0.f) & 0xffffu); }
}

#define XB_TMO      128
#define XB_XCNT(j)  (256  + 64 * (j))
#define XB_XSUB(j)  (1280 + 64 * (j))
#define XB_XGEN(j)  (2304 + 64 * (j))
#define XB_TOP      3328
#define XB_TOPGEN   3392
#define XCD_BAR_WORDS 3456
#define XB_SPIN_CAP (1u << 18)

__device__ __forceinline__ unsigned xb_ld(unsigned* p)              { return __hip_atomic_load(p, __ATOMIC_RELAXED, __HIP_MEMORY_SCOPE_AGENT); }
__device__ __forceinline__ unsigned xb_add(unsigned* p, unsigned v) { return __hip_atomic_fetch_add(p, v, __ATOMIC_RELAXED, __HIP_MEMORY_SCOPE_AGENT); }
__device__ __forceinline__ unsigned xb_xcc_id() { return (unsigned)__builtin_amdgcn_s_getreg((3 << 11) | 20) & 0xFu; }
#define XB_SPIN(cond, bar) do { unsigned _sp = 0; while (cond) { __builtin_amdgcn_s_sleep(1); \
    if ((++_sp & 255u) == 0u) { if (xb_ld(&(bar)[XB_TMO])) break; if (_sp > XB_SPIN_CAP) { atomicAdd(&(bar)[XB_TMO], 1u); break; } } } } while (0)

struct XcdBarrier {
    unsigned* bar; unsigned x;
    volatile LAS unsigned* st;
};

__device__ __forceinline__ XcdBarrier xcd_barrier_post(unsigned* bar, volatile LAS unsigned* st) {
    XcdBarrier b; b.bar = bar; b.x = xb_xcc_id(); b.st = st;
    if (threadIdx.x == 0) (void)xb_add(&bar[XB_XCNT(b.x)], 1u);
    return b;
}
__device__ __forceinline__ void xcd_barrier_complete(unsigned* bar, unsigned x, unsigned& nloc, unsigned& nx) {
    const unsigned G = gridDim.x * gridDim.y * gridDim.z;
    unsigned sum, cnt, mine, sp = 0u;
    for (;;) {
        sum = 0u; cnt = 0u; mine = 0u;
#pragma unroll
        for (unsigned j = 0; j < 16; ++j) { const unsigned c = xb_ld(&bar[XB_XCNT(j)]); sum += c; cnt += (c > 0u) ? 1u : 0u; mine = (j == x) ? c : mine; }
        if (sum == G) break;
        __builtin_amdgcn_s_sleep(1);
        if ((++sp & 255u) == 0u) { if (xb_ld(&bar[XB_TMO])) break; if (sp > XB_SPIN_CAP) { atomicAdd(&bar[XB_TMO], 1u); break; } }
    }
    nloc = mine > 0u ? mine : 1u; nx = cnt > 0u ? cnt : 1u;
}

__device__ __forceinline__ void xcd_barrier(const XcdBarrier& b) {
    asm volatile("s_waitcnt vmcnt(0)" ::: "memory");
    __syncthreads();
    if (threadIdx.x == 0) {
        unsigned* bar = b.bar;
        __builtin_amdgcn_s_waitcnt(0);
        unsigned nloc = b.st[0], nx = b.st[1];
        if (nloc == 0u) { xcd_barrier_complete(bar, b.x, nloc, nx); b.st[0] = nloc; b.st[1] = nx; }
        const unsigned old = xb_add(&bar[XB_XSUB(b.x)], 1u);
        const unsigned gen = old / nloc;
        if (old + 1u == (gen + 1u) * nloc) {
            __builtin_amdgcn_fence(__ATOMIC_RELEASE, "agent");
            asm volatile("s_waitcnt vmcnt(0)" ::: "memory");
            const unsigned og = xb_add(&bar[XB_TOP], 1u);
            const unsigned tg = og / nx;
            if (og + 1u == (tg + 1u) * nx) xb_add(&bar[XB_TOPGEN], 1u);
            else XB_SPIN(xb_ld(&bar[XB_TOPGEN]) == tg, bar);
            __builtin_amdgcn_fence(__ATOMIC_ACQUIRE, "agent");
            xb_add(&bar[XB_XGEN(b.x)], 1u);
            asm volatile("s_waitcnt vmcnt(0)" ::: "memory");
        } else {
            XB_SPIN(xb_ld(&bar[XB_XGEN(b.x)]) == gen, bar);
            __builtin_amdgcn_fence(__ATOMIC_ACQUIRE, "agent");
            asm volatile("s_waitcnt vmcnt(0)" ::: "memory");
        }
    }
    __syncthreads();
}

__global__ void __launch_bounds__(512, 2) fwd_kernel(KArgs a) {
    extern __shared__ __attribute__((aligned(16))) unsigned char lds_raw[];
    LAS unsigned char* lds = (LAS unsigned char*)lds_raw;
    Ctx cx; cx.in = a.in; cx.out = a.out; cx.ws = a.ws;
    const int tid = threadIdx.x, lane = tid & 63, wave = __builtin_amdgcn_readfirstlane(tid >> 6);
    const int G = gridDim.x, bid = blockIdx.x, gw = bid * 8 + wave, NGW = G * 8;
    volatile LAS unsigned* bst = (volatile LAS unsigned*)(lds + 131072);
    if (tid < 16) bst[tid] = 0u;
    __syncthreads();
    XcdBarrier xbar = xcd_barrier_post((unsigned*)a.ws, bst);
#ifndef REPMASK
#define REPMASK 0
#endif
#ifndef PHMASK
#define PHMASK 0x1fff
#endif
#define IN(k) (((PHMASK >> (k)) & 1) && a.lo <= (k) && (k) < a.hi)
#define SEAM(k) do { if (IN(k) && IN((k) + 1)) xcd_barrier(xbar); } while (0)

    if (IN(0)) for (int rep_ = 0; rep_ < 1 + ((REPMASK >> 0) & 1); ++rep_) {
        if (bid < 32 || G < 64) { for (int g = bid; g < 32; g += G) s5_tables(cx, g, lds); }
        const int nb2 = G >= 64 ? G - 32 : G, b2 = G >= 64 ? bid - 32 : bid;
        if (b2 >= 0) {
            for (int it = b2; it < 192; it += nb2) ada_block(cx, it, lds);
            LAS bf16* scr = (LAS bf16*)(lds + wave * 16384);
            for (int it = (nb2 - 1 - b2) * 8 + wave; it < N_TR_ITEMS; it += nb2 * 8) transpose_dispatch(cx, it, scr, lane);
        }
    }
    SEAM(0);
    if (IN(1)) for (int rep_ = 0; rep_ < 1 + ((REPMASK >> 1) & 1); ++rep_) {
        for (int r = gw; r < MTOK; r += NGW) { const float* xr = r < MPR ? cx.I(0) + (size_t)r * DM : cx.I(1) + (size_t)(r - MPR) * DM; const float* md = cx.MOD() + (size_t)mod_row(r) * NMOD;
            norm_mod_row(xr, cx.I(10), md + 1024, md, cx.XN() + (size_t)r * DM, lane); }
    }
    SEAM(1);
    if (IN(2)) for (int rep_ = 0; rep_ < 1 + ((REPMASK >> 2) & 1); ++rep_) {
        pg8::Gemm g{cx.XN(), cx.WIN(), MPAD, NPROJ, DM}; Sched2 S; S.init(NPROJ, DM, G, bid, DM / 64);
        EpiProj E{cx.LRUX(), cx.GATE(), cx.S5U()};
        pg8::gemm_phase<EpiProj, Sched2, true, true>(lds, g, S, E);
    }
    SEAM(2);
    if (IN(3)) for (int rep_ = 0; rep_ < 1 + ((REPMASK >> 3) & 1); ++rep_) {
#ifndef NO_LRU
        for (int q_ = 0; q_ < 1 + ((REPMASK >> 13) & 1); ++q_)
        for (int u = bid; u < 256 + NBS / SCH; u += G) {
            if (u < 256) lru_local_unit(cx, u * LCH, LCH, false, u, lds); else lru_local_unit(cx, MPR + (u - 256) * SCH, SCH, true, 0, lds);
        }
#endif
#ifndef NO_E
        for (int q_ = 0; q_ < 1 + ((REPMASK >> 14) & 1); ++q_)
        for (int it = gw; it < 2048; it += NGW) s5_gemm_e_item(cx, it, lane);
#endif
    }
    SEAM(3);
    if (IN(4)) for (int rep_ = 0; rep_ < 1 + ((REPMASK >> 4) & 1); ++rep_) {
        if (wave == 0) { for (int it = bid; it < 256; it += G) s5_chain_item(cx, it, lane); }
        for (int u = bid; u < 256 + NBS / SCH; u += G) {
            if (u < 256) lru_fix_unit(cx, u * LCH, LCH, false, u >> 5, u & 31, lds); else lru_fix_unit(cx, MPR + (u - 256) * SCH, SCH, true, 0, 0, lds);
        }
    }
    SEAM(4);
    if (IN(5)) for (int rep_ = 0; rep_ < 1 + ((REPMASK >> 5) & 1); ++rep_) {
        for (int it = gw; it < 2048; it += NGW) s5_gemm_tf_item(cx, it, lane);
        for (int it = gw; it < NBS * 32; it += NGW) s5_sample_item(cx, it, lane);
    }
    SEAM(5);
    if (IN(6)) for (int rep_ = 0; rep_ < 1 + ((REPMASK >> 6) & 1); ++rep_) {
        pg8::Gemm g{cx.GY(), cx.WGLU(), MPAD, 1024, 512}; Sched3 S; S.init(1024, 512, G, bid, 2);
        EpiGluNorm E{cx.MERGED(), cx.I(29), cx.PART(), RmsPanel{(float*)(cx.ws + WS_XSLOT), (unsigned*)cx.ws + 4096, 1.f / 512, EPS}};
        pg8::gemm_phase<EpiGluNorm, Sched3, true, true>(lds, g, S, E);
    }
    SEAM(6);
    if (IN(7)) for (int rep_ = 0; rep_ < 1 + ((REPMASK >> 7) & 1); ++rep_) {
        const float* gs = cx.I(29);
        for (int r = MPR + gw; r < MTOK; r += NGW) { const float* sr = cx.S5OUT() + (size_t)r * 512;
            f32x4 v0, v1;
            if (r < MPR) { v0 = ((const f32x4*)sr)[lane]; v1 = ((const f32x4*)sr)[lane + 64]; }
            else { const float* pp = cx.PART() + (size_t)(r - MPR) * 1024; const int c0 = 4 * lane, ca0 = 256 * (c0 >> 7) + (c0 & 127), ca1 = ca0 + 512;
                f32x4 a0 = (f32x4){0.f, 0.f, 0.f, 0.f}, b0 = a0, a1 = a0, b1 = a0;
#pragma unroll
                for (int sl = 0; sl < 4; ++sl) { const float* q = pp + (size_t)sl * 128 * 1024; a0 += *(const f32x4*)(q + ca0); b0 += *(const f32x4*)(q + ca0 + 128); a1 += *(const f32x4*)(q + ca1); b1 += *(const f32x4*)(q + ca1 + 128); }
#pragma unroll
                for (int i = 0; i < 4; ++i) { v0[i] = a0[i] * sigm(b0[i]); v1[i] = a1[i] * sigm(b1[i]); } }
            const float ss = (v0.x * v0.x + v0.y * v0.y) + (v0.z * v0.z + v0.w * v0.w) + (v1.x * v1.x + v1.y * v1.y) + (v1.z * v1.z + v1.w * v1.w);
            const float rstd = rsqrtf(wave_sum(ss) * (1.f / 512) + EPS);
            const f32x4 o0 = v0 * rstd * ((const f32x4*)gs)[lane], o1 = v1 * rstd * ((const f32x4*)gs)[lane + 64];
            bf16* mp = cx.MERGED() + (size_t)r * DM + 512; u32x2 w0, w1; w0.x = pk2(o0.x, o0.y); w0.y = pk2(o0.z, o0.w); w1.x = pk2(o1.x, o1.y); w1.y = pk2(o1.z, o1.w);
            *(u32x2*)(mp + 4 * lane) = w0; *(u32x2*)(mp + 256 + 4 * lane) = w1; }
    }
    SEAM(7);
    if (IN(8)) for (int rep_ = 0; rep_ < 1 + ((REPMASK >> 8) & 1); ++rep_) {
        pg8::Gemm g{cx.MERGED(), cx.WOUT(), MPAD, DM, DM}; Sched3 S; S.init(DM, DM, G, bid, 2);
        EpiResNorm<1> E{cx.I(0), cx.MOD(), cx.I(31), cx.out, cx.XN2(), cx.PART(), RmsPanel{(float*)(cx.ws + WS_XSLOT + 262144), (unsigned*)cx.ws + 8192, 1.f / DM, EPS}};
        pg8::gemm_phase<EpiResNorm<1>, Sched3, true, true>(lds, g, S, E);
    }
    SEAM(8);
    if (IN(9)) for (int rep_ = 0; rep_ < 1 + ((REPMASK >> 9) & 1); ++rep_) {
        for (int r = MPR + gw; r < MTOK; r += NGW) { const float* md = cx.MOD() + (size_t)mod_row(r) * NMOD;
            if (r >= MPR) { const float* pp = cx.PART() + (size_t)(r - MPR) * 1024; const float* xr = cx.I(1) + (size_t)(r - MPR) * DM; float* orow = cx.out + (size_t)r * DM;
#pragma unroll
                for (int j = 0; j < 4; ++j) { const int col = 4 * (lane + 64 * j); f32x4 sm = (f32x4){0.f, 0.f, 0.f, 0.f};
#pragma unroll
                    for (int sl = 0; sl < 8; ++sl) sm += *(const f32x4*)(pp + (size_t)sl * 128 * 1024 + col);
                    *(f32x4*)(orow + col) = *(const f32x4*)(xr + col) + *(const f32x4*)(md + 2048 + col) * sm; } }
            norm_mod_row(cx.out + (size_t)r * DM, cx.I(31), md + 4096, md + 3072, cx.XN2() + (size_t)r * DM, lane); }
    }
    SEAM(9);
    if (IN(10)) for (int rep_ = 0; rep_ < 1 + ((REPMASK >> 10) & 1); ++rep_) {
        pg8::Gemm g{cx.XN2(), cx.WGU(), MPAD, 2 * DFF, DM}; Sched2 S; S.init(2 * DFF, DM, G, bid, DM / 64);
        EpiSwiglu E{cx.HB()};
        pg8::gemm_phase<EpiSwiglu, Sched2, true, true>(lds, g, S, E);
    }
    SEAM(10);
    if (IN(11)) for (int rep_ = 0; rep_ < 1 + ((REPMASK >> 11) & 1); ++rep_) {
        pg8::Gemm g{cx.HB(), cx.WDN(), MPAD, DM, DFF}; Sched3 S; S.init(DM, DFF, G, bid, 2);
        EpiResNorm<2> E{nullptr, cx.MOD(), cx.I(35), cx.out, nullptr, cx.PART(), RmsPanel{(float*)(cx.ws + WS_XSLOT + 524288), (unsigned*)cx.ws + 12288, 1.f / DM, EPS}};
        pg8::gemm_phase<EpiResNorm<2>, Sched3, true, true>(lds, g, S, E);
    }
    SEAM(11);
    if (IN(12)) for (int rep_ = 0; rep_ < 1 + ((REPMASK >> 12) & 1); ++rep_) {
        const float* fg = cx.I(35);
        for (int r = MPR + gw; r < MTOK; r += NGW) { float* xr = cx.out + (size_t)r * DM; f32x4 v[4]; float ss = 0.f;
#pragma unroll
            for (int j = 0; j < 4; ++j) { v[j] = ((const f32x4*)xr)[lane + 64 * j];
                if (r >= MPR) { const int col = 4 * (lane + 64 * j); const float* pp = cx.PART() + (size_t)(r - MPR) * 1024 + col; f32x4 sm = (f32x4){0.f, 0.f, 0.f, 0.f};
#pragma unroll 2
                    for (int sl = 0; sl < 22; ++sl) sm += *(const f32x4*)(pp + (size_t)sl * 128 * 1024);
                    v[j] += *(const f32x4*)(cx.MOD() + (size_t)mod_row(r) * NMOD + 5120 + col) * sm; }
                ss += (v[j].x * v[j].x + v[j].y * v[j].y) + (v[j].z * v[j].z + v[j].w * v[j].w); }
            const float rstd = rsqrtf(wave_sum(ss) * (1.f / DM) + EPS);
#pragma unroll
            for (int j = 0; j < 4; ++j) ((f32x4*)xr)[lane + 64 * j] = v[j] * rstd * ((const f32x4*)fg)[lane + 64 * j]; }
    }
#undef IN
#undef SEAM
}

constexpr int LDS_BYTES = 131072 + 256;
#ifndef MK_SINGLE
#define MK_SINGLE 1
#endif
extern "C" void kernel_launch(void* const* d_in, const int* in_sizes, int n_in, void* d_out, int out_size, void* d_ws, size_t ws_size, hipStream_t stream) {
    static int grid = 0;
    if (grid == 0) {
        if (n_in != 36 || (size_t)out_size != O_END || ws_size < WS_END) { fprintf(stderr, "kernel_launch: unexpected shapes n_in %d out %d ws %zu\n", n_in, out_size, ws_size); grid = -1; return; }
        int dev = 0, cus = 0, per_cu = 0;
        hipGetDevice(&dev); hipDeviceGetAttribute(&cus, hipDeviceAttributeMultiprocessorCount, dev);
        hipFuncSetAttribute((const void*)fwd_kernel, hipFuncAttributeMaxDynamicSharedMemorySize, LDS_BYTES);
        hipOccupancyMaxActiveBlocksPerMultiprocessor(&per_cu, (const void*)fwd_kernel, 512, LDS_BYTES);
        if (per_cu < 1) { fprintf(stderr, "kernel_launch: occupancy query says %d blocks per CU\n", per_cu); grid = -1; return; }
        if (cus != 256) { fprintf(stderr, "kernel_launch: built for 256 CUs (one 256x256 unit per workgroup in the fused-norm GEMM phases), found %d\n", cus); grid = -1; return; }
        grid = cus;
    }
    if (grid < 0) return;
    if (hipMemsetAsync(d_ws, 0, 65536, stream) != hipSuccess) { fprintf(stderr, "kernel_launch: memset of the barrier words failed\n"); return; }
    KArgs a{};
    for (int i = 0; i < 36; ++i) a.in[i] = (const float*)d_in[i];
    a.out = (float*)d_out; a.ws = (unsigned char*)d_ws;
#if MK_SINGLE
    a.lo = 0; a.hi = NPHASE;
    void* args[] = {&a};
    hipError_t e = hipLaunchCooperativeKernel((const void*)fwd_kernel, dim3(grid), dim3(512), args, LDS_BYTES, stream);
    if (e != hipSuccess) fprintf(stderr, "cooperative launch failed: %s (grid %d)\n", hipGetErrorString(e), grid);
#else
    for (int p = 0; p < NPHASE; ++p) { a.lo = p; a.hi = p + 1; hipLaunchKernelGGL(fwd_kernel, dim3(grid), dim3(512), LDS_BYTES, stream, a); }
#endif
}
```

```cpp
#include <hip/hip_runtime.h>
#include <hip/hip_cooperative_groups.h>
#include <cstdio>
#include <cstdint>
namespace cg = cooperative_groups;
namespace pg8 {
#define PG8_LAS __attribute__((address_space(3)))
typedef unsigned short bf16_t;
typedef short bf16x8 __attribute__((ext_vector_type(8)));
typedef float f32x4 __attribute__((ext_vector_type(4)));
typedef unsigned u32x4 __attribute__((ext_vector_type(4)));
constexpr int BM = 256, BK = 64, HALF = 128, HTB = HALF * BK * 2  , STAGE_BYTES = 8 * HTB, NXCD = 8, WGM = 8;

__host__ __device__ __forceinline__ int lds_byte(int r, int c) { const int st = (r >> 4) * 2 + (c >> 5), rr = r & 15, cc = c & 31, ob = rr * 64 + cc * 2; return st * 1024 + (ob ^ (((ob >> 9) & 1) << 5)); }
__host__ __device__ __forceinline__ void stage_rc(int b, int& R, int& C) { const int st = b / 1024, sb = b % 1024, swz = sb ^ (((sb >> 9) & 1) << 5); R = (st >> 1) * 16 + swz / 64; C = (st & 1) * 32 + (swz % 64) / 2; }
__host__ __device__ __forceinline__ int perm32(int rho) { const int n = rho >> 4, i = rho & 15; return 8 * (i >> 2) + 4 * n + (i & 3); }

struct Unit { int pm, pn, kt0, nkt, kind, slice; };
struct Gemm { const bf16_t* A; const bf16_t* Bt; int M, N, K; };

struct StaticOrder {
    int nM, nN, nwg, G, c;
    __host__ __device__ __forceinline__ void init(int M, int N, int G_, int c_) { nM = M / BM; nN = N / BM; nwg = nM * nN; G = G_; c = c_; }
    __host__ __device__ __forceinline__ bool next(int i, Unit& u) const {
        const long L = (long)i * G + c; if (L >= nwg) return false;
        int wgid = (int)L; { const int q = nwg / NXCD, r = nwg % NXCD, xcd = wgid % NXCD, off = wgid / NXCD; wgid = (xcd < r ? xcd * (q + 1) : r * (q + 1) + (xcd - r) * q) + off; }
        const int nig = WGM * nN, gid = wgid / nig, fm = gid * WGM, gsz = (nM - fm) < WGM ? (nM - fm) : WGM;
        u.pm = fm + ((wgid % nig) % gsz); u.pn = (wgid % nig) / gsz; return true;
    }
    __device__ __forceinline__ void a_ready(const Unit&) const {}
    __device__ __forceinline__ void done(const Unit&) const {}
};

__device__ __forceinline__ unsigned cvt_pk_bf16(float lo, float hi) { unsigned r; asm("v_cvt_pk_bf16_f32 %0, %1, %2" : "=v"(r) : "v"(lo), "v"(hi)); return r; }
typedef float f32x2 __attribute__((ext_vector_type(2)));
template <class Epi, class Sched, bool ALIGN_EPI = false, bool SP2 = false>
__device__ __forceinline__ void gemm_phase(PG8_LAS unsigned char* lds, const Gemm g, const Sched& S, const Epi& E) {
    const int tid = threadIdx.x, wid = __builtin_amdgcn_readfirstlane(tid >> 6), lane = tid & 63, wr = wid >> 2, wc = wid & 3, fr = lane & 15, fq = lane >> 4;
    const int K = g.K;
    unsigned voffA[2], voffB[2];
#pragma unroll
    for (int i = 0; i < 2; ++i) { int R, C; stage_rc(tid * 16 + i * 8192, R, C); const int Rb = Epi::PERM ? ((R & ~31) + perm32(R & 31)) : R;
        voffA[i] = (unsigned)(R * K + C) * 2u; voffB[i] = (unsigned)(Rb * K + C) * 2u; }
    const size_t kstep = (size_t)(BK * 2);
    const size_t hstep = (size_t)HALF * K * 2;
    const size_t tstep = 2 * hstep;
    const unsigned ldsw = (unsigned)wid * 1024u;
    const int aoff = lds_byte(wr * 64 + fr, fq * 8), boff = lds_byte(wc * 32 + fr, fq * 8);
#define PG8_SA(b, h) (((b) * 2 + (h)) * HTB)
#define PG8_SB(b, h) ((4 + (b) * 2 + (h)) * HTB)
#define PG8_STAGE(bufoff, gbase, voff) do { _Pragma("unroll") for (int _i = 0; _i < 2; ++_i) \
        __builtin_amdgcn_global_load_lds((const unsigned*)((const char*)(gbase) + (voff)[_i]), (PG8_LAS unsigned*)(lds + (bufoff) + ldsw + _i * 8192), 16, 0, 0); } while (0)
#define PG8_LDA(dst, b, h) do { _Pragma("unroll") for (int m = 0; m < 4; ++m) _Pragma("unroll") for (int k = 0; k < 2; ++k) dst[m][k] = *(const PG8_LAS bf16x8*)(lds + PG8_SA(b, h) + aoff + m * 2048 + k * 1024); } while (0)
#define PG8_LDB(dst, b, h) do { _Pragma("unroll") for (int n = 0; n < 2; ++n) _Pragma("unroll") for (int k = 0; k < 2; ++k) dst[n][k] = *(const PG8_LAS bf16x8*)(lds + PG8_SB(b, h) + boff + n * 2048 + k * 1024); } while (0)
#define PG8_MMA(ai, bj, At, Bt) do { __builtin_amdgcn_s_setprio(1); _Pragma("unroll") for (int m = 0; m < 4; ++m) _Pragma("unroll") for (int n = 0; n < 2; ++n) _Pragma("unroll") for (int k = 0; k < 2; ++k) \
        acc[ai][bj][m][n] = __builtin_amdgcn_mfma_f32_16x16x32_bf16(Bt[n][k], At[m][k], acc[ai][bj][m][n], 0, 0, 0); __builtin_amdgcn_s_setprio(0); } while (0)
#define PG8_WAIT_V(n) asm volatile("s_waitcnt vmcnt(" #n ")" ::: "memory")
#define PG8_WAIT_L(n) asm volatile("s_waitcnt lgkmcnt(" #n ")" ::: "memory")
#define PG8_BAR __builtin_amdgcn_s_barrier()
#define PG8_SCHED __builtin_amdgcn_sched_barrier(0)
    Unit cur = {0, 0, 0, 0, 0, 0}, nxt = {0, 0, 0, 0, 0, 0}; int ui = 0;
    if (!S.next(0, cur)) return;
    f32x4 acc[2][2][4][2];
#pragma unroll
    for (int a = 0; a < 2; ++a)
#pragma unroll
        for (int b = 0; b < 2; ++b)
#pragma unroll
            for (int m = 0; m < 4; ++m)
#pragma unroll
                for (int n = 0; n < 2; ++n) acc[a][b][m][n] = (f32x4){0.f, 0.f, 0.f, 0.f};
    bf16x8 At[4][2], B0[2][2], B1[2][2];
    const char* cA = (const char*)g.A + (size_t)cur.pm * tstep + (size_t)cur.kt0 * kstep; const char* cB = (const char*)g.Bt + (size_t)cur.pn * tstep + (size_t)cur.kt0 * kstep;
    S.a_ready(cur);
    if constexpr (SP2) {
        PG8_STAGE(PG8_SB(0, 0), cB, voffB); PG8_STAGE(PG8_SB(0, 1), cB + hstep, voffB); PG8_STAGE(PG8_SA(0, 0), cA, voffA); PG8_STAGE(PG8_SA(0, 1), cA + hstep, voffA);
        if (wr == 1) PG8_BAR;
        PG8_WAIT_V(2); PG8_BAR;
        PG8_STAGE(PG8_SB(1, 0), cB + kstep, voffB); PG8_STAGE(PG8_SA(1, 0), cA + kstep, voffA); PG8_STAGE(PG8_SB(1, 1), cB + hstep + kstep, voffB);
        PG8_WAIT_V(6); PG8_BAR;
    } else {
        PG8_STAGE(PG8_SB(0, 0), cB, voffB); PG8_STAGE(PG8_SA(0, 0), cA, voffA); PG8_STAGE(PG8_SB(0, 1), cB + hstep, voffB); PG8_STAGE(PG8_SA(0, 1), cA + hstep, voffA);
        if (wr == 1) PG8_BAR;
        PG8_WAIT_V(4); PG8_BAR;
        PG8_STAGE(PG8_SB(1, 0), cB + kstep, voffB); PG8_STAGE(PG8_SA(1, 0), cA + kstep, voffA); PG8_STAGE(PG8_SB(1, 1), cB + hstep + kstep, voffB);
        PG8_WAIT_V(6); PG8_BAR;
    }
    for (;;) {
        const bool has_next = S.next(ui + 1, nxt);
        const char* nA = has_next ? (const char*)g.A + (size_t)nxt.pm * tstep + (size_t)nxt.kt0 * kstep : cA; const char* nB = has_next ? (const char*)g.Bt + (size_t)nxt.pn * tstep + (size_t)nxt.kt0 * kstep : cB;
        const int nt = cur.nkt;
        for (int t = 0; t < nt; t += 2) {
            const bool last = (t == nt - 2);
            const char* a1 = cA + (size_t)(t + 1) * kstep;
            const char* a2 = last ? nA : cA + (size_t)(t + 2) * kstep; const char* b2 = last ? nB : cB + (size_t)(t + 2) * kstep;
            const char* a3 = a2 + kstep; const char* b3 = b2 + kstep;
            if (last && has_next) S.a_ready(nxt);
            if constexpr (SP2) {
            PG8_LDB(B0, 0, 0); PG8_LDB(B1, 0, 1); PG8_SCHED; PG8_LDA(At, 0, 0); PG8_STAGE(PG8_SA(1, 1), a1 + hstep, voffA);
            PG8_WAIT_V(8); PG8_WAIT_L(0); PG8_BAR; PG8_MMA(0, 0, At, B0); PG8_MMA(0, 1, At, B1); PG8_BAR; PG8_SCHED;
            PG8_LDA(At, 0, 1); PG8_STAGE(PG8_SB(0, 0), b2, voffB); PG8_STAGE(PG8_SB(0, 1), b2 + hstep, voffB); PG8_STAGE(PG8_SA(0, 0), a2, voffA);
            PG8_WAIT_V(8); PG8_WAIT_L(0); PG8_BAR; PG8_MMA(1, 0, At, B0); PG8_MMA(1, 1, At, B1); PG8_BAR; PG8_SCHED;
            PG8_LDB(B0, 1, 0); PG8_LDB(B1, 1, 1); PG8_SCHED; PG8_LDA(At, 1, 0); PG8_STAGE(PG8_SA(0, 1), a2 + hstep, voffA);
            PG8_WAIT_V(8); PG8_WAIT_L(0); PG8_BAR; PG8_MMA(0, 0, At, B0); PG8_MMA(0, 1, At, B1); PG8_BAR; PG8_SCHED;
            PG8_LDA(At, 1, 1); PG8_STAGE(PG8_SB(1, 0), b3, voffB); PG8_STAGE(PG8_SB(1, 1), b3 + hstep, voffB); PG8_STAGE(PG8_SA(1, 0), a3, voffA);
            PG8_WAIT_V(8); PG8_WAIT_L(0); PG8_BAR; PG8_MMA(1, 0, At, B0); PG8_MMA(1, 1, At, B1); PG8_BAR; PG8_SCHED;
            } else {
            PG8_LDB(B0, 0, 0); PG8_SCHED; PG8_LDA(At, 0, 0); PG8_STAGE(PG8_SA(1, 1), a1 + hstep, voffA);
            PG8_WAIT_L(8); PG8_BAR; PG8_WAIT_L(0); PG8_MMA(0, 0, At, B0); PG8_BAR; PG8_SCHED;
            PG8_LDB(B1, 0, 1); PG8_STAGE(PG8_SB(0, 0), b2, voffB);
            PG8_BAR; PG8_WAIT_L(0); PG8_MMA(0, 1, At, B1); PG8_BAR;
            PG8_LDA(At, 0, 1); PG8_STAGE(PG8_SA(0, 0), a2, voffA);
            PG8_BAR; PG8_WAIT_L(0); PG8_MMA(1, 0, At, B0); PG8_BAR; PG8_SCHED;
            PG8_STAGE(PG8_SB(0, 1), b2 + hstep, voffB);
            PG8_WAIT_V(6); PG8_BAR; PG8_MMA(1, 1, At, B1); PG8_BAR;
            PG8_LDB(B0, 1, 0); PG8_SCHED; PG8_LDA(At, 1, 0); PG8_STAGE(PG8_SA(0, 1), a2 + hstep, voffA);
            PG8_WAIT_L(8); PG8_BAR; PG8_WAIT_L(0); PG8_MMA(0, 0, At, B0); PG8_BAR; PG8_SCHED;
            PG8_LDB(B1, 1, 1); PG8_STAGE(PG8_SB(1, 0), b3, voffB);
            PG8_BAR; PG8_WAIT_L(0); PG8_MMA(0, 1, At, B1); PG8_BAR;
            PG8_LDA(At, 1, 1); PG8_STAGE(PG8_SA(1, 0), a3, voffA);
            PG8_BAR; PG8_WAIT_L(0); PG8_MMA(1, 0, At, B0); PG8_BAR; PG8_SCHED;
            PG8_STAGE(PG8_SB(1, 1), b3 + hstep, voffB);
            PG8_WAIT_V(6); PG8_BAR; PG8_MMA(1, 1, At, B1); PG8_BAR;
            }
        }
        if constexpr (ALIGN_EPI) { if (wr == 0) PG8_BAR; }
        if constexpr (!Epi::AFTER_DRAIN) { E(acc, cur, wr, wc, fr, fq); S.done(cur); } else { if (has_next) E(acc, cur, wr, wc, fr, fq); }
        if (!has_next) break;
#pragma unroll
        for (int a = 0; a < 2; ++a)
#pragma unroll
            for (int b = 0; b < 2; ++b)
#pragma unroll
                for (int m = 0; m < 4; ++m)
#pragma unroll
                    for (int n = 0; n < 2; ++n) acc[a][b][m][n] = (f32x4){0.f, 0.f, 0.f, 0.f};
        cur = nxt; cA = nA; cB = nB; ++ui;
        if constexpr (ALIGN_EPI) { if (wr == 1) PG8_BAR; }
    }
    PG8_WAIT_V(0);
    if constexpr (!ALIGN_EPI) { if (wr == 0) PG8_BAR; }
    PG8_BAR;
    if constexpr (Epi::AFTER_DRAIN) { E.fused(acc, cur, wr, wc, fr, fq, lds, wid, lane); S.done(cur); }
#undef PG8_SA
#undef PG8_SB
#undef PG8_STAGE
#undef PG8_LDA
#undef PG8_LDB
#undef PG8_MMA
#undef PG8_WAIT_V
#undef PG8_WAIT_L
#undef PG8_BAR
#undef PG8_SCHED
}
}

#define LAS __attribute__((address_space(3)))
typedef unsigned short bf16;
typedef float f32x4 __attribute__((ext_vector_type(4)));
typedef float f32x2 __attribute__((ext_vector_type(2)));
typedef short bf16x8 __attribute__((ext_vector_type(8)));
typedef unsigned u32x4 __attribute__((ext_vector_type(4)));
typedef unsigned u32x2 __attribute__((ext_vector_type(2)));

constexpr int DM = 1024, NBP = 8, SEQ = 2048, MPR = NBP * SEQ, NBS = 128, MTOK = MPR + NBS, MPAD = 16640;
constexpr int DL = 512, NPROJ = 1536, NMOD = 6144, NBT = NBP + NBS, DFF = 2816;
constexpr int LCH = 64, NCH = SEQ / LCH;
constexpr int SCH = 16;
constexpr int SL = 16, SNCH = SEQ / SL, SROWS = NBP * SNCH;
constexpr float EPS = 1e-6f;
constexpr int NPHASE = 13;

constexpr size_t O_Y = 0, O_CONVP = (size_t)MTOK * DM, O_LRUP = O_CONVP + 8 * 3 * 512, O_S5RP = O_LRUP + 8 * 512, O_S5IP = O_S5RP + 8 * 32 * 64,
                 O_CONVS = O_S5IP + 8 * 32 * 64, O_LRUS = O_CONVS + 128 * 3 * 512, O_S5RS = O_LRUS + 128 * 512, O_S5IS = O_S5RS + 128 * 32 * 64, O_END = O_S5IS + 128 * 32 * 64;

constexpr size_t HM = 1u << 19;
constexpr size_t WS_WIN = 2 * HM, WS_WGLU = 8 * HM, WS_WOUT = 10 * HM, WS_WGU = 14 * HM, WS_WDN = 36 * HM  , WS_MOD = 48 * HM  ,
                 WS_TF = 56 * HM  , WS_E = 68 * HM  , WS_TAB = 72 * HM, WS_AGG = 74 * HM  ,
                 WS_XN = 80 * HM  , WS_LRUX = 146 * HM  , WS_GATE = 211 * HM  ,
                 WS_S5U = 244 * HM  , WS_HLOC = 277 * HM  , WS_CUM = 342 * HM, WS_GY = 407 * HM  ,
                 WS_SK = 440 * HM  , WS_HIN = 472 * HM  , WS_HB = 277 * HM  , WS_X1B = 211 * HM  , WS_PART = 488 * HM  , WS_END = 512 * HM;
constexpr size_t WS_XSLOT = 65536;
constexpr size_t T_ABAR = 0, T_A16 = 4096, T_BBR = 8192, T_BBI = 8192 + 32768, T_WG = 81920  , T_GCD = T_WG + 32768  ;

struct KArgs { const float* in[36]; float* out; unsigned char* ws; int lo, hi; };

struct Ctx {
    const float* const* in; float* out; unsigned char* ws;
    __device__ __forceinline__ const float* I(int i) const { return in[i]; }
    __device__ __forceinline__ bf16* WIN() const { return (bf16*)(ws + WS_WIN); }
    __device__ __forceinline__ bf16* WGLU() const { return (bf16*)(ws + WS_WGLU); }
    __device__ __forceinline__ bf16* WOUT() const { return (bf16*)(ws + WS_WOUT); }
    __device__ __forceinline__ bf16* WGU() const { return (bf16*)(ws + WS_WGU); }
    __device__ __forceinline__ bf16* WDN() const { return (bf16*)(ws + WS_WDN); }
    __device__ __forceinline__ float* MOD() const { return (float*)(ws + WS_MOD); }
    __device__ __forceinline__ bf16* TF() const { return (bf16*)(ws + WS_TF); }
    __device__ __forceinline__ bf16* EM() const { return (bf16*)(ws + WS_E); }
    __device__ __forceinline__ float* TAB() const { return (float*)(ws + WS_TAB); }
    __device__ __forceinline__ f32x2* AGG() const { return (f32x2*)(ws + WS_AGG); }
    __device__ __forceinline__ bf16* XN() const { return (bf16*)(ws + WS_XN); }
    __device__ __forceinline__ bf16* MERGED() const { return (bf16*)(ws + WS_XN); }
    __device__ __forceinline__ bf16* LRUX() const { return (bf16*)(ws + WS_LRUX); }
    __device__ __forceinline__ bf16* XN2() const { return (bf16*)(ws + WS_LRUX); }
    __device__ __forceinline__ bf16* GATE() const { return (bf16*)(ws + WS_GATE); }
    __device__ __forceinline__ bf16* S5U() const { return (bf16*)(ws + WS_S5U); }
    __device__ __forceinline__ float* HLOC() const { return (float*)(ws + WS_HLOC); }
    __device__ __forceinline__ float* S5OUT() const { return (float*)(ws + WS_HLOC); }
    __device__ __forceinline__ float* CUM() const { return (float*)(ws + WS_CUM); }
    __device__ __forceinline__ bf16* GY() const { return (bf16*)(ws + WS_GY); }
    __device__ __forceinline__ float* SK() const { return (float*)(ws + WS_SK); }
    __device__ __forceinline__ bf16* HIN() const { return (bf16*)(ws + WS_HIN); }
    __device__ __forceinline__ bf16* HB() const { return (bf16*)(ws + WS_HB); }
    __device__ __forceinline__ float* PART() const { return (float*)(ws + WS_PART); }
    __device__ __forceinline__ bf16* X1B() const { return (bf16*)(ws + WS_X1B); }
};

#define LDS_WAIT() asm volatile("s_waitcnt lgkmcnt(0)" ::: "memory")
__device__ __forceinline__ unsigned pk2(float lo, float hi) { return pg8::cvt_pk_bf16(lo, hi); }
__device__ __forceinline__ float bf2f(unsigned b) { return __uint_as_float(b << 16); }
__device__ __forceinline__ float bflo(unsigned w) { return __uint_as_float(w << 16); }
__device__ __forceinline__ float bfhi(unsigned w) { return __uint_as_float(w & 0xffff0000u); }
__device__ __forceinline__ float wave_sum(float v) {
#pragma unroll
    for (int o = 1; o < 64; o <<= 1) v += __shfl_xor(v, o);
    return v;
}
__device__ __forceinline__ float sigm(float v) { return __builtin_amdgcn_rcpf(1.f + __builtin_amdgcn_exp2f(-1.44269504089f * v)); }
__device__ __forceinline__ float gelu_tanh(float x) { const float u = (-1.5957691216f * 1.44269504089f) * (x + 0.044715f * x * x * x); return x * __builtin_amdgcn_rcpf(1.f + __builtin_amdgcn_exp2f(u)); }
__device__ __forceinline__ int mod_row(int row) { return row < MPR ? (row >> 11) : (NBP + row - MPR); }
__device__ __forceinline__ u32x4 pack8(f32x4 a, f32x4 b) { u32x4 w; w.x = pk2(a[0], a[1]); w.y = pk2(a[2], a[3]); w.z = pk2(b[0], b[1]); w.w = pk2(b[2], b[3]); return w; }

struct Sched2 {
    pg8::StaticOrder so; int nkt_full, n_extra, ex_nn, ex_nkt;
    __device__ __forceinline__ void init(int N, int K, int G, int c, int ex_nkt_) { so.init(MPR, N, G, c); nkt_full = K / 64; ex_nn = N / 256; ex_nkt = ex_nkt_; n_extra = ex_nn * (nkt_full / ex_nkt_); }
    __device__ __forceinline__ bool next(int i, pg8::Unit& u) const {
        const long L = (long)i * so.G + so.c;
        const bool prompt = L < so.nwg; const int e = (int)(L - so.nwg);
        if (!prompt && e >= n_extra) return false;
        pg8::Unit t; t.pm = 0; t.pn = 0; t.kt0 = 0; t.nkt = 0; t.kind = 0; t.slice = 0;
        if (prompt) so.next(i, t);
        const int sl = prompt ? 0 : e / ex_nn;
        pg8::Unit r; r.pm = prompt ? t.pm : 64; r.pn = prompt ? t.pn : e % ex_nn; r.kt0 = sl * ex_nkt; r.nkt = prompt ? nkt_full : ex_nkt; r.kind = prompt ? 0 : ((ex_nkt == nkt_full) ? 1 : 2); r.slice = sl;
        u = r; return true;
    }
    __device__ __forceinline__ void a_ready(const pg8::Unit&) const {}
    __device__ __forceinline__ void done(const pg8::Unit&) const {}
};
__device__ __forceinline__ void store_partial(const f32x4 (&acc)[2][2][4][2], const pg8::Unit& u, int wr, int wc, int fr, int fq, float* part, unsigned* cnt) {
    float* base = part + (size_t)u.slice * 128 * 1024 + u.pn * 256 + wc * 32 + 8 * fq;
#pragma unroll
    for (int m = 0; m < 4; ++m) { float* rp = base + (size_t)(wr * 64 + m * 16 + fr) * 1024;
#pragma unroll
        for (int bj = 0; bj < 2; ++bj)
#pragma unroll
            for (int n = 0; n < 2; ++n) { const f32x4 v = acc[0][bj][m][n]; unsigned long long* q = (unsigned long long*)(rp + bj * 128 + 4 * n);
                __hip_atomic_store(q, ((unsigned long long)__float_as_uint(v.y) << 32) | __float_as_uint(v.x), __ATOMIC_RELAXED, __HIP_MEMORY_SCOPE_AGENT);
                __hip_atomic_store(q + 1, ((unsigned long long)__float_as_uint(v.w) << 32) | __float_as_uint(v.z), __ATOMIC_RELAXED, __HIP_MEMORY_SCOPE_AGENT); } }
    asm volatile("s_waitcnt vmcnt(0)" ::: "memory");
    if ((threadIdx.x & 63) == 0) __hip_atomic_fetch_add(cnt, 1u, __ATOMIC_RELAXED, __HIP_MEMORY_SCOPE_AGENT);
}
__device__ __forceinline__ void wait_partials(unsigned* cnt, unsigned want) {
    unsigned sp = 0;
    while ((unsigned)__builtin_amdgcn_readfirstlane(__hip_atomic_load(cnt, __ATOMIC_RELAXED, __HIP_MEMORY_SCOPE_AGENT)) < want) { __builtin_amdgcn_s_sleep(4); if (++sp > (1u << 22)) break; }
    __builtin_amdgcn_fence(__ATOMIC_ACQUIRE, "agent");
}

struct EpiProj {
    static constexpr bool PERM = true, AFTER_DRAIN = false; bf16* lrux; bf16* gate; bf16* s5u;
    __device__ __forceinline__ void operator()(const f32x4 (&acc)[2][2][4][2], const pg8::Unit& u, int wr, int wc, int fr, int fq) const {
        const int colt = u.pn * 256 + wc * 32 + 8 * fq;
#pragma unroll
        for (int ai = 0; ai < 2; ++ai)
#pragma unroll
            for (int m = 0; m < 4; ++m) { const int row = u.pm * 256 + ai * 128 + wr * 64 + m * 16 + fr; if (row >= MTOK) continue;
#pragma unroll
                for (int bj = 0; bj < 2; ++bj) { const int col = colt + bj * 128; const f32x4 v0 = acc[ai][bj][m][0], v1 = acc[ai][bj][m][1];
                    if (u.pn < 2) { *(u32x4*)(lrux + (size_t)row * 512 + col) = pack8(v0, v1); }
                    else if (u.pn < 4) { *(u32x4*)(gate + (size_t)row * 512 + (col - 512)) = pack8(v0, v1); }
                    else { *(u32x4*)(s5u + (size_t)row * 512 + (col - 1024)) = pack8(v0, v1); } } }
    }
};
struct EpiGlu {
    static constexpr bool PERM = true, AFTER_DRAIN = false; float* o; float* part;
    __device__ __forceinline__ void operator()(const f32x4 (&acc)[2][2][4][2], const pg8::Unit& u, int wr, int wc, int fr, int fq) const {
        const int col = u.pn * 128 + wc * 32 + 8 * fq;
#pragma unroll
        for (int ai = 0; ai < 2; ++ai)
#pragma unroll
            for (int m = 0; m < 4; ++m) { const int row = u.pm * 256 + ai * 128 + wr * 64 + m * 16 + fr; if (row >= MTOK) continue;
#pragma unroll
                for (int n = 0; n < 2; ++n) { const f32x4 a = acc[ai][0][m][n], b = acc[ai][1][m][n]; f32x4 s;
#pragma unroll
                    for (int i = 0; i < 4; ++i) s[i] = a[i] * sigm(b[i]);
                    *(f32x4*)(o + (size_t)row * 512 + col + 4 * n) = s; } }
    }
};
template <int GOFF> struct EpiRes {
    static constexpr bool PERM = true, AFTER_DRAIN = false; const float* xp; const float* xs; const float* mod; float* out; float* part;
    __device__ __forceinline__ void operator()(const f32x4 (&acc)[2][2][4][2], const pg8::Unit& u, int wr, int wc, int fr, int fq) const {
        const int colt = u.pn * 256 + wc * 32 + 8 * fq;
#pragma unroll
        for (int ai = 0; ai < 2; ++ai)
#pragma unroll
            for (int m = 0; m < 4; ++m) { const int row = u.pm * 256 + ai * 128 + wr * 64 + m * 16 + fr; if (row >= MTOK) continue;
                const float* gp = mod + (size_t)mod_row(row) * NMOD + GOFF; float* op = out + (size_t)row * DM;
                const float* bp = xp ? (row < MPR ? xp + (size_t)row * DM : xs + (size_t)(row - MPR) * DM) : op;
#pragma unroll
                for (int bj = 0; bj < 2; ++bj)
#pragma unroll
                    for (int n = 0; n < 2; ++n) { const int c = colt + bj * 128 + 4 * n; const f32x4 x4 = *(const f32x4*)(bp + c), g4 = *(const f32x4*)(gp + c);
                        *(f32x4*)(op + c) = x4 + g4 * acc[ai][bj][m][n]; } }
    }
};
struct EpiSwiglu {
    static constexpr bool PERM = true, AFTER_DRAIN = false; bf16* h;
    __device__ __forceinline__ void operator()(const f32x4 (&acc)[2][2][4][2], const pg8::Unit& u, int wr, int wc, int fr, int fq) const {
        const int col = u.pn * 128 + wc * 32 + 8 * fq;
#pragma unroll
        for (int ai = 0; ai < 2; ++ai)
#pragma unroll
            for (int m = 0; m < 4; ++m) { const int row = u.pm * 256 + ai * 128 + wr * 64 + m * 16 + fr; if (row >= MTOK) continue;
                f32x4 s[2];
#pragma unroll
                for (int n = 0; n < 2; ++n) { const f32x4 a = acc[ai][0][m][n], b = acc[ai][1][m][n];
#pragma unroll
                    for (int i = 0; i < 4; ++i) s[n][i] = a[i] * sigm(a[i]) * b[i]; }
                *(u32x4*)(h + (size_t)row * DFF + col) = pack8(s[0], s[1]); }
    }
};

struct Sched3 {
    pg8::StaticOrder so; int nkt_full, n_extra, ex_nn, ex_nkt;
    __device__ __forceinline__ void init(int N, int K, int G, int c, int ex_nkt_) { so.init(MPR, N, G, c); nkt_full = K / 64; ex_nn = N / 256; ex_nkt = ex_nkt_; n_extra = ex_nn * (nkt_full / ex_nkt_); }
    __device__ __forceinline__ bool next(int i, pg8::Unit& u) const {
        const bool has_ex = so.c < n_extra; const int j = has_ex ? i : i + 1;
        if (j > 1) return false;
        const bool prompt = (j == 1); const int e = so.c;
        pg8::Unit t; t.pm = 0; t.pn = 0; t.kt0 = 0; t.nkt = 0; t.kind = 0; t.slice = 0;
        if (prompt) so.next(0, t);
        const int sl = prompt ? 0 : e / ex_nn;
        pg8::Unit r; r.pm = prompt ? t.pm : 64; r.pn = prompt ? t.pn : e % ex_nn; r.kt0 = sl * ex_nkt; r.nkt = prompt ? nkt_full : ex_nkt; r.kind = prompt ? 0 : 2; r.slice = sl;
        u = r; return true;
    }
    __device__ __forceinline__ void a_ready(const pg8::Unit&) const {}
    __device__ __forceinline__ void done(const pg8::Unit&) const {}
};
struct RmsPanel {
    float* xbuf;
    unsigned* cnt;
    float inv_n, eps;
    __device__ __forceinline__ void put(float t, int r, int wc, int fq, LAS unsigned char* lds) const { t += __shfl_xor(t, 16); t += __shfl_xor(t, 32); if (fq == 0) ((LAS float*)lds)[r * 4 + wc] = t; }
    __device__ __forceinline__ void finish(const pg8::Unit& u, LAS unsigned char* lds, int wid, int lane) const {
        LAS float* P = (LAS float*)lds; LAS float* S = (LAS float*)(lds + 4096);
        asm volatile("s_waitcnt lgkmcnt(0)" ::: "memory"); __builtin_amdgcn_s_barrier(); asm volatile("" ::: "memory");
        const int row = wid * 32 + (lane & 31);
        if (lane < 32) { const f32x4 p = *(const LAS f32x4*)(P + row * 4); const float t = (p.x + p.y) + (p.z + p.w);
            __hip_atomic_store(xbuf + ((size_t)(u.pm * 256 + row) * 4 + u.pn), t, __ATOMIC_RELAXED, __HIP_MEMORY_SCOPE_AGENT); }
        asm volatile("s_waitcnt vmcnt(0)" ::: "memory");
        if (lane == 0) __hip_atomic_fetch_add(cnt + 64 * u.pm, 1u, __ATOMIC_RELAXED, __HIP_MEMORY_SCOPE_AGENT);
        if (wid == 0) { unsigned sp = 0;
            while ((unsigned)__builtin_amdgcn_readfirstlane(__hip_atomic_load(cnt + 64 * u.pm, __ATOMIC_RELAXED, __HIP_MEMORY_SCOPE_AGENT)) < 32u) { __builtin_amdgcn_s_sleep(2); if (++sp > (1u << 22)) break; }
            __builtin_amdgcn_fence(__ATOMIC_ACQUIRE, "agent"); }
        asm volatile("s_waitcnt vmcnt(0) lgkmcnt(0)" ::: "memory"); __builtin_amdgcn_s_barrier(); asm volatile("" ::: "memory");
        if (lane < 32) { const float* slot = xbuf + (size_t)(u.pm * 256 + row) * 4; float t = 0.f;
#pragma unroll
            for (int q = 0; q < 4; ++q) t += __hip_atomic_load(slot + q, __ATOMIC_RELAXED, __HIP_MEMORY_SCOPE_AGENT);
            S[row] = rsqrtf(t * inv_n + eps); }
        asm volatile("s_waitcnt lgkmcnt(0)" ::: "memory"); __builtin_amdgcn_s_barrier(); asm volatile("" ::: "memory");
    }
};
struct EpiGluNorm {
    static constexpr bool PERM = true, AFTER_DRAIN = true; bf16* merged; const float* gs; float* part; unsigned* pcnt; RmsPanel st;
    __device__ __forceinline__ void operator()(const f32x4 (&acc)[2][2][4][2], const pg8::Unit& u, int wr, int wc, int fr, int fq) const { if (u.kind == 2) store_partial(acc, u, wr, wc, fr, fq, part, pcnt); }
    __device__ __forceinline__ void fused(f32x4 (&acc)[2][2][4][2], const pg8::Unit& u, int wr, int wc, int fr, int fq, LAS unsigned char* lds, int wid, int lane) const {
#pragma unroll
        for (int ai = 0; ai < 2; ++ai)
#pragma unroll
            for (int m = 0; m < 4; ++m) { float ss = 0.f;
#pragma unroll
                for (int n = 0; n < 2; ++n) { const f32x4 a = acc[ai][0][m][n], b = acc[ai][1][m][n]; f32x4 sv;
#pragma unroll
                    for (int i = 0; i < 4; ++i) { sv[i] = a[i] * sigm(b[i]); ss += sv[i] * sv[i]; }
                    acc[ai][0][m][n] = sv; }
                st.put(ss, ai * 128 + wr * 64 + m * 16 + fr, wc, fq, lds); }
        st.finish(u, lds, wid, lane);
        const LAS float* S = (const LAS float*)(lds + 4096);
        const int col = u.pn * 128 + wc * 32 + 8 * fq; const f32x4 g0 = *(const f32x4*)(gs + col), g1 = *(const f32x4*)(gs + col + 4);
#pragma unroll
        for (int ai = 0; ai < 2; ++ai)
#pragma unroll
            for (int m = 0; m < 4; ++m) { const int r = ai * 128 + wr * 64 + m * 16 + fr; const float rstd = S[r];
                *(u32x4*)(merged + (size_t)(u.pm * 256 + r) * DM + 512 + col) = pack8(acc[ai][0][m][0] * rstd * g0, acc[ai][0][m][1] * rstd * g1); }
    }
};
template <int MODE> struct EpiResNorm {
    static constexpr bool PERM = true, AFTER_DRAIN = true; const float* xp; const float* mod; const float* gn; float* out; bf16* xn; bf16* x1b; float* part; unsigned* pcnt; RmsPanel st;
    __device__ __forceinline__ void operator()(const f32x4 (&acc)[2][2][4][2], const pg8::Unit& u, int wr, int wc, int fr, int fq) const { if (u.kind == 2) store_partial(acc, u, wr, wc, fr, fq, part, pcnt); }
    __device__ __forceinline__ void fused(f32x4 (&acc)[2][2][4][2], const pg8::Unit& u, int wr, int wc, int fr, int fq, LAS unsigned char* lds, int wid, int lane) const {
        const int colt = u.pn * 256 + wc * 32 + 8 * fq; const float* mrow = mod + (size_t)(u.pm >> 3) * NMOD;
        constexpr int GOFF = MODE == 1 ? 2048 : 5120;
        f32x4 gv[2][2];
#pragma unroll
        for (int bj = 0; bj < 2; ++bj)
#pragma unroll
            for (int n = 0; n < 2; ++n) gv[bj][n] = *(const f32x4*)(mrow + GOFF + colt + bj * 128 + 4 * n);
#pragma unroll
        for (int ai = 0; ai < 2; ++ai) {
            f32x4 pre1[4][2][2]; u32x4 pre2[4][2];
#pragma unroll
            for (int m = 0; m < 4; ++m) { const size_t ro = (size_t)(u.pm * 256 + ai * 128 + wr * 64 + m * 16 + fr) * DM + colt;
#pragma unroll
                for (int bj = 0; bj < 2; ++bj) { if (MODE == 1) { pre1[m][bj][0] = *(const f32x4*)(xp + ro + bj * 128); pre1[m][bj][1] = *(const f32x4*)(xp + ro + bj * 128 + 4); } else pre2[m][bj] = *(const u32x4*)(x1b + ro + bj * 128); } }
#pragma unroll
            for (int m = 0; m < 4; ++m) { const size_t ro = (size_t)(u.pm * 256 + ai * 128 + wr * 64 + m * 16 + fr) * DM + colt; float ss = 0.f;
#pragma unroll
                for (int bj = 0; bj < 2; ++bj) { f32x4 b0, b1;
                    if (MODE == 1) { b0 = pre1[m][bj][0]; b1 = pre1[m][bj][1]; }
                    else { const u32x4 q = pre2[m][bj]; b0 = (f32x4){bflo(q.x), bfhi(q.x), bflo(q.y), bfhi(q.y)}; b1 = (f32x4){bflo(q.z), bfhi(q.z), bflo(q.w), bfhi(q.w)}; }
                    const f32x4 v0 = b0 + gv[bj][0] * acc[ai][bj][m][0], v1 = b1 + gv[bj][1] * acc[ai][bj][m][1]; acc[ai][bj][m][0] = v0; acc[ai][bj][m][1] = v1;
                    if (MODE == 1) *(u32x4*)(x1b + ro + bj * 128) = pack8(v0, v1);
                    ss += (v0.x * v0.x + v0.y * v0.y) + (v0.z * v0.z + v0.w * v0.w) + (v1.x * v1.x + v1.y * v1.y) + (v1.z * v1.z + v1.w * v1.w); }
                st.put(ss, ai * 128 + wr * 64 + m * 16 + fr, wc, fq, lds);
                asm volatile("" : "+v"(acc[ai][0][m][0]), "+v"(acc[ai][0][m][1]), "+v"(acc[ai][1][m][0]), "+v"(acc[ai][1][m][1])); }
            asm volatile("" ::: "memory"); }
        st.finish(u, lds, wid, lane);
        const LAS float* S = (const LAS float*)(lds + 4096);
#pragma unroll
        for (int bj = 0; bj < 2; ++bj) { const int c = colt + bj * 128;
            f32x4 w0 = *(const f32x4*)(gn + c), w1 = *(const f32x4*)(gn + c + 4), s0 = (f32x4){0.f, 0.f, 0.f, 0.f}, s1 = s0;
            if (MODE == 1) { w0 = w0 * (1.f + *(const f32x4*)(mrow + 4096 + c)); w1 = w1 * (1.f + *(const f32x4*)(mrow + 4096 + c + 4)); s0 = *(const f32x4*)(mrow + 3072 + c); s1 = *(const f32x4*)(mrow + 3072 + c + 4); }
#pragma unroll
            for (int ai = 0; ai < 2; ++ai)
#pragma unroll
                for (int m = 0; m < 4; ++m) { const int r = ai * 128 + wr * 64 + m * 16 + fr; const float rstd = S[r]; const size_t ro = (size_t)(u.pm * 256 + r) * DM + c;
                    const f32x4 o0 = acc[ai][bj][m][0] * rstd * w0 + s0, o1 = acc[ai][bj][m][1] * rstd * w1 + s1;
                    if (MODE == 1) *(u32x4*)(xn + ro) = pack8(o0, o1); else { *(f32x4*)(out + ro) = o0; *(f32x4*)(out + ro + 4) = o1; } } }
    }
};

__device__ __forceinline__ void transpose_item(const float* W, int ldw, int k0, int n0, bf16* WT, int K, int drow0, LAS bf16* scr, int lane) {
    const int lr = lane >> 4, lc = lane & 15;
    f32x4 v[16];
#pragma unroll
    for (int i = 0; i < 16; ++i) v[i] = *(const f32x4*)(W + (size_t)(k0 + lr + 4 * i) * ldw + n0 + 4 * lc);
#pragma unroll
    for (int i = 0; i < 16; ++i) { u32x2 p; p.x = pk2(v[i].x, v[i].y); p.y = pk2(v[i].z, v[i].w); *(LAS u32x2*)(scr + (lr + 4 * i) * 68 + 4 * lc) = p; }
    LDS_WAIT();
    const int kc = lane & 7;
#pragma unroll
    for (int j = 0; j < 8; ++j) { const int n = (lane >> 3) + 8 * j; const LAS bf16* sp = scr + (8 * kc) * 68 + n;
        u32x4 o; o.x = (unsigned)sp[0] | ((unsigned)sp[68] << 16); o.y = (unsigned)sp[2 * 68] | ((unsigned)sp[3 * 68] << 16);
        o.z = (unsigned)sp[4 * 68] | ((unsigned)sp[5 * 68] << 16); o.w = (unsigned)sp[6 * 68] | ((unsigned)sp[7 * 68] << 16);
        *(u32x4*)(WT + (size_t)(drow0 + n) * K + k0 + 8 * kc) = o; }
    LDS_WAIT();
}
__device__ __forceinline__ void transpose_dispatch(const Ctx& cx, int it, LAS bf16* scr, int lane) {
    if (it < 384) { const int kb = it / 24, nb = it % 24; transpose_item(cx.I(11), NPROJ, 64 * kb, 64 * nb, cx.WIN(), DM, 64 * nb, scr, lane); return; } it -= 384;
    if (it < 128) { const int kb = it / 16, nb = it % 16, n0 = 64 * nb; const int dr = 256 * ((n0 & 511) >> 7) + 128 * (n0 >> 9) + (n0 & 127);
        transpose_item(cx.I(27), 1024, 64 * kb, n0, cx.WGLU(), 512, dr, scr, lane); return; } it -= 128;
    if (it < 256) { const int kb = it / 16, nb = it % 16; transpose_item(cx.I(30), DM, 64 * kb, 64 * nb, cx.WOUT(), DM, 64 * nb, scr, lane); return; } it -= 256;
    if (it < 704) { const int kb = it / 44, nb = it % 44, n0 = 64 * nb; transpose_item(cx.I(32), DFF, 64 * kb, n0, cx.WGU(), DM, 256 * (n0 >> 7) + (n0 & 127), scr, lane); return; } it -= 704;
    if (it < 704) { const int kb = it / 44, nb = it % 44, n0 = 64 * nb; transpose_item(cx.I(33), DFF, 64 * kb, n0, cx.WGU(), DM, 256 * (n0 >> 7) + 128 + (n0 & 127), scr, lane); return; } it -= 704;
    { const int kb = it / 16, nb = it % 16; transpose_item(cx.I(34), DM, 64 * kb, 64 * nb, cx.WDN(), DFF, 64 * nb, scr, lane); }
}
constexpr int N_TR_ITEMS = 384 + 128 + 256 + 704 + 704 + 704;

__device__ __forceinline__ void ada_block(const Ctx& cx, int item, LAS unsigned char* lds) {
    const int tid = threadIdx.x, w = __builtin_amdgcn_readfirstlane(tid >> 6), lane = tid & 63, fr = lane & 15, fq = lane >> 4, n0 = 32 * item;
    const float* W = cx.I(8); const float* cp = cx.I(6); const float* cs = cx.I(7);
    bf16x8 wf[4][2];
#pragma unroll
    for (int ks = 0; ks < 4; ++ks)
#pragma unroll
        for (int nt = 0; nt < 2; ++nt) { const float* src = W + (size_t)(128 * w + 32 * ks + 8 * fq) * NMOD + n0 + 16 * nt + fr;
            u32x4 o; o.x = pk2(src[0], src[NMOD]); o.y = pk2(src[2 * NMOD], src[3 * NMOD]); o.z = pk2(src[4 * NMOD], src[5 * NMOD]); o.w = pk2(src[6 * NMOD], src[7 * NMOD]); wf[ks][nt] = __builtin_bit_cast(bf16x8, o); }
    f32x4 acc[9][2];
#pragma unroll
    for (int i = 0; i < 9; ++i) { acc[i][0] = (f32x4){0.f, 0.f, 0.f, 0.f}; acc[i][1] = (f32x4){0.f, 0.f, 0.f, 0.f}; }
#pragma unroll
    for (int mt = 0; mt < 9; ++mt) { int row = 16 * mt + fr; row = row < NBT ? row : NBT - 1;
        const float* src = (row < NBP ? cp + (size_t)row * DM : cs + (size_t)(row - NBP) * DM) + 128 * w + 8 * fq;
#pragma unroll
        for (int ks = 0; ks < 4; ++ks) { f32x4 a0 = *(const f32x4*)(src + 32 * ks), a1 = *(const f32x4*)(src + 32 * ks + 4);
#pragma unroll
            for (int i = 0; i < 4; ++i) { a0[i] = a0[i] * sigm(a0[i]); a1[i] = a1[i] * sigm(a1[i]); }
            const bf16x8 af = __builtin_bit_cast(bf16x8, pack8(a0, a1));
            acc[mt][0] = __builtin_amdgcn_mfma_f32_16x16x32_bf16(wf[ks][0], af, acc[mt][0], 0, 0, 0);
            acc[mt][1] = __builtin_amdgcn_mfma_f32_16x16x32_bf16(wf[ks][1], af, acc[mt][1], 0, 0, 0); } }
    LAS f32x4* red = (LAS f32x4*)lds;
#pragma unroll
    for (int st = 4; st >= 1; st >>= 1) {
        if (w >= st && w < 2 * st) {
#pragma unroll
            for (int i = 0; i < 9; ++i) { red[((w - st) * 18 + 2 * i) * 64 + lane] = acc[i][0]; red[((w - st) * 18 + 2 * i + 1) * 64 + lane] = acc[i][1]; } }
        __syncthreads();
        if (w < st) {
#pragma unroll
            for (int i = 0; i < 9; ++i) { acc[i][0] += red[(w * 18 + 2 * i) * 64 + lane]; acc[i][1] += red[(w * 18 + 2 * i + 1) * 64 + lane]; } }
        __syncthreads();
    }
    if (w == 0) {
#pragma unroll
        for (int nt = 0; nt < 2; ++nt) { const f32x4 b4 = *(const f32x4*)(cx.I(9) + n0 + 16 * nt + 4 * fq);
#pragma unroll
            for (int mt = 0; mt < 9; ++mt) { const int row = 16 * mt + fr; if (row < NBT) *(f32x4*)(cx.MOD() + (size_t)row * NMOD + n0 + 16 * nt + 4 * fq) = acc[mt][nt] + b4; } } }
}

__device__ __forceinline__ void lru_gate_tables(const Ctx& cx, int item) {
    const int e = item * 512 + threadIdx.x;
    const int lane = e & 63, ks = (e >> 6) & 1, nt = (e >> 7) & 7, w = e >> 10, fr = lane & 15, fq = lane >> 4;
    const float* src = (nt < 4 ? cx.I(14) : cx.I(16)) + (size_t)w * 4096 + (32 * ks + 8 * fq) * 64 + 16 * (nt & 3) + fr;
    u32x4 o; o.x = pk2(src[0], src[64]); o.y = pk2(src[128], src[192]); o.z = pk2(src[256], src[320]); o.w = pk2(src[384], src[448]);
    ((u32x4*)(cx.TAB() + T_WG))[e] = o;
    if (item == 0) cx.TAB()[T_GCD + threadIdx.x] = -8.f * 1.44269504089f * log1pf(expf(-cx.I(18)[threadIdx.x]));
}
__device__ __forceinline__ void s5_tables(const Ctx& cx, int g, LAS unsigned char* lds, int part, int nparts) {
    LAS f32x2* Ap = (LAS f32x2*)lds;
    LAS f32x2* Bb = Ap + 17 * 64;
    LAS f32x2* Cc = Bb + 1024;
    LAS f32x2* Ff = Cc + 1024;
    LAS float* Kt = (LAS float*)(Ff + 64);
    const int tid = threadIdx.x;
    float* tab = cx.TAB();
    if (tid < 64) {
        const int n = tid; const float lr = cx.I(19)[g * 64 + n], li = cx.I(20)[g * 64 + n], dt = expf(cx.I(21)[g]);
        const float mag = expf(lr * dt);
        const double ang = (double)li * (double)dt; const double kq = rint(ang * 0.63661977236758134308); const double r = ang - kq * 1.57079632679489661923; const double r2 = r * r;
        const double sn = r * (1.0 + r2 * (-1.0 / 6 + r2 * (1.0 / 120 + r2 * (-1.0 / 5040 + r2 * (1.0 / 362880 + r2 * (-1.0 / 39916800 + r2 * (1.0 / 6227020800.0)))))));
        const double cn = 1.0 + r2 * (-0.5 + r2 * (1.0 / 24 + r2 * (-1.0 / 720 + r2 * (1.0 / 40320 + r2 * (-1.0 / 3628800 + r2 * (1.0 / 479001600.0))))));
        const int q = ((int)kq) & 3; const double cv = q == 0 ? cn : q == 1 ? -sn : q == 2 ? -cn : sn, sv = q == 0 ? sn : q == 1 ? cn : q == 2 ? -sn : -cn;
        const float abr = mag * (float)cv, abi = mag * (float)sv; const float den = lr * lr + li * li;
        const float frr = ((abr - 1.f) * lr + abi * li) / den, fii = (abi * lr - (abr - 1.f) * li) / den;
        f32x2 p = (f32x2){1.f, 0.f}; Ap[n] = p;
#pragma unroll 1
        for (int t = 1; t <= 16; ++t) { const float pr = p.x * abr - p.y * abi, pi = p.x * abi + p.y * abr; p = (f32x2){pr, pi}; Ap[t * 64 + n] = p; }
        Ff[n] = (f32x2){frr, fii};
        if (part == 0) { ((f32x2*)(tab + T_ABAR))[g * 64 + n] = (f32x2){abr, abi}; ((f32x2*)(tab + T_A16))[g * 64 + n] = p; }
    }
    __syncthreads();
    for (int e = tid; e < 1024; e += 512) { const int n = e >> 4; const float br = cx.I(22)[g * 1024 + e], bi = cx.I(23)[g * 1024 + e]; const f32x2 f = Ff[n];
        const float bbr = f.x * br - f.y * bi, bbi = f.x * bi + f.y * br; Bb[e] = (f32x2){bbr, bbi}; if (part == 0) { tab[T_BBR + g * 1024 + e] = bbr; tab[T_BBI + g * 1024 + e] = bbi; }
        Cc[e] = (f32x2){cx.I(24)[g * 1024 + e], cx.I(25)[g * 1024 + e]}; }
    __syncthreads();
    { const int tau = tid >> 5, c0 = 2 * ((tid >> 2) & 7), cp0 = 4 * (tid & 3);
        float s00 = 0.f, s01 = 0.f, s02 = 0.f, s03 = 0.f, s10 = 0.f, s11 = 0.f, s12 = 0.f, s13 = 0.f;
#pragma unroll 8
        for (int n = 0; n < 64; ++n) { const f32x2 a = Ap[tau * 64 + n], q0 = Cc[c0 * 64 + n], q1 = Cc[(c0 + 1) * 64 + n];
            const f32x4 bA = *(const LAS f32x4*)(Bb + n * 16 + cp0), bB = *(const LAS f32x4*)(Bb + n * 16 + cp0 + 2);
            float pr, pi;
            pr = a.x * bA.x - a.y * bA.y; pi = a.x * bA.y + a.y * bA.x; s00 += q0.x * pr - q0.y * pi; s10 += q1.x * pr - q1.y * pi;
            pr = a.x * bA.z - a.y * bA.w; pi = a.x * bA.w + a.y * bA.z; s01 += q0.x * pr - q0.y * pi; s11 += q1.x * pr - q1.y * pi;
            pr = a.x * bB.x - a.y * bB.y; pi = a.x * bB.y + a.y * bB.x; s02 += q0.x * pr - q0.y * pi; s12 += q1.x * pr - q1.y * pi;
            pr = a.x * bB.z - a.y * bB.w; pi = a.x * bB.w + a.y * bB.z; s03 += q0.x * pr - q0.y * pi; s13 += q1.x * pr - q1.y * pi; }
        LAS float* k0 = Kt + (tau << 8) + (c0 << 4) + cp0; k0[0] = s00; k0[1] = s01; k0[2] = s02; k0[3] = s03; k0[16] = s10; k0[17] = s11; k0[18] = s12; k0[19] = s13; }
    __syncthreads();
    bf16* TFg = cx.TF() + (size_t)g * 256 * 384;
    for (int pc = tid + 512 * part; pc < 256 * 48; pc += 512 * nparts) { const int row = pc / 48, k8 = (pc % 48) * 8, j = row >> 4, c = row & 15; float v[8];
#pragma unroll
        for (int q = 0; q < 8; ++q) { const int kk = k8 + q;
            if (kk < 256) { const int s = kk >> 4, cp = kk & 15; v[q] = (j >= s) ? Kt[((j - s) << 8) + (c << 4) + cp] : 0.f; }
            else { const int n = (kk - 256) & 63; const f32x2 p = Ap[(j + 1) * 64 + n], cc = Cc[c * 64 + n]; v[q] = (kk < 320) ? (cc.x * p.x - cc.y * p.y) : (-cc.x * p.y - cc.y * p.x); } }
        u32x4 o; o.x = pk2(v[0], v[1]); o.y = pk2(v[2], v[3]); o.z = pk2(v[4], v[5]); o.w = pk2(v[6], v[7]);
        *(u32x4*)(TFg + (size_t)row * 384 + k8) = o; }
    bf16* Eg = cx.EM() + (size_t)g * 128 * 256;
    for (int pc = tid + 512 * part; pc < 128 * 32; pc += 512 * nparts) { const int np = pc >> 5, k8 = (pc & 31) * 8, n = np & 63, im = np >> 6; float v[8];
#pragma unroll
        for (int q = 0; q < 8; ++q) { const int kk = k8 + q, s = kk >> 4, cp = kk & 15; const f32x2 a = Ap[(15 - s) * 64 + n], b = Bb[n * 16 + cp];
            v[q] = im ? (a.x * b.y + a.y * b.x) : (a.x * b.x - a.y * b.y); }
        u32x4 o; o.x = pk2(v[0], v[1]); o.y = pk2(v[2], v[3]); o.z = pk2(v[4], v[5]); o.w = pk2(v[6], v[7]);
        *(u32x4*)(Eg + (size_t)np * 256 + k8) = o; }
    __syncthreads();
}

__device__ __forceinline__ void norm_mod_row(const float* xrow, const float* g, const float* sc, const float* sh, bf16* orow, int lane) {
    f32x4 v[4]; float ss = 0.f;
#pragma unroll
    for (int j = 0; j < 4; ++j) { v[j] = ((const f32x4*)xrow)[lane + 64 * j]; ss += (v[j].x * v[j].x + v[j].y * v[j].y) + (v[j].z * v[j].z + v[j].w * v[j].w); }
    const float rstd = rsqrtf(wave_sum(ss) * (1.f / DM) + EPS);
#pragma unroll
    for (int j = 0; j < 4; ++j) { const int col = 4 * (lane + 64 * j); const f32x4 gg = *(const f32x4*)(g + col), s1 = *(const f32x4*)(sc + col), s2 = *(const f32x4*)(sh + col);
        const f32x4 o = v[j] * rstd * gg * (1.f + s1) + s2; u32x2 w; w.x = pk2(o.x, o.y); w.y = pk2(o.z, o.w); *(u32x2*)(orow + col) = w; }
}

__device__ __forceinline__ void lru_local_unit(const Ctx& cx, int row0, int ntok, bool samp, int aggidx, LAS unsigned char* lds) {
    const int d = threadIdx.x, w = __builtin_amdgcn_readfirstlane(d >> 6), lane = d & 63, fr = lane & 15, fq = lane >> 4;
    LAS float* cf = (LAS float*)(lds + w * 8192);
    LAS bf16* cbf = (LAS bf16*)(lds + w * 8192 + 4608);
    bf16x8 wf[8][2];
    { const bf16x8* wg = (const bf16x8*)(cx.TAB() + T_WG) + (size_t)w * 1024 + lane;
#pragma unroll
      for (int nt = 0; nt < 8; ++nt)
#pragma unroll
          for (int ks = 0; ks < 2; ++ks) wf[nt][ks] = wg[(nt * 2 + ks) * 64]; }
    const float cw0 = cx.I(12)[d], cw1 = cx.I(12)[512 + d], cw2 = cx.I(12)[1024 + d], cw3 = cx.I(12)[1536 + d], cb = cx.I(13)[d];
    float gba[4], gbx[4], gcd[4], hc[4], cc[4];
#pragma unroll
    for (int nt = 0; nt < 4; ++nt) { const int ch = 64 * w + 16 * nt + fr; gba[nt] = cx.I(15)[ch]; gbx[nt] = cx.I(17)[ch]; gcd[nt] = cx.TAB()[T_GCD + ch]; hc[nt] = 0.f; cc[nt] = 1.f; }
    const bf16* X = cx.LRUX(); float* HL = cx.HLOC(); float* CU = cx.CUM();
    float xm3 = 0.f, xm2 = 0.f, xm1 = 0.f;
    if (!samp) { const int t0 = row0 & (SEQ - 1); if (t0 >= 3) { xm3 = bf2f(X[(size_t)(row0 - 3) * DL + d]); xm2 = bf2f(X[(size_t)(row0 - 2) * DL + d]); xm1 = bf2f(X[(size_t)(row0 - 1) * DL + d]); } }
    float xv[16];
#pragma unroll
    for (int i = 0; i < 16; ++i) xv[i] = bf2f(X[(size_t)(row0 + i) * DL + d]);
    for (int t0 = 0; t0 < ntok; t0 += 16) {
        if (samp) {
#pragma unroll
            for (int i = 0; i < 16; ++i) { const int row = row0 + t0 + i; const float* sc = cx.I(2) + (size_t)(row - MPR) * 1536 + d;
                const float cv = cb + cw0 * sc[0] + cw1 * sc[512] + cw2 * sc[1024] + cw3 * xv[i];
                cf[i * 68 + lane] = cv; cbf[i * 72 + lane] = (bf16)(pk2(cv, cv) & 0xffffu); }
        } else {
#pragma unroll
            for (int i = 0; i < 16; ++i) { const float x = xv[i]; const float cv = cb + cw0 * xm3 + cw1 * xm2 + cw2 * xm1 + cw3 * x; xm3 = xm2; xm2 = xm1; xm1 = x;
                cf[i * 68 + lane] = cv; cbf[i * 72 + lane] = (bf16)(pk2(cv, cv) & 0xffffu); }
        }
        if (t0 + 16 < ntok) {
#pragma unroll
            for (int i = 0; i < 16; ++i) xv[i] = bf2f(X[(size_t)(row0 + t0 + 16 + i) * DL + d]); }
        LDS_WAIT();
        f32x4 acc[8];
#pragma unroll
        for (int nt = 0; nt < 8; ++nt) acc[nt] = (f32x4){0.f, 0.f, 0.f, 0.f};
#pragma unroll
        for (int ks = 0; ks < 2; ++ks) { const bf16x8 af = *(const LAS bf16x8*)(cbf + fr * 72 + 32 * ks + 8 * fq);
#pragma unroll
            for (int nt = 0; nt < 8; ++nt) acc[nt] = __builtin_amdgcn_mfma_f32_16x16x32_bf16(af, wf[nt][ks], acc[nt], 0, 0, 0); }
#pragma unroll
        for (int nt = 0; nt < 4; ++nt) { const int ch = 64 * w + 16 * nt + fr;
            float av[4], hv[4]; float P = 1.f, H = 0.f;
#pragma unroll
            for (int r = 0; r < 4; ++r) { const int tok = 4 * fq + r; const float cvv = cf[tok * 68 + 16 * nt + fr];
                const float rr = sigm(acc[nt][r] + gba[nt]), ig = sigm(acc[nt + 4][r] + gbx[nt]);
                const float a = __builtin_amdgcn_exp2f(gcd[nt] * rr);
                const float bb = __builtin_amdgcn_sqrtf(fmaf(-a, a, 1.f)) * ig * cvv;
                if (samp) { const float h0 = cx.I(3)[(size_t)(row0 + t0 + tok - MPR) * DL + ch]; hv[r] = a * h0 + bb; av[r] = 0.f; }
                else { H = a * H + bb; P = P * a; hv[r] = H; av[r] = P; } }
            if (!samp) {
                const float Pown = P, Hown = H;
                float Pp = __shfl_up(P, 16), Hp = __shfl_up(H, 16); if (fq >= 1) { H = P * Hp + H; P = P * Pp; }
                Pp = __shfl_up(P, 32); Hp = __shfl_up(H, 32); if (fq >= 2) { H = P * Hp + H; P = P * Pp; }
                const float rown = __builtin_amdgcn_rcpf(Pown);
                const float Pe = P * rown, He = (H - Hown) * rown;
                const float hstart = He + Pe * hc[nt], cstart = Pe * cc[nt];
#pragma unroll
                for (int r = 0; r < 4; ++r) { hv[r] = hv[r] + av[r] * hstart; av[r] = av[r] * cstart; }
                const float Pl = __shfl(P, 48 + fr), Hl = __shfl(H, 48 + fr); hc[nt] = Hl + Pl * hc[nt]; cc[nt] = Pl * cc[nt];
            }
#pragma unroll
            for (int r = 0; r < 4; ++r) { const size_t o = (size_t)(row0 + t0 + 4 * fq + r) * DL + ch; ((unsigned*)HL)[o] = pk2(hv[r], av[r]); }
            if (nt == 1) __builtin_amdgcn_sched_barrier(0);
        }
        LDS_WAIT();
    }
    if (!samp && fq == 0) {
#pragma unroll
        for (int nt = 0; nt < 4; ++nt) cx.AGG()[(size_t)aggidx * DL + 64 * w + 16 * nt + fr] = (f32x2){cc[nt], hc[nt]}; }
}

__device__ __forceinline__ void s5_gemm_e_unit(const Ctx& cx, int unit, LAS unsigned char* lds) {
    const int tid = threadIdx.x, w = __builtin_amdgcn_readfirstlane(tid >> 6), lane = tid & 63, fr = lane & 15, fq = lane >> 4;
    const int g = unit >> 3, rg = unit & 7, cr = rg * 128 + 16 * w + fr;
    const bf16* U = cx.S5U() + (size_t)(16 * cr + (fq >> 1)) * 512 + 16 * g + 8 * (fq & 1); const bf16* Eg = cx.EM() + (size_t)g * 128 * 256;
    bf16x8 af[8];
#pragma unroll
    for (int ks = 0; ks < 8; ++ks) af[ks] = *(const bf16x8*)(U + (size_t)(2 * ks) * 512);
    __syncthreads();
    LAS bf16* Bs = (LAS bf16*)lds;
    { u32x4 t[8];
#pragma unroll
      for (int i = 0; i < 8; ++i) { const int p = tid + 512 * i; t[i] = *(const u32x4*)(Eg + (size_t)(p >> 5) * 256 + (p & 31) * 8); }
#pragma unroll
      for (int i = 0; i < 8; ++i) { const int p = tid + 512 * i; *(LAS u32x4*)(Bs + (p >> 5) * 272 + (p & 31) * 8) = t[i]; } }
    __syncthreads();
    f32x4 acc[8];
#pragma unroll
    for (int n = 0; n < 8; ++n) acc[n] = (f32x4){0.f, 0.f, 0.f, 0.f};
#pragma unroll
    for (int ks = 0; ks < 8; ++ks)
#pragma unroll
        for (int nt = 0; nt < 8; ++nt) { const bf16x8 wf = *(const LAS bf16x8*)(Bs + (16 * nt + fr) * 272 + 32 * ks + 8 * fq); acc[nt] = __builtin_amdgcn_mfma_f32_16x16x32_bf16(wf, af[ks], acc[nt], 0, 0, 0); }
    float* S = cx.SK() + ((size_t)cr * 32 + g) * 128 + 4 * fq;
#pragma unroll
    for (int nt = 0; nt < 8; ++nt) *(f32x4*)(S + 16 * nt) = acc[nt];
    __syncthreads();
}

__device__ __forceinline__ void s5_chain_item(const Ctx& cx, int item, int lane) {
    const int idx = item * 64 + lane, b = idx >> 11, g = (idx >> 6) & 31, n = idx & 63;
    const f32x2 A = ((const f32x2*)(cx.TAB() + T_A16))[g * 64 + n];
    const float* S = cx.SK() + ((size_t)(b * SNCH) * 32 + g) * 128 + n; bf16* H = cx.HIN() + ((size_t)g * SROWS + b * SNCH) * 128 + n;
    float hr = 0.f, hi = 0.f; float s0r[8], s0i[8], s1r[8], s1i[8];
#define CH_LOAD(R, I, K0) do { _Pragma("unroll") for (int i = 0; i < 8; ++i) { R[i] = S[(size_t)((K0) + i) * 4096]; I[i] = S[(size_t)((K0) + i) * 4096 + 64]; } } while (0)
#define CH_STEP(R, I, K0) do { _Pragma("unroll") for (int i = 0; i < 8; ++i) { H[(size_t)((K0) + i) * 128] = (bf16)(pk2(hr, hr) & 0xffffu); H[(size_t)((K0) + i) * 128 + 64] = (bf16)(pk2(hi, hi) & 0xffffu); \
        const float nr = A.x * hr - A.y * hi + R[i], ni = A.x * hi + A.y * hr + I[i]; hr = nr; hi = ni; } } while (0)
    CH_LOAD(s0r, s0i, 0);
    for (int k0 = 0; k0 < SNCH; k0 += 16) { CH_LOAD(s1r, s1i, k0 + 8); CH_STEP(s0r, s0i, k0); if (k0 + 16 < SNCH) CH_LOAD(s0r, s0i, k0 + 16); CH_STEP(s1r, s1i, k0 + 8); }
#undef CH_LOAD
#undef CH_STEP
    cx.out[O_S5RP + (size_t)(b * 32 + g) * 64 + n] = hr; cx.out[O_S5IP + (size_t)(b * 32 + g) * 64 + n] = hi;
}

__device__ __forceinline__ void lru_fix_unit(const Ctx& cx, int row0, int ntok, bool samp, int b, int k, LAS unsigned char* lds, int chain_item, int chain_item1) {
    const int d = threadIdx.x, w = d >> 6, lane = d & 63;
    LAS float* hs = (LAS float*)lds;
    float hin = 0.f;
    if (!samp) { const f32x2* ag = cx.AGG() + (size_t)(b * NCH) * DL + d; f32x2 pp[NCH - 1];
#pragma unroll
        for (int kk = 0; kk < NCH - 1; ++kk) pp[kk] = (kk < k) ? ag[(size_t)kk * DL] : (f32x2){1.f, 0.f};
#pragma unroll
        for (int kk = 0; kk < NCH - 1; ++kk) hin = pp[kk].x * hin + pp[kk].y; }
    hs[d] = hin;
    const bf16* X = cx.LRUX();
    if (!samp && k == NCH - 1) {
#pragma unroll
        for (int j = 0; j < 3; ++j) cx.out[O_CONVP + (size_t)(b * 3 + j) * DL + d] = bf2f(X[(size_t)(row0 + LCH - 3 + j) * DL + d]); }
    if (samp) { for (int t = 0; t < ntok; ++t) { const int sb = row0 + t - MPR; const float* sc = cx.I(2) + (size_t)sb * 1536 + d; float* o = cx.out + O_CONVS + (size_t)sb * 1536 + d;
            o[0] = sc[512]; o[512] = sc[1024]; o[1024] = bf2f(X[(size_t)(row0 + t) * DL + d]); } }
    __syncthreads();
    const float* HL = cx.HLOC(); const float* CU = cx.CUM(); const bf16* GT = cx.GATE(); bf16* MG = cx.MERGED(); const float* gl = cx.I(28);
    const f32x4 hi0 = *(const LAS f32x4*)(hs + 8 * lane), hi1 = *(const LAS f32x4*)(hs + 8 * lane + 4);
    const f32x4 g0 = *(const f32x4*)(gl + 8 * lane), g1 = *(const f32x4*)(gl + 8 * lane + 4);
    const bool with_chain = chain_item >= 0;
    if (with_chain && w == 0) { s5_chain_item(cx, chain_item, lane); asm volatile("s_waitcnt vmcnt(0)" ::: "memory"); }
    if (with_chain && w == 1) { s5_chain_item(cx, chain_item1, lane); asm volatile("s_waitcnt vmcnt(0)" ::: "memory"); }
    const int tstart = with_chain ? w - 2 : w, tstep = with_chain ? 6 : 8;
#pragma unroll 4
    for (int t = (tstart < 0 ? ntok : tstart); t < ntok; t += tstep) { const size_t ro = (size_t)(row0 + t) * DL + 8 * lane;
        const u32x4 q0 = *(const u32x4*)((const unsigned*)HL + ro), q1 = *(const u32x4*)((const unsigned*)HL + ro + 4);
        const f32x4 a0 = (f32x4){bflo(q0.x), bflo(q0.y), bflo(q0.z), bflo(q0.w)}, a1 = (f32x4){bflo(q1.x), bflo(q1.y), bflo(q1.z), bflo(q1.w)};
        const f32x4 c0 = (f32x4){bfhi(q0.x), bfhi(q0.y), bfhi(q0.z), bfhi(q0.w)}, c1 = (f32x4){bfhi(q1.x), bfhi(q1.y), bfhi(q1.z), bfhi(q1.w)};
        const u32x4 gw = *(const u32x4*)(GT + ro);
        const f32x4 h0 = a0 + c0 * hi0, h1 = a1 + c1 * hi1;
        f32x4 l0, l1;
        l0[0] = h0[0] * gelu_tanh(bflo(gw.x)); l0[1] = h0[1] * gelu_tanh(bfhi(gw.x)); l0[2] = h0[2] * gelu_tanh(bflo(gw.y)); l0[3] = h0[3] * gelu_tanh(bfhi(gw.y));
        l1[0] = h1[0] * gelu_tanh(bflo(gw.z)); l1[1] = h1[1] * gelu_tanh(bfhi(gw.z)); l1[2] = h1[2] * gelu_tanh(bflo(gw.w)); l1[3] = h1[3] * gelu_tanh(bfhi(gw.w));
        float ss = (l0[0] * l0[0] + l0[1] * l0[1]) + (l0[2] * l0[2] + l0[3] * l0[3]) + (l1[0] * l1[0] + l1[1] * l1[1]) + (l1[2] * l1[2] + l1[3] * l1[3]);
        const float rstd = rsqrtf(wave_sum(ss) * (1.f / DL) + EPS);
        *(u32x4*)(MG + (size_t)(row0 + t) * DM + 8 * lane) = pack8(l0 * rstd * g0, l1 * rstd * g1);
        if (samp) { float* o = cx.out + O_LRUS + (size_t)(row0 + t - MPR) * DL + 8 * lane; *(f32x4*)o = h0; *(f32x4*)(o + 4) = h1; }
        else if (k == NCH - 1 && t == LCH - 1) { float* o = cx.out + O_LRUP + (size_t)b * DL + 8 * lane; *(f32x4*)o = h0; *(f32x4*)(o + 4) = h1; }
    }
    __syncthreads();
}

__device__ __forceinline__ void s5_gemm_tf_unit(const Ctx& cx, int unit, LAS unsigned char* lds) {
    const int tid = threadIdx.x, w = __builtin_amdgcn_readfirstlane(tid >> 6), lane = tid & 63, fr = lane & 15, fq = lane >> 4;
    const int half = unit & 1, rq = (unit >> 1) & 3, g = unit >> 3;
    const bf16* U = cx.S5U(); const bf16* TFg = cx.TF() + ((size_t)g * 256 + 128 * half) * 384; const bf16* Hg = cx.HIN() + (size_t)g * SROWS * 128;
    __syncthreads();
    LAS bf16* Bs = (LAS bf16*)lds;
    u32x4 t[12];
#pragma unroll
    for (int i = 0; i < 12; ++i) { const int p = tid + 512 * i; t[i] = *(const u32x4*)(TFg + (size_t)(p / 48) * 384 + (p % 48) * 8); }
    bf16x8 af[2][12];
#pragma unroll
    for (int mt = 0; mt < 2; ++mt) { const int cr = rq * 256 + w * 32 + 16 * mt + fr;
#pragma unroll
        for (int ks = 0; ks < 12; ++ks)
            af[mt][ks] = (ks < 8) ? *(const bf16x8*)(U + ((size_t)(16 * cr + 2 * ks + (fq >> 1)) * 512 + 16 * g + 8 * (fq & 1))) : *(const bf16x8*)(Hg + (size_t)cr * 128 + 32 * (ks - 8) + 8 * fq); }
#pragma unroll
    for (int i = 0; i < 12; ++i) { const int p = tid + 512 * i; *(LAS u32x4*)(Bs + (p / 48) * 400 + (p % 48) * 8) = t[i]; }
    __syncthreads();
    const f32x4 d4 = *(const f32x4*)(cx.I(26) + 16 * g + 4 * fq); bf16* GY = cx.GY();
#pragma unroll
    for (int mt = 0; mt < 2; ++mt) { const int cr = rq * 256 + w * 32 + 16 * mt + fr;
        f32x4 acc[8];
#pragma unroll
        for (int n = 0; n < 8; ++n) acc[n] = (f32x4){0.f, 0.f, 0.f, 0.f};
        u32x2 uw[8];
#pragma unroll
        for (int nt = 0; nt < 8; ++nt) uw[nt] = *(const u32x2*)(U + (size_t)(16 * cr + 8 * half + nt) * 512 + 16 * g + 4 * fq);
#pragma unroll
        for (int ks = 0; ks < 12; ++ks)
#pragma unroll
            for (int nt = 0; nt < 8; ++nt) { const bf16x8 wf = *(const LAS bf16x8*)(Bs + (16 * nt + fr) * 400 + 32 * ks + 8 * fq); acc[nt] = __builtin_amdgcn_mfma_f32_16x16x32_bf16(wf, af[mt][ks], acc[nt], 0, 0, 0); }
#pragma unroll
        for (int nt = 0; nt < 8; ++nt) { const size_t off = (size_t)(16 * cr + 8 * half + nt) * 512 + 16 * g + 4 * fq;
            const f32x4 y = acc[nt] + d4 * (f32x4){bflo(uw[nt].x), bfhi(uw[nt].x), bflo(uw[nt].y), bfhi(uw[nt].y)};
            u32x2 o; o.x = pk2(gelu_tanh(y[0]), gelu_tanh(y[1])); o.y = pk2(gelu_tanh(y[2]), gelu_tanh(y[3])); *(u32x2*)(GY + off) = o; }
        __builtin_amdgcn_sched_barrier(0); }
    __syncthreads();
}
__device__ __forceinline__ void s5_sample_item(const Ctx& cx, int item, int lane) {
    const int sb = item >> 5, g = item & 31, n = lane; const int row = MPR + sb;
    const float* tab = cx.TAB(); const f32x2 A = ((const f32x2*)(tab + T_ABAR))[g * 64 + n];
    const float h0r = cx.I(4)[((size_t)sb * 32 + g) * 64 + n], h0i = cx.I(5)[((size_t)sb * 32 + g) * 64 + n];
    const bf16* up = cx.S5U() + (size_t)row * 512 + 16 * g; const u32x4 u0 = *(const u32x4*)up, u1 = *(const u32x4*)(up + 8);
    float uu[16]; uu[0] = bflo(u0.x); uu[1] = bfhi(u0.x); uu[2] = bflo(u0.y); uu[3] = bfhi(u0.y); uu[4] = bflo(u0.z); uu[5] = bfhi(u0.z); uu[6] = bflo(u0.w); uu[7] = bfhi(u0.w);
    uu[8] = bflo(u1.x); uu[9] = bfhi(u1.x); uu[10] = bflo(u1.y); uu[11] = bfhi(u1.y); uu[12] = bflo(u1.z); uu[13] = bfhi(u1.z); uu[14] = bflo(u1.w); uu[15] = bfhi(u1.w);
    float bur = 0.f, bui = 0.f; const float* br = tab + T_BBR + (size_t)(g * 64 + n) * 16; const float* bi = tab + T_BBI + (size_t)(g * 64 + n) * 16;
#pragma unroll
    for (int c4 = 0; c4 < 4; ++c4) { const f32x4 r4 = *(const f32x4*)(br + 4 * c4), i4 = *(const f32x4*)(bi + 4 * c4);
#pragma unroll
        for (int i = 0; i < 4; ++i) { bur += r4[i] * uu[4 * c4 + i]; bui += i4[i] * uu[4 * c4 + i]; } }
    const float hr = A.x * h0r - A.y * h0i + bur, hi = A.x * h0i + A.y * h0r + bui;
    cx.out[O_S5RS + ((size_t)sb * 32 + g) * 64 + n] = hr; cx.out[O_S5IS + ((size_t)sb * 32 + g) * 64 + n] = hi;
    float my = 0.f, myu = 0.f;
#pragma unroll
    for (int c = 0; c < 16; ++c) { const float v = wave_sum(cx.I(24)[((size_t)g * 16 + c) * 64 + n] * hr - cx.I(25)[((size_t)g * 16 + c) * 64 + n] * hi); if (lane == c) { my = v; myu = uu[c]; } }
    if (lane < 16) { const float y = my + cx.I(26)[16 * g + lane] * myu; cx.GY()[(size_t)row * 512 + 16 * g + lane] = (bf16)(pk2(gelu_tanh(y), 0.f) & 0xffffu); }
}

#define XB_TMO      128
#define XB_XCNT(j)  (256  + 64 * (j))
#define XB_XSUB(j)  (1280 + 64 * (j))
#define XB_XGEN(j)  (2304 + 64 * (j))
#define XB_TOP      3328
#define XB_TOPGEN   3392
#define XCD_BAR_WORDS 3456
#define XB_SPIN_CAP (1u << 18)

__device__ __forceinline__ unsigned xb_ld(unsigned* p)              { return __hip_atomic_load(p, __ATOMIC_RELAXED, __HIP_MEMORY_SCOPE_AGENT); }
__device__ __forceinline__ unsigned xb_add(unsigned* p, unsigned v) { return __hip_atomic_fetch_add(p, v, __ATOMIC_RELAXED, __HIP_MEMORY_SCOPE_AGENT); }
__device__ __forceinline__ unsigned xb_xcc_id() { return (unsigned)__builtin_amdgcn_s_getreg((3 << 11) | 20) & 0xFu; }
#define XB_SPIN(cond, bar) do { unsigned _sp = 0; while (cond) { __builtin_amdgcn_s_sleep(1); \
    if ((++_sp & 255u) == 0u) { if (xb_ld(&(bar)[XB_TMO])) break; if (_sp > XB_SPIN_CAP) { atomicAdd(&(bar)[XB_TMO], 1u); break; } } } } while (0)

struct XcdBarrier {
    unsigned* bar; unsigned x;
    volatile LAS unsigned* st;
};

__device__ __forceinline__ XcdBarrier xcd_barrier_post(unsigned* bar, volatile LAS unsigned* st) {
    XcdBarrier b; b.bar = bar; b.x = xb_xcc_id(); b.st = st;
    if (threadIdx.x == 0) (void)xb_add(&bar[XB_XCNT(b.x)], 1u);
    return b;
}
__device__ __forceinline__ void xcd_barrier_complete(unsigned* bar, unsigned x, unsigned& nloc, unsigned& nx) {
    const unsigned G = gridDim.x * gridDim.y * gridDim.z;
    unsigned sum, cnt, mine, sp = 0u;
    for (;;) {
        sum = 0u; cnt = 0u; mine = 0u;
#pragma unroll
        for (unsigned j = 0; j < 16; ++j) { const unsigned c = xb_ld(&bar[XB_XCNT(j)]); sum += c; cnt += (c > 0u) ? 1u : 0u; mine = (j == x) ? c : mine; }
        if (sum == G) break;
        __builtin_amdgcn_s_sleep(1);
        if ((++sp & 255u) == 0u) { if (xb_ld(&bar[XB_TMO])) break; if (sp > XB_SPIN_CAP) { atomicAdd(&bar[XB_TMO], 1u); break; } }
    }
    nloc = mine > 0u ? mine : 1u; nx = cnt > 0u ? cnt : 1u;
}

__device__ __forceinline__ void xcd_barrier(const XcdBarrier& b) {
    asm volatile("s_waitcnt vmcnt(0)" ::: "memory");
    __syncthreads();
    if (threadIdx.x == 0) {
        unsigned* bar = b.bar;
        __builtin_amdgcn_s_waitcnt(0);
        unsigned nloc = b.st[0], nx = b.st[1];
        if (nloc == 0u) { xcd_barrier_complete(bar, b.x, nloc, nx); b.st[0] = nloc; b.st[1] = nx; }
        const unsigned old = xb_add(&bar[XB_XSUB(b.x)], 1u);
        const unsigned gen = old / nloc;
        if (old + 1u == (gen + 1u) * nloc) {
            __builtin_amdgcn_fence(__ATOMIC_RELEASE, "agent");
            asm volatile("s_waitcnt vmcnt(0)" ::: "memory");
            const unsigned og = xb_add(&bar[XB_TOP], 1u);
            const unsigned tg = og / nx;
            if (og + 1u == (tg + 1u) * nx) xb_add(&bar[XB_TOPGEN], 1u);
            else XB_SPIN(xb_ld(&bar[XB_TOPGEN]) == tg, bar);
            __builtin_amdgcn_fence(__ATOMIC_ACQUIRE, "agent");
            xb_add(&bar[XB_XGEN(b.x)], 1u);
            asm volatile("s_waitcnt vmcnt(0)" ::: "memory");
        } else {
            XB_SPIN(xb_ld(&bar[XB_XGEN(b.x)]) == gen, bar);
            __builtin_amdgcn_fence(__ATOMIC_ACQUIRE, "agent");
            asm volatile("s_waitcnt vmcnt(0)" ::: "memory");
        }
    }
    __syncthreads();
}

__global__ void __launch_bounds__(512, 2) fwd_kernel(KArgs a) {
    extern __shared__ __attribute__((aligned(16))) unsigned char lds_raw[];
    LAS unsigned char* lds = (LAS unsigned char*)lds_raw;
    Ctx cx; cx.in = a.in; cx.out = a.out; cx.ws = a.ws;
    const int tid = threadIdx.x, lane = tid & 63, wave = __builtin_amdgcn_readfirstlane(tid >> 6);
    const int G = gridDim.x, bid = blockIdx.x, gw = bid * 8 + wave, NGW = G * 8;
    volatile LAS unsigned* bst = (volatile LAS unsigned*)(lds + 131072);
    if (tid < 16) bst[tid] = 0u;
    __syncthreads();
    XcdBarrier xbar = xcd_barrier_post((unsigned*)a.ws, bst);
#ifndef REPMASK
#define REPMASK 0
#endif
#ifndef PHMASK
#define PHMASK 0x1fff
#endif
#define IN(k) (((PHMASK >> (k)) & 1) && a.lo <= (k) && (k) < a.hi)
#ifndef PROBE_LO
#define PROBE_LO -1
#define PROBE_HI -1
#endif
    unsigned long long pt0 = 0;
#define PSTART(k) do { if ((k) == PROBE_LO && bid == 0 && tid == 0) pt0 = __builtin_amdgcn_s_memrealtime(); } while (0)
#define PEND(k) do { if ((k) == PROBE_HI && bid == 0) { if (tid == 0) { const unsigned long long t1 = __builtin_amdgcn_s_memrealtime(); const unsigned long long d = t1 - pt0; while (__builtin_amdgcn_s_memrealtime() - t1 < d) __builtin_amdgcn_s_sleep(8); } __syncthreads(); } } while (0)
#define SEAM(k) do { if (IN(k) && IN((k) + 1)) xcd_barrier(xbar); PEND(k); PSTART((k) + 1); } while (0)

    PSTART(0);
    if (IN(0)) for (int rep_ = 0; rep_ < 1 + ((REPMASK >> 0) & 1); ++rep_) {
        if (bid >= 32 && bid < 224) ada_block(cx, bid - 32, lds);
        else { LAS bf16* scr = (LAS bf16*)(lds + wave * 16384); const int w2 = (bid < 32 ? bid : bid - 192) * 8 + wave;
            for (int it = w2; it < 384; it += 512) transpose_dispatch(cx, it, scr, lane);
            if (bid < 16) lru_gate_tables(cx, bid); }
    }
    SEAM(0);
    if (IN(1)) for (int rep_ = 0; rep_ < 1 + ((REPMASK >> 1) & 1); ++rep_) {
        for (int r = gw; r < MTOK; r += 2 * NGW) { const int r2 = r + NGW; const bool two = r2 < MTOK; const int rb = two ? r2 : r;
            const float* xa = r < MPR ? cx.I(0) + (size_t)r * DM : cx.I(1) + (size_t)(r - MPR) * DM; const float* xb = rb < MPR ? cx.I(0) + (size_t)rb * DM : cx.I(1) + (size_t)(rb - MPR) * DM;
            const float* ma = cx.MOD() + (size_t)mod_row(r) * NMOD; const float* mb = cx.MOD() + (size_t)mod_row(rb) * NMOD; const float* g = cx.I(10);
            f32x4 va[4], vb[4], gg[4], sca[4], sha[4], scb[4], shb[4]; float sa = 0.f, sb = 0.f;
#pragma unroll
            for (int j = 0; j < 4; ++j) { va[j] = ((const f32x4*)xa)[lane + 64 * j]; vb[j] = ((const f32x4*)xb)[lane + 64 * j]; }
#pragma unroll
            for (int j = 0; j < 4; ++j) { const int col = 4 * (lane + 64 * j);
                gg[j] = *(const f32x4*)(g + col); sca[j] = *(const f32x4*)(ma + 1024 + col); sha[j] = *(const f32x4*)(ma + col); scb[j] = *(const f32x4*)(mb + 1024 + col); shb[j] = *(const f32x4*)(mb + col); }
#pragma unroll
            for (int j = 0; j < 4; ++j) { sa += (va[j].x * va[j].x + va[j].y * va[j].y) + (va[j].z * va[j].z + va[j].w * va[j].w); sb += (vb[j].x * vb[j].x + vb[j].y * vb[j].y) + (vb[j].z * vb[j].z + vb[j].w * vb[j].w); }
#pragma unroll
            for (int o = 1; o < 64; o <<= 1) { sa += __shfl_xor(sa, o); sb += __shfl_xor(sb, o); }
            const float ra = rsqrtf(sa * (1.f / DM) + EPS), rbs = rsqrtf(sb * (1.f / DM) + EPS);
#pragma unroll
            for (int j = 0; j < 4; ++j) { const int col = 4 * (lane + 64 * j);
                const f32x4 oa = va[j] * ra * gg[j] * (1.f + sca[j]) + sha[j]; u32x2 w; w.x = pk2(oa.x, oa.y); w.y = pk2(oa.z, oa.w); *(u32x2*)(cx.XN() + (size_t)r * DM + col) = w;
                if (two) { const f32x4 ob = vb[j] * rbs * gg[j] * (1.f + scb[j]) + shb[j]; u32x2 w2; w2.x = pk2(ob.x, ob.y); w2.y = pk2(ob.z, ob.w); *(u32x2*)(cx.XN() + (size_t)rb * DM + col) = w2; } } }
    }
    SEAM(1);
    if (IN(2)) for (int rep_ = 0; rep_ < 1 + ((REPMASK >> 2) & 1); ++rep_) {
        pg8::Gemm g{cx.XN(), cx.WIN(), MPAD, NPROJ, DM}; Sched2 S; S.init(NPROJ, DM, G, bid, DM / 64);
        EpiProj E{cx.LRUX(), cx.GATE(), cx.S5U()};
        pg8::gemm_phase<EpiProj, Sched2, true, true>(lds, g, S, E);
        for (int q_ = 0; q_ < 1 + ((REPMASK >> 15) & 1); ++q_)
        if (bid >= 134 && bid < 198) s5_tables(cx, (bid - 134) >> 1, lds, (bid - 134) & 1, 2);
        for (int q_ = 0; q_ < 1 + ((REPMASK >> 12) & 1); ++q_)
        if (bid >= 198) { LAS bf16* scr = (LAS bf16*)(lds + wave * 16384);
            for (int it = 384 + (255 - bid) * 8 + wave; it < N_TR_ITEMS; it += 58 * 8) transpose_dispatch(cx, it, scr, lane); }
    }
    SEAM(2);
    if (IN(3)) for (int rep_ = 0; rep_ < 1 + ((REPMASK >> 3) & 1); ++rep_) {
#ifndef NO_LRU
        for (int q_ = 0; q_ < 1 + ((REPMASK >> 13) & 1); ++q_)
        for (int u = bid; u < 256 + NBS / SCH; u += G) {
            if (u < 256) lru_local_unit(cx, u * LCH, LCH, false, u, lds); else lru_local_unit(cx, MPR + (u - 256) * SCH, SCH, true, 0, lds);
        }
#endif
#ifndef NO_E
        for (int q_ = 0; q_ < 1 + ((REPMASK >> 14) & 1); ++q_)
        if (G == 256) { if (bid >= 8) { s5_gemm_e_unit(cx, bid, lds); if (bid < 16) s5_gemm_e_unit(cx, bid - 8, lds); } }
        else for (int u = bid; u < 256; u += G) s5_gemm_e_unit(cx, u, lds);
#endif
    }
    SEAM(3);
    if (IN(4)) for (int rep_ = 0; rep_ < 1 + ((REPMASK >> 4) & 1); ++rep_) {
        for (int u = bid; u < 256 + NBS / SCH; u += G) {
            const int cg = bid >> 3, cb0 = 2 * ((bid >> 1) & 3);
            if (u < 256) lru_fix_unit(cx, u * LCH, LCH, false, u >> 5, u & 31, lds, (u == bid && G == 256) ? cb0 * 32 + cg : -1, (cb0 + 1) * 32 + cg); else lru_fix_unit(cx, MPR + (u - 256) * SCH, SCH, true, 0, 0, lds, -1, -1);
        }
        for (int u = bid; u < 256; u += G) s5_gemm_tf_unit(cx, u, lds);
        for (int it = gw; it < NBS * 32; it += NGW) s5_sample_item(cx, it, lane);
    }
    SEAM(5);
    if (IN(6)) for (int rep_ = 0; rep_ < 1 + ((REPMASK >> 6) & 1); ++rep_) {
        pg8::Gemm g{cx.GY(), cx.WGLU(), MPAD, 1024, 512}; Sched3 S; S.init(1024, 512, G, bid, 2);
        EpiGluNorm E{cx.MERGED(), cx.I(29), cx.PART(), (unsigned*)cx.ws + 3584, RmsPanel{(float*)(cx.ws + WS_XSLOT), (unsigned*)cx.ws + 4096, 1.f / 512, EPS}};
        pg8::gemm_phase<EpiGluNorm, Sched3, true, true>(lds, g, S, E);
        if (bid >= 240) { wait_partials((unsigned*)cx.ws + 3584, 16u * 8u);
            const float* gs = cx.I(29); const int r = MPR + (bid - 240) * 8 + wave;
            const float* pp = cx.PART() + (size_t)(r - MPR) * 1024; const int c0 = 4 * lane, ca0 = 256 * (c0 >> 7) + (c0 & 127), ca1 = ca0 + 512;
            f32x4 a0 = (f32x4){0.f, 0.f, 0.f, 0.f}, b0 = a0, a1 = a0, b1 = a0, v0, v1;
#pragma unroll
            for (int sl = 0; sl < 4; ++sl) { const float* q = pp + (size_t)sl * 128 * 1024; a0 += *(const f32x4*)(q + ca0); b0 += *(const f32x4*)(q + ca0 + 128); a1 += *(const f32x4*)(q + ca1); b1 += *(const f32x4*)(q + ca1 + 128); }
#pragma unroll
            for (int i = 0; i < 4; ++i) { v0[i] = a0[i] * sigm(b0[i]); v1[i] = a1[i] * sigm(b1[i]); }
            const float ss = (v0.x * v0.x + v0.y * v0.y) + (v0.z * v0.z + v0.w * v0.w) + (v1.x * v1.x + v1.y * v1.y) + (v1.z * v1.z + v1.w * v1.w);
            const float rstd = rsqrtf(wave_sum(ss) * (1.f / 512) + EPS);
            const f32x4 o0 = v0 * rstd * ((const f32x4*)gs)[lane], o1 = v1 * rstd * ((const f32x4*)gs)[lane + 64];
            bf16* mp = cx.MERGED() + (size_t)r * DM + 512; u32x2 w0, w1; w0.x = pk2(o0.x, o0.y); w0.y = pk2(o0.z, o0.w); w1.x = pk2(o1.x, o1.y); w1.y = pk2(o1.z, o1.w);
            *(u32x2*)(mp + 4 * lane) = w0; *(u32x2*)(mp + 256 + 4 * lane) = w1; }
    }
    SEAM(7);
    if (IN(8)) for (int rep_ = 0; rep_ < 1 + ((REPMASK >> 8) & 1); ++rep_) {
        pg8::Gemm g{cx.MERGED(), cx.WOUT(), MPAD, DM, DM}; Sched3 S; S.init(DM, DM, G, bid, 2);
        EpiResNorm<1> E{cx.I(0), cx.MOD(), cx.I(31), cx.out, cx.XN2(), cx.X1B(), cx.PART(), (unsigned*)cx.ws + 3648, RmsPanel{(float*)(cx.ws + WS_XSLOT + 262144), (unsigned*)cx.ws + 8192, 1.f / DM, EPS}};
        pg8::gemm_phase<EpiResNorm<1>, Sched3, true, true>(lds, g, S, E);
        if (bid >= 192) { if (wave == 0) wait_partials((unsigned*)cx.ws + 3648, 32u * 8u);
            __syncthreads();
            const int r = MPR + (bid - 192) * 2 + (wave >> 2), col = 256 * (wave & 3) + 4 * lane; const float* md = cx.MOD() + (size_t)mod_row(r) * NMOD;
            const float* pp = cx.PART() + (size_t)(r - MPR) * 1024 + col; f32x4 sm = (f32x4){0.f, 0.f, 0.f, 0.f};
            f32x4 v = *(const f32x4*)(cx.I(1) + (size_t)(r - MPR) * DM + col); const f32x4 g1v = *(const f32x4*)(md + 2048 + col), gn = *(const f32x4*)(cx.I(31) + col), sc = *(const f32x4*)(md + 4096 + col), sh = *(const f32x4*)(md + 3072 + col);
#pragma unroll
            for (int sl = 0; sl < 8; ++sl) sm += *(const f32x4*)(pp + (size_t)sl * 128 * 1024);
            v += g1v * sm;
            *(f32x4*)(cx.out + (size_t)r * DM + col) = v;
            const float ssw = wave_sum((v.x * v.x + v.y * v.y) + (v.z * v.z + v.w * v.w));
            LAS float* red = (LAS float*)lds;
            if (lane == 0) red[wave] = ssw;
            __syncthreads();
            const int w0 = wave & 4; const float ss = (red[w0] + red[w0 + 1]) + (red[w0 + 2] + red[w0 + 3]);
            const float rstd = rsqrtf(ss * (1.f / DM) + EPS);
            const f32x4 o = v * rstd * gn * (1.f + sc) + sh; u32x2 w; w.x = pk2(o.x, o.y); w.y = pk2(o.z, o.w); *(u32x2*)(cx.XN2() + (size_t)r * DM + col) = w; }
    }
    SEAM(9);
    if (IN(10)) for (int rep_ = 0; rep_ < 1 + ((REPMASK >> 10) & 1); ++rep_) {
        pg8::Gemm g{cx.XN2(), cx.WGU(), MPAD, 2 * DFF, DM}; Sched2 S; S.init(2 * DFF, DM, G, bid, DM / 64);
        EpiSwiglu E{cx.HB()};
        pg8::gemm_phase<EpiSwiglu, Sched2, true, true>(lds, g, S, E);
    }
    SEAM(10);
    if (IN(11)) for (int rep_ = 0; rep_ < 1 + ((REPMASK >> 11) & 1); ++rep_) {
        pg8::Gemm g{cx.HB(), cx.WDN(), MPAD, DM, DFF}; Sched3 S; S.init(DM, DFF, G, bid, 2);
        EpiResNorm<2> E{nullptr, cx.MOD(), cx.I(35), cx.out, nullptr, cx.X1B(), cx.PART(), (unsigned*)cx.ws + 3712, RmsPanel{(float*)(cx.ws + WS_XSLOT + 524288), (unsigned*)cx.ws + 12288, 1.f / DM, EPS}};
        pg8::gemm_phase<EpiResNorm<2>, Sched3, true, true>(lds, g, S, E);
        if (bid >= 192) { if (wave == 0) wait_partials((unsigned*)cx.ws + 3712, 88u * 8u);
            __syncthreads();
            const float* fg = cx.I(35); const int r = MPR + (bid - 192) * 2 + (wave >> 2), col = 256 * (wave & 3) + 4 * lane; float* xr = cx.out + (size_t)r * DM + col;
            const float* pp = cx.PART() + (size_t)(r - MPR) * 1024 + col; f32x4 sm = (f32x4){0.f, 0.f, 0.f, 0.f};
            f32x4 v = *(const f32x4*)xr; const f32x4 g2v = *(const f32x4*)(cx.MOD() + (size_t)mod_row(r) * NMOD + 5120 + col), fgv = *(const f32x4*)(fg + col);
#pragma unroll
            for (int sl = 0; sl < 22; ++sl) sm += *(const f32x4*)(pp + (size_t)sl * 128 * 1024);
            v += g2v * sm;
            const float ssw = wave_sum((v.x * v.x + v.y * v.y) + (v.z * v.z + v.w * v.w));
            LAS float* red = (LAS float*)lds;
            if (lane == 0) red[wave] = ssw;
            __syncthreads();
            const int w0 = wave & 4; const float ss = (red[w0] + red[w0 + 1]) + (red[w0 + 2] + red[w0 + 3]);
            const float rstd = rsqrtf(ss * (1.f / DM) + EPS);
            *(f32x4*)xr = v * rstd * fgv; }
    }
    PEND(12);
#undef IN
#undef SEAM
}

constexpr int LDS_BYTES = 131072 + 256;
#ifndef MK_SINGLE
#define MK_SINGLE 1
#endif
extern "C" void kernel_launch(void* const* d_in, const int* in_sizes, int n_in, void* d_out, int out_size, void* d_ws, size_t ws_size, hipStream_t stream) {
    static int grid = 0;
    if (grid == 0) {
        if (n_in != 36 || (size_t)out_size != O_END || ws_size < WS_END) { fprintf(stderr, "kernel_launch: unexpected shapes n_in %d out %d ws %zu\n", n_in, out_size, ws_size); grid = -1; return; }
        int dev = 0, cus = 0, per_cu = 0;
        hipGetDevice(&dev); hipDeviceGetAttribute(&cus, hipDeviceAttributeMultiprocessorCount, dev);
        hipFuncSetAttribute((const void*)fwd_kernel, hipFuncAttributeMaxDynamicSharedMemorySize, LDS_BYTES);
        hipOccupancyMaxActiveBlocksPerMultiprocessor(&per_cu, (const void*)fwd_kernel, 512, LDS_BYTES);
        if (per_cu < 1) { fprintf(stderr, "kernel_launch: occupancy query says %d blocks per CU\n", per_cu); grid = -1; return; }
        if (cus != 256) { fprintf(stderr, "kernel_launch: built for 256 CUs (one 256x256 unit per workgroup in the fused-norm GEMM phases), found %d\n", cus); grid = -1; return; }
        grid = cus;
    }
    if (grid < 0) return;
    if (hipMemsetAsync(d_ws, 0, 65536, stream) != hipSuccess) { fprintf(stderr, "kernel_launch: memset of the barrier words failed\n"); return; }
    KArgs a{};
    for (int i = 0; i < 36; ++i) a.in[i] = (const float*)d_in[i];
    a.out = (float*)d_out; a.ws = (unsigned char*)d_ws;
#if MK_SINGLE
    a.lo = 0; a.hi = NPHASE;
    void* args[] = {&a};
#ifdef PLAIN_LAUNCH
    hipLaunchKernelGGL(fwd_kernel, dim3(grid), dim3(512), LDS_BYTES, stream, a); hipError_t e = hipPeekAtLastError(); (void)args;
#else
    hipError_t e = hipLaunchCooperativeKernel((const void*)fwd_kernel, dim3(grid), dim3(512), args, LDS_BYTES, stream);
#endif
    if (e != hipSuccess) fprintf(stderr, "cooperative launch failed: %s (grid %d)\n", hipGetErrorString(e), grid);
#else
    for (int p = 0; p < NPHASE; ++p) { a.lo = p; a.hi = p + 1; hipLaunchKernelGGL(fwd_kernel, dim3(grid), dim3(512), LDS_BYTES, stream, a); }
#endif
}
```

```cpp
#include <hip/hip_runtime.h>
#include <hip/hip_cooperative_groups.h>
#include <cstdio>
#include <cstdint>
namespace cg = cooperative_groups;
namespace pg8 {
#define PG8_LAS __attribute__((address_space(3)))
typedef unsigned short bf16_t;
typedef short bf16x8 __attribute__((ext_vector_type(8)));
typedef float f32x4 __attribute__((ext_vector_type(4)));
typedef unsigned u32x4 __attribute__((ext_vector_type(4)));
constexpr int BM = 256, BK = 64, HALF = 128, HTB = HALF * BK * 2  , STAGE_BYTES = 8 * HTB, NXCD = 8, WGM = 8;

__host__ __device__ __forceinline__ int lds_byte(int r, int c) { const int st = (r >> 4) * 2 + (c >> 5), rr = r & 15, cc = c & 31, ob = rr * 64 + cc * 2; return st * 1024 + (ob ^ (((ob >> 9) & 1) << 5)); }
__host__ __device__ __forceinline__ void stage_rc(int b, int& R, int& C) { const int st = b / 1024, sb = b % 1024, swz = sb ^ (((sb >> 9) & 1) << 5); R = (st >> 1) * 16 + swz / 64; C = (st & 1) * 32 + (swz % 64) / 2; }
__host__ __device__ __forceinline__ int perm32(int rho) { const int n = rho >> 4, i = rho & 15; return 8 * (i >> 2) + 4 * n + (i & 3); }

struct Unit { int pm, pn, kt0, nkt, kind, slice; };
struct Gemm { const bf16_t* A; const bf16_t* Bt; int M, N, K; };

struct StaticOrder {
    int nM, nN, nwg, G, c;
    __host__ __device__ __forceinline__ void init(int M, int N, int G_, int c_) { nM = M / BM; nN = N / BM; nwg = nM * nN; G = G_; c = c_; }
    __host__ __device__ __forceinline__ bool next(int i, Unit& u) const {
        const long L = (long)i * G + c; if (L >= nwg) return false;
        int wgid = (int)L; { const int q = nwg / NXCD, r = nwg % NXCD, xcd = wgid % NXCD, off = wgid / NXCD; wgid = (xcd < r ? xcd * (q + 1) : r * (q + 1) + (xcd - r) * q) + off; }
        const int nig = WGM * nN, gid = wgid / nig, fm = gid * WGM, gsz = (nM - fm) < WGM ? (nM - fm) : WGM;
        u.pm = fm + ((wgid % nig) % gsz); u.pn = (wgid % nig) / gsz; return true;
    }
    __device__ __forceinline__ void a_ready(const Unit&) const {}
    __device__ __forceinline__ void done(const Unit&) const {}
};

__device__ __forceinline__ unsigned cvt_pk_bf16(float lo, float hi) { unsigned r; asm("v_cvt_pk_bf16_f32 %0, %1, %2" : "=v"(r) : "v"(lo), "v"(hi)); return r; }
typedef float f32x2 __attribute__((ext_vector_type(2)));
template <class Epi, class Sched, bool ALIGN_EPI = false, bool SP2 = false>
__device__ __forceinline__ void gemm_phase(PG8_LAS unsigned char* lds, const Gemm g, const Sched& S, const Epi& E) {
    const int tid = threadIdx.x, wid = __builtin_amdgcn_readfirstlane(tid >> 6), lane = tid & 63, wr = wid >> 2, wc = wid & 3, fr = lane & 15, fq = lane >> 4;
    const int K = g.K;
    unsigned voffA[2], voffB[2];
#pragma unroll
    for (int i = 0; i < 2; ++i) { int R, C; stage_rc(tid * 16 + i * 8192, R, C); const int Rb = Epi::PERM ? ((R & ~31) + perm32(R & 31)) : R;
        voffA[i] = (unsigned)(R * K + C) * 2u; voffB[i] = (unsigned)(Rb * K + C) * 2u; }
    const size_t kstep = (size_t)(BK * 2);
    const size_t hstep = (size_t)HALF * K * 2;
    const size_t tstep = 2 * hstep;
    const unsigned ldsw = (unsigned)wid * 1024u;
    const int aoff = lds_byte(wr * 64 + fr, fq * 8), boff = lds_byte(wc * 32 + fr, fq * 8);
#define PG8_SA(b, h) (((b) * 2 + (h)) * HTB)
#define PG8_SB(b, h) ((4 + (b) * 2 + (h)) * HTB)
#define PG8_STAGE(bufoff, gbase, voff) do { _Pragma("unroll") for (int _i = 0; _i < 2; ++_i) \
        __builtin_amdgcn_global_load_lds((const unsigned*)((const char*)(gbase) + (voff)[_i]), (PG8_LAS unsigned*)(lds + (bufoff) + ldsw + _i * 8192), 16, 0, 0); } while (0)
#define PG8_LDA(dst, b, h) do { _Pragma("unroll") for (int m = 0; m < 4; ++m) _Pragma("unroll") for (int k = 0; k < 2; ++k) dst[m][k] = *(const PG8_LAS bf16x8*)(lds + PG8_SA(b, h) + aoff + m * 2048 + k * 1024); } while (0)
#define PG8_LDB(dst, b, h) do { _Pragma("unroll") for (int n = 0; n < 2; ++n) _Pragma("unroll") for (int k = 0; k < 2; ++k) dst[n][k] = *(const PG8_LAS bf16x8*)(lds + PG8_SB(b, h) + boff + n * 2048 + k * 1024); } while (0)
#define PG8_MMA(ai, bj, At, Bt) do { __builtin_amdgcn_s_setprio(1); _Pragma("unroll") for (int m = 0; m < 4; ++m) _Pragma("unroll") for (int n = 0; n < 2; ++n) _Pragma("unroll") for (int k = 0; k < 2; ++k) \
        acc[ai][bj][m][n] = __builtin_amdgcn_mfma_f32_16x16x32_bf16(Bt[n][k], At[m][k], acc[ai][bj][m][n], 0, 0, 0); __builtin_amdgcn_s_setprio(0); } while (0)
#define PG8_WAIT_V(n) asm volatile("s_waitcnt vmcnt(" #n ")" ::: "memory")
#define PG8_WAIT_L(n) asm volatile("s_waitcnt lgkmcnt(" #n ")" ::: "memory")
#define PG8_BAR __builtin_amdgcn_s_barrier()
#define PG8_SCHED __builtin_amdgcn_sched_barrier(0)
    Unit cur = {0, 0, 0, 0, 0, 0}, nxt = {0, 0, 0, 0, 0, 0}; int ui = 0;
    if (!S.next(0, cur)) return;
    f32x4 acc[2][2][4][2];
#pragma unroll
    for (int a = 0; a < 2; ++a)
#pragma unroll
        for (int b = 0; b < 2; ++b)
#pragma unroll
            for (int m = 0; m < 4; ++m)
#pragma unroll
                for (int n = 0; n < 2; ++n) acc[a][b][m][n] = (f32x4){0.f, 0.f, 0.f, 0.f};
    bf16x8 At[4][2], B0[2][2], B1[2][2];
    const char* cA = (const char*)g.A + (size_t)cur.pm * tstep + (size_t)cur.kt0 * kstep; const char* cB = (const char*)g.Bt + (size_t)cur.pn * tstep + (size_t)cur.kt0 * kstep;
    S.a_ready(cur);
    if constexpr (SP2) {
        PG8_STAGE(PG8_SB(0, 0), cB, voffB); PG8_STAGE(PG8_SB(0, 1), cB + hstep, voffB); PG8_STAGE(PG8_SA(0, 0), cA, voffA); PG8_STAGE(PG8_SA(0, 1), cA + hstep, voffA);
        if (wr == 1) PG8_BAR;
        PG8_WAIT_V(2); PG8_BAR;
        PG8_STAGE(PG8_SB(1, 0), cB + kstep, voffB); PG8_STAGE(PG8_SA(1, 0), cA + kstep, voffA); PG8_STAGE(PG8_SB(1, 1), cB + hstep + kstep, voffB);
        PG8_WAIT_V(6); PG8_BAR;
    } else {
        PG8_STAGE(PG8_SB(0, 0), cB, voffB); PG8_STAGE(PG8_SA(0, 0), cA, voffA); PG8_STAGE(PG8_SB(0, 1), cB + hstep, voffB); PG8_STAGE(PG8_SA(0, 1), cA + hstep, voffA);
        if (wr == 1) PG8_BAR;
        PG8_WAIT_V(4); PG8_BAR;
        PG8_STAGE(PG8_SB(1, 0), cB + kstep, voffB); PG8_STAGE(PG8_SA(1, 0), cA + kstep, voffA); PG8_STAGE(PG8_SB(1, 1), cB + hstep + kstep, voffB);
        PG8_WAIT_V(6); PG8_BAR;
    }
    for (;;) {
        const bool has_next = S.next(ui + 1, nxt);
        const char* nA = has_next ? (const char*)g.A + (size_t)nxt.pm * tstep + (size_t)nxt.kt0 * kstep : cA; const char* nB = has_next ? (const char*)g.Bt + (size_t)nxt.pn * tstep + (size_t)nxt.kt0 * kstep : cB;
        const int nt = cur.nkt;
        for (int t = 0; t < nt; t += 2) {
            const bool last = (t == nt - 2);
            const char* a1 = cA + (size_t)(t + 1) * kstep;
            const char* a2 = last ? nA : cA + (size_t)(t + 2) * kstep; const char* b2 = last ? nB : cB + (size_t)(t + 2) * kstep;
            const char* a3 = a2 + kstep; const char* b3 = b2 + kstep;
            if (last && has_next) S.a_ready(nxt);
            if constexpr (SP2) {
            PG8_LDB(B0, 0, 0); PG8_LDB(B1, 0, 1); PG8_SCHED; PG8_LDA(At, 0, 0); PG8_STAGE(PG8_SA(1, 1), a1 + hstep, voffA);
            PG8_WAIT_V(8); PG8_WAIT_L(0); PG8_BAR; PG8_MMA(0, 0, At, B0); PG8_MMA(0, 1, At, B1); PG8_BAR; PG8_SCHED;
            PG8_LDA(At, 0, 1); PG8_STAGE(PG8_SB(0, 0), b2, voffB); PG8_STAGE(PG8_SB(0, 1), b2 + hstep, voffB); PG8_STAGE(PG8_SA(0, 0), a2, voffA);
            PG8_WAIT_V(8); PG8_WAIT_L(0); PG8_BAR; PG8_MMA(1, 0, At, B0); PG8_MMA(1, 1, At, B1); PG8_BAR; PG8_SCHED;
            PG8_LDB(B0, 1, 0); PG8_LDB(B1, 1, 1); PG8_SCHED; PG8_LDA(At, 1, 0); PG8_STAGE(PG8_SA(0, 1), a2 + hstep, voffA);
            PG8_WAIT_V(8); PG8_WAIT_L(0); PG8_BAR; PG8_MMA(0, 0, At, B0); PG8_MMA(0, 1, At, B1); PG8_BAR; PG8_SCHED;
            PG8_LDA(At, 1, 1); PG8_STAGE(PG8_SB(1, 0), b3, voffB); PG8_STAGE(PG8_SB(1, 1), b3 + hstep, voffB); PG8_STAGE(PG8_SA(1, 0), a3, voffA);
            PG8_WAIT_V(8); PG8_WAIT_L(0); PG8_BAR; PG8_MMA(1, 0, At, B0); PG8_MMA(1, 1, At, B1); PG8_BAR; PG8_SCHED;
            } else {
            PG8_LDB(B0, 0, 0); PG8_SCHED; PG8_LDA(At, 0, 0); PG8_STAGE(PG8_SA(1, 1), a1 + hstep, voffA);
            PG8_WAIT_L(8); PG8_BAR; PG8_WAIT_L(0); PG8_MMA(0, 0, At, B0); PG8_BAR; PG8_SCHED;
            PG8_LDB(B1, 0, 1); PG8_STAGE(PG8_SB(0, 0), b2, voffB);
            PG8_BAR; PG8_WAIT_L(0); PG8_MMA(0, 1, At, B1); PG8_BAR;
            PG8_LDA(At, 0, 1); PG8_STAGE(PG8_SA(0, 0), a2, voffA);
            PG8_BAR; PG8_WAIT_L(0); PG8_MMA(1, 0, At, B0); PG8_BAR; PG8_SCHED;
            PG8_STAGE(PG8_SB(0, 1), b2 + hstep, voffB);
            PG8_WAIT_V(6); PG8_BAR; PG8_MMA(1, 1, At, B1); PG8_BAR;
            PG8_LDB(B0, 1, 0); PG8_SCHED; PG8_LDA(At, 1, 0); PG8_STAGE(PG8_SA(0, 1), a2 + hstep, voffA);
            PG8_WAIT_L(8); PG8_BAR; PG8_WAIT_L(0); PG8_MMA(0, 0, At, B0); PG8_BAR; PG8_SCHED;
            PG8_LDB(B1, 1, 1); PG8_STAGE(PG8_SB(1, 0), b3, voffB);
            PG8_BAR; PG8_WAIT_L(0); PG8_MMA(0, 1, At, B1); PG8_BAR;
            PG8_LDA(At, 1, 1); PG8_STAGE(PG8_SA(1, 0), a3, voffA);
            PG8_BAR; PG8_WAIT_L(0); PG8_MMA(1, 0, At, B0); PG8_BAR; PG8_SCHED;
            PG8_STAGE(PG8_SB(1, 1), b3 + hstep, voffB);
            PG8_WAIT_V(6); PG8_BAR; PG8_MMA(1, 1, At, B1); PG8_BAR;
            }
        }
        if constexpr (ALIGN_EPI) { if (wr == 0) PG8_BAR; }
        if constexpr (!Epi::AFTER_DRAIN) { E(acc, cur, wr, wc, fr, fq); S.done(cur); } else { if (has_next) E(acc, cur, wr, wc, fr, fq); }
        if (!has_next) break;
#pragma unroll
        for (int a = 0; a < 2; ++a)
#pragma unroll
            for (int b = 0; b < 2; ++b)
#pragma unroll
                for (int m = 0; m < 4; ++m)
#pragma unroll
                    for (int n = 0; n < 2; ++n) acc[a][b][m][n] = (f32x4){0.f, 0.f, 0.f, 0.f};
        cur = nxt; cA = nA; cB = nB; ++ui;
        if constexpr (ALIGN_EPI) { if (wr == 1) PG8_BAR; }
    }
    PG8_WAIT_V(0);
    if constexpr (!ALIGN_EPI) { if (wr == 0) PG8_BAR; }
    PG8_BAR;
    if constexpr (Epi::AFTER_DRAIN) { E.fused(acc, cur, wr, wc, fr, fq, lds, wid, lane); S.done(cur); }
#undef PG8_SA
#undef PG8_SB
#undef PG8_STAGE
#undef PG8_LDA
#undef PG8_LDB
#undef PG8_MMA
#undef PG8_WAIT_V
#undef PG8_WAIT_L
#undef PG8_BAR
#undef PG8_SCHED
}
}

#define LAS __attribute__((address_space(3)))
typedef unsigned short bf16;
typedef float f32x4 __attribute__((ext_vector_type(4)));
typedef float f32x2 __attribute__((ext_vector_type(2)));
typedef short bf16x8 __attribute__((ext_vector_type(8)));
typedef unsigned u32x4 __attribute__((ext_vector_type(4)));
typedef unsigned u32x2 __attribute__((ext_vector_type(2)));

constexpr int DM = 1024, NBP = 8, SEQ = 2048, MPR = NBP * SEQ, NBS = 128, MTOK = MPR + NBS, MPAD = 16640;
constexpr int DL = 512, NPROJ = 1536, NMOD = 6144, NBT = NBP + NBS, DFF = 2816;
constexpr int LCH = 64, NCH = SEQ / LCH;
constexpr int SCH = 16;
constexpr int SL = 16, SNCH = SEQ / SL, SROWS = NBP * SNCH;
constexpr float EPS = 1e-6f;
constexpr int NPHASE = 13;

constexpr size_t O_Y = 0, O_CONVP = (size_t)MTOK * DM, O_LRUP = O_CONVP + 8 * 3 * 512, O_S5RP = O_LRUP + 8 * 512, O_S5IP = O_S5RP + 8 * 32 * 64,
                 O_CONVS = O_S5IP + 8 * 32 * 64, O_LRUS = O_CONVS + 128 * 3 * 512, O_S5RS = O_LRUS + 128 * 512, O_S5IS = O_S5RS + 128 * 32 * 64, O_END = O_S5IS + 128 * 32 * 64;

constexpr size_t HM = 1u << 19;
constexpr size_t WS_WIN = 2 * HM, WS_WGLU = 8 * HM, WS_WOUT = 10 * HM, WS_WGU = 14 * HM, WS_WDN = 36 * HM  , WS_MOD = 48 * HM  ,
                 WS_TF = 56 * HM  , WS_E = 68 * HM  , WS_TAB = 72 * HM, WS_AGG = 74 * HM  ,
                 WS_XN = 80 * HM  , WS_LRUX = 146 * HM  , WS_GATE = 211 * HM  ,
                 WS_S5U = 244 * HM  , WS_HLOC = 277 * HM  , WS_CUM = 342 * HM, WS_GY = 407 * HM  ,
                 WS_SK = 440 * HM  , WS_HIN = 472 * HM  , WS_HB = 277 * HM  , WS_X1B = 211 * HM  , WS_PART = 488 * HM  , WS_END = 512 * HM;
constexpr size_t WS_XSLOT = 65536;
constexpr size_t T_ABAR = 0, T_A16 = 4096, T_BBR = 8192, T_BBI = 8192 + 32768, T_WG = 81920  , T_GCD = T_WG + 32768  ;

struct KArgs { const float* in[36]; float* out; unsigned char* ws; int lo, hi; };

struct Ctx {
    const float* const* in; float* out; unsigned char* ws;
    __device__ __forceinline__ const float* I(int i) const { return in[i]; }
    __device__ __forceinline__ bf16* WIN() const { return (bf16*)(ws + WS_WIN); }
    __device__ __forceinline__ bf16* WGLU() const { return (bf16*)(ws + WS_WGLU); }
    __device__ __forceinline__ bf16* WOUT() const { return (bf16*)(ws + WS_WOUT); }
    __device__ __forceinline__ bf16* WGU() const { return (bf16*)(ws + WS_WGU); }
    __device__ __forceinline__ bf16* WDN() const { return (bf16*)(ws + WS_WDN); }
    __device__ __forceinline__ float* MOD() const { return (float*)(ws + WS_MOD); }
    __device__ __forceinline__ bf16* TF() const { return (bf16*)(ws + WS_TF); }
    __device__ __forceinline__ bf16* EM() const { return (bf16*)(ws + WS_E); }
    __device__ __forceinline__ float* TAB() const { return (float*)(ws + WS_TAB); }
    __device__ __forceinline__ f32x2* AGG() const { return (f32x2*)(ws + WS_AGG); }
    __device__ __forceinline__ bf16* XN() const { return (bf16*)(ws + WS_XN); }
    __device__ __forceinline__ bf16* MERGED() const { return (bf16*)(ws + WS_XN); }
    __device__ __forceinline__ bf16* LRUX() const { return (bf16*)(ws + WS_LRUX); }
    __device__ __forceinline__ bf16* XN2() const { return (bf16*)(ws + WS_LRUX); }
    __device__ __forceinline__ bf16* GATE() const { return (bf16*)(ws + WS_GATE); }
    __device__ __forceinline__ bf16* S5U() const { return (bf16*)(ws + WS_S5U); }
    __device__ __forceinline__ float* HLOC() const { return (float*)(ws + WS_HLOC); }
    __device__ __forceinline__ float* S5OUT() const { return (float*)(ws + WS_HLOC); }
    __device__ __forceinline__ float* CUM() const { return (float*)(ws + WS_CUM); }
    __device__ __forceinline__ bf16* GY() const { return (bf16*)(ws + WS_GY); }
    __device__ __forceinline__ float* SK() const { return (float*)(ws + WS_SK); }
    __device__ __forceinline__ bf16* HIN() const { return (bf16*)(ws + WS_HIN); }
    __device__ __forceinline__ bf16* HB() const { return (bf16*)(ws + WS_HB); }
    __device__ __forceinline__ float* PART() const { return (float*)(ws + WS_PART); }
    __device__ __forceinline__ bf16* X1B() const { return (bf16*)(ws + WS_X1B); }
};

#define LDS_WAIT() asm volatile("s_waitcnt lgkmcnt(0)" ::: "memory")
__device__ __forceinline__ unsigned pk2(float lo, float hi) { return pg8::cvt_pk_bf16(lo, hi); }
__device__ __forceinline__ float bf2f(unsigned b) { return __uint_as_float(b << 16); }
__device__ __forceinline__ float bflo(unsigned w) { return __uint_as_float(w << 16); }
__device__ __forceinline__ float bfhi(unsigned w) { return __uint_as_float(w & 0xffff0000u); }
__device__ __forceinline__ float wave_sum(float v) {
#pragma unroll
    for (int o = 1; o < 64; o <<= 1) v += __shfl_xor(v, o);
    return v;
}
__device__ __forceinline__ float sigm(float v) { return __builtin_amdgcn_rcpf(1.f + __builtin_amdgcn_exp2f(-1.44269504089f * v)); }
__device__ __forceinline__ float gelu_tanh(float x) { const float u = (-1.5957691216f * 1.44269504089f) * (x + 0.044715f * x * x * x); return x * __builtin_amdgcn_rcpf(1.f + __builtin_amdgcn_exp2f(u)); }
__device__ __forceinline__ int mod_row(int row) { return row < MPR ? (row >> 11) : (NBP + row - MPR); }
__device__ __forceinline__ u32x4 pack8(f32x4 a, f32x4 b) { u32x4 w; w.x = pk2(a[0], a[1]); w.y = pk2(a[2], a[3]); w.z = pk2(b[0], b[1]); w.w = pk2(b[2], b[3]); return w; }

struct Sched2 {
    pg8::StaticOrder so; int nkt_full, n_extra, ex_nn, ex_nkt;
    __device__ __forceinline__ void init(int N, int K, int G, int c, int ex_nkt_) { so.init(MPR, N, G, c); nkt_full = K / 64; ex_nn = N / 256; ex_nkt = ex_nkt_; n_extra = ex_nn * (nkt_full / ex_nkt_); }
    __device__ __forceinline__ bool next(int i, pg8::Unit& u) const {
        const long L = (long)i * so.G + so.c;
        const bool prompt = L < so.nwg; const int e = (int)(L - so.nwg);
        if (!prompt && e >= n_extra) return false;
        pg8::Unit t; t.pm = 0; t.pn = 0; t.kt0 = 0; t.nkt = 0; t.kind = 0; t.slice = 0;
        if (prompt) so.next(i, t);
        const int sl = prompt ? 0 : e / ex_nn;
        pg8::Unit r; r.pm = prompt ? t.pm : 64; r.pn = prompt ? t.pn : e % ex_nn; r.kt0 = sl * ex_nkt; r.nkt = prompt ? nkt_full : ex_nkt; r.kind = prompt ? 0 : ((ex_nkt == nkt_full) ? 1 : 2); r.slice = sl;
        u = r; return true;
    }
    __device__ __forceinline__ void a_ready(const pg8::Unit&) const {}
    __device__ __forceinline__ void done(const pg8::Unit&) const {}
};
__device__ __forceinline__ void store_partial(const f32x4 (&acc)[2][2][4][2], const pg8::Unit& u, int wr, int wc, int fr, int fq, float* part, unsigned* cnt) {
    float* base = part + (size_t)u.slice * 128 * 1024 + u.pn * 256 + wc * 32 + 8 * fq;
#pragma unroll
    for (int m = 0; m < 4; ++m) { float* rp = base + (size_t)(wr * 64 + m * 16 + fr) * 1024;
#pragma unroll
        for (int bj = 0; bj < 2; ++bj)
#pragma unroll
            for (int n = 0; n < 2; ++n) { const f32x4 v = acc[0][bj][m][n]; unsigned long long* q = (unsigned long long*)(rp + bj * 128 + 4 * n);
                __hip_atomic_store(q, ((unsigned long long)__float_as_uint(v.y) << 32) | __float_as_uint(v.x), __ATOMIC_RELAXED, __HIP_MEMORY_SCOPE_AGENT);
                __hip_atomic_store(q + 1, ((unsigned long long)__float_as_uint(v.w) << 32) | __float_as_uint(v.z), __ATOMIC_RELAXED, __HIP_MEMORY_SCOPE_AGENT); } }
    asm volatile("s_waitcnt vmcnt(0)" ::: "memory");
    if ((threadIdx.x & 63) == 0) __hip_atomic_fetch_add(cnt, 1u, __ATOMIC_RELAXED, __HIP_MEMORY_SCOPE_AGENT);
}
__device__ __forceinline__ void wait_partials(unsigned* cnt, unsigned want) {
    unsigned sp = 0;
    while ((unsigned)__builtin_amdgcn_readfirstlane(__hip_atomic_load(cnt, __ATOMIC_RELAXED, __HIP_MEMORY_SCOPE_AGENT)) < want) { __builtin_amdgcn_s_sleep(4); if (++sp > (1u << 22)) break; }
    __builtin_amdgcn_fence(__ATOMIC_ACQUIRE, "agent");
}

struct EpiProj {
    static constexpr bool PERM = true, AFTER_DRAIN = false; bf16* lrux; bf16* gate; bf16* s5u;
    __device__ __forceinline__ void operator()(const f32x4 (&acc)[2][2][4][2], const pg8::Unit& u, int wr, int wc, int fr, int fq) const {
        const int colt = u.pn * 256 + wc * 32 + 8 * fq;
#pragma unroll
        for (int ai = 0; ai < 2; ++ai)
#pragma unroll
            for (int m = 0; m < 4; ++m) { const int row = u.pm * 256 + ai * 128 + wr * 64 + m * 16 + fr; if (row >= MTOK) continue;
#pragma unroll
                for (int bj = 0; bj < 2; ++bj) { const int col = colt + bj * 128; const f32x4 v0 = acc[ai][bj][m][0], v1 = acc[ai][bj][m][1];
                    if (u.pn < 2) { *(u32x4*)(lrux + (size_t)row * 512 + col) = pack8(v0, v1); }
                    else if (u.pn < 4) { *(u32x4*)(gate + (size_t)row * 512 + (col - 512)) = pack8(v0, v1); }
                    else { *(u32x4*)(s5u + (size_t)row * 512 + (col - 1024)) = pack8(v0, v1); } } }
    }
};
struct EpiGlu {
    static constexpr bool PERM = true, AFTER_DRAIN = false; float* o; float* part;
    __device__ __forceinline__ void operator()(const f32x4 (&acc)[2][2][4][2], const pg8::Unit& u, int wr, int wc, int fr, int fq) const {
        const int col = u.pn * 128 + wc * 32 + 8 * fq;
#pragma unroll
        for (int ai = 0; ai < 2; ++ai)
#pragma unroll
            for (int m = 0; m < 4; ++m) { const int row = u.pm * 256 + ai * 128 + wr * 64 + m * 16 + fr; if (row >= MTOK) continue;
#pragma unroll
                for (int n = 0; n < 2; ++n) { const f32x4 a = acc[ai][0][m][n], b = acc[ai][1][m][n]; f32x4 s;
#pragma unroll
                    for (int i = 0; i < 4; ++i) s[i] = a[i] * sigm(b[i]);
                    *(f32x4*)(o + (size_t)row * 512 + col + 4 * n) = s; } }
    }
};
template <int GOFF> struct EpiRes {
    static constexpr bool PERM = true, AFTER_DRAIN = false; const float* xp; const float* xs; const float* mod; float* out; float* part;
    __device__ __forceinline__ void operator()(const f32x4 (&acc)[2][2][4][2], const pg8::Unit& u, int wr, int wc, int fr, int fq) const {
        const int colt = u.pn * 256 + wc * 32 + 8 * fq;
#pragma unroll
        for (int ai = 0; ai < 2; ++ai)
#pragma unroll
            for (int m = 0; m < 4; ++m) { const int row = u.pm * 256 + ai * 128 + wr * 64 + m * 16 + fr; if (row >= MTOK) continue;
                const float* gp = mod + (size_t)mod_row(row) * NMOD + GOFF; float* op = out + (size_t)row * DM;
                const float* bp = xp ? (row < MPR ? xp + (size_t)row * DM : xs + (size_t)(row - MPR) * DM) : op;
#pragma unroll
                for (int bj = 0; bj < 2; ++bj)
#pragma unroll
                    for (int n = 0; n < 2; ++n) { const int c = colt + bj * 128 + 4 * n; const f32x4 x4 = *(const f32x4*)(bp + c), g4 = *(const f32x4*)(gp + c);
                        *(f32x4*)(op + c) = x4 + g4 * acc[ai][bj][m][n]; } }
    }
};
struct EpiSwiglu {
    static constexpr bool PERM = true, AFTER_DRAIN = false; bf16* h;
    __device__ __forceinline__ void operator()(const f32x4 (&acc)[2][2][4][2], const pg8::Unit& u, int wr, int wc, int fr, int fq) const {
        const int col = u.pn * 128 + wc * 32 + 8 * fq;
#pragma unroll
        for (int ai = 0; ai < 2; ++ai)
#pragma unroll
            for (int m = 0; m < 4; ++m) { const int row = u.pm * 256 + ai * 128 + wr * 64 + m * 16 + fr; if (row >= MTOK) continue;
                f32x4 s[2];
#pragma unroll
                for (int n = 0; n < 2; ++n) { const f32x4 a = acc[ai][0][m][n], b = acc[ai][1][m][n];
#pragma unroll
                    for (int i = 0; i < 4; ++i) s[n][i] = a[i] * sigm(a[i]) * b[i]; }
                *(u32x4*)(h + (size_t)row * DFF + col) = pack8(s[0], s[1]); }
    }
};

struct Sched3 {
    pg8::StaticOrder so; int nkt_full, n_extra, ex_nn, ex_nkt;
    __device__ __forceinline__ void init(int N, int K, int G, int c, int ex_nkt_) { so.init(MPR, N, G, c); nkt_full = K / 64; ex_nn = N / 256; ex_nkt = ex_nkt_; n_extra = ex_nn * (nkt_full / ex_nkt_); }
    __device__ __forceinline__ bool next(int i, pg8::Unit& u) const {
        const bool has_ex = so.c < n_extra; const int j = has_ex ? i : i + 1;
        if (j > 1) return false;
        const bool prompt = (j == 1); const int e = so.c;
        pg8::Unit t; t.pm = 0; t.pn = 0; t.kt0 = 0; t.nkt = 0; t.kind = 0; t.slice = 0;
        if (prompt) so.next(0, t);
        const int sl = prompt ? 0 : e / ex_nn;
        pg8::Unit r; r.pm = prompt ? t.pm : 64; r.pn = prompt ? t.pn : e % ex_nn; r.kt0 = sl * ex_nkt; r.nkt = prompt ? nkt_full : ex_nkt; r.kind = prompt ? 0 : 2; r.slice = sl;
        u = r; return true;
    }
    __device__ __forceinline__ void a_ready(const pg8::Unit&) const {}
    __device__ __forceinline__ void done(const pg8::Unit&) const {}
};
struct RmsPanel {
    float* xbuf;
    unsigned* cnt;
    float inv_n, eps;
    __device__ __forceinline__ void put(float t, int r, int wc, int fq, LAS unsigned char* lds) const { t += __shfl_xor(t, 16); t += __shfl_xor(t, 32); if (fq == 0) ((LAS float*)lds)[r * 4 + wc] = t; }
    __device__ __forceinline__ void finish(const pg8::Unit& u, LAS unsigned char* lds, int wid, int lane) const {
        LAS float* P = (LAS float*)lds; LAS float* S = (LAS float*)(lds + 4096);
        asm volatile("s_waitcnt lgkmcnt(0)" ::: "memory"); __builtin_amdgcn_s_barrier(); asm volatile("" ::: "memory");
        const int row = wid * 32 + (lane & 31);
        if (lane < 32) { const f32x4 p = *(const LAS f32x4*)(P + row * 4); const float t = (p.x + p.y) + (p.z + p.w);
            __hip_atomic_store(xbuf + ((size_t)(u.pm * 256 + row) * 4 + u.pn), t, __ATOMIC_RELAXED, __HIP_MEMORY_SCOPE_AGENT); }
        asm volatile("s_waitcnt vmcnt(0)" ::: "memory");
        if (lane == 0) __hip_atomic_fetch_add(cnt + 64 * u.pm, 1u, __ATOMIC_RELAXED, __HIP_MEMORY_SCOPE_AGENT);
        if (wid == 0) { unsigned sp = 0;
            while ((unsigned)__builtin_amdgcn_readfirstlane(__hip_atomic_load(cnt + 64 * u.pm, __ATOMIC_RELAXED, __HIP_MEMORY_SCOPE_AGENT)) < 32u) { __builtin_amdgcn_s_sleep(2); if (++sp > (1u << 22)) break; }
            __builtin_amdgcn_fence(__ATOMIC_ACQUIRE, "agent"); }
        asm volatile("s_waitcnt vmcnt(0) lgkmcnt(0)" ::: "memory"); __builtin_amdgcn_s_barrier(); asm volatile("" ::: "memory");
        if (lane < 32) { const float* slot = xbuf + (size_t)(u.pm * 256 + row) * 4; float t = 0.f;
#pragma unroll
            for (int q = 0; q < 4; ++q) t += __hip_atomic_load(slot + q, __ATOMIC_RELAXED, __HIP_MEMORY_SCOPE_AGENT);
            S[row] = rsqrtf(t * inv_n + eps); }
        asm volatile("s_waitcnt lgkmcnt(0)" ::: "memory"); __builtin_amdgcn_s_barrier(); asm volatile("" ::: "memory");
    }
};
struct EpiGluNorm {
    static constexpr bool PERM = true, AFTER_DRAIN = true; bf16* merged; const float* gs; float* part; unsigned* pcnt; RmsPanel st;
    __device__ __forceinline__ void operator()(const f32x4 (&acc)[2][2][4][2], const pg8::Unit& u, int wr, int wc, int fr, int fq) const { if (u.kind == 2) store_partial(acc, u, wr, wc, fr, fq, part, pcnt); }
    __device__ __forceinline__ void fused(f32x4 (&acc)[2][2][4][2], const pg8::Unit& u, int wr, int wc, int fr, int fq, LAS unsigned char* lds, int wid, int lane) const {
#pragma unroll
        for (int ai = 0; ai < 2; ++ai)
#pragma unroll
            for (int m = 0; m < 4; ++m) { float ss = 0.f;
#pragma unroll
                for (int n = 0; n < 2; ++n) { const f32x4 a = acc[ai][0][m][n], b = acc[ai][1][m][n]; f32x4 sv;
#pragma unroll
                    for (int i = 0; i < 4; ++i) { sv[i] = a[i] * sigm(b[i]); ss += sv[i] * sv[i]; }
                    acc[ai][0][m][n] = sv; }
                st.put(ss, ai * 128 + wr * 64 + m * 16 + fr, wc, fq, lds); }
        st.finish(u, lds, wid, lane);
        const LAS float* S = (const LAS float*)(lds + 4096);
        const int col = u.pn * 128 + wc * 32 + 8 * fq; const f32x4 g0 = *(const f32x4*)(gs + col), g1 = *(const f32x4*)(gs + col + 4);
#pragma unroll
        for (int ai = 0; ai < 2; ++ai)
#pragma unroll
            for (int m = 0; m < 4; ++m) { const int r = ai * 128 + wr * 64 + m * 16 + fr; const float rstd = S[r];
                *(u32x4*)(merged + (size_t)(u.pm * 256 + r) * DM + 512 + col) = pack8(acc[ai][0][m][0] * rstd * g0, acc[ai][0][m][1] * rstd * g1); }
    }
};
template <int MODE> struct EpiResNorm {
    static constexpr bool PERM = true, AFTER_DRAIN = true; const float* xp; const float* mod; const float* gn; float* out; bf16* xn; bf16* x1b; float* part; unsigned* pcnt; RmsPanel st;
    __device__ __forceinline__ void operator()(const f32x4 (&acc)[2][2][4][2], const pg8::Unit& u, int wr, int wc, int fr, int fq) const { if (u.kind == 2) store_partial(acc, u, wr, wc, fr, fq, part, pcnt); }
    __device__ __forceinline__ void fused(f32x4 (&acc)[2][2][4][2], const pg8::Unit& u, int wr, int wc, int fr, int fq, LAS unsigned char* lds, int wid, int lane) const {
        const int colt = u.pn * 256 + wc * 32 + 8 * fq; const float* mrow = mod + (size_t)(u.pm >> 3) * NMOD;
        constexpr int GOFF = MODE == 1 ? 2048 : 5120;
        f32x4 gv[2][2];
#pragma unroll
        for (int bj = 0; bj < 2; ++bj)
#pragma unroll
            for (int n = 0; n < 2; ++n) gv[bj][n] = *(const f32x4*)(mrow + GOFF + colt + bj * 128 + 4 * n);
#pragma unroll
        for (int ai = 0; ai < 2; ++ai) {
            f32x4 pre1[4][2][2]; u32x4 pre2[4][2];
#pragma unroll
            for (int m = 0; m < 4; ++m) { const size_t ro = (size_t)(u.pm * 256 + ai * 128 + wr * 64 + m * 16 + fr) * DM + colt;
#pragma unroll
                for (int bj = 0; bj < 2; ++bj) { if (MODE == 1) { pre1[m][bj][0] = *(const f32x4*)(xp + ro + bj * 128); pre1[m][bj][1] = *(const f32x4*)(xp + ro + bj * 128 + 4); } else pre2[m][bj] = *(const u32x4*)(x1b + ro + bj * 128); } }
#pragma unroll
            for (int m = 0; m < 4; ++m) { const size_t ro = (size_t)(u.pm * 256 + ai * 128 + wr * 64 + m * 16 + fr) * DM + colt; float ss = 0.f;
#pragma unroll
                for (int bj = 0; bj < 2; ++bj) { f32x4 b0, b1;
                    if (MODE == 1) { b0 = pre1[m][bj][0]; b1 = pre1[m][bj][1]; }
                    else { const u32x4 q = pre2[m][bj]; b0 = (f32x4){bflo(q.x), bfhi(q.x), bflo(q.y), bfhi(q.y)}; b1 = (f32x4){bflo(q.z), bfhi(q.z), bflo(q.w), bfhi(q.w)}; }
                    const f32x4 v0 = b0 + gv[bj][0] * acc[ai][bj][m][0], v1 = b1 + gv[bj][1] * acc[ai][bj][m][1]; acc[ai][bj][m][0] = v0; acc[ai][bj][m][1] = v1;
                    if (MODE == 1) *(u32x4*)(x1b + ro + bj * 128) = pack8(v0, v1);
                    ss += (v0.x * v0.x + v0.y * v0.y) + (v0.z * v0.z + v0.w * v0.w) + (v1.x * v1.x + v1.y * v1.y) + (v1.z * v1.z + v1.w * v1.w); }
                st.put(ss, ai * 128 + wr * 64 + m * 16 + fr, wc, fq, lds);
                asm volatile("" : "+v"(acc[ai][0][m][0]), "+v"(acc[ai][0][m][1]), "+v"(acc[ai][1][m][0]), "+v"(acc[ai][1][m][1])); }
            asm volatile("" ::: "memory"); }
        st.finish(u, lds, wid, lane);
        const LAS float* S = (const LAS float*)(lds + 4096);
#pragma unroll
        for (int bj = 0; bj < 2; ++bj) { const int c = colt + bj * 128;
            f32x4 w0 = *(const f32x4*)(gn + c), w1 = *(const f32x4*)(gn + c + 4), s0 = (f32x4){0.f, 0.f, 0.f, 0.f}, s1 = s0;
            if (MODE == 1) { w0 = w0 * (1.f + *(const f32x4*)(mrow + 4096 + c)); w1 = w1 * (1.f + *(const f32x4*)(mrow + 4096 + c + 4)); s0 = *(const f32x4*)(mrow + 3072 + c); s1 = *(const f32x4*)(mrow + 3072 + c + 4); }
#pragma unroll
            for (int ai = 0; ai < 2; ++ai)
#pragma unroll
                for (int m = 0; m < 4; ++m) { const int r = ai * 128 + wr * 64 + m * 16 + fr; const float rstd = S[r]; const size_t ro = (size_t)(u.pm * 256 + r) * DM + c;
                    const f32x4 o0 = acc[ai][bj][m][0] * rstd * w0 + s0, o1 = acc[ai][bj][m][1] * rstd * w1 + s1;
                    if (MODE == 1) *(u32x4*)(xn + ro) = pack8(o0, o1); else { *(f32x4*)(out + ro) = o0; *(f32x4*)(out + ro + 4) = o1; } } }
    }
};

__device__ __forceinline__ void transpose_item(const float* W, int ldw, int k0, int n0, bf16* WT, int K, int drow0, LAS bf16* scr, int lane) {
    const int lr = lane >> 4, lc = lane & 15;
    f32x4 v[16];
#pragma unroll
    for (int i = 0; i < 16; ++i) v[i] = *(const f32x4*)(W + (size_t)(k0 + lr + 4 * i) * ldw + n0 + 4 * lc);
#pragma unroll
    for (int i = 0; i < 16; ++i) { u32x2 p; p.x = pk2(v[i].x, v[i].y); p.y = pk2(v[i].z, v[i].w); *(LAS u32x2*)(scr + (lr + 4 * i) * 68 + 4 * lc) = p; }
    LDS_WAIT();
    const int kc = lane & 7;
#pragma unroll
    for (int j = 0; j < 8; ++j) { const int n = (lane >> 3) + 8 * j; const LAS bf16* sp = scr + (8 * kc) * 68 + n;
        u32x4 o; o.x = (unsigned)sp[0] | ((unsigned)sp[68] << 16); o.y = (unsigned)sp[2 * 68] | ((unsigned)sp[3 * 68] << 16);
        o.z = (unsigned)sp[4 * 68] | ((unsigned)sp[5 * 68] << 16); o.w = (unsigned)sp[6 * 68] | ((unsigned)sp[7 * 68] << 16);
        *(u32x4*)(WT + (size_t)(drow0 + n) * K + k0 + 8 * kc) = o; }
    LDS_WAIT();
}
__device__ __forceinline__ void transpose_dispatch(const Ctx& cx, int it, LAS bf16* scr, int lane) {
    if (it < 384) { const int kb = it / 24, nb = it % 24; transpose_item(cx.I(11), NPROJ, 64 * kb, 64 * nb, cx.WIN(), DM, 64 * nb, scr, lane); return; } it -= 384;
    if (it < 128) { const int kb = it / 16, nb = it % 16, n0 = 64 * nb; const int dr = 256 * ((n0 & 511) >> 7) + 128 * (n0 >> 9) + (n0 & 127);
        transpose_item(cx.I(27), 1024, 64 * kb, n0, cx.WGLU(), 512, dr, scr, lane); return; } it -= 128;
    if (it < 256) { const int kb = it / 16, nb = it % 16; transpose_item(cx.I(30), DM, 64 * kb, 64 * nb, cx.WOUT(), DM, 64 * nb, scr, lane); return; } it -= 256;
    if (it < 704) { const int kb = it / 44, nb = it % 44, n0 = 64 * nb; transpose_item(cx.I(32), DFF, 64 * kb, n0, cx.WGU(), DM, 256 * (n0 >> 7) + (n0 & 127), scr, lane); return; } it -= 704;
    if (it < 704) { const int kb = it / 44, nb = it % 44, n0 = 64 * nb; transpose_item(cx.I(33), DFF, 64 * kb, n0, cx.WGU(), DM, 256 * (n0 >> 7) + 128 + (n0 & 127), scr, lane); return; } it -= 704;
    { const int kb = it / 16, nb = it % 16; transpose_item(cx.I(34), DM, 64 * kb, 64 * nb, cx.WDN(), DFF, 64 * nb, scr, lane); }
}
constexpr int N_TR_ITEMS = 384 + 128 + 256 + 704 + 704 + 704;

__device__ __forceinline__ void ada_block(const Ctx& cx, int item, LAS unsigned char* lds) {
    const int tid = threadIdx.x, w = __builtin_amdgcn_readfirstlane(tid >> 6), lane = tid & 63, fr = lane & 15, fq = lane >> 4, n0 = 32 * item;
    const float* W = cx.I(8); const float* cp = cx.I(6); const float* cs = cx.I(7);
    bf16x8 wf[4][2];
#pragma unroll
    for (int ks = 0; ks < 4; ++ks)
#pragma unroll
        for (int nt = 0; nt < 2; ++nt) { const float* src = W + (size_t)(128 * w + 32 * ks + 8 * fq) * NMOD + n0 + 16 * nt + fr;
            u32x4 o; o.x = pk2(src[0], src[NMOD]); o.y = pk2(src[2 * NMOD], src[3 * NMOD]); o.z = pk2(src[4 * NMOD], src[5 * NMOD]); o.w = pk2(src[6 * NMOD], src[7 * NMOD]); wf[ks][nt] = __builtin_bit_cast(bf16x8, o); }
    f32x4 acc[9][2];
#pragma unroll
    for (int i = 0; i < 9; ++i) { acc[i][0] = (f32x4){0.f, 0.f, 0.f, 0.f}; acc[i][1] = (f32x4){0.f, 0.f, 0.f, 0.f}; }
#pragma unroll
    for (int mt = 0; mt < 9; ++mt) { int row = 16 * mt + fr; row = row < NBT ? row : NBT - 1;
        const float* src = (row < NBP ? cp + (size_t)row * DM : cs + (size_t)(row - NBP) * DM) + 128 * w + 8 * fq;
#pragma unroll
        for (int ks = 0; ks < 4; ++ks) { f32x4 a0 = *(const f32x4*)(src + 32 * ks), a1 = *(const f32x4*)(src + 32 * ks + 4);
#pragma unroll
            for (int i = 0; i < 4; ++i) { a0[i] = a0[i] * sigm(a0[i]); a1[i] = a1[i] * sigm(a1[i]); }
            const bf16x8 af = __builtin_bit_cast(bf16x8, pack8(a0, a1));
            acc[mt][0] = __builtin_amdgcn_mfma_f32_16x16x32_bf16(wf[ks][0], af, acc[mt][0], 0, 0, 0);
            acc[mt][1] = __builtin_amdgcn_mfma_f32_16x16x32_bf16(wf[ks][1], af, acc[mt][1], 0, 0, 0); } }
    LAS f32x4* red = (LAS f32x4*)lds;
#pragma unroll
    for (int st = 4; st >= 1; st >>= 1) {
        if (w >= st && w < 2 * st) {
#pragma unroll
            for (int i = 0; i < 9; ++i) { red[((w - st) * 18 + 2 * i) * 64 + lane] = acc[i][0]; red[((w - st) * 18 + 2 * i + 1) * 64 + lane] = acc[i][1]; } }
        __syncthreads();
        if (w < st) {
#pragma unroll
            for (int i = 0; i < 9; ++i) { acc[i][0] += red[(w * 18 + 2 * i) * 64 + lane]; acc[i][1] += red[(w * 18 + 2 * i + 1) * 64 + lane]; } }
        __syncthreads();
    }
    if (w == 0) {
#pragma unroll
        for (int nt = 0; nt < 2; ++nt) { const f32x4 b4 = *(const f32x4*)(cx.I(9) + n0 + 16 * nt + 4 * fq);
#pragma unroll
            for (int mt = 0; mt < 9; ++mt) { const int row = 16 * mt + fr; if (row < NBT) *(f32x4*)(cx.MOD() + (size_t)row * NMOD + n0 + 16 * nt + 4 * fq) = acc[mt][nt] + b4; } } }
}

__device__ __forceinline__ void lru_gate_tables(const Ctx& cx, int item) {
    const int e = item * 512 + threadIdx.x;
    const int lane = e & 63, ks = (e >> 6) & 1, nt = (e >> 7) & 7, w = e >> 10, fr = lane & 15, fq = lane >> 4;
    const float* src = (nt < 4 ? cx.I(14) : cx.I(16)) + (size_t)w * 4096 + (32 * ks + 8 * fq) * 64 + 16 * (nt & 3) + fr;
    u32x4 o; o.x = pk2(src[0], src[64]); o.y = pk2(src[128], src[192]); o.z = pk2(src[256], src[320]); o.w = pk2(src[384], src[448]);
    ((u32x4*)(cx.TAB() + T_WG))[e] = o;
    if (item == 0) cx.TAB()[T_GCD + threadIdx.x] = -8.f * 1.44269504089f * log1pf(expf(-cx.I(18)[threadIdx.x]));
}
__device__ __forceinline__ void s5_tables(const Ctx& cx, int g, LAS unsigned char* lds, int part, int nparts) {
    LAS f32x2* Ap = (LAS f32x2*)lds;
    LAS f32x2* Bb = Ap + 17 * 64;
    LAS f32x2* Cc = Bb + 1024;
    LAS f32x2* Ff = Cc + 1024;
    LAS float* Kt = (LAS float*)(Ff + 64);
    const int tid = threadIdx.x;
    float* tab = cx.TAB();
    if (tid < 64) {
        const int n = tid; const float lr = cx.I(19)[g * 64 + n], li = cx.I(20)[g * 64 + n], dt = expf(cx.I(21)[g]);
        const float mag = expf(lr * dt);
        const double ang = (double)li * (double)dt; const double kq = rint(ang * 0.63661977236758134308); const double r = ang - kq * 1.57079632679489661923; const double r2 = r * r;
        const double sn = r * (1.0 + r2 * (-1.0 / 6 + r2 * (1.0 / 120 + r2 * (-1.0 / 5040 + r2 * (1.0 / 362880 + r2 * (-1.0 / 39916800 + r2 * (1.0 / 6227020800.0)))))));
        const double cn = 1.0 + r2 * (-0.5 + r2 * (1.0 / 24 + r2 * (-1.0 / 720 + r2 * (1.0 / 40320 + r2 * (-1.0 / 3628800 + r2 * (1.0 / 479001600.0))))));
        const int q = ((int)kq) & 3; const double cv = q == 0 ? cn : q == 1 ? -sn : q == 2 ? -cn : sn, sv = q == 0 ? sn : q == 1 ? cn : q == 2 ? -sn : -cn;
        const float abr = mag * (float)cv, abi = mag * (float)sv; const float den = lr * lr + li * li;
        const float frr = ((abr - 1.f) * lr + abi * li) / den, fii = (abi * lr - (abr - 1.f) * li) / den;
        f32x2 p = (f32x2){1.f, 0.f}; Ap[n] = p;
#pragma unroll 1
        for (int t = 1; t <= 16; ++t) { const float pr = p.x * abr - p.y * abi, pi = p.x * abi + p.y * abr; p = (f32x2){pr, pi}; Ap[t * 64 + n] = p; }
        Ff[n] = (f32x2){frr, fii};
        if (part == 0) { ((f32x2*)(tab + T_ABAR))[g * 64 + n] = (f32x2){abr, abi}; ((f32x2*)(tab + T_A16))[g * 64 + n] = p; }
    }
    __syncthreads();
    for (int e = tid; e < 1024; e += 512) { const int n = e >> 4; const float br = cx.I(22)[g * 1024 + e], bi = cx.I(23)[g * 1024 + e]; const f32x2 f = Ff[n];
        const float bbr = f.x * br - f.y * bi, bbi = f.x * bi + f.y * br; Bb[e] = (f32x2){bbr, bbi}; if (part == 0) { tab[T_BBR + g * 1024 + e] = bbr; tab[T_BBI + g * 1024 + e] = bbi; }
        Cc[e] = (f32x2){cx.I(24)[g * 1024 + e], cx.I(25)[g * 1024 + e]}; }
    __syncthreads();
    { const int tau = tid >> 5, c0 = 2 * ((tid >> 2) & 7), cp0 = 4 * (tid & 3);
        float s00 = 0.f, s01 = 0.f, s02 = 0.f, s03 = 0.f, s10 = 0.f, s11 = 0.f, s12 = 0.f, s13 = 0.f;
#pragma unroll 8
        for (int n = 0; n < 64; ++n) { const f32x2 a = Ap[tau * 64 + n], q0 = Cc[c0 * 64 + n], q1 = Cc[(c0 + 1) * 64 + n];
            const f32x4 bA = *(const LAS f32x4*)(Bb + n * 16 + cp0), bB = *(const LAS f32x4*)(Bb + n * 16 + cp0 + 2);
            float pr, pi;
            pr = a.x * bA.x - a.y * bA.y; pi = a.x * bA.y + a.y * bA.x; s00 += q0.x * pr - q0.y * pi; s10 += q1.x * pr - q1.y * pi;
            pr = a.x * bA.z - a.y * bA.w; pi = a.x * bA.w + a.y * bA.z; s01 += q0.x * pr - q0.y * pi; s11 += q1.x * pr - q1.y * pi;
            pr = a.x * bB.x - a.y * bB.y; pi = a.x * bB.y + a.y * bB.x; s02 += q0.x * pr - q0.y * pi; s12 += q1.x * pr - q1.y * pi;
            pr = a.x * bB.z - a.y * bB.w; pi = a.x * bB.w + a.y * bB.z; s03 += q0.x * pr - q0.y * pi; s13 += q1.x * pr - q1.y * pi; }
        LAS float* k0 = Kt + (tau << 8) + (c0 << 4) + cp0; k0[0] = s00; k0[1] = s01; k0[2] = s02; k0[3] = s03; k0[16] = s10; k0[17] = s11; k0[18] = s12; k0[19] = s13; }
    __syncthreads();
    bf16* TFg = cx.TF() + (size_t)g * 256 * 384;
    for (int pc = tid + 512 * part; pc < 256 * 48; pc += 512 * nparts) { const int row = pc / 48, k8 = (pc % 48) * 8, j = row >> 4, c = row & 15; float v[8];
#pragma unroll
        for (int q = 0; q < 8; ++q) { const int kk = k8 + q;
            if (kk < 256) { const int s = kk >> 4, cp = kk & 15; v[q] = (j >= s) ? Kt[((j - s) << 8) + (c << 4) + cp] : 0.f; }
            else { const int n = (kk - 256) & 63; const f32x2 p = Ap[(j + 1) * 64 + n], cc = Cc[c * 64 + n]; v[q] = (kk < 320) ? (cc.x * p.x - cc.y * p.y) : (-cc.x * p.y - cc.y * p.x); } }
        u32x4 o; o.x = pk2(v[0], v[1]); o.y = pk2(v[2], v[3]); o.z = pk2(v[4], v[5]); o.w = pk2(v[6], v[7]);
        *(u32x4*)(TFg + (size_t)row * 384 + k8) = o; }
    bf16* Eg = cx.EM() + (size_t)g * 128 * 256;
    for (int pc = tid + 512 * part; pc < 128 * 32; pc += 512 * nparts) { const int np = pc >> 5, k8 = (pc & 31) * 8, n = np & 63, im = np >> 6; float v[8];
#pragma unroll
        for (int q = 0; q < 8; ++q) { const int kk = k8 + q, s = kk >> 4, cp = kk & 15; const f32x2 a = Ap[(15 - s) * 64 + n], b = Bb[n * 16 + cp];
            v[q] = im ? (a.x * b.y + a.y * b.x) : (a.x * b.x - a.y * b.y); }
        u32x4 o; o.x = pk2(v[0], v[1]); o.y = pk2(v[2], v[3]); o.z = pk2(v[4], v[5]); o.w = pk2(v[6], v[7]);
        *(u32x4*)(Eg + (size_t)np * 256 + k8) = o; }
    __syncthreads();
}

__device__ __forceinline__ void norm_mod_row(const float* xrow, const float* g, const float* sc, const float* sh, bf16* orow, int lane) {
    f32x4 v[4]; float ss = 0.f;
#pragma unroll
    for (int j = 0; j < 4; ++j) { v[j] = ((const f32x4*)xrow)[lane + 64 * j]; ss += (v[j].x * v[j].x + v[j].y * v[j].y) + (v[j].z * v[j].z + v[j].w * v[j].w); }
    const float rstd = rsqrtf(wave_sum(ss) * (1.f / DM) + EPS);
#pragma unroll
    for (int j = 0; j < 4; ++j) { const int col = 4 * (lane + 64 * j); const f32x4 gg = *(const f32x4*)(g + col), s1 = *(const f32x4*)(sc + col), s2 = *(const f32x4*)(sh + col);
        const f32x4 o = v[j] * rstd * gg * (1.f + s1) + s2; u32x2 w; w.x = pk2(o.x, o.y); w.y = pk2(o.z, o.w); *(u32x2*)(orow + col) = w; }
}

__device__ __forceinline__ void lru_local_unit(const Ctx& cx, int row0, int ntok, bool samp, int aggidx, LAS unsigned char* lds) {
    const int d = threadIdx.x, w = __builtin_amdgcn_readfirstlane(d >> 6), lane = d & 63, fr = lane & 15, fq = lane >> 4;
    LAS float* cf = (LAS float*)(lds + w * 8192);
    LAS bf16* cbf = (LAS bf16*)(lds + w * 8192 + 4608);
    bf16x8 wf[8][2];
    { const bf16x8* wg = (const bf16x8*)(cx.TAB() + T_WG) + (size_t)w * 1024 + lane;
#pragma unroll
      for (int nt = 0; nt < 8; ++nt)
#pragma unroll
          for (int ks = 0; ks < 2; ++ks) wf[nt][ks] = wg[(nt * 2 + ks) * 64]; }
    const float cw0 = cx.I(12)[d], cw1 = cx.I(12)[512 + d], cw2 = cx.I(12)[1024 + d], cw3 = cx.I(12)[1536 + d], cb = cx.I(13)[d];
    float gba[4], gbx[4], gcd[4], hc[4], cc[4];
#pragma unroll
    for (int nt = 0; nt < 4; ++nt) { const int ch = 64 * w + 16 * nt + fr; gba[nt] = cx.I(15)[ch]; gbx[nt] = cx.I(17)[ch]; gcd[nt] = cx.TAB()[T_GCD + ch]; hc[nt] = 0.f; cc[nt] = 1.f; }
    const bf16* X = cx.LRUX(); float* HL = cx.HLOC(); float* CU = cx.CUM();
    float xm3 = 0.f, xm2 = 0.f, xm1 = 0.f;
    if (!samp) { const int t0 = row0 & (SEQ - 1); if (t0 >= 3) { xm3 = bf2f(X[(size_t)(row0 - 3) * DL + d]); xm2 = bf2f(X[(size_t)(row0 - 2) * DL + d]); xm1 = bf2f(X[(size_t)(row0 - 1) * DL + d]); } }
    float xv[16];
#pragma unroll
    for (int i = 0; i < 16; ++i) xv[i] = bf2f(X[(size_t)(row0 + i) * DL + d]);
    for (int t0 = 0; t0 < ntok; t0 += 16) {
        if (samp) {
#pragma unroll
            for (int i = 0; i < 16; ++i) { const int row = row0 + t0 + i; const float* sc = cx.I(2) + (size_t)(row - MPR) * 1536 + d;
                const float cv = cb + cw0 * sc[0] + cw1 * sc[512] + cw2 * sc[1024] + cw3 * xv[i];
                cf[i * 68 + lane] = cv; cbf[i * 72 + lane] = (bf16)(pk2(cv, cv) & 0xffffu); }
        } else {
#pragma unroll
            for (int i = 0; i < 16; ++i) { const float x = xv[i]; const float cv = cb + cw0 * xm3 + cw1 * xm2 + cw2 * xm1 + cw3 * x; xm3 = xm2; xm2 = xm1; xm1 = x;
                cf[i * 68 + lane] = cv; cbf[i * 72 + lane] = (bf16)(pk2(cv, cv) & 0xffffu); }
        }
        if (t0 + 16 < ntok) {
#pragma unroll
            for (int i = 0; i < 16; ++i) xv[i] = bf2f(X[(size_t)(row0 + t0 + 16 + i) * DL + d]); }
        LDS_WAIT();
        f32x4 acc[8];
#pragma unroll
        for (int nt = 0; nt < 8; ++nt) acc[nt] = (f32x4){0.f, 0.f, 0.f, 0.f};
#pragma unroll
        for (int ks = 0; ks < 2; ++ks) { const bf16x8 af = *(const LAS bf16x8*)(cbf + fr * 72 + 32 * ks + 8 * fq);
#pragma unroll
            for (int nt = 0; nt < 8; ++nt) acc[nt] = __builtin_amdgcn_mfma_f32_16x16x32_bf16(af, wf[nt][ks], acc[nt], 0, 0, 0); }
#pragma unroll
        for (int nt = 0; nt < 4; ++nt) { const int ch = 64 * w + 16 * nt + fr;
            float av[4], hv[4]; float P = 1.f, H = 0.f;
#pragma unroll
            for (int r = 0; r < 4; ++r) { const int tok = 4 * fq + r; const float cvv = cf[tok * 68 + 16 * nt + fr];
                const float rr = sigm(acc[nt][r] + gba[nt]), ig = sigm(acc[nt + 4][r] + gbx[nt]);
                const float a = __builtin_amdgcn_exp2f(gcd[nt] * rr);
                const float bb = __builtin_amdgcn_sqrtf(fmaf(-a, a, 1.f)) * ig * cvv;
                if (samp) { const float h0 = cx.I(3)[(size_t)(row0 + t0 + tok - MPR) * DL + ch]; hv[r] = a * h0 + bb; av[r] = 0.f; }
                else { H = a * H + bb; P = P * a; hv[r] = H; av[r] = P; } }
            if (!samp) {
                const float Pown = P, Hown = H;
                float Pp = __shfl_up(P, 16), Hp = __shfl_up(H, 16); if (fq >= 1) { H = P * Hp + H; P = P * Pp; }
                Pp = __shfl_up(P, 32); Hp = __shfl_up(H, 32); if (fq >= 2) { H = P * Hp + H; P = P * Pp; }
                const float rown = __builtin_amdgcn_rcpf(Pown);
                const float Pe = P * rown, He = (H - Hown) * rown;
                const float hstart = He + Pe * hc[nt], cstart = Pe * cc[nt];
#pragma unroll
                for (int r = 0; r < 4; ++r) { hv[r] = hv[r] + av[r] * hstart; av[r] = av[r] * cstart; }
                const float Pl = __shfl(P, 48 + fr), Hl = __shfl(H, 48 + fr); hc[nt] = Hl + Pl * hc[nt]; cc[nt] = Pl * cc[nt];
            }
#pragma unroll
            for (int r = 0; r < 4; ++r) { const size_t o = (size_t)(row0 + t0 + 4 * fq + r) * DL + ch; ((unsigned*)HL)[o] = pk2(hv[r], av[r]); }
            if (nt == 1) __builtin_amdgcn_sched_barrier(0);
        }
        LDS_WAIT();
    }
    if (!samp && fq == 0) {
#pragma unroll
        for (int nt = 0; nt < 4; ++nt) cx.AGG()[(size_t)aggidx * DL + 64 * w + 16 * nt + fr] = (f32x2){cc[nt], hc[nt]}; }
}

__device__ __forceinline__ void s5_gemm_e_unit(const Ctx& cx, int unit, LAS unsigned char* lds) {
    const int tid = threadIdx.x, w = __builtin_amdgcn_readfirstlane(tid >> 6), lane = tid & 63, fr = lane & 15, fq = lane >> 4;
    const int g = unit >> 3, rg = unit & 7, cr = rg * 128 + 16 * w + fr;
    const bf16* U = cx.S5U() + (size_t)(16 * cr + (fq >> 1)) * 512 + 16 * g + 8 * (fq & 1); const bf16* Eg = cx.EM() + (size_t)g * 128 * 256;
    bf16x8 af[8];
#pragma unroll
    for (int ks = 0; ks < 8; ++ks) af[ks] = *(const bf16x8*)(U + (size_t)(2 * ks) * 512);
    __syncthreads();
    LAS bf16* Bs = (LAS bf16*)lds;
    { u32x4 t[8];
#pragma unroll
      for (int i = 0; i < 8; ++i) { const int p = tid + 512 * i; t[i] = *(const u32x4*)(Eg + (size_t)(p >> 5) * 256 + (p & 31) * 8); }
#pragma unroll
      for (int i = 0; i < 8; ++i) { const int p = tid + 512 * i; *(LAS u32x4*)(Bs + (p >> 5) * 272 + (p & 31) * 8) = t[i]; } }
    __syncthreads();
    f32x4 acc[8];
#pragma unroll
    for (int n = 0; n < 8; ++n) acc[n] = (f32x4){0.f, 0.f, 0.f, 0.f};
#pragma unroll
    for (int ks = 0; ks < 8; ++ks)
#pragma unroll
        for (int nt = 0; nt < 8; ++nt) { const bf16x8 wf = *(const LAS bf16x8*)(Bs + (16 * nt + fr) * 272 + 32 * ks + 8 * fq); acc[nt] = __builtin_amdgcn_mfma_f32_16x16x32_bf16(wf, af[ks], acc[nt], 0, 0, 0); }
    float* S = cx.SK() + ((size_t)cr * 32 + g) * 128 + 4 * fq;
#pragma unroll
    for (int nt = 0; nt < 8; ++nt) *(f32x4*)(S + 16 * nt) = acc[nt];
    __syncthreads();
}

__device__ __forceinline__ void s5_chain_item(const Ctx& cx, int item, int lane) {
    const int idx = item * 64 + lane, b = idx >> 11, g = (idx >> 6) & 31, n = idx & 63;
    const f32x2 A = ((const f32x2*)(cx.TAB() + T_A16))[g * 64 + n];
    const float* S = cx.SK() + ((size_t)(b * SNCH) * 32 + g) * 128 + n; bf16* H = cx.HIN() + ((size_t)g * SROWS + b * SNCH) * 128 + n;
    float hr = 0.f, hi = 0.f; float s0r[8], s0i[8], s1r[8], s1i[8];
#define CH_LOAD(R, I, K0) do { _Pragma("unroll") for (int i = 0; i < 8; ++i) { R[i] = S[(size_t)((K0) + i) * 4096]; I[i] = S[(size_t)((K0) + i) * 4096 + 64]; } } while (0)
#define CH_STEP(R, I, K0) do { _Pragma("unroll") for (int i = 0; i < 8; ++i) { H[(size_t)((K0) + i) * 128] = (bf16)(pk2(hr, hr) & 0xffffu); H[(size_t)((K0) + i) * 128 + 64] = (bf16)(pk2(hi, hi) & 0xffffu); \
        const float nr = A.x * hr - A.y * hi + R[i], ni = A.x * hi + A.y * hr + I[i]; hr = nr; hi = ni; } } while (0)
    CH_LOAD(s0r, s0i, 0);
    for (int k0 = 0; k0 < SNCH; k0 += 16) { CH_LOAD(s1r, s1i, k0 + 8); CH_STEP(s0r, s0i, k0); if (k0 + 16 < SNCH) CH_LOAD(s0r, s0i, k0 + 16); CH_STEP(s1r, s1i, k0 + 8); }
#undef CH_LOAD
#undef CH_STEP
    cx.out[O_S5RP + (size_t)(b * 32 + g) * 64 + n] = hr; cx.out[O_S5IP + (size_t)(b * 32 + g) * 64 + n] = hi;
}

__device__ __forceinline__ void lru_fix_unit(const Ctx& cx, int row0, int ntok, bool samp, int b, int k, LAS unsigned char* lds, int chain_item, int chain_item1) {
    const int d = threadIdx.x, w = d >> 6, lane = d & 63;
    LAS float* hs = (LAS float*)lds;
    float hin = 0.f;
    if (!samp) { const f32x2* ag = cx.AGG() + (size_t)(b * NCH) * DL + d; f32x2 pp[NCH - 1];
#pragma unroll
        for (int kk = 0; kk < NCH - 1; ++kk) pp[kk] = (kk < k) ? ag[(size_t)kk * DL] : (f32x2){1.f, 0.f};
#pragma unroll
        for (int kk = 0; kk < NCH - 1; ++kk) hin = pp[kk].x * hin + pp[kk].y; }
    hs[d] = hin;
    const bf16* X = cx.LRUX();
    if (!samp && k == NCH - 1) {
#pragma unroll
        for (int j = 0; j < 3; ++j) cx.out[O_CONVP + (size_t)(b * 3 + j) * DL + d] = bf2f(X[(size_t)(row0 + LCH - 3 + j) * DL + d]); }
    if (samp) {
        float c1[SCH], c2[SCH], c3[SCH];
#pragma unroll
        for (int t = 0; t < SCH; ++t) { const float* sc = cx.I(2) + (size_t)(row0 + t - MPR) * 1536 + d; c1[t] = sc[512]; c2[t] = sc[1024]; c3[t] = bf2f(X[(size_t)(row0 + t) * DL + d]); }
#pragma unroll
        for (int t = 0; t < SCH; ++t) { float* o = cx.out + O_CONVS + (size_t)(row0 + t - MPR) * 1536 + d; o[0] = c1[t]; o[512] = c2[t]; o[1024] = c3[t]; } }
    __syncthreads();
    const float* HL = cx.HLOC(); const float* CU = cx.CUM(); const bf16* GT = cx.GATE(); bf16* MG = cx.MERGED(); const float* gl = cx.I(28);
    const f32x4 hi0 = *(const LAS f32x4*)(hs + 8 * lane), hi1 = *(const LAS f32x4*)(hs + 8 * lane + 4);
    const f32x4 g0 = *(const f32x4*)(gl + 8 * lane), g1 = *(const f32x4*)(gl + 8 * lane + 4);
    const bool with_chain = chain_item >= 0;
    if (with_chain && w == 0) { s5_chain_item(cx, chain_item, lane); asm volatile("s_waitcnt vmcnt(0)" ::: "memory"); }
    if (with_chain && w == 1) { s5_chain_item(cx, chain_item1, lane); asm volatile("s_waitcnt vmcnt(0)" ::: "memory"); }
    const int tstart = with_chain ? w - 2 : w, tstep = with_chain ? 6 : 8;
#pragma unroll 4
    for (int t = (tstart < 0 ? ntok : tstart); t < ntok; t += tstep) { const size_t ro = (size_t)(row0 + t) * DL + 8 * lane;
        const u32x4 q0 = *(const u32x4*)((const unsigned*)HL + ro), q1 = *(const u32x4*)((const unsigned*)HL + ro + 4);
        const f32x4 a0 = (f32x4){bflo(q0.x), bflo(q0.y), bflo(q0.z), bflo(q0.w)}, a1 = (f32x4){bflo(q1.x), bflo(q1.y), bflo(q1.z), bflo(q1.w)};
        const f32x4 c0 = (f32x4){bfhi(q0.x), bfhi(q0.y), bfhi(q0.z), bfhi(q0.w)}, c1 = (f32x4){bfhi(q1.x), bfhi(q1.y), bfhi(q1.z), bfhi(q1.w)};
        const u32x4 gw = *(const u32x4*)(GT + ro);
        const f32x4 h0 = a0 + c0 * hi0, h1 = a1 + c1 * hi1;
        f32x4 l0, l1;
        l0[0] = h0[0] * gelu_tanh(bflo(gw.x)); l0[1] = h0[1] * gelu_tanh(bfhi(gw.x)); l0[2] = h0[2] * gelu_tanh(bflo(gw.y)); l0[3] = h0[3] * gelu_tanh(bfhi(gw.y));
        l1[0] = h1[0] * gelu_tanh(bflo(gw.z)); l1[1] = h1[1] * gelu_tanh(bfhi(gw.z)); l1[2] = h1[2] * gelu_tanh(bflo(gw.w)); l1[3] = h1[3] * gelu_tanh(bfhi(gw.w));
        float ss = (l0[0] * l0[0] + l0[1] * l0[1]) + (l0[2] * l0[2] + l0[3] * l0[3]) + (l1[0] * l1[0] + l1[1] * l1[1]) + (l1[2] * l1[2] + l1[3] * l1[3]);
        const float rstd = rsqrtf(wave_sum(ss) * (1.f / DL) + EPS);
        *(u32x4*)(MG + (size_t)(row0 + t) * DM + 8 * lane) = pack8(l0 * rstd * g0, l1 * rstd * g1);
        if (samp) { float* o = cx.out + O_LRUS + (size_t)(row0 + t - MPR) * DL + 8 * lane; *(f32x4*)o = h0; *(f32x4*)(o + 4) = h1; }
        else if (k == NCH - 1 && t == LCH - 1) { float* o = cx.out + O_LRUP + (size_t)b * DL + 8 * lane; *(f32x4*)o = h0; *(f32x4*)(o + 4) = h1; }
    }
    __syncthreads();
}

__device__ __forceinline__ void s5_gemm_tf_unit(const Ctx& cx, int unit, LAS unsigned char* lds) {
    const int tid = threadIdx.x, w = __builtin_amdgcn_readfirstlane(tid >> 6), lane = tid & 63, fr = lane & 15, fq = lane >> 4;
    const int half = unit & 1, rq = (unit >> 1) & 3, g = unit >> 3;
    const bf16* U = cx.S5U(); const bf16* TFg = cx.TF() + ((size_t)g * 256 + 128 * half) * 384; const bf16* Hg = cx.HIN() + (size_t)g * SROWS * 128;
    __syncthreads();
    LAS bf16* Bs = (LAS bf16*)lds;
    u32x4 t[12];
#pragma unroll
    for (int i = 0; i < 12; ++i) { const int p = tid + 512 * i; t[i] = *(const u32x4*)(TFg + (size_t)(p / 48) * 384 + (p % 48) * 8); }
    bf16x8 af[2][12];
#pragma unroll
    for (int mt = 0; mt < 2; ++mt) { const int cr = rq * 256 + w * 32 + 16 * mt + fr;
#pragma unroll
        for (int ks = 0; ks < 12; ++ks)
            af[mt][ks] = (ks < 8) ? *(const bf16x8*)(U + ((size_t)(16 * cr + 2 * ks + (fq >> 1)) * 512 + 16 * g + 8 * (fq & 1))) : *(const bf16x8*)(Hg + (size_t)cr * 128 + 32 * (ks - 8) + 8 * fq); }
#pragma unroll
    for (int i = 0; i < 12; ++i) { const int p = tid + 512 * i; *(LAS u32x4*)(Bs + (p / 48) * 400 + (p % 48) * 8) = t[i]; }
    __syncthreads();
    const f32x4 d4 = *(const f32x4*)(cx.I(26) + 16 * g + 4 * fq); bf16* GY = cx.GY();
#pragma unroll
    for (int mt = 0; mt < 2; ++mt) { const int cr = rq * 256 + w * 32 + 16 * mt + fr;
        f32x4 acc[8];
#pragma unroll
        for (int n = 0; n < 8; ++n) acc[n] = (f32x4){0.f, 0.f, 0.f, 0.f};
        u32x2 uw[8];
#pragma unroll
        for (int nt = 0; nt < 8; ++nt) uw[nt] = *(const u32x2*)(U + (size_t)(16 * cr + 8 * half + nt) * 512 + 16 * g + 4 * fq);
#pragma unroll
        for (int ks = 0; ks < 12; ++ks)
#pragma unroll
            for (int nt = 0; nt < 8; ++nt) { const bf16x8 wf = *(const LAS bf16x8*)(Bs + (16 * nt + fr) * 400 + 32 * ks + 8 * fq); acc[nt] = __builtin_amdgcn_mfma_f32_16x16x32_bf16(wf, af[mt][ks], acc[nt], 0, 0, 0); }
#pragma unroll
        for (int nt = 0; nt < 8; ++nt) { const size_t off = (size_t)(16 * cr + 8 * half + nt) * 512 + 16 * g + 4 * fq;
            const f32x4 y = acc[nt] + d4 * (f32x4){bflo(uw[nt].x), bfhi(uw[nt].x), bflo(uw[nt].y), bfhi(uw[nt].y)};
            u32x2 o; o.x = pk2(gelu_tanh(y[0]), gelu_tanh(y[1])); o.y = pk2(gelu_tanh(y[2]), gelu_tanh(y[3])); *(u32x2*)(GY + off) = o; }
        __builtin_amdgcn_sched_barrier(0); }
    __syncthreads();
}
__device__ __forceinline__ void s5_sample_item(const Ctx& cx, int item, int lane) {
    const int sb = item >> 5, g = item & 31, n = lane; const int row = MPR + sb;
    const float* tab = cx.TAB(); const f32x2 A = ((const f32x2*)(tab + T_ABAR))[g * 64 + n];
    const float h0r = cx.I(4)[((size_t)sb * 32 + g) * 64 + n], h0i = cx.I(5)[((size_t)sb * 32 + g) * 64 + n];
    const bf16* up = cx.S5U() + (size_t)row * 512 + 16 * g; const u32x4 u0 = *(const u32x4*)up, u1 = *(const u32x4*)(up + 8);
    float uu[16]; uu[0] = bflo(u0.x); uu[1] = bfhi(u0.x); uu[2] = bflo(u0.y); uu[3] = bfhi(u0.y); uu[4] = bflo(u0.z); uu[5] = bfhi(u0.z); uu[6] = bflo(u0.w); uu[7] = bfhi(u0.w);
    uu[8] = bflo(u1.x); uu[9] = bfhi(u1.x); uu[10] = bflo(u1.y); uu[11] = bfhi(u1.y); uu[12] = bflo(u1.z); uu[13] = bfhi(u1.z); uu[14] = bflo(u1.w); uu[15] = bfhi(u1.w);
    float bur = 0.f, bui = 0.f; const float* br = tab + T_BBR + (size_t)(g * 64 + n) * 16; const float* bi = tab + T_BBI + (size_t)(g * 64 + n) * 16;
#pragma unroll
    for (int c4 = 0; c4 < 4; ++c4) { const f32x4 r4 = *(const f32x4*)(br + 4 * c4), i4 = *(const f32x4*)(bi + 4 * c4);
#pragma unroll
        for (int i = 0; i < 4; ++i) { bur += r4[i] * uu[4 * c4 + i]; bui += i4[i] * uu[4 * c4 + i]; } }
    const float hr = A.x * h0r - A.y * h0i + bur, hi = A.x * h0i + A.y * h0r + bui;
    cx.out[O_S5RS + ((size_t)sb * 32 + g) * 64 + n] = hr; cx.out[O_S5IS + ((size_t)sb * 32 + g) * 64 + n] = hi;
    float my = 0.f, myu = 0.f;
#pragma unroll
    for (int c = 0; c < 16; ++c) { const float v = wave_sum(cx.I(24)[((size_t)g * 16 + c) * 64 + n] * hr - cx.I(25)[((size_t)g * 16 + c) * 64 + n] * hi); if (lane == c) { my = v; myu = uu[c]; } }
    if (lane < 16) { const float y = my + cx.I(26)[16 * g + lane] * myu; cx.GY()[(size_t)row * 512 + 16 * g + lane] = (bf16)(pk2(gelu_tanh(y), 0.f) & 0xffffu); }
}

#define XB_TMO      128
#define XB_XCNT(j)  (256  + 64 * (j))
#define XB_XSUB(j)  (1280 + 64 * (j))
#define XB_XGEN(j)  (2304 + 64 * (j))
#define XB_TOP      3328
#define XB_TOPGEN   3392
#define XCD_BAR_WORDS 3456
#define XB_SPIN_CAP (1u << 18)

__device__ __forceinline__ unsigned xb_ld(unsigned* p)              { return __hip_atomic_load(p, __ATOMIC_RELAXED, __HIP_MEMORY_SCOPE_AGENT); }
__device__ __forceinline__ unsigned xb_add(unsigned* p, unsigned v) { return __hip_atomic_fetch_add(p, v, __ATOMIC_RELAXED, __HIP_MEMORY_SCOPE_AGENT); }
__device__ __forceinline__ unsigned xb_xcc_id() { return (unsigned)__builtin_amdgcn_s_getreg((3 << 11) | 20) & 0xFu; }
#define XB_SPIN(cond, bar) do { unsigned _sp = 0; while (cond) { __builtin_amdgcn_s_sleep(1); \
    if ((++_sp & 255u) == 0u) { if (xb_ld(&(bar)[XB_TMO])) break; if (_sp > XB_SPIN_CAP) { atomicAdd(&(bar)[XB_TMO], 1u); break; } } } } while (0)

struct XcdBarrier {
    unsigned* bar; unsigned x;
    volatile LAS unsigned* st;
};

__device__ __forceinline__ XcdBarrier xcd_barrier_post(unsigned* bar, volatile LAS unsigned* st) {
    XcdBarrier b; b.bar = bar; b.x = xb_xcc_id(); b.st = st;
    if (threadIdx.x == 0) (void)xb_add(&bar[XB_XCNT(b.x)], 1u);
    return b;
}
__device__ __forceinline__ void xcd_barrier_complete(unsigned* bar, unsigned x, unsigned& nloc, unsigned& nx) {
    const unsigned G = gridDim.x * gridDim.y * gridDim.z;
    unsigned sum, cnt, mine, sp = 0u;
    for (;;) {
        sum = 0u; cnt = 0u; mine = 0u;
#pragma unroll
        for (unsigned j = 0; j < 16; ++j) { const unsigned c = xb_ld(&bar[XB_XCNT(j)]); sum += c; cnt += (c > 0u) ? 1u : 0u; mine = (j == x) ? c : mine; }
        if (sum == G) break;
        __builtin_amdgcn_s_sleep(1);
        if ((++sp & 255u) == 0u) { if (xb_ld(&bar[XB_TMO])) break; if (sp > XB_SPIN_CAP) { atomicAdd(&bar[XB_TMO], 1u); break; } }
    }
    nloc = mine > 0u ? mine : 1u; nx = cnt > 0u ? cnt : 1u;
}

__device__ __forceinline__ void xcd_barrier(const XcdBarrier& b) {
    asm volatile("s_waitcnt vmcnt(0)" ::: "memory");
    __syncthreads();
    if (threadIdx.x == 0) {
        unsigned* bar = b.bar;
        __builtin_amdgcn_s_waitcnt(0);
        unsigned nloc = b.st[0], nx = b.st[1];
        if (nloc == 0u) { xcd_barrier_complete(bar, b.x, nloc, nx); b.st[0] = nloc; b.st[1] = nx; }
        const unsigned old = xb_add(&bar[XB_XSUB(b.x)], 1u);
        const unsigned gen = old / nloc;
        if (old + 1u == (gen + 1u) * nloc) {
            __builtin_amdgcn_fence(__ATOMIC_RELEASE, "agent");
            asm volatile("s_waitcnt vmcnt(0)" ::: "memory");
            const unsigned og = xb_add(&bar[XB_TOP], 1u);
            const unsigned tg = og / nx;
            if (og + 1u == (tg + 1u) * nx) xb_add(&bar[XB_TOPGEN], 1u);
            else XB_SPIN(xb_ld(&bar[XB_TOPGEN]) == tg, bar);
            __builtin_amdgcn_fence(__ATOMIC_ACQUIRE, "agent");
            xb_add(&bar[XB_XGEN(b.x)], 1u);
            asm volatile("s_waitcnt vmcnt(0)" ::: "memory");
        } else {
            XB_SPIN(xb_ld(&bar[XB_XGEN(b.x)]) == gen, bar);
            __builtin_amdgcn_fence(__ATOMIC_ACQUIRE, "agent");
            asm volatile("s_waitcnt vmcnt(0)" ::: "memory");
        }
    }
    __syncthreads();
}

__global__ void __launch_bounds__(512, 2) fwd_kernel(KArgs a) {
    extern __shared__ __attribute__((aligned(16))) unsigned char lds_raw[];
    LAS unsigned char* lds = (LAS unsigned char*)lds_raw;
    Ctx cx; cx.in = a.in; cx.out = a.out; cx.ws = a.ws;
    const int tid = threadIdx.x, lane = tid & 63, wave = __builtin_amdgcn_readfirstlane(tid >> 6);
    const int G = gridDim.x, bid = blockIdx.x, gw = bid * 8 + wave, NGW = G * 8;
    volatile LAS unsigned* bst = (volatile LAS unsigned*)(lds + 131072);
    if (tid < 16) bst[tid] = 0u;
    __syncthreads();
    XcdBarrier xbar = xcd_barrier_post((unsigned*)a.ws, bst);
#ifndef REPMASK
#define REPMASK 0
#endif
#ifndef PHMASK
#define PHMASK 0x1fff
#endif
#define IN(k) (((PHMASK >> (k)) & 1) && a.lo <= (k) && (k) < a.hi)
#ifndef PROBE_LO
#define PROBE_LO -1
#define PROBE_HI -1
#endif
    unsigned long long pt0 = 0;
#define PSTART(k) do { if ((k) == PROBE_LO && bid == 0 && tid == 0) pt0 = __builtin_amdgcn_s_memrealtime(); } while (0)
#define PEND(k) do { if ((k) == PROBE_HI && bid == 0) { if (tid == 0) { const unsigned long long t1 = __builtin_amdgcn_s_memrealtime(); const unsigned long long d = t1 - pt0; while (__builtin_amdgcn_s_memrealtime() - t1 < d) __builtin_amdgcn_s_sleep(8); } __syncthreads(); } } while (0)
#define SEAM(k) do { if (IN(k) && IN((k) + 1)) xcd_barrier(xbar); PEND(k); PSTART((k) + 1); } while (0)

    PSTART(0);
    if (IN(0)) for (int rep_ = 0; rep_ < 1 + ((REPMASK >> 0) & 1); ++rep_) {
        if (bid >= 32 && bid < 224) ada_block(cx, bid - 32, lds);
        else { LAS bf16* scr = (LAS bf16*)(lds + wave * 16384); const int w2 = (bid < 32 ? bid : bid - 192) * 8 + wave;
            for (int it = w2; it < 384; it += 512) transpose_dispatch(cx, it, scr, lane);
            if (bid < 16) lru_gate_tables(cx, bid); }
    }
    SEAM(0);
    if (IN(1)) for (int rep_ = 0; rep_ < 1 + ((REPMASK >> 1) & 1); ++rep_) {
        for (int r = gw; r < MTOK; r += 2 * NGW) { const int r2 = r + NGW; const bool two = r2 < MTOK; const int rb = two ? r2 : r;
            const float* xa = r < MPR ? cx.I(0) + (size_t)r * DM : cx.I(1) + (size_t)(r - MPR) * DM; const float* xb = rb < MPR ? cx.I(0) + (size_t)rb * DM : cx.I(1) + (size_t)(rb - MPR) * DM;
            const float* ma = cx.MOD() + (size_t)mod_row(r) * NMOD; const float* mb = cx.MOD() + (size_t)mod_row(rb) * NMOD; const float* g = cx.I(10);
            f32x4 va[4], vb[4], gg[4], sca[4], sha[4], scb[4], shb[4]; float sa = 0.f, sb = 0.f;
#pragma unroll
            for (int j = 0; j < 4; ++j) { va[j] = ((const f32x4*)xa)[lane + 64 * j]; vb[j] = ((const f32x4*)xb)[lane + 64 * j]; }
#pragma unroll
            for (int j = 0; j < 4; ++j) { const int col = 4 * (lane + 64 * j);
                gg[j] = *(const f32x4*)(g + col); sca[j] = *(const f32x4*)(ma + 1024 + col); sha[j] = *(const f32x4*)(ma + col); scb[j] = *(const f32x4*)(mb + 1024 + col); shb[j] = *(const f32x4*)(mb + col); }
#pragma unroll
            for (int j = 0; j < 4; ++j) { sa += (va[j].x * va[j].x + va[j].y * va[j].y) + (va[j].z * va[j].z + va[j].w * va[j].w); sb += (vb[j].x * vb[j].x + vb[j].y * vb[j].y) + (vb[j].z * vb[j].z + vb[j].w * vb[j].w); }
#pragma unroll
            for (int o = 1; o < 64; o <<= 1) { sa += __shfl_xor(sa, o); sb += __shfl_xor(sb, o); }
            const float ra = rsqrtf(sa * (1.f / DM) + EPS), rbs = rsqrtf(sb * (1.f / DM) + EPS);
#pragma unroll
            for (int j = 0; j < 4; ++j) { const int col = 4 * (lane + 64 * j);
                const f32x4 oa = va[j] * ra * gg[j] * (1.f + sca[j]) + sha[j]; u32x2 w; w.x = pk2(oa.x, oa.y); w.y = pk2(oa.z, oa.w); *(u32x2*)(cx.XN() + (size_t)r * DM + col) = w;
                if (two) { const f32x4 ob = vb[j] * rbs * gg[j] * (1.f + scb[j]) + shb[j]; u32x2 w2; w2.x = pk2(ob.x, ob.y); w2.y = pk2(ob.z, ob.w); *(u32x2*)(cx.XN() + (size_t)rb * DM + col) = w2; } } }
    }
    SEAM(1);
    if (IN(2)) for (int rep_ = 0; rep_ < 1 + ((REPMASK >> 2) & 1); ++rep_) {
        pg8::Gemm g{cx.XN(), cx.WIN(), MPAD, NPROJ, DM}; Sched2 S; S.init(NPROJ, DM, G, bid, DM / 64);
        EpiProj E{cx.LRUX(), cx.GATE(), cx.S5U()};
        pg8::gemm_phase<EpiProj, Sched2, true, true>(lds, g, S, E);
        for (int q_ = 0; q_ < 1 + ((REPMASK >> 15) & 1); ++q_)
        if (bid >= 134 && bid < 198) s5_tables(cx, (bid - 134) >> 1, lds, (bid - 134) & 1, 2);
        for (int q_ = 0; q_ < 1 + ((REPMASK >> 12) & 1); ++q_)
        if (bid >= 198) { LAS bf16* scr = (LAS bf16*)(lds + wave * 16384);
            for (int it = 384 + (255 - bid) * 8 + wave; it < N_TR_ITEMS; it += 58 * 8) transpose_dispatch(cx, it, scr, lane); }
    }
    SEAM(2);
    if (IN(3)) for (int rep_ = 0; rep_ < 1 + ((REPMASK >> 3) & 1); ++rep_) {
#ifndef NO_LRU
        for (int q_ = 0; q_ < 1 + ((REPMASK >> 13) & 1); ++q_)
        for (int u = bid; u < 256 + NBS / SCH; u += G) {
            if (u < 256) lru_local_unit(cx, u * LCH, LCH, false, u, lds); else lru_local_unit(cx, MPR + (u - 256) * SCH, SCH, true, 0, lds);
        }
#endif
#ifndef NO_E
        for (int q_ = 0; q_ < 1 + ((REPMASK >> 14) & 1); ++q_)
        if (G == 256) { if (bid >= 8) { s5_gemm_e_unit(cx, bid, lds); if (bid < 16) s5_gemm_e_unit(cx, bid - 8, lds); } }
        else for (int u = bid; u < 256; u += G) s5_gemm_e_unit(cx, u, lds);
#endif
    }
    SEAM(3);
    if (IN(4)) for (int rep_ = 0; rep_ < 1 + ((REPMASK >> 4) & 1); ++rep_) {
        for (int u = bid; u < 256 + NBS / SCH; u += G) {
            const int cg = bid >> 3, cb0 = 2 * ((bid >> 1) & 3);
            if (u < 256) lru_fix_unit(cx, u * LCH, LCH, false, u >> 5, u & 31, lds, (u == bid && G == 256) ? cb0 * 32 + cg : -1, (cb0 + 1) * 32 + cg); else lru_fix_unit(cx, MPR + (u - 256) * SCH, SCH, true, 0, 0, lds, -1, -1);
        }
        for (int u = bid; u < 256; u += G) s5_gemm_tf_unit(cx, u, lds);
        for (int it = gw; it < NBS * 32; it += NGW) s5_sample_item(cx, it, lane);
    }
    SEAM(5);
    if (IN(6)) for (int rep_ = 0; rep_ < 1 + ((REPMASK >> 6) & 1); ++rep_) {
        pg8::Gemm g{cx.GY(), cx.WGLU(), MPAD, 1024, 512}; Sched3 S; S.init(1024, 512, G, bid, 2);
        EpiGluNorm E{cx.MERGED(), cx.I(29), cx.PART(), (unsigned*)cx.ws + 3584, RmsPanel{(float*)(cx.ws + WS_XSLOT), (unsigned*)cx.ws + 4096, 1.f / 512, EPS}};
        pg8::gemm_phase<EpiGluNorm, Sched3, true, true>(lds, g, S, E);
        if (bid >= 240) { wait_partials((unsigned*)cx.ws + 3584, 16u * 8u);
            const float* gs = cx.I(29); const int r = MPR + (bid - 240) * 8 + wave;
            const float* pp = cx.PART() + (size_t)(r - MPR) * 1024; const int c0 = 4 * lane, ca0 = 256 * (c0 >> 7) + (c0 & 127), ca1 = ca0 + 512;
            f32x4 a0 = (f32x4){0.f, 0.f, 0.f, 0.f}, b0 = a0, a1 = a0, b1 = a0, v0, v1;
#pragma unroll
            for (int sl = 0; sl < 4; ++sl) { const float* q = pp + (size_t)sl * 128 * 1024; a0 += *(const f32x4*)(q + ca0); b0 += *(const f32x4*)(q + ca0 + 128); a1 += *(const f32x4*)(q + ca1); b1 += *(const f32x4*)(q + ca1 + 128); }
#pragma unroll
            for (int i = 0; i < 4; ++i) { v0[i] = a0[i] * sigm(b0[i]); v1[i] = a1[i] * sigm(b1[i]); }
            const float ss = (v0.x * v0.x + v0.y * v0.y) + (v0.z * v0.z + v0.w * v0.w) + (v1.x * v1.x + v1.y * v1.y) + (v1.z * v1.z + v1.w * v1.w);
            const float rstd = rsqrtf(wave_sum(ss) * (1.f / 512) + EPS);
            const f32x4 o0 = v0 * rstd * ((const f32x4*)gs)[lane], o1 = v1 * rstd * ((const f32x4*)gs)[lane + 64];
            bf16* mp = cx.MERGED() + (size_t)r * DM + 512; u32x2 w0, w1; w0.x = pk2(o0.x, o0.y); w0.y = pk2(o0.z, o0.w); w1.x = pk2(o1.x, o1.y); w1.y = pk2(o1.z, o1.w);
            *(u32x2*)(mp + 4 * lane) = w0; *(u32x2*)(mp + 256 + 4 * lane) = w1; }
    }
    SEAM(7);
    if (IN(8)) for (int rep_ = 0; rep_ < 1 + ((REPMASK >> 8) & 1); ++rep_) {
        pg8::Gemm g{cx.MERGED(), cx.WOUT(), MPAD, DM, DM}; Sched3 S; S.init(DM, DM, G, bid, 2);
        EpiResNorm<1> E{cx.I(0), cx.MOD(), cx.I(31), cx.out, cx.XN2(), cx.X1B(), cx.PART(), (unsigned*)cx.ws + 3648, RmsPanel{(float*)(cx.ws + WS_XSLOT + 262144), (unsigned*)cx.ws + 8192, 1.f / DM, EPS}};
        pg8::gemm_phase<EpiResNorm<1>, Sched3, true, true>(lds, g, S, E);
        if (bid >= 240) { wait_partials((unsigned*)cx.ws + 3648, 32u * 8u);
            const int r = MPR + (bid - 240) * 8 + wave; const float* md = cx.MOD() + (size_t)mod_row(r) * NMOD;
            const float* pp = cx.PART() + (size_t)(r - MPR) * 1024; const float* xr = cx.I(1) + (size_t)(r - MPR) * DM; float* orow = cx.out + (size_t)r * DM;
#pragma unroll
            for (int j = 0; j < 4; ++j) { const int col = 4 * (lane + 64 * j); f32x4 sm = (f32x4){0.f, 0.f, 0.f, 0.f};
#pragma unroll
                for (int sl = 0; sl < 8; ++sl) sm += *(const f32x4*)(pp + (size_t)sl * 128 * 1024 + col);
                *(f32x4*)(orow + col) = *(const f32x4*)(xr + col) + *(const f32x4*)(md + 2048 + col) * sm; }
            norm_mod_row(cx.out + (size_t)r * DM, cx.I(31), md + 4096, md + 3072, cx.XN2() + (size_t)r * DM, lane); }
    }
    SEAM(9);
    if (IN(10)) for (int rep_ = 0; rep_ < 1 + ((REPMASK >> 10) & 1); ++rep_) {
        pg8::Gemm g{cx.XN2(), cx.WGU(), MPAD, 2 * DFF, DM}; Sched2 S; S.init(2 * DFF, DM, G, bid, DM / 64);
        EpiSwiglu E{cx.HB()};
        pg8::gemm_phase<EpiSwiglu, Sched2, true, true>(lds, g, S, E);
    }
    SEAM(10);
    if (IN(11)) for (int rep_ = 0; rep_ < 1 + ((REPMASK >> 11) & 1); ++rep_) {
        pg8::Gemm g{cx.HB(), cx.WDN(), MPAD, DM, DFF}; Sched3 S; S.init(DM, DFF, G, bid, 2);
        EpiResNorm<2> E{nullptr, cx.MOD(), cx.I(35), cx.out, nullptr, cx.X1B(), cx.PART(), (unsigned*)cx.ws + 3712, RmsPanel{(float*)(cx.ws + WS_XSLOT + 524288), (unsigned*)cx.ws + 12288, 1.f / DM, EPS}};
        pg8::gemm_phase<EpiResNorm<2>, Sched3, true, true>(lds, g, S, E);
        if (bid >= 192) { wait_partials((unsigned*)cx.ws + 3712, 88u * 8u);
            const float* fg = cx.I(35); const int r = MPR + (bid - 192) * 2 + (wave >> 2), col = 256 * (wave & 3) + 4 * lane; float* xr = cx.out + (size_t)r * DM + col;
            const float* pp = cx.PART() + (size_t)(r - MPR) * 1024 + col; f32x4 sm = (f32x4){0.f, 0.f, 0.f, 0.f};
            f32x4 v = *(const f32x4*)xr; const f32x4 g2v = *(const f32x4*)(cx.MOD() + (size_t)mod_row(r) * NMOD + 5120 + col), fgv = *(const f32x4*)(fg + col);
#pragma unroll
            for (int sl = 0; sl < 22; ++sl) sm += *(const f32x4*)(pp + (size_t)sl * 128 * 1024);
            v += g2v * sm;
            const float ssw = wave_sum((v.x * v.x + v.y * v.y) + (v.z * v.z + v.w * v.w));
            LAS float* red = (LAS float*)lds;
            if (lane == 0) red[wave] = ssw;
            __syncthreads();
            const int w0 = wave & 4; const float ss = (red[w0] + red[w0 + 1]) + (red[w0 + 2] + red[w0 + 3]);
            const float rstd = rsqrtf(ss * (1.f / DM) + EPS);
            *(f32x4*)xr = v * rstd * fgv; }
    }
    PEND(12);
#undef IN
#undef SEAM
}

constexpr int LDS_BYTES = 131072 + 256;
#ifndef MK_SINGLE
#define MK_SINGLE 1
#endif
extern "C" void kernel_launch(void* const* d_in, const int* in_sizes, int n_in, void* d_out, int out_size, void* d_ws, size_t ws_size, hipStream_t stream) {
    static int grid = 0;
    if (grid == 0) {
        if (n_in != 36 || (size_t)out_size != O_END || ws_size < WS_END) { fprintf(stderr, "kernel_launch: unexpected shapes n_in %d out %d ws %zu\n", n_in, out_size, ws_size); grid = -1; return; }
        int dev = 0, cus = 0, per_cu = 0;
        hipGetDevice(&dev); hipDeviceGetAttribute(&cus, hipDeviceAttributeMultiprocessorCount, dev);
        hipFuncSetAttribute((const void*)fwd_kernel, hipFuncAttributeMaxDynamicSharedMemorySize, LDS_BYTES);
        hipOccupancyMaxActiveBlocksPerMultiprocessor(&per_cu, (const void*)fwd_kernel, 512, LDS_BYTES);
        if (per_cu < 1) { fprintf(stderr, "kernel_launch: occupancy query says %d blocks per CU\n", per_cu); grid = -1; return; }
        if (cus != 256) { fprintf(stderr, "kernel_launch: built for 256 CUs (one 256x256 unit per workgroup in the fused-norm GEMM phases), found %d\n", cus); grid = -1; return; }
        grid = cus;
    }
    if (grid < 0) return;
    if (hipMemsetAsync(d_ws, 0, 65536, stream) != hipSuccess) { fprintf(stderr, "kernel_launch: memset of the barrier words failed\n"); return; }
    KArgs a{};
    for (int i = 0; i < 36; ++i) a.in[i] = (const float*)d_in[i];
    a.out = (float*)d_out; a.ws = (unsigned char*)d_ws;
#if MK_SINGLE
    a.lo = 0; a.hi = NPHASE;
    void* args[] = {&a};
#ifdef PLAIN_LAUNCH
    hipLaunchKernelGGL(fwd_kernel, dim3(grid), dim3(512), LDS_BYTES, stream, a); hipError_t e = hipPeekAtLastError(); (void)args;
#else
    hipError_t e = hipLaunchCooperativeKernel((const void*)fwd_kernel, dim3(grid), dim3(512), args, LDS_BYTES, stream);
#endif
    if (e != hipSuccess) fprintf(stderr, "cooperative launch failed: %s (grid %d)\n", hipGetErrorString(e), grid);
#else
    for (int p = 0; p < NPHASE; ++p) { a.lo = p; a.hi = p + 1; hipLaunchKernelGGL(fwd_kernel, dim3(grid), dim3(512), LDS_BYTES, stream, a); }
#endif
}
```

```cpp
#include <hip/hip_runtime.h>
#include <hip/hip_cooperative_groups.h>
#include <cstdio>
#include <cstdint>
namespace cg = cooperative_groups;
namespace pg8 {
#define PG8_LAS __attribute__((address_space(3)))
typedef unsigned short bf16_t;
typedef short bf16x8 __attribute__((ext_vector_type(8)));
typedef float f32x4 __attribute__((ext_vector_type(4)));
typedef unsigned u32x4 __attribute__((ext_vector_type(4)));
constexpr int BM = 256, BK = 64, HALF = 128, HTB = HALF * BK * 2  , STAGE_BYTES = 8 * HTB, NXCD = 8, WGM = 8;

__host__ __device__ __forceinline__ int lds_byte(int r, int c) { const int st = (r >> 4) * 2 + (c >> 5), rr = r & 15, cc = c & 31, ob = rr * 64 + cc * 2; return st * 1024 + (ob ^ (((ob >> 9) & 1) << 5)); }
__host__ __device__ __forceinline__ void stage_rc(int b, int& R, int& C) { const int st = b / 1024, sb = b % 1024, swz = sb ^ (((sb >> 9) & 1) << 5); R = (st >> 1) * 16 + swz / 64; C = (st & 1) * 32 + (swz % 64) / 2; }
__host__ __device__ __forceinline__ int perm32(int rho) { const int n = rho >> 4, i = rho & 15; return 8 * (i >> 2) + 4 * n + (i & 3); }

struct Unit { int pm, pn, kt0, nkt, kind, slice; };
struct Gemm { const bf16_t* A; const bf16_t* Bt; int M, N, K; };

struct StaticOrder {
    int nM, nN, nwg, G, c;
    __host__ __device__ __forceinline__ void init(int M, int N, int G_, int c_) { nM = M / BM; nN = N / BM; nwg = nM * nN; G = G_; c = c_; }
    __host__ __device__ __forceinline__ bool next(int i, Unit& u) const {
        const long L = (long)i * G + c; if (L >= nwg) return false;
        int wgid = (int)L; { const int q = nwg / NXCD, r = nwg % NXCD, xcd = wgid % NXCD, off = wgid / NXCD; wgid = (xcd < r ? xcd * (q + 1) : r * (q + 1) + (xcd - r) * q) + off; }
        const int nig = WGM * nN, gid = wgid / nig, fm = gid * WGM, gsz = (nM - fm) < WGM ? (nM - fm) : WGM;
        u.pm = fm + ((wgid % nig) % gsz); u.pn = (wgid % nig) / gsz; return true;
    }
    __device__ __forceinline__ void a_ready(const Unit&) const {}
    __device__ __forceinline__ void done(const Unit&) const {}
};

__device__ __forceinline__ unsigned cvt_pk_bf16(float lo, float hi) { unsigned r; asm("v_cvt_pk_bf16_f32 %0, %1, %2" : "=v"(r) : "v"(lo), "v"(hi)); return r; }
typedef float f32x2 __attribute__((ext_vector_type(2)));
template <class Epi, class Sched, bool ALIGN_EPI = false, bool SP2 = false>
__device__ __forceinline__ void gemm_phase(PG8_LAS unsigned char* lds, const Gemm g, const Sched& S, const Epi& E) {
    const int tid = threadIdx.x, wid = __builtin_amdgcn_readfirstlane(tid >> 6), lane = tid & 63, wr = wid >> 2, wc = wid & 3, fr = lane & 15, fq = lane >> 4;
    const int K = g.K;
    unsigned voffA[2], voffB[2];
#pragma unroll
    for (int i = 0; i < 2; ++i) { int R, C; stage_rc(tid * 16 + i * 8192, R, C); const int Rb = Epi::PERM ? ((R & ~31) + perm32(R & 31)) : R;
        voffA[i] = (unsigned)(R * K + C) * 2u; voffB[i] = (unsigned)(Rb * K + C) * 2u; }
    const size_t kstep = (size_t)(BK * 2);
    const size_t hstep = (size_t)HALF * K * 2;
    const size_t tstep = 2 * hstep;
    const unsigned ldsw = (unsigned)wid * 1024u;
    const int aoff = lds_byte(wr * 64 + fr, fq * 8), boff = lds_byte(wc * 32 + fr, fq * 8);
#define PG8_SA(b, h) (((b) * 2 + (h)) * HTB)
#define PG8_SB(b, h) ((4 + (b) * 2 + (h)) * HTB)
#define PG8_STAGE(bufoff, gbase, voff) do { _Pragma("unroll") for (int _i = 0; _i < 2; ++_i) \
        __builtin_amdgcn_global_load_lds((const unsigned*)((const char*)(gbase) + (voff)[_i]), (PG8_LAS unsigned*)(lds + (bufoff) + ldsw + _i * 8192), 16, 0, 0); } while (0)
#define PG8_LDA(dst, b, h) do { _Pragma("unroll") for (int m = 0; m < 4; ++m) _Pragma("unroll") for (int k = 0; k < 2; ++k) dst[m][k] = *(const PG8_LAS bf16x8*)(lds + PG8_SA(b, h) + aoff + m * 2048 + k * 1024); } while (0)
#define PG8_LDB(dst, b, h) do { _Pragma("unroll") for (int n = 0; n < 2; ++n) _Pragma("unroll") for (int k = 0; k < 2; ++k) dst[n][k] = *(const PG8_LAS bf16x8*)(lds + PG8_SB(b, h) + boff + n * 2048 + k * 1024); } while (0)
#define PG8_MMA(ai, bj, At, Bt) do { __builtin_amdgcn_s_setprio(1); _Pragma("unroll") for (int m = 0; m < 4; ++m) _Pragma("unroll") for (int n = 0; n < 2; ++n) _Pragma("unroll") for (int k = 0; k < 2; ++k) \
        acc[ai][bj][m][n] = __builtin_amdgcn_mfma_f32_16x16x32_bf16(Bt[n][k], At[m][k], acc[ai][bj][m][n], 0, 0, 0); __builtin_amdgcn_s_setprio(0); } while (0)
#define PG8_WAIT_V(n) asm volatile("s_waitcnt vmcnt(" #n ")" ::: "memory")
#define PG8_WAIT_L(n) asm volatile("s_waitcnt lgkmcnt(" #n ")" ::: "memory")
#define PG8_BAR __builtin_amdgcn_s_barrier()
#define PG8_SCHED __builtin_amdgcn_sched_barrier(0)
    Unit cur = {0, 0, 0, 0, 0, 0}, nxt = {0, 0, 0, 0, 0, 0}; int ui = 0;
    if (!S.next(0, cur)) return;
    f32x4 acc[2][2][4][2];
#pragma unroll
    for (int a = 0; a < 2; ++a)
#pragma unroll
        for (int b = 0; b < 2; ++b)
#pragma unroll
            for (int m = 0; m < 4; ++m)
#pragma unroll
                for (int n = 0; n < 2; ++n) acc[a][b][m][n] = (f32x4){0.f, 0.f, 0.f, 0.f};
    bf16x8 At[4][2], B0[2][2], B1[2][2];
    const char* cA = (const char*)g.A + (size_t)cur.pm * tstep + (size_t)cur.kt0 * kstep; const char* cB = (const char*)g.Bt + (size_t)cur.pn * tstep + (size_t)cur.kt0 * kstep;
    S.a_ready(cur);
    if constexpr (SP2) {
        PG8_STAGE(PG8_SB(0, 0), cB, voffB); PG8_STAGE(PG8_SB(0, 1), cB + hstep, voffB); PG8_STAGE(PG8_SA(0, 0), cA, voffA); PG8_STAGE(PG8_SA(0, 1), cA + hstep, voffA);
        if (wr == 1) PG8_BAR;
        PG8_WAIT_V(2); PG8_BAR;
        PG8_STAGE(PG8_SB(1, 0), cB + kstep, voffB); PG8_STAGE(PG8_SA(1, 0), cA + kstep, voffA); PG8_STAGE(PG8_SB(1, 1), cB + hstep + kstep, voffB);
        PG8_WAIT_V(6); PG8_BAR;
    } else {
        PG8_STAGE(PG8_SB(0, 0), cB, voffB); PG8_STAGE(PG8_SA(0, 0), cA, voffA); PG8_STAGE(PG8_SB(0, 1), cB + hstep, voffB); PG8_STAGE(PG8_SA(0, 1), cA + hstep, voffA);
        if (wr == 1) PG8_BAR;
        PG8_WAIT_V(4); PG8_BAR;
        PG8_STAGE(PG8_SB(1, 0), cB + kstep, voffB); PG8_STAGE(PG8_SA(1, 0), cA + kstep, voffA); PG8_STAGE(PG8_SB(1, 1), cB + hstep + kstep, voffB);
        PG8_WAIT_V(6); PG8_BAR;
    }
    for (;;) {
        const bool has_next = S.next(ui + 1, nxt);
        const char* nA = has_next ? (const char*)g.A + (size_t)nxt.pm * tstep + (size_t)nxt.kt0 * kstep : cA; const char* nB = has_next ? (const char*)g.Bt + (size_t)nxt.pn * tstep + (size_t)nxt.kt0 * kstep : cB;
        const int nt = cur.nkt;
        for (int t = 0; t < nt; t += 2) {
            const bool last = (t == nt - 2);
            const char* a1 = cA + (size_t)(t + 1) * kstep;
            const char* a2 = last ? nA : cA + (size_t)(t + 2) * kstep; const char* b2 = last ? nB : cB + (size_t)(t + 2) * kstep;
            const char* a3 = a2 + kstep; const char* b3 = b2 + kstep;
            if (last && has_next) S.a_ready(nxt);
            if constexpr (SP2) {
            PG8_LDB(B0, 0, 0); PG8_LDB(B1, 0, 1); PG8_SCHED; PG8_LDA(At, 0, 0); PG8_STAGE(PG8_SA(1, 1), a1 + hstep, voffA);
            PG8_WAIT_V(8); PG8_WAIT_L(0); PG8_BAR; PG8_MMA(0, 0, At, B0); PG8_MMA(0, 1, At, B1); PG8_BAR; PG8_SCHED;
            PG8_LDA(At, 0, 1); PG8_STAGE(PG8_SB(0, 0), b2, voffB); PG8_STAGE(PG8_SB(0, 1), b2 + hstep, voffB); PG8_STAGE(PG8_SA(0, 0), a2, voffA);
            PG8_WAIT_V(8); PG8_WAIT_L(0); PG8_BAR; PG8_MMA(1, 0, At, B0); PG8_MMA(1, 1, At, B1); PG8_BAR; PG8_SCHED;
            PG8_LDB(B0, 1, 0); PG8_LDB(B1, 1, 1); PG8_SCHED; PG8_LDA(At, 1, 0); PG8_STAGE(PG8_SA(0, 1), a2 + hstep, voffA);
            PG8_WAIT_V(8); PG8_WAIT_L(0); PG8_BAR; PG8_MMA(0, 0, At, B0); PG8_MMA(0, 1, At, B1); PG8_BAR; PG8_SCHED;
            PG8_LDA(At, 1, 1); PG8_STAGE(PG8_SB(1, 0), b3, voffB); PG8_STAGE(PG8_SB(1, 1), b3 + hstep, voffB); PG8_STAGE(PG8_SA(1, 0), a3, voffA);
            PG8_WAIT_V(8); PG8_WAIT_L(0); PG8_BAR; PG8_MMA(1, 0, At, B0); PG8_MMA(1, 1, At, B1); PG8_BAR; PG8_SCHED;
            } else {
            PG8_LDB(B0, 0, 0); PG8_SCHED; PG8_LDA(At, 0, 0); PG8_STAGE(PG8_SA(1, 1), a1 + hstep, voffA);
            PG8_WAIT_L(8); PG8_BAR; PG8_WAIT_L(0); PG8_MMA(0, 0, At, B0); PG8_BAR; PG8_SCHED;
            PG8_LDB(B1, 0, 1); PG8_STAGE(PG8_SB(0, 0), b2, voffB);
            PG8_BAR; PG8_WAIT_L(0); PG8_MMA(0, 1, At, B1); PG8_BAR;
            PG8_LDA(At, 0, 1); PG8_STAGE(PG8_SA(0, 0), a2, voffA);
            PG8_BAR; PG8_WAIT_L(0); PG8_MMA(1, 0, At, B0); PG8_BAR; PG8_SCHED;
            PG8_STAGE(PG8_SB(0, 1), b2 + hstep, voffB);
            PG8_WAIT_V(6); PG8_BAR; PG8_MMA(1, 1, At, B1); PG8_BAR;
            PG8_LDB(B0, 1, 0); PG8_SCHED; PG8_LDA(At, 1, 0); PG8_STAGE(PG8_SA(0, 1), a2 + hstep, voffA);
            PG8_WAIT_L(8); PG8_BAR; PG8_WAIT_L(0); PG8_MMA(0, 0, At, B0); PG8_BAR; PG8_SCHED;
            PG8_LDB(B1, 1, 1); PG8_STAGE(PG8_SB(1, 0), b3, voffB);
            PG8_BAR; PG8_WAIT_L(0); PG8_MMA(0, 1, At, B1); PG8_BAR;
            PG8_LDA(At, 1, 1); PG8_STAGE(PG8_SA(1, 0), a3, voffA);
            PG8_BAR; PG8_WAIT_L(0); PG8_MMA(1, 0, At, B0); PG8_BAR; PG8_SCHED;
            PG8_STAGE(PG8_SB(1, 1), b3 + hstep, voffB);
            PG8_WAIT_V(6); PG8_BAR; PG8_MMA(1, 1, At, B1); PG8_BAR;
            }
        }
        if constexpr (ALIGN_EPI) { if (wr == 0) PG8_BAR; }
        if constexpr (!Epi::AFTER_DRAIN) { E(acc, cur, wr, wc, fr, fq); S.done(cur); } else { if (has_next) E(acc, cur, wr, wc, fr, fq); }
        if (!has_next) break;
#pragma unroll
        for (int a = 0; a < 2; ++a)
#pragma unroll
            for (int b = 0; b < 2; ++b)
#pragma unroll
                for (int m = 0; m < 4; ++m)
#pragma unroll
                    for (int n = 0; n < 2; ++n) acc[a][b][m][n] = (f32x4){0.f, 0.f, 0.f, 0.f};
        cur = nxt; cA = nA; cB = nB; ++ui;
        if constexpr (ALIGN_EPI) { if (wr == 1) PG8_BAR; }
    }
    PG8_WAIT_V(0);
    if constexpr (!ALIGN_EPI) { if (wr == 0) PG8_BAR; }
    PG8_BAR;
    if constexpr (Epi::AFTER_DRAIN) { E.fused(acc, cur, wr, wc, fr, fq, lds, wid, lane); S.done(cur); }
#undef PG8_SA
#undef PG8_SB
#undef PG8_STAGE
#undef PG8_LDA
#undef PG8_LDB
#undef PG8_MMA
#undef PG8_WAIT_V
#undef PG8_WAIT_L
#undef PG8_BAR
#undef PG8_SCHED
}
}

#define LAS __attribute__((address_space(3)))
typedef unsigned short bf16;
typedef float f32x4 __attribute__((ext_vector_type(4)));
typedef float f32x2 __attribute__((ext_vector_type(2)));
typedef short bf16x8 __attribute__((ext_vector_type(8)));
typedef unsigned u32x4 __attribute__((ext_vector_type(4)));
typedef unsigned u32x2 __attribute__((ext_vector_type(2)));

constexpr int DM = 1024, NBP = 8, SEQ = 2048, MPR = NBP * SEQ, NBS = 128, MTOK = MPR + NBS, MPAD = 16640;
constexpr int DL = 512, NPROJ = 1536, NMOD = 6144, NBT = NBP + NBS, DFF = 2816;
constexpr int LCH = 64, NCH = SEQ / LCH;
constexpr int SCH = 16;
constexpr int SL = 16, SNCH = SEQ / SL, SROWS = NBP * SNCH;
constexpr float EPS = 1e-6f;
constexpr int NPHASE = 13;

constexpr size_t O_Y = 0, O_CONVP = (size_t)MTOK * DM, O_LRUP = O_CONVP + 8 * 3 * 512, O_S5RP = O_LRUP + 8 * 512, O_S5IP = O_S5RP + 8 * 32 * 64,
                 O_CONVS = O_S5IP + 8 * 32 * 64, O_LRUS = O_CONVS + 128 * 3 * 512, O_S5RS = O_LRUS + 128 * 512, O_S5IS = O_S5RS + 128 * 32 * 64, O_END = O_S5IS + 128 * 32 * 64;

constexpr size_t HM = 1u << 19;
constexpr size_t WS_WIN = 2 * HM, WS_WGLU = 8 * HM, WS_WOUT = 10 * HM, WS_WGU = 14 * HM, WS_WDN = 36 * HM  , WS_MOD = 48 * HM  ,
                 WS_TF = 56 * HM  , WS_E = 68 * HM  , WS_TAB = 72 * HM, WS_AGG = 74 * HM  ,
                 WS_XN = 80 * HM  , WS_LRUX = 146 * HM  , WS_GATE = 211 * HM  ,
                 WS_S5U = 244 * HM  , WS_HLOC = 277 * HM  , WS_CUM = 342 * HM, WS_GY = 407 * HM  ,
                 WS_SK = 440 * HM  , WS_HIN = 472 * HM  , WS_HB = 277 * HM  , WS_X1B = 211 * HM  , WS_PART = 488 * HM  , WS_END = 512 * HM;
constexpr size_t WS_XSLOT = 65536;
constexpr size_t T_ABAR = 0, T_A16 = 4096, T_BBR = 8192, T_BBI = 8192 + 32768, T_WG = 81920  , T_GCD = T_WG + 32768  ;

struct KArgs { const float* in[36]; float* out; unsigned char* ws; int lo, hi; };

struct Ctx {
    const float* const* in; float* out; unsigned char* ws;
    __device__ __forceinline__ const float* I(int i) const { return in[i]; }
    __device__ __forceinline__ bf16* WIN() const { return (bf16*)(ws + WS_WIN); }
    __device__ __forceinline__ bf16* WGLU() const { return (bf16*)(ws + WS_WGLU); }
    __device__ __forceinline__ bf16* WOUT() const { return (bf16*)(ws + WS_WOUT); }
    __device__ __forceinline__ bf16* WGU() const { return (bf16*)(ws + WS_WGU); }
    __device__ __forceinline__ bf16* WDN() const { return (bf16*)(ws + WS_WDN); }
    __device__ __forceinline__ float* MOD() const { return (float*)(ws + WS_MOD); }
    __device__ __forceinline__ bf16* TF() const { return (bf16*)(ws + WS_TF); }
    __device__ __forceinline__ bf16* EM() const { return (bf16*)(ws + WS_E); }
    __device__ __forceinline__ float* TAB() const { return (float*)(ws + WS_TAB); }
    __device__ __forceinline__ f32x2* AGG() const { return (f32x2*)(ws + WS_AGG); }
    __device__ __forceinline__ bf16* XN() const { return (bf16*)(ws + WS_XN); }
    __device__ __forceinline__ bf16* MERGED() const { return (bf16*)(ws + WS_XN); }
    __device__ __forceinline__ bf16* LRUX() const { return (bf16*)(ws + WS_LRUX); }
    __device__ __forceinline__ bf16* XN2() const { return (bf16*)(ws + WS_LRUX); }
    __device__ __forceinline__ bf16* GATE() const { return (bf16*)(ws + WS_GATE); }
    __device__ __forceinline__ bf16* S5U() const { return (bf16*)(ws + WS_S5U); }
    __device__ __forceinline__ float* HLOC() const { return (float*)(ws + WS_HLOC); }
    __device__ __forceinline__ float* S5OUT() const { return (float*)(ws + WS_HLOC); }
    __device__ __forceinline__ float* CUM() const { return (float*)(ws + WS_CUM); }
    __device__ __forceinline__ bf16* GY() const { return (bf16*)(ws + WS_GY); }
    __device__ __forceinline__ float* SK() const { return (float*)(ws + WS_SK); }
    __device__ __forceinline__ bf16* HIN() const { return (bf16*)(ws + WS_HIN); }
    __device__ __forceinline__ bf16* HB() const { return (bf16*)(ws + WS_HB); }
    __device__ __forceinline__ float* PART() const { return (float*)(ws + WS_PART); }
    __device__ __forceinline__ bf16* X1B() const { return (bf16*)(ws + WS_X1B); }
};

#define LDS_WAIT() asm volatile("s_waitcnt lgkmcnt(0)" ::: "memory")
__device__ __forceinline__ unsigned pk2(float lo, float hi) { return pg8::cvt_pk_bf16(lo, hi); }
__device__ __forceinline__ float bf2f(unsigned b) { return __uint_as_float(b << 16); }
__device__ __forceinline__ float bflo(unsigned w) { return __uint_as_float(w << 16); }
__device__ __forceinline__ float bfhi(unsigned w) { return __uint_as_float(w & 0xffff0000u); }
__device__ __forceinline__ float wave_sum(float v) {
#pragma unroll
    for (int o = 1; o < 64; o <<= 1) v += __shfl_xor(v, o);
    return v;
}
__device__ __forceinline__ float sigm(float v) { return __builtin_amdgcn_rcpf(1.f + __builtin_amdgcn_exp2f(-1.44269504089f * v)); }
__device__ __forceinline__ float gelu_tanh(float x) { const float u = (-1.5957691216f * 1.44269504089f) * (x + 0.044715f * x * x * x); return x * __builtin_amdgcn_rcpf(1.f + __builtin_amdgcn_exp2f(u)); }
__device__ __forceinline__ int mod_row(int row) { return row < MPR ? (row >> 11) : (NBP + row - MPR); }
__device__ __forceinline__ u32x4 pack8(f32x4 a, f32x4 b) { u32x4 w; w.x = pk2(a[0], a[1]); w.y = pk2(a[2], a[3]); w.z = pk2(b[0], b[1]); w.w = pk2(b[2], b[3]); return w; }

struct Sched2 {
    pg8::StaticOrder so; int nkt_full, n_extra, ex_nn, ex_nkt;
    __device__ __forceinline__ void init(int N, int K, int G, int c, int ex_nkt_) { so.init(MPR, N, G, c); nkt_full = K / 64; ex_nn = N / 256; ex_nkt = ex_nkt_; n_extra = ex_nn * (nkt_full / ex_nkt_); }
    __device__ __forceinline__ bool next(int i, pg8::Unit& u) const {
        const long L = (long)i * so.G + so.c;
        const bool prompt = L < so.nwg; const int e = (int)(L - so.nwg);
        if (!prompt && e >= n_extra) return false;
        pg8::Unit t; t.pm = 0; t.pn = 0; t.kt0 = 0; t.nkt = 0; t.kind = 0; t.slice = 0;
        if (prompt) so.next(i, t);
        const int sl = prompt ? 0 : e / ex_nn;
        pg8::Unit r; r.pm = prompt ? t.pm : 64; r.pn = prompt ? t.pn : e % ex_nn; r.kt0 = sl * ex_nkt; r.nkt = prompt ? nkt_full : ex_nkt; r.kind = prompt ? 0 : ((ex_nkt == nkt_full) ? 1 : 2); r.slice = sl;
        u = r; return true;
    }
    __device__ __forceinline__ void a_ready(const pg8::Unit&) const {}
    __device__ __forceinline__ void done(const pg8::Unit&) const {}
};
__device__ __forceinline__ void store_partial(const f32x4 (&acc)[2][2][4][2], const pg8::Unit& u, int wr, int wc, int fr, int fq, float* part, unsigned* cnt) {
    float* base = part + (size_t)u.slice * 128 * 1024 + u.pn * 256 + wc * 32 + 8 * fq;
#pragma unroll
    for (int m = 0; m < 4; ++m) { float* rp = base + (size_t)(wr * 64 + m * 16 + fr) * 1024;
#pragma unroll
        for (int bj = 0; bj < 2; ++bj)
#pragma unroll
            for (int n = 0; n < 2; ++n) { const f32x4 v = acc[0][bj][m][n]; unsigned long long* q = (unsigned long long*)(rp + bj * 128 + 4 * n);
                __hip_atomic_store(q, ((unsigned long long)__float_as_uint(v.y) << 32) | __float_as_uint(v.x), __ATOMIC_RELAXED, __HIP_MEMORY_SCOPE_AGENT);
                __hip_atomic_store(q + 1, ((unsigned long long)__float_as_uint(v.w) << 32) | __float_as_uint(v.z), __ATOMIC_RELAXED, __HIP_MEMORY_SCOPE_AGENT); } }
    asm volatile("s_waitcnt vmcnt(0)" ::: "memory");
    if ((threadIdx.x & 63) == 0) __hip_atomic_fetch_add(cnt, 1u, __ATOMIC_RELAXED, __HIP_MEMORY_SCOPE_AGENT);
}
__device__ __forceinline__ void wait_partials(unsigned* cnt, unsigned want) {
    unsigned sp = 0;
    while ((unsigned)__builtin_amdgcn_readfirstlane(__hip_atomic_load(cnt, __ATOMIC_RELAXED, __HIP_MEMORY_SCOPE_AGENT)) < want) { __builtin_amdgcn_s_sleep(4); if (++sp > (1u << 22)) break; }
    __builtin_amdgcn_fence(__ATOMIC_ACQUIRE, "agent");
}

struct EpiProj {
    static constexpr bool PERM = true, AFTER_DRAIN = false; bf16* lrux; bf16* gate; bf16* s5u;
    __device__ __forceinline__ void operator()(const f32x4 (&acc)[2][2][4][2], const pg8::Unit& u, int wr, int wc, int fr, int fq) const {
        const int colt = u.pn * 256 + wc * 32 + 8 * fq;
#pragma unroll
        for (int ai = 0; ai < 2; ++ai)
#pragma unroll
            for (int m = 0; m < 4; ++m) { const int row = u.pm * 256 + ai * 128 + wr * 64 + m * 16 + fr; if (row >= MTOK) continue;
#pragma unroll
                for (int bj = 0; bj < 2; ++bj) { const int col = colt + bj * 128; const f32x4 v0 = acc[ai][bj][m][0], v1 = acc[ai][bj][m][1];
                    if (u.pn < 2) { *(u32x4*)(lrux + (size_t)row * 512 + col) = pack8(v0, v1); }
                    else if (u.pn < 4) { *(u32x4*)(gate + (size_t)row * 512 + (col - 512)) = pack8(v0, v1); }
                    else { *(u32x4*)(s5u + (size_t)row * 512 + (col - 1024)) = pack8(v0, v1); } } }
    }
};
struct EpiGlu {
    static constexpr bool PERM = true, AFTER_DRAIN = false; float* o; float* part;
    __device__ __forceinline__ void operator()(const f32x4 (&acc)[2][2][4][2], const pg8::Unit& u, int wr, int wc, int fr, int fq) const {
        const int col = u.pn * 128 + wc * 32 + 8 * fq;
#pragma unroll
        for (int ai = 0; ai < 2; ++ai)
#pragma unroll
            for (int m = 0; m < 4; ++m) { const int row = u.pm * 256 + ai * 128 + wr * 64 + m * 16 + fr; if (row >= MTOK) continue;
#pragma unroll
                for (int n = 0; n < 2; ++n) { const f32x4 a = acc[ai][0][m][n], b = acc[ai][1][m][n]; f32x4 s;
#pragma unroll
                    for (int i = 0; i < 4; ++i) s[i] = a[i] * sigm(b[i]);
                    *(f32x4*)(o + (size_t)row * 512 + col + 4 * n) = s; } }
    }
};
template <int GOFF> struct EpiRes {
    static constexpr bool PERM = true, AFTER_DRAIN = false; const float* xp; const float* xs; const float* mod; float* out; float* part;
    __device__ __forceinline__ void operator()(const f32x4 (&acc)[2][2][4][2], const pg8::Unit& u, int wr, int wc, int fr, int fq) const {
        const int colt = u.pn * 256 + wc * 32 + 8 * fq;
#pragma unroll
        for (int ai = 0; ai < 2; ++ai)
#pragma unroll
            for (int m = 0; m < 4; ++m) { const int row = u.pm * 256 + ai * 128 + wr * 64 + m * 16 + fr; if (row >= MTOK) continue;
                const float* gp = mod + (size_t)mod_row(row) * NMOD + GOFF; float* op = out + (size_t)row * DM;
                const float* bp = xp ? (row < MPR ? xp + (size_t)row * DM : xs + (size_t)(row - MPR) * DM) : op;
#pragma unroll
                for (int bj = 0; bj < 2; ++bj)
#pragma unroll
                    for (int n = 0; n < 2; ++n) { const int c = colt + bj * 128 + 4 * n; const f32x4 x4 = *(const f32x4*)(bp + c), g4 = *(const f32x4*)(gp + c);
                        *(f32x4*)(op + c) = x4 + g4 * acc[ai][bj][m][n]; } }
    }
};
struct EpiSwiglu {
    static constexpr bool PERM = true, AFTER_DRAIN = false; bf16* h;
    __device__ __forceinline__ void operator()(const f32x4 (&acc)[2][2][4][2], const pg8::Unit& u, int wr, int wc, int fr, int fq) const {
        const int col = u.pn * 128 + wc * 32 + 8 * fq;
#pragma unroll
        for (int ai = 0; ai < 2; ++ai)
#pragma unroll
            for (int m = 0; m < 4; ++m) { const int row = u.pm * 256 + ai * 128 + wr * 64 + m * 16 + fr; if (row >= MTOK) continue;
                f32x4 s[2];
#pragma unroll
                for (int n = 0; n < 2; ++n) { const f32x4 a = acc[ai][0][m][n], b = acc[ai][1][m][n];
#pragma unroll
                    for (int i = 0; i < 4; ++i) s[n][i] = a[i] * sigm(a[i]) * b[i]; }
                *(u32x4*)(h + (size_t)row * DFF + col) = pack8(s[0], s[1]); }
    }
};

struct Sched3 {
    pg8::StaticOrder so; int nkt_full, n_extra, ex_nn, ex_nkt;
    __device__ __forceinline__ void init(int N, int K, int G, int c, int ex_nkt_) { so.init(MPR, N, G, c); nkt_full = K / 64; ex_nn = N / 256; ex_nkt = ex_nkt_; n_extra = ex_nn * (nkt_full / ex_nkt_); }
    __device__ __forceinline__ bool next(int i, pg8::Unit& u) const {
        const bool has_ex = so.c < n_extra; const int j = has_ex ? i : i + 1;
        if (j > 1) return false;
        const bool prompt = (j == 1); const int e = so.c;
        pg8::Unit t; t.pm = 0; t.pn = 0; t.kt0 = 0; t.nkt = 0; t.kind = 0; t.slice = 0;
        if (prompt) so.next(0, t);
        const int sl = prompt ? 0 : e / ex_nn;
        pg8::Unit r; r.pm = prompt ? t.pm : 64; r.pn = prompt ? t.pn : e % ex_nn; r.kt0 = sl * ex_nkt; r.nkt = prompt ? nkt_full : ex_nkt; r.kind = prompt ? 0 : 2; r.slice = sl;
        u = r; return true;
    }
    __device__ __forceinline__ void a_ready(const pg8::Unit&) const {}
    __device__ __forceinline__ void done(const pg8::Unit&) const {}
};
struct RmsPanel {
    float* xbuf;
    unsigned* cnt;
    float inv_n, eps;
    __device__ __forceinline__ void put(float t, int r, int wc, int fq, LAS unsigned char* lds) const { t += __shfl_xor(t, 16); t += __shfl_xor(t, 32); if (fq == 0) ((LAS float*)lds)[r * 4 + wc] = t; }
    __device__ __forceinline__ void finish(const pg8::Unit& u, LAS unsigned char* lds, int wid, int lane) const {
        LAS float* P = (LAS float*)lds; LAS float* S = (LAS float*)(lds + 4096);
        asm volatile("s_waitcnt lgkmcnt(0)" ::: "memory"); __builtin_amdgcn_s_barrier(); asm volatile("" ::: "memory");
        const int row = wid * 32 + (lane & 31);
        if (lane < 32) { const f32x4 p = *(const LAS f32x4*)(P + row * 4); const float t = (p.x + p.y) + (p.z + p.w);
            __hip_atomic_store(xbuf + ((size_t)(u.pm * 256 + row) * 4 + u.pn), t, __ATOMIC_RELAXED, __HIP_MEMORY_SCOPE_AGENT); }
        asm volatile("s_waitcnt vmcnt(0)" ::: "memory");
        if (lane == 0) __hip_atomic_fetch_add(cnt + 64 * u.pm, 1u, __ATOMIC_RELAXED, __HIP_MEMORY_SCOPE_AGENT);
        if (wid == 0) { unsigned sp = 0;
            while ((unsigned)__builtin_amdgcn_readfirstlane(__hip_atomic_load(cnt + 64 * u.pm, __ATOMIC_RELAXED, __HIP_MEMORY_SCOPE_AGENT)) < 32u) { __builtin_amdgcn_s_sleep(2); if (++sp > (1u << 22)) break; }
            __builtin_amdgcn_fence(__ATOMIC_ACQUIRE, "agent"); }
        asm volatile("s_waitcnt vmcnt(0) lgkmcnt(0)" ::: "memory"); __builtin_amdgcn_s_barrier(); asm volatile("" ::: "memory");
        if (lane < 32) { const float* slot = xbuf + (size_t)(u.pm * 256 + row) * 4; float t = 0.f;
#pragma unroll
            for (int q = 0; q < 4; ++q) t += __hip_atomic_load(slot + q, __ATOMIC_RELAXED, __HIP_MEMORY_SCOPE_AGENT);
            S[row] = rsqrtf(t * inv_n + eps); }
        asm volatile("s_waitcnt lgkmcnt(0)" ::: "memory"); __builtin_amdgcn_s_barrier(); asm volatile("" ::: "memory");
    }
};
struct EpiGluNorm {
    static constexpr bool PERM = true, AFTER_DRAIN = true; bf16* merged; const float* gs; float* part; unsigned* pcnt; RmsPanel st;
    __device__ __forceinline__ void operator()(const f32x4 (&acc)[2][2][4][2], const pg8::Unit& u, int wr, int wc, int fr, int fq) const { if (u.kind == 2) store_partial(acc, u, wr, wc, fr, fq, part, pcnt); }
    __device__ __forceinline__ void fused(f32x4 (&acc)[2][2][4][2], const pg8::Unit& u, int wr, int wc, int fr, int fq, LAS unsigned char* lds, int wid, int lane) const {
#pragma unroll
        for (int ai = 0; ai < 2; ++ai)
#pragma unroll
            for (int m = 0; m < 4; ++m) { float ss = 0.f;
#pragma unroll
                for (int n = 0; n < 2; ++n) { const f32x4 a = acc[ai][0][m][n], b = acc[ai][1][m][n]; f32x4 sv;
#pragma unroll
                    for (int i = 0; i < 4; ++i) { sv[i] = a[i] * sigm(b[i]); ss += sv[i] * sv[i]; }
                    acc[ai][0][m][n] = sv; }
                st.put(ss, ai * 128 + wr * 64 + m * 16 + fr, wc, fq, lds); }
        st.finish(u, lds, wid, lane);
        const LAS float* S = (const LAS float*)(lds + 4096);
        const int col = u.pn * 128 + wc * 32 + 8 * fq; const f32x4 g0 = *(const f32x4*)(gs + col), g1 = *(const f32x4*)(gs + col + 4);
#pragma unroll
        for (int ai = 0; ai < 2; ++ai)
#pragma unroll
            for (int m = 0; m < 4; ++m) { const int r = ai * 128 + wr * 64 + m * 16 + fr; const float rstd = S[r];
                *(u32x4*)(merged + (size_t)(u.pm * 256 + r) * DM + 512 + col) = pack8(acc[ai][0][m][0] * rstd * g0, acc[ai][0][m][1] * rstd * g1); }
    }
};
template <int MODE> struct EpiResNorm {
    static constexpr bool PERM = true, AFTER_DRAIN = true; const float* xp; const float* mod; const float* gn; float* out; bf16* xn; bf16* x1b; float* part; unsigned* pcnt; RmsPanel st;
    __device__ __forceinline__ void operator()(const f32x4 (&acc)[2][2][4][2], const pg8::Unit& u, int wr, int wc, int fr, int fq) const { if (u.kind == 2) store_partial(acc, u, wr, wc, fr, fq, part, pcnt); }
    __device__ __forceinline__ void fused(f32x4 (&acc)[2][2][4][2], const pg8::Unit& u, int wr, int wc, int fr, int fq, LAS unsigned char* lds, int wid, int lane) const {
        const int colt = u.pn * 256 + wc * 32 + 8 * fq; const float* mrow = mod + (size_t)(u.pm >> 3) * NMOD;
        constexpr int GOFF = MODE == 1 ? 2048 : 5120;
        f32x4 gv[2][2];
#pragma unroll
        for (int bj = 0; bj < 2; ++bj)
#pragma unroll
            for (int n = 0; n < 2; ++n) gv[bj][n] = *(const f32x4*)(mrow + GOFF + colt + bj * 128 + 4 * n);
#pragma unroll
        for (int ai = 0; ai < 2; ++ai) {
            f32x4 pre1[4][2][2]; u32x4 pre2[4][2];
#pragma unroll
            for (int m = 0; m < 4; ++m) { const size_t ro = (size_t)(u.pm * 256 + ai * 128 + wr * 64 + m * 16 + fr) * DM + colt;
#pragma unroll
                for (int bj = 0; bj < 2; ++bj) { if (MODE == 1) { pre1[m][bj][0] = *(const f32x4*)(xp + ro + bj * 128); pre1[m][bj][1] = *(const f32x4*)(xp + ro + bj * 128 + 4); } else pre2[m][bj] = *(const u32x4*)(x1b + ro + bj * 128); } }
#pragma unroll
            for (int m = 0; m < 4; ++m) { const size_t ro = (size_t)(u.pm * 256 + ai * 128 + wr * 64 + m * 16 + fr) * DM + colt; float ss = 0.f;
#pragma unroll
                for (int bj = 0; bj < 2; ++bj) { f32x4 b0, b1;
                    if (MODE == 1) { b0 = pre1[m][bj][0]; b1 = pre1[m][bj][1]; }
                    else { const u32x4 q = pre2[m][bj]; b0 = (f32x4){bflo(q.x), bfhi(q.x), bflo(q.y), bfhi(q.y)}; b1 = (f32x4){bflo(q.z), bfhi(q.z), bflo(q.w), bfhi(q.w)}; }
                    const f32x4 v0 = b0 + gv[bj][0] * acc[ai][bj][m][0], v1 = b1 + gv[bj][1] * acc[ai][bj][m][1]; acc[ai][bj][m][0] = v0; acc[ai][bj][m][1] = v1;
                    if (MODE == 1) *(u32x4*)(x1b + ro + bj * 128) = pack8(v0, v1);
                    ss += (v0.x * v0.x + v0.y * v0.y) + (v0.z * v0.z + v0.w * v0.w) + (v1.x * v1.x + v1.y * v1.y) + (v1.z * v1.z + v1.w * v1.w); }
                st.put(ss, ai * 128 + wr * 64 + m * 16 + fr, wc, fq, lds);
                asm volatile("" : "+v"(acc[ai][0][m][0]), "+v"(acc[ai][0][m][1]), "+v"(acc[ai][1][m][0]), "+v"(acc[ai][1][m][1])); }
            asm volatile("" ::: "memory"); }
        st.finish(u, lds, wid, lane);
        const LAS float* S = (const LAS float*)(lds + 4096);
#pragma unroll
        for (int bj = 0; bj < 2; ++bj) { const int c = colt + bj * 128;
            f32x4 w0 = *(const f32x4*)(gn + c), w1 = *(const f32x4*)(gn + c + 4), s0 = (f32x4){0.f, 0.f, 0.f, 0.f}, s1 = s0;
            if (MODE == 1) { w0 = w0 * (1.f + *(const f32x4*)(mrow + 4096 + c)); w1 = w1 * (1.f + *(const f32x4*)(mrow + 4096 + c + 4)); s0 = *(const f32x4*)(mrow + 3072 + c); s1 = *(const f32x4*)(mrow + 3072 + c + 4); }
#pragma unroll
            for (int ai = 0; ai < 2; ++ai)
#pragma unroll
                for (int m = 0; m < 4; ++m) { const int r = ai * 128 + wr * 64 + m * 16 + fr; const float rstd = S[r]; const size_t ro = (size_t)(u.pm * 256 + r) * DM + c;
                    const f32x4 o0 = acc[ai][bj][m][0] * rstd * w0 + s0, o1 = acc[ai][bj][m][1] * rstd * w1 + s1;
                    if (MODE == 1) *(u32x4*)(xn + ro) = pack8(o0, o1); else { *(f32x4*)(out + ro) = o0; *(f32x4*)(out + ro + 4) = o1; } } }
    }
};

__device__ __forceinline__ void transpose_item(const float* W, int ldw, int k0, int n0, bf16* WT, int K, int drow0, LAS bf16* scr, int lane) {
    const int lr = lane >> 4, lc = lane & 15;
    f32x4 v[16];
#pragma unroll
    for (int i = 0; i < 16; ++i) v[i] = *(const f32x4*)(W + (size_t)(k0 + lr + 4 * i) * ldw + n0 + 4 * lc);
#pragma unroll
    for (int i = 0; i < 16; ++i) { u32x2 p; p.x = pk2(v[i].x, v[i].y); p.y = pk2(v[i].z, v[i].w); *(LAS u32x2*)(scr + (lr + 4 * i) * 68 + 4 * lc) = p; }
    LDS_WAIT();
    const int kc = lane & 7;
#pragma unroll
    for (int j = 0; j < 8; ++j) { const int n = (lane >> 3) + 8 * j; const LAS bf16* sp = scr + (8 * kc) * 68 + n;
        u32x4 o; o.x = (unsigned)sp[0] | ((unsigned)sp[68] << 16); o.y = (unsigned)sp[2 * 68] | ((unsigned)sp[3 * 68] << 16);
        o.z = (unsigned)sp[4 * 68] | ((unsigned)sp[5 * 68] << 16); o.w = (unsigned)sp[6 * 68] | ((unsigned)sp[7 * 68] << 16);
        *(u32x4*)(WT + (size_t)(drow0 + n) * K + k0 + 8 * kc) = o; }
    LDS_WAIT();
}
__device__ __forceinline__ void transpose_dispatch(const Ctx& cx, int it, LAS bf16* scr, int lane) {
    if (it < 384) { const int kb = it / 24, nb = it % 24; transpose_item(cx.I(11), NPROJ, 64 * kb, 64 * nb, cx.WIN(), DM, 64 * nb, scr, lane); return; } it -= 384;
    if (it < 128) { const int kb = it / 16, nb = it % 16, n0 = 64 * nb; const int dr = 256 * ((n0 & 511) >> 7) + 128 * (n0 >> 9) + (n0 & 127);
        transpose_item(cx.I(27), 1024, 64 * kb, n0, cx.WGLU(), 512, dr, scr, lane); return; } it -= 128;
    if (it < 256) { const int kb = it / 16, nb = it % 16; transpose_item(cx.I(30), DM, 64 * kb, 64 * nb, cx.WOUT(), DM, 64 * nb, scr, lane); return; } it -= 256;
    if (it < 704) { const int kb = it / 44, nb = it % 44, n0 = 64 * nb; transpose_item(cx.I(32), DFF, 64 * kb, n0, cx.WGU(), DM, 256 * (n0 >> 7) + (n0 & 127), scr, lane); return; } it -= 704;
    if (it < 704) { const int kb = it / 44, nb = it % 44, n0 = 64 * nb; transpose_item(cx.I(33), DFF, 64 * kb, n0, cx.WGU(), DM, 256 * (n0 >> 7) + 128 + (n0 & 127), scr, lane); return; } it -= 704;
    { const int kb = it / 16, nb = it % 16; transpose_item(cx.I(34), DM, 64 * kb, 64 * nb, cx.WDN(), DFF, 64 * nb, scr, lane); }
}
constexpr int N_TR_ITEMS = 384 + 128 + 256 + 704 + 704 + 704;

__device__ __forceinline__ void ada_block(const Ctx& cx, int item, LAS unsigned char* lds) {
    const int tid = threadIdx.x, w = __builtin_amdgcn_readfirstlane(tid >> 6), lane = tid & 63, fr = lane & 15, fq = lane >> 4, n0 = 32 * item;
    const float* W = cx.I(8); const float* cp = cx.I(6); const float* cs = cx.I(7);
    bf16x8 wf[4][2];
#pragma unroll
    for (int ks = 0; ks < 4; ++ks)
#pragma unroll
        for (int nt = 0; nt < 2; ++nt) { const float* src = W + (size_t)(128 * w + 32 * ks + 8 * fq) * NMOD + n0 + 16 * nt + fr;
            u32x4 o; o.x = pk2(src[0], src[NMOD]); o.y = pk2(src[2 * NMOD], src[3 * NMOD]); o.z = pk2(src[4 * NMOD], src[5 * NMOD]); o.w = pk2(src[6 * NMOD], src[7 * NMOD]); wf[ks][nt] = __builtin_bit_cast(bf16x8, o); }
    f32x4 acc[9][2];
#pragma unroll
    for (int i = 0; i < 9; ++i) { acc[i][0] = (f32x4){0.f, 0.f, 0.f, 0.f}; acc[i][1] = (f32x4){0.f, 0.f, 0.f, 0.f}; }
#pragma unroll
    for (int mt = 0; mt < 9; ++mt) { int row = 16 * mt + fr; row = row < NBT ? row : NBT - 1;
        const float* src = (row < NBP ? cp + (size_t)row * DM : cs + (size_t)(row - NBP) * DM) + 128 * w + 8 * fq;
#pragma unroll
        for (int ks = 0; ks < 4; ++ks) { f32x4 a0 = *(const f32x4*)(src + 32 * ks), a1 = *(const f32x4*)(src + 32 * ks + 4);
#pragma unroll
            for (int i = 0; i < 4; ++i) { a0[i] = a0[i] * sigm(a0[i]); a1[i] = a1[i] * sigm(a1[i]); }
            const bf16x8 af = __builtin_bit_cast(bf16x8, pack8(a0, a1));
            acc[mt][0] = __builtin_amdgcn_mfma_f32_16x16x32_bf16(wf[ks][0], af, acc[mt][0], 0, 0, 0);
            acc[mt][1] = __builtin_amdgcn_mfma_f32_16x16x32_bf16(wf[ks][1], af, acc[mt][1], 0, 0, 0); } }
    LAS f32x4* red = (LAS f32x4*)lds;
#pragma unroll
    for (int st = 4; st >= 1; st >>= 1) {
        if (w >= st && w < 2 * st) {
#pragma unroll
            for (int i = 0; i < 9; ++i) { red[((w - st) * 18 + 2 * i) * 64 + lane] = acc[i][0]; red[((w - st) * 18 + 2 * i + 1) * 64 + lane] = acc[i][1]; } }
        __syncthreads();
        if (w < st) {
#pragma unroll
            for (int i = 0; i < 9; ++i) { acc[i][0] += red[(w * 18 + 2 * i) * 64 + lane]; acc[i][1] += red[(w * 18 + 2 * i + 1) * 64 + lane]; } }
        __syncthreads();
    }
    if (w == 0) {
#pragma unroll
        for (int nt = 0; nt < 2; ++nt) { const f32x4 b4 = *(const f32x4*)(cx.I(9) + n0 + 16 * nt + 4 * fq);
#pragma unroll
            for (int mt = 0; mt < 9; ++mt) { const int row = 16 * mt + fr; if (row < NBT) *(f32x4*)(cx.MOD() + (size_t)row * NMOD + n0 + 16 * nt + 4 * fq) = acc[mt][nt] + b4; } } }
}

__device__ __forceinline__ void lru_gate_tables(const Ctx& cx, int item) {
    const int e = item * 512 + threadIdx.x;
    const int lane = e & 63, ks = (e >> 6) & 1, nt = (e >> 7) & 7, w = e >> 10, fr = lane & 15, fq = lane >> 4;
    const float* src = (nt < 4 ? cx.I(14) : cx.I(16)) + (size_t)w * 4096 + (32 * ks + 8 * fq) * 64 + 16 * (nt & 3) + fr;
    u32x4 o; o.x = pk2(src[0], src[64]); o.y = pk2(src[128], src[192]); o.z = pk2(src[256], src[320]); o.w = pk2(src[384], src[448]);
    ((u32x4*)(cx.TAB() + T_WG))[e] = o;
    if (item == 0) cx.TAB()[T_GCD + threadIdx.x] = -8.f * 1.44269504089f * log1pf(expf(-cx.I(18)[threadIdx.x]));
}
__device__ __forceinline__ void s5_tables(const Ctx& cx, int g, LAS unsigned char* lds, int part, int nparts) {
    LAS f32x2* Ap = (LAS f32x2*)lds;
    LAS f32x2* Bb = Ap + 17 * 64;
    LAS f32x2* Cc = Bb + 1024;
    LAS f32x2* Ff = Cc + 1024;
    LAS float* Kt = (LAS float*)(Ff + 64);
    const int tid = threadIdx.x;
    float* tab = cx.TAB();
    if (tid < 64) {
        const int n = tid; const float lr = cx.I(19)[g * 64 + n], li = cx.I(20)[g * 64 + n], dt = expf(cx.I(21)[g]);
        const float mag = expf(lr * dt);
        const double ang = (double)li * (double)dt; const double kq = rint(ang * 0.63661977236758134308); const double r = ang - kq * 1.57079632679489661923; const double r2 = r * r;
        const double sn = r * (1.0 + r2 * (-1.0 / 6 + r2 * (1.0 / 120 + r2 * (-1.0 / 5040 + r2 * (1.0 / 362880 + r2 * (-1.0 / 39916800 + r2 * (1.0 / 6227020800.0)))))));
        const double cn = 1.0 + r2 * (-0.5 + r2 * (1.0 / 24 + r2 * (-1.0 / 720 + r2 * (1.0 / 40320 + r2 * (-1.0 / 3628800 + r2 * (1.0 / 479001600.0))))));
        const int q = ((int)kq) & 3; const double cv = q == 0 ? cn : q == 1 ? -sn : q == 2 ? -cn : sn, sv = q == 0 ? sn : q == 1 ? cn : q == 2 ? -sn : -cn;
        const float abr = mag * (float)cv, abi = mag * (float)sv; const float den = lr * lr + li * li;
        const float frr = ((abr - 1.f) * lr + abi * li) / den, fii = (abi * lr - (abr - 1.f) * li) / den;
        f32x2 p = (f32x2){1.f, 0.f}; Ap[n] = p;
#pragma unroll 1
        for (int t = 1; t <= 16; ++t) { const float pr = p.x * abr - p.y * abi, pi = p.x * abi + p.y * abr; p = (f32x2){pr, pi}; Ap[t * 64 + n] = p; }
        Ff[n] = (f32x2){frr, fii};
        if (part == 0) { ((f32x2*)(tab + T_ABAR))[g * 64 + n] = (f32x2){abr, abi}; ((f32x2*)(tab + T_A16))[g * 64 + n] = p; }
    }
    __syncthreads();
    for (int e = tid; e < 1024; e += 512) { const int n = e >> 4; const float br = cx.I(22)[g * 1024 + e], bi = cx.I(23)[g * 1024 + e]; const f32x2 f = Ff[n];
        const float bbr = f.x * br - f.y * bi, bbi = f.x * bi + f.y * br; Bb[e] = (f32x2){bbr, bbi}; if (part == 0) { tab[T_BBR + g * 1024 + e] = bbr; tab[T_BBI + g * 1024 + e] = bbi; }
        Cc[e] = (f32x2){cx.I(24)[g * 1024 + e], cx.I(25)[g * 1024 + e]}; }
    __syncthreads();
    { const int tau = tid >> 5, c0 = 2 * ((tid >> 2) & 7), cp0 = 4 * (tid & 3);
        float s00 = 0.f, s01 = 0.f, s02 = 0.f, s03 = 0.f, s10 = 0.f, s11 = 0.f, s12 = 0.f, s13 = 0.f;
#pragma unroll 8
        for (int n = 0; n < 64; ++n) { const f32x2 a = Ap[tau * 64 + n], q0 = Cc[c0 * 64 + n], q1 = Cc[(c0 + 1) * 64 + n];
            const f32x4 bA = *(const LAS f32x4*)(Bb + n * 16 + cp0), bB = *(const LAS f32x4*)(Bb + n * 16 + cp0 + 2);
            float pr, pi;
            pr = a.x * bA.x - a.y * bA.y; pi = a.x * bA.y + a.y * bA.x; s00 += q0.x * pr - q0.y * pi; s10 += q1.x * pr - q1.y * pi;
            pr = a.x * bA.z - a.y * bA.w; pi = a.x * bA.w + a.y * bA.z; s01 += q0.x * pr - q0.y * pi; s11 += q1.x * pr - q1.y * pi;
            pr = a.x * bB.x - a.y * bB.y; pi = a.x * bB.y + a.y * bB.x; s02 += q0.x * pr - q0.y * pi; s12 += q1.x * pr - q1.y * pi;
            pr = a.x * bB.z - a.y * bB.w; pi = a.x * bB.w + a.y * bB.z; s03 += q0.x * pr - q0.y * pi; s13 += q1.x * pr - q1.y * pi; }
        LAS float* k0 = Kt + (tau << 8) + (c0 << 4) + cp0; k0[0] = s00; k0[1] = s01; k0[2] = s02; k0[3] = s03; k0[16] = s10; k0[17] = s11; k0[18] = s12; k0[19] = s13; }
    __syncthreads();
    bf16* TFg = cx.TF() + (size_t)g * 256 * 384;
    for (int pc = tid + 512 * part; pc < 256 * 48; pc += 512 * nparts) { const int row = pc / 48, k8 = (pc % 48) * 8, j = row >> 4, c = row & 15; float v[8];
#pragma unroll
        for (int q = 0; q < 8; ++q) { const int kk = k8 + q;
            if (kk < 256) { const int s = kk >> 4, cp = kk & 15; v[q] = (j >= s) ? Kt[((j - s) << 8) + (c << 4) + cp] : 0.f; }
            else { const int n = (kk - 256) & 63; const f32x2 p = Ap[(j + 1) * 64 + n], cc = Cc[c * 64 + n]; v[q] = (kk < 320) ? (cc.x * p.x - cc.y * p.y) : (-cc.x * p.y - cc.y * p.x); } }
        u32x4 o; o.x = pk2(v[0], v[1]); o.y = pk2(v[2], v[3]); o.z = pk2(v[4], v[5]); o.w = pk2(v[6], v[7]);
        *(u32x4*)(TFg + (size_t)row * 384 + k8) = o; }
    bf16* Eg = cx.EM() + (size_t)g * 128 * 256;
    for (int pc = tid + 512 * part; pc < 128 * 32; pc += 512 * nparts) { const int np = pc >> 5, k8 = (pc & 31) * 8, n = np & 63, im = np >> 6; float v[8];
#pragma unroll
        for (int q = 0; q < 8; ++q) { const int kk = k8 + q, s = kk >> 4, cp = kk & 15; const f32x2 a = Ap[(15 - s) * 64 + n], b = Bb[n * 16 + cp];
            v[q] = im ? (a.x * b.y + a.y * b.x) : (a.x * b.x - a.y * b.y); }
        u32x4 o; o.x = pk2(v[0], v[1]); o.y = pk2(v[2], v[3]); o.z = pk2(v[4], v[5]); o.w = pk2(v[6], v[7]);
        *(u32x4*)(Eg + (size_t)np * 256 + k8) = o; }
    __syncthreads();
}

__device__ __forceinline__ void norm_mod_row(const float* xrow, const float* g, const float* sc, const float* sh, bf16* orow, int lane) {
    f32x4 v[4]; float ss = 0.f;
#pragma unroll
    for (int j = 0; j < 4; ++j) { v[j] = ((const f32x4*)xrow)[lane + 64 * j]; ss += (v[j].x * v[j].x + v[j].y * v[j].y) + (v[j].z * v[j].z + v[j].w * v[j].w); }
    const float rstd = rsqrtf(wave_sum(ss) * (1.f / DM) + EPS);
#pragma unroll
    for (int j = 0; j < 4; ++j) { const int col = 4 * (lane + 64 * j); const f32x4 gg = *(const f32x4*)(g + col), s1 = *(const f32x4*)(sc + col), s2 = *(const f32x4*)(sh + col);
        const f32x4 o = v[j] * rstd * gg * (1.f + s1) + s2; u32x2 w; w.x = pk2(o.x, o.y); w.y = pk2(o.z, o.w); *(u32x2*)(orow + col) = w; }
}

__device__ __forceinline__ void lru_local_unit(const Ctx& cx, int row0, int ntok, bool samp, int aggidx, LAS unsigned char* lds) {
    const int d = threadIdx.x, w = __builtin_amdgcn_readfirstlane(d >> 6), lane = d & 63, fr = lane & 15, fq = lane >> 4;
    LAS float* cf = (LAS float*)(lds + w * 8192);
    LAS bf16* cbf = (LAS bf16*)(lds + w * 8192 + 4608);
    bf16x8 wf[8][2];
    { const bf16x8* wg = (const bf16x8*)(cx.TAB() + T_WG) + (size_t)w * 1024 + lane;
#pragma unroll
      for (int nt = 0; nt < 8; ++nt)
#pragma unroll
          for (int ks = 0; ks < 2; ++ks) wf[nt][ks] = wg[(nt * 2 + ks) * 64]; }
    const float cw0 = cx.I(12)[d], cw1 = cx.I(12)[512 + d], cw2 = cx.I(12)[1024 + d], cw3 = cx.I(12)[1536 + d], cb = cx.I(13)[d];
    float gba[4], gbx[4], gcd[4], hc[4], cc[4];
#pragma unroll
    for (int nt = 0; nt < 4; ++nt) { const int ch = 64 * w + 16 * nt + fr; gba[nt] = cx.I(15)[ch]; gbx[nt] = cx.I(17)[ch]; gcd[nt] = cx.TAB()[T_GCD + ch]; hc[nt] = 0.f; cc[nt] = 1.f; }
    const bf16* X = cx.LRUX(); float* HL = cx.HLOC(); float* CU = cx.CUM();
    float xm3 = 0.f, xm2 = 0.f, xm1 = 0.f;
    if (!samp) { const int t0 = row0 & (SEQ - 1); if (t0 >= 3) { xm3 = bf2f(X[(size_t)(row0 - 3) * DL + d]); xm2 = bf2f(X[(size_t)(row0 - 2) * DL + d]); xm1 = bf2f(X[(size_t)(row0 - 1) * DL + d]); } }
    float xv[16];
#pragma unroll
    for (int i = 0; i < 16; ++i) xv[i] = bf2f(X[(size_t)(row0 + i) * DL + d]);
    for (int t0 = 0; t0 < ntok; t0 += 16) {
        if (samp) {
#pragma unroll
            for (int i = 0; i < 16; ++i) { const int row = row0 + t0 + i; const float* sc = cx.I(2) + (size_t)(row - MPR) * 1536 + d;
                const float cv = cb + cw0 * sc[0] + cw1 * sc[512] + cw2 * sc[1024] + cw3 * xv[i];
                cf[i * 68 + lane] = cv; cbf[i * 72 + lane] = (bf16)(pk2(cv, cv) & 0xffffu); }
        } else {
#pragma unroll
            for (int i = 0; i < 16; ++i) { const float x = xv[i]; const float cv = cb + cw0 * xm3 + cw1 * xm2 + cw2 * xm1 + cw3 * x; xm3 = xm2; xm2 = xm1; xm1 = x;
                cf[i * 68 + lane] = cv; cbf[i * 72 + lane] = (bf16)(pk2(cv, cv) & 0xffffu); }
        }
        if (t0 + 16 < ntok) {
#pragma unroll
            for (int i = 0; i < 16; ++i) xv[i] = bf2f(X[(size_t)(row0 + t0 + 16 + i) * DL + d]); }
        LDS_WAIT();
        f32x4 acc[8];
#pragma unroll
        for (int nt = 0; nt < 8; ++nt) acc[nt] = (f32x4){0.f, 0.f, 0.f, 0.f};
#pragma unroll
        for (int ks = 0; ks < 2; ++ks) { const bf16x8 af = *(const LAS bf16x8*)(cbf + fr * 72 + 32 * ks + 8 * fq);
#pragma unroll
            for (int nt = 0; nt < 8; ++nt) acc[nt] = __builtin_amdgcn_mfma_f32_16x16x32_bf16(af, wf[nt][ks], acc[nt], 0, 0, 0); }
        float h0v[4][4];
#pragma unroll
        for (int nt = 0; nt < 4; ++nt)
#pragma unroll
            for (int r = 0; r < 4; ++r) h0v[nt][r] = samp ? cx.I(3)[(size_t)(row0 + t0 + 4 * fq + r - MPR) * DL + 64 * w + 16 * nt + fr] : 0.f;
#pragma unroll
        for (int nt = 0; nt < 4; ++nt) { const int ch = 64 * w + 16 * nt + fr;
            float av[4], hv[4]; float P = 1.f, H = 0.f;
#pragma unroll
            for (int r = 0; r < 4; ++r) { const int tok = 4 * fq + r; const float cvv = cf[tok * 68 + 16 * nt + fr];
                const float rr = sigm(acc[nt][r] + gba[nt]), ig = sigm(acc[nt + 4][r] + gbx[nt]);
                const float a = __builtin_amdgcn_exp2f(gcd[nt] * rr);
                const float bb = __builtin_amdgcn_sqrtf(fmaf(-a, a, 1.f)) * ig * cvv;
                if (samp) { hv[r] = a * h0v[nt][r] + bb; av[r] = 0.f; }
                else { H = a * H + bb; P = P * a; hv[r] = H; av[r] = P; } }
            if (!samp) {
                const float Pown = P, Hown = H;
                float Pp = __shfl_up(P, 16), Hp = __shfl_up(H, 16); if (fq >= 1) { H = P * Hp + H; P = P * Pp; }
                Pp = __shfl_up(P, 32); Hp = __shfl_up(H, 32); if (fq >= 2) { H = P * Hp + H; P = P * Pp; }
                const float rown = __builtin_amdgcn_rcpf(Pown);
                const float Pe = P * rown, He = (H - Hown) * rown;
                const float hstart = He + Pe * hc[nt], cstart = Pe * cc[nt];
#pragma unroll
                for (int r = 0; r < 4; ++r) { hv[r] = hv[r] + av[r] * hstart; av[r] = av[r] * cstart; }
                const float Pl = __shfl(P, 48 + fr), Hl = __shfl(H, 48 + fr); hc[nt] = Hl + Pl * hc[nt]; cc[nt] = Pl * cc[nt];
            }
#pragma unroll
            for (int r = 0; r < 4; ++r) { const size_t o = (size_t)(row0 + t0 + 4 * fq + r) * DL + ch; ((unsigned*)HL)[o] = pk2(hv[r], av[r]); }
            if (nt == 1) __builtin_amdgcn_sched_barrier(0);
        }
        LDS_WAIT();
    }
    if (!samp && fq == 0) {
#pragma unroll
        for (int nt = 0; nt < 4; ++nt) cx.AGG()[(size_t)aggidx * DL + 64 * w + 16 * nt + fr] = (f32x2){cc[nt], hc[nt]}; }
}

__device__ __forceinline__ void s5_gemm_e_unit(const Ctx& cx, int unit, LAS unsigned char* lds) {
    const int tid = threadIdx.x, w = __builtin_amdgcn_readfirstlane(tid >> 6), lane = tid & 63, fr = lane & 15, fq = lane >> 4;
    const int g = unit >> 3, rg = unit & 7, cr = rg * 128 + 16 * w + fr;
    const bf16* U = cx.S5U() + (size_t)(16 * cr + (fq >> 1)) * 512 + 16 * g + 8 * (fq & 1); const bf16* Eg = cx.EM() + (size_t)g * 128 * 256;
    bf16x8 af[8];
#pragma unroll
    for (int ks = 0; ks < 8; ++ks) af[ks] = *(const bf16x8*)(U + (size_t)(2 * ks) * 512);
    __syncthreads();
    LAS bf16* Bs = (LAS bf16*)lds;
    { u32x4 t[8];
#pragma unroll
      for (int i = 0; i < 8; ++i) { const int p = tid + 512 * i; t[i] = *(const u32x4*)(Eg + (size_t)(p >> 5) * 256 + (p & 31) * 8); }
#pragma unroll
      for (int i = 0; i < 8; ++i) { const int p = tid + 512 * i; *(LAS u32x4*)(Bs + (p >> 5) * 272 + (p & 31) * 8) = t[i]; } }
    __syncthreads();
    f32x4 acc[8];
#pragma unroll
    for (int n = 0; n < 8; ++n) acc[n] = (f32x4){0.f, 0.f, 0.f, 0.f};
#pragma unroll
    for (int ks = 0; ks < 8; ++ks)
#pragma unroll
        for (int nt = 0; nt < 8; ++nt) { const bf16x8 wf = *(const LAS bf16x8*)(Bs + (16 * nt + fr) * 272 + 32 * ks + 8 * fq); acc[nt] = __builtin_amdgcn_mfma_f32_16x16x32_bf16(wf, af[ks], acc[nt], 0, 0, 0); }
    float* S = cx.SK() + ((size_t)cr * 32 + g) * 128 + 4 * fq;
#pragma unroll
    for (int nt = 0; nt < 8; ++nt) *(f32x4*)(S + 16 * nt) = acc[nt];
    __syncthreads();
}

__device__ __forceinline__ void s5_chain_item(const Ctx& cx, int item, int lane) {
    const int idx = item * 64 + lane, b = idx >> 11, g = (idx >> 6) & 31, n = idx & 63;
    const f32x2 A = ((const f32x2*)(cx.TAB() + T_A16))[g * 64 + n];
    const float* S = cx.SK() + ((size_t)(b * SNCH) * 32 + g) * 128 + n; bf16* H = cx.HIN() + ((size_t)g * SROWS + b * SNCH) * 128 + n;
    float hr = 0.f, hi = 0.f; float s0r[8], s0i[8], s1r[8], s1i[8];
#define CH_LOAD(R, I, K0) do { _Pragma("unroll") for (int i = 0; i < 8; ++i) { R[i] = S[(size_t)((K0) + i) * 4096]; I[i] = S[(size_t)((K0) + i) * 4096 + 64]; } } while (0)
#define CH_STEP(R, I, K0) do { _Pragma("unroll") for (int i = 0; i < 8; ++i) { H[(size_t)((K0) + i) * 128] = (bf16)(pk2(hr, hr) & 0xffffu); H[(size_t)((K0) + i) * 128 + 64] = (bf16)(pk2(hi, hi) & 0xffffu); \
        const float nr = A.x * hr - A.y * hi + R[i], ni = A.x * hi + A.y * hr + I[i]; hr = nr; hi = ni; } } while (0)
    CH_LOAD(s0r, s0i, 0);
    for (int k0 = 0; k0 < SNCH; k0 += 16) { CH_LOAD(s1r, s1i, k0 + 8); CH_STEP(s0r, s0i, k0); if (k0 + 16 < SNCH) CH_LOAD(s0r, s0i, k0 + 16); CH_STEP(s1r, s1i, k0 + 8); }
#undef CH_LOAD
#undef CH_STEP
    cx.out[O_S5RP + (size_t)(b * 32 + g) * 64 + n] = hr; cx.out[O_S5IP + (size_t)(b * 32 + g) * 64 + n] = hi;
}

__device__ __forceinline__ void lru_fix_unit(const Ctx& cx, int row0, int ntok, bool samp, int b, int k, LAS unsigned char* lds, int chain_item, int chain_item1) {
    const int d = threadIdx.x, w = d >> 6, lane = d & 63;
    LAS float* hs = (LAS float*)lds;
    float hin = 0.f;
    if (!samp) { const f32x2* ag = cx.AGG() + (size_t)(b * NCH) * DL + d; f32x2 pp[NCH - 1];
#pragma unroll
        for (int kk = 0; kk < NCH - 1; ++kk) pp[kk] = (kk < k) ? ag[(size_t)kk * DL] : (f32x2){1.f, 0.f};
#pragma unroll
        for (int kk = 0; kk < NCH - 1; ++kk) hin = pp[kk].x * hin + pp[kk].y; }
    hs[d] = hin;
    const bf16* X = cx.LRUX();
    if (!samp && k == NCH - 1) {
#pragma unroll
        for (int j = 0; j < 3; ++j) cx.out[O_CONVP + (size_t)(b * 3 + j) * DL + d] = bf2f(X[(size_t)(row0 + LCH - 3 + j) * DL + d]); }
    if (samp) {
        float c1[SCH], c2[SCH], c3[SCH];
#pragma unroll
        for (int t = 0; t < SCH; ++t) { const float* sc = cx.I(2) + (size_t)(row0 + t - MPR) * 1536 + d; c1[t] = sc[512]; c2[t] = sc[1024]; c3[t] = bf2f(X[(size_t)(row0 + t) * DL + d]); }
#pragma unroll
        for (int t = 0; t < SCH; ++t) { float* o = cx.out + O_CONVS + (size_t)(row0 + t - MPR) * 1536 + d; o[0] = c1[t]; o[512] = c2[t]; o[1024] = c3[t]; } }
    __syncthreads();
    const float* HL = cx.HLOC(); const float* CU = cx.CUM(); const bf16* GT = cx.GATE(); bf16* MG = cx.MERGED(); const float* gl = cx.I(28);
    const f32x4 hi0 = *(const LAS f32x4*)(hs + 8 * lane), hi1 = *(const LAS f32x4*)(hs + 8 * lane + 4);
    const f32x4 g0 = *(const f32x4*)(gl + 8 * lane), g1 = *(const f32x4*)(gl + 8 * lane + 4);
    const bool with_chain = chain_item >= 0;
    if (with_chain && w == 0) { s5_chain_item(cx, chain_item, lane); asm volatile("s_waitcnt vmcnt(0)" ::: "memory"); }
    if (with_chain && w == 1) { s5_chain_item(cx, chain_item1, lane); asm volatile("s_waitcnt vmcnt(0)" ::: "memory"); }
    const int tstart = with_chain ? w - 2 : w, tstep = with_chain ? 6 : 8;
#pragma unroll 4
    for (int t = (tstart < 0 ? ntok : tstart); t < ntok; t += tstep) { const size_t ro = (size_t)(row0 + t) * DL + 8 * lane;
        const u32x4 q0 = *(const u32x4*)((const unsigned*)HL + ro), q1 = *(const u32x4*)((const unsigned*)HL + ro + 4);
        const f32x4 a0 = (f32x4){bflo(q0.x), bflo(q0.y), bflo(q0.z), bflo(q0.w)}, a1 = (f32x4){bflo(q1.x), bflo(q1.y), bflo(q1.z), bflo(q1.w)};
        const f32x4 c0 = (f32x4){bfhi(q0.x), bfhi(q0.y), bfhi(q0.z), bfhi(q0.w)}, c1 = (f32x4){bfhi(q1.x), bfhi(q1.y), bfhi(q1.z), bfhi(q1.w)};
        const u32x4 gw = *(const u32x4*)(GT + ro);
        const f32x4 h0 = a0 + c0 * hi0, h1 = a1 + c1 * hi1;
        f32x4 l0, l1;
        l0[0] = h0[0] * gelu_tanh(bflo(gw.x)); l0[1] = h0[1] * gelu_tanh(bfhi(gw.x)); l0[2] = h0[2] * gelu_tanh(bflo(gw.y)); l0[3] = h0[3] * gelu_tanh(bfhi(gw.y));
        l1[0] = h1[0] * gelu_tanh(bflo(gw.z)); l1[1] = h1[1] * gelu_tanh(bfhi(gw.z)); l1[2] = h1[2] * gelu_tanh(bflo(gw.w)); l1[3] = h1[3] * gelu_tanh(bfhi(gw.w));
        float ss = (l0[0] * l0[0] + l0[1] * l0[1]) + (l0[2] * l0[2] + l0[3] * l0[3]) + (l1[0] * l1[0] + l1[1] * l1[1]) + (l1[2] * l1[2] + l1[3] * l1[3]);
        const float rstd = rsqrtf(wave_sum(ss) * (1.f / DL) + EPS);
        *(u32x4*)(MG + (size_t)(row0 + t) * DM + 8 * lane) = pack8(l0 * rstd * g0, l1 * rstd * g1);
        if (samp) { float* o = cx.out + O_LRUS + (size_t)(row0 + t - MPR) * DL + 8 * lane; *(f32x4*)o = h0; *(f32x4*)(o + 4) = h1; }
        else if (k == NCH - 1 && t == LCH - 1) { float* o = cx.out + O_LRUP + (size_t)b * DL + 8 * lane; *(f32x4*)o = h0; *(f32x4*)(o + 4) = h1; }
    }
    __syncthreads();
}

__device__ __forceinline__ void s5_gemm_tf_unit(const Ctx& cx, int unit, LAS unsigned char* lds) {
    const int tid = threadIdx.x, w = __builtin_amdgcn_readfirstlane(tid >> 6), lane = tid & 63, fr = lane & 15, fq = lane >> 4;
    const int half = unit & 1, rq = (unit >> 1) & 3, g = unit >> 3;
    const bf16* U = cx.S5U(); const bf16* TFg = cx.TF() + ((size_t)g * 256 + 128 * half) * 384; const bf16* Hg = cx.HIN() + (size_t)g * SROWS * 128;
    __syncthreads();
    LAS bf16* Bs = (LAS bf16*)lds;
    u32x4 t[12];
#pragma unroll
    for (int i = 0; i < 12; ++i) { const int p = tid + 512 * i; t[i] = *(const u32x4*)(TFg + (size_t)(p / 48) * 384 + (p % 48) * 8); }
    bf16x8 af[2][12];
#pragma unroll
    for (int mt = 0; mt < 2; ++mt) { const int cr = rq * 256 + w * 32 + 16 * mt + fr;
#pragma unroll
        for (int ks = 0; ks < 12; ++ks)
            af[mt][ks] = (ks < 8) ? *(const bf16x8*)(U + ((size_t)(16 * cr + 2 * ks + (fq >> 1)) * 512 + 16 * g + 8 * (fq & 1))) : *(const bf16x8*)(Hg + (size_t)cr * 128 + 32 * (ks - 8) + 8 * fq); }
#pragma unroll
    for (int i = 0; i < 12; ++i) { const int p = tid + 512 * i; *(LAS u32x4*)(Bs + (p / 48) * 400 + (p % 48) * 8) = t[i]; }
    __syncthreads();
    const f32x4 d4 = *(const f32x4*)(cx.I(26) + 16 * g + 4 * fq); bf16* GY = cx.GY();
#pragma unroll
    for (int mt = 0; mt < 2; ++mt) { const int cr = rq * 256 + w * 32 + 16 * mt + fr;
        f32x4 acc[8];
#pragma unroll
        for (int n = 0; n < 8; ++n) acc[n] = (f32x4){0.f, 0.f, 0.f, 0.f};
        u32x2 uw[8];
#pragma unroll
        for (int nt = 0; nt < 8; ++nt) uw[nt] = *(const u32x2*)(U + (size_t)(16 * cr + 8 * half + nt) * 512 + 16 * g + 4 * fq);
#pragma unroll
        for (int ks = 0; ks < 12; ++ks)
#pragma unroll
            for (int nt = 0; nt < 8; ++nt) { const bf16x8 wf = *(const LAS bf16x8*)(Bs + (16 * nt + fr) * 400 + 32 * ks + 8 * fq); acc[nt] = __builtin_amdgcn_mfma_f32_16x16x32_bf16(wf, af[mt][ks], acc[nt], 0, 0, 0); }
#pragma unroll
        for (int nt = 0; nt < 8; ++nt) { const size_t off = (size_t)(16 * cr + 8 * half + nt) * 512 + 16 * g + 4 * fq;
            const f32x4 y = acc[nt] + d4 * (f32x4){bflo(uw[nt].x), bfhi(uw[nt].x), bflo(uw[nt].y), bfhi(uw[nt].y)};
            u32x2 o; o.x = pk2(gelu_tanh(y[0]), gelu_tanh(y[1])); o.y = pk2(gelu_tanh(y[2]), gelu_tanh(y[3])); *(u32x2*)(GY + off) = o; }
        __builtin_amdgcn_sched_barrier(0); }
    __syncthreads();
}
__device__ __forceinline__ void s5_sample_item(const Ctx& cx, int item, int lane) {
    const int sb = item >> 5, g = item & 31, n = lane; const int row = MPR + sb;
    const float* tab = cx.TAB(); const f32x2 A = ((const f32x2*)(tab + T_ABAR))[g * 64 + n];
    const float h0r = cx.I(4)[((size_t)sb * 32 + g) * 64 + n], h0i = cx.I(5)[((size_t)sb * 32 + g) * 64 + n];
    const bf16* up = cx.S5U() + (size_t)row * 512 + 16 * g; const u32x4 u0 = *(const u32x4*)up, u1 = *(const u32x4*)(up + 8);
    float uu[16]; uu[0] = bflo(u0.x); uu[1] = bfhi(u0.x); uu[2] = bflo(u0.y); uu[3] = bfhi(u0.y); uu[4] = bflo(u0.z); uu[5] = bfhi(u0.z); uu[6] = bflo(u0.w); uu[7] = bfhi(u0.w);
    uu[8] = bflo(u1.x); uu[9] = bfhi(u1.x); uu[10] = bflo(u1.y); uu[11] = bfhi(u1.y); uu[12] = bflo(u1.z); uu[13] = bfhi(u1.z); uu[14] = bflo(u1.w); uu[15] = bfhi(u1.w);
    float bur = 0.f, bui = 0.f; const float* br = tab + T_BBR + (size_t)(g * 64 + n) * 16; const float* bi = tab + T_BBI + (size_t)(g * 64 + n) * 16;
#pragma unroll
    for (int c4 = 0; c4 < 4; ++c4) { const f32x4 r4 = *(const f32x4*)(br + 4 * c4), i4 = *(const f32x4*)(bi + 4 * c4);
#pragma unroll
        for (int i = 0; i < 4; ++i) { bur += r4[i] * uu[4 * c4 + i]; bui += i4[i] * uu[4 * c4 + i]; } }
    const float hr = A.x * h0r - A.y * h0i + bur, hi = A.x * h0i + A.y * h0r + bui;
    cx.out[O_S5RS + ((size_t)sb * 32 + g) * 64 + n] = hr; cx.out[O_S5IS + ((size_t)sb * 32 + g) * 64 + n] = hi;
    float my = 0.f, myu = 0.f;
#pragma unroll
    for (int c = 0; c < 16; ++c) { const float v = wave_sum(cx.I(24)[((size_t)g * 16 + c) * 64 + n] * hr - cx.I(25)[((size_t)g * 16 + c) * 64 + n] * hi); if (lane == c) { my = v; myu = uu[c]; } }
    if (lane < 16) { const float y = my + cx.I(26)[16 * g + lane] * myu; cx.GY()[(size_t)row * 512 + 16 * g + lane] = (bf16)(pk2(gelu_tanh(y), 0.f) & 0xffffu); }
}

#define XB_TMO      128
#define XB_XCNT(j)  (256  + 64 * (j))
#define XB_XSUB(j)  (1280 + 64 * (j))
#define XB_XGEN(j)  (2304 + 64 * (j))
#define XB_TOP      3328
#define XB_TOPGEN   3392
#define XCD_BAR_WORDS 3456
#define XB_SPIN_CAP (1u << 18)

__device__ __forceinline__ unsigned xb_ld(unsigned* p)              { return __hip_atomic_load(p, __ATOMIC_RELAXED, __HIP_MEMORY_SCOPE_AGENT); }
__device__ __forceinline__ unsigned xb_add(unsigned* p, unsigned v) { return __hip_atomic_fetch_add(p, v, __ATOMIC_RELAXED, __HIP_MEMORY_SCOPE_AGENT); }
__device__ __forceinline__ unsigned xb_xcc_id() { return (unsigned)__builtin_amdgcn_s_getreg((3 << 11) | 20) & 0xFu; }
#define XB_SPIN(cond, bar) do { unsigned _sp = 0; while (cond) { __builtin_amdgcn_s_sleep(1); \
    if ((++_sp & 255u) == 0u) { if (xb_ld(&(bar)[XB_TMO])) break; if (_sp > XB_SPIN_CAP) { atomicAdd(&(bar)[XB_TMO], 1u); break; } } } } while (0)

struct XcdBarrier {
    unsigned* bar; unsigned x;
    volatile LAS unsigned* st;
};

__device__ __forceinline__ XcdBarrier xcd_barrier_post(unsigned* bar, volatile LAS unsigned* st) {
    XcdBarrier b; b.bar = bar; b.x = xb_xcc_id(); b.st = st;
    if (threadIdx.x == 0) (void)xb_add(&bar[XB_XCNT(b.x)], 1u);
    return b;
}
__device__ __forceinline__ void xcd_barrier_complete(unsigned* bar, unsigned x, unsigned& nloc, unsigned& nx) {
    const unsigned G = gridDim.x * gridDim.y * gridDim.z;
    unsigned sum, cnt, mine, sp = 0u;
    for (;;) {
        sum = 0u; cnt = 0u; mine = 0u;
#pragma unroll
        for (unsigned j = 0; j < 16; ++j) { const unsigned c = xb_ld(&bar[XB_XCNT(j)]); sum += c; cnt += (c > 0u) ? 1u : 0u; mine = (j == x) ? c : mine; }
        if (sum == G) break;
        __builtin_amdgcn_s_sleep(1);
        if ((++sp & 255u) == 0u) { if (xb_ld(&bar[XB_TMO])) break; if (sp > XB_SPIN_CAP) { atomicAdd(&bar[XB_TMO], 1u); break; } }
    }
    nloc = mine > 0u ? mine : 1u; nx = cnt > 0u ? cnt : 1u;
}

__device__ __forceinline__ void xcd_barrier(const XcdBarrier& b) {
    asm volatile("s_waitcnt vmcnt(0)" ::: "memory");
    __syncthreads();
    if (threadIdx.x == 0) {
        unsigned* bar = b.bar;
        __builtin_amdgcn_s_waitcnt(0);
        unsigned nloc = b.st[0], nx = b.st[1];
        if (nloc == 0u) { xcd_barrier_complete(bar, b.x, nloc, nx); b.st[0] = nloc; b.st[1] = nx; }
        const unsigned old = xb_add(&bar[XB_XSUB(b.x)], 1u);
        const unsigned gen = old / nloc;
        if (old + 1u == (gen + 1u) * nloc) {
            __builtin_amdgcn_fence(__ATOMIC_RELEASE, "agent");
            asm volatile("s_waitcnt vmcnt(0)" ::: "memory");
            const unsigned og = xb_add(&bar[XB_TOP], 1u);
            const unsigned tg = og / nx;
            if (og + 1u == (tg + 1u) * nx) xb_add(&bar[XB_TOPGEN], 1u);
            else XB_SPIN(xb_ld(&bar[XB_TOPGEN]) == tg, bar);
            __builtin_amdgcn_fence(__ATOMIC_ACQUIRE, "agent");
            xb_add(&bar[XB_XGEN(b.x)], 1u);
            asm volatile("s_waitcnt vmcnt(0)" ::: "memory");
        } else {
            XB_SPIN(xb_ld(&bar[XB_XGEN(b.x)]) == gen, bar);
            __builtin_amdgcn_fence(__ATOMIC_ACQUIRE, "agent");
            asm volatile("s_waitcnt vmcnt(0)" ::: "memory");
        }
    }
    __syncthreads();
}

__global__ void __launch_bounds__(512, 2) fwd_kernel(KArgs a) {
    extern __shared__ __attribute__((aligned(16))) unsigned char lds_raw[];
    LAS unsigned char* lds = (LAS unsigned char*)lds_raw;
    Ctx cx; cx.in = a.in; cx.out = a.out; cx.ws = a.ws;
    const int tid = threadIdx.x, lane = tid & 63, wave = __builtin_amdgcn_readfirstlane(tid >> 6);
    const int G = gridDim.x, bid = blockIdx.x, gw = bid * 8 + wave, NGW = G * 8;
    volatile LAS unsigned* bst = (volatile LAS unsigned*)(lds + 131072);
    if (tid < 16) bst[tid] = 0u;
    __syncthreads();
    XcdBarrier xbar = xcd_barrier_post((unsigned*)a.ws, bst);
#ifndef REPMASK
#define REPMASK 0
#endif
#ifndef PHMASK
#define PHMASK 0x1fff
#endif
#define IN(k) (((PHMASK >> (k)) & 1) && a.lo <= (k) && (k) < a.hi)
#ifndef PROBE_LO
#define PROBE_LO -1
#define PROBE_HI -1
#endif
    unsigned long long pt0 = 0;
#define PSTART(k) do { if ((k) == PROBE_LO && bid == 0 && tid == 0) pt0 = __builtin_amdgcn_s_memrealtime(); } while (0)
#define PEND(k) do { if ((k) == PROBE_HI && bid == 0) { if (tid == 0) { const unsigned long long t1 = __builtin_amdgcn_s_memrealtime(); const unsigned long long d = t1 - pt0; while (__builtin_amdgcn_s_memrealtime() - t1 < d) __builtin_amdgcn_s_sleep(8); } __syncthreads(); } } while (0)
#define SEAM(k) do { if (IN(k) && IN((k) + 1)) xcd_barrier(xbar); PEND(k); PSTART((k) + 1); } while (0)

    PSTART(0);
    if (IN(0)) for (int rep_ = 0; rep_ < 1 + ((REPMASK >> 0) & 1); ++rep_) {
        if (bid >= 32 && bid < 224) ada_block(cx, bid - 32, lds);
        else { LAS bf16* scr = (LAS bf16*)(lds + wave * 16384); const int w2 = (bid < 32 ? bid : bid - 192) * 8 + wave;
            for (int it = w2; it < 384; it += 512) transpose_dispatch(cx, it, scr, lane);
            if (bid < 16) lru_gate_tables(cx, bid); }
    }
    SEAM(0);
    if (IN(1)) for (int rep_ = 0; rep_ < 1 + ((REPMASK >> 1) & 1); ++rep_) {
        for (int r = gw; r < MTOK; r += 2 * NGW) { const int r2 = r + NGW; const bool two = r2 < MTOK; const int rb = two ? r2 : r;
            const float* xa = r < MPR ? cx.I(0) + (size_t)r * DM : cx.I(1) + (size_t)(r - MPR) * DM; const float* xb = rb < MPR ? cx.I(0) + (size_t)rb * DM : cx.I(1) + (size_t)(rb - MPR) * DM;
            const float* ma = cx.MOD() + (size_t)mod_row(r) * NMOD; const float* mb = cx.MOD() + (size_t)mod_row(rb) * NMOD; const float* g = cx.I(10);
            f32x4 va[4], vb[4], gg[4], sca[4], sha[4], scb[4], shb[4]; float sa = 0.f, sb = 0.f;
#pragma unroll
            for (int j = 0; j < 4; ++j) { va[j] = ((const f32x4*)xa)[lane + 64 * j]; vb[j] = ((const f32x4*)xb)[lane + 64 * j]; }
#pragma unroll
            for (int j = 0; j < 4; ++j) { const int col = 4 * (lane + 64 * j);
                gg[j] = *(const f32x4*)(g + col); sca[j] = *(const f32x4*)(ma + 1024 + col); sha[j] = *(const f32x4*)(ma + col); scb[j] = *(const f32x4*)(mb + 1024 + col); shb[j] = *(const f32x4*)(mb + col); }
#pragma unroll
            for (int j = 0; j < 4; ++j) { sa += (va[j].x * va[j].x + va[j].y * va[j].y) + (va[j].z * va[j].z + va[j].w * va[j].w); sb += (vb[j].x * vb[j].x + vb[j].y * vb[j].y) + (vb[j].z * vb[j].z + vb[j].w * vb[j].w); }
#pragma unroll
            for (int o = 1; o < 64; o <<= 1) { sa += __shfl_xor(sa, o); sb += __shfl_xor(sb, o); }
            const float ra = rsqrtf(sa * (1.f / DM) + EPS), rbs = rsqrtf(sb * (1.f / DM) + EPS);
#pragma unroll
            for (int j = 0; j < 4; ++j) { const int col = 4 * (lane + 64 * j);
                const f32x4 oa = va[j] * ra * gg[j] * (1.f + sca[j]) + sha[j]; u32x2 w; w.x = pk2(oa.x, oa.y); w.y = pk2(oa.z, oa.w); *(u32x2*)(cx.XN() + (size_t)r * DM + col) = w;
                if (two) { const f32x4 ob = vb[j] * rbs * gg[j] * (1.f + scb[j]) + shb[j]; u32x2 w2; w2.x = pk2(ob.x, ob.y); w2.y = pk2(ob.z, ob.w); *(u32x2*)(cx.XN() + (size_t)rb * DM + col) = w2; } } }
    }
    SEAM(1);
    if (IN(2)) for (int rep_ = 0; rep_ < 1 + ((REPMASK >> 2) & 1); ++rep_) {
        pg8::Gemm g{cx.XN(), cx.WIN(), MPAD, NPROJ, DM}; Sched2 S; S.init(NPROJ, DM, G, bid, DM / 64);
        EpiProj E{cx.LRUX(), cx.GATE(), cx.S5U()};
        pg8::gemm_phase<EpiProj, Sched2, true, true>(lds, g, S, E);
        for (int q_ = 0; q_ < 1 + ((REPMASK >> 15) & 1); ++q_)
        if (bid >= 134 && bid < 198) s5_tables(cx, (bid - 134) >> 1, lds, (bid - 134) & 1, 2);
        for (int q_ = 0; q_ < 1 + ((REPMASK >> 12) & 1); ++q_)
        if (bid >= 198) { LAS bf16* scr = (LAS bf16*)(lds + wave * 16384);
            for (int it = 384 + (255 - bid) * 8 + wave; it < N_TR_ITEMS; it += 58 * 8) transpose_dispatch(cx, it, scr, lane); }
    }
    SEAM(2);
    if (IN(3)) for (int rep_ = 0; rep_ < 1 + ((REPMASK >> 3) & 1); ++rep_) {
#ifndef NO_LRU
        for (int q_ = 0; q_ < 1 + ((REPMASK >> 13) & 1); ++q_)
        for (int u = bid; u < 256 + NBS / SCH; u += G) {
            if (u < 256) lru_local_unit(cx, u * LCH, LCH, false, u, lds); else lru_local_unit(cx, MPR + (u - 256) * SCH, SCH, true, 0, lds);
        }
#endif
#ifndef NO_E
        for (int q_ = 0; q_ < 1 + ((REPMASK >> 14) & 1); ++q_)
        if (G == 256) { if (bid >= 8) { s5_gemm_e_unit(cx, bid, lds); if (bid < 16) s5_gemm_e_unit(cx, bid - 8, lds); } }
        else for (int u = bid; u < 256; u += G) s5_gemm_e_unit(cx, u, lds);
#endif
    }
    SEAM(3);
    if (IN(4)) for (int rep_ = 0; rep_ < 1 + ((REPMASK >> 4) & 1); ++rep_) {
        for (int u = bid; u < 256 + NBS / SCH; u += G) {
            const int cg = bid >> 3, cb0 = 2 * ((bid >> 1) & 3);
            if (u < 256) lru_fix_unit(cx, u * LCH, LCH, false, u >> 5, u & 31, lds, (u == bid && G == 256) ? cb0 * 32 + cg : -1, (cb0 + 1) * 32 + cg); else lru_fix_unit(cx, MPR + (u - 256) * SCH, SCH, true, 0, 0, lds, -1, -1);
        }
        for (int u = bid; u < 256; u += G) s5_gemm_tf_unit(cx, u, lds);
        for (int it = gw; it < NBS * 32; it += NGW) s5_sample_item(cx, it, lane);
    }
    SEAM(5);
    if (IN(6)) for (int rep_ = 0; rep_ < 1 + ((REPMASK >> 6) & 1); ++rep_) {
        pg8::Gemm g{cx.GY(), cx.WGLU(), MPAD, 1024, 512}; Sched3 S; S.init(1024, 512, G, bid, 2);
        EpiGluNorm E{cx.MERGED(), cx.I(29), cx.PART(), (unsigned*)cx.ws + 3584, RmsPanel{(float*)(cx.ws + WS_XSLOT), (unsigned*)cx.ws + 4096, 1.f / 512, EPS}};
        pg8::gemm_phase<EpiGluNorm, Sched3, true, true>(lds, g, S, E);
        if (bid >= 240) { wait_partials((unsigned*)cx.ws + 3584, 16u * 8u);
            const float* gs = cx.I(29); const int r = MPR + (bid - 240) * 8 + wave;
            const float* pp = cx.PART() + (size_t)(r - MPR) * 1024; const int c0 = 4 * lane, ca0 = 256 * (c0 >> 7) + (c0 & 127), ca1 = ca0 + 512;
            f32x4 a0 = (f32x4){0.f, 0.f, 0.f, 0.f}, b0 = a0, a1 = a0, b1 = a0, v0, v1;
#pragma unroll
            for (int sl = 0; sl < 4; ++sl) { const float* q = pp + (size_t)sl * 128 * 1024; a0 += *(const f32x4*)(q + ca0); b0 += *(const f32x4*)(q + ca0 + 128); a1 += *(const f32x4*)(q + ca1); b1 += *(const f32x4*)(q + ca1 + 128); }
#pragma unroll
            for (int i = 0; i < 4; ++i) { v0[i] = a0[i] * sigm(b0[i]); v1[i] = a1[i] * sigm(b1[i]); }
            const float ss = (v0.x * v0.x + v0.y * v0.y) + (v0.z * v0.z + v0.w * v0.w) + (v1.x * v1.x + v1.y * v1.y) + (v1.z * v1.z + v1.w * v1.w);
            const float rstd = rsqrtf(wave_sum(ss) * (1.f / 512) + EPS);
            const f32x4 o0 = v0 * rstd * ((const f32x4*)gs)[lane], o1 = v1 * rstd * ((const f32x4*)gs)[lane + 64];
            bf16* mp = cx.MERGED() + (size_t)r * DM + 512; u32x2 w0, w1; w0.x = pk2(o0.x, o0.y); w0.y = pk2(o0.z, o0.w); w1.x = pk2(o1.x, o1.y); w1.y = pk2(o1.z, o1.w);
            *(u32x2*)(mp + 4 * lane) = w0; *(u32x2*)(mp + 256 + 4 * lane) = w1; }
    }
    SEAM(7);
    if (IN(8)) for (int rep_ = 0; rep_ < 1 + ((REPMASK >> 8) & 1); ++rep_) {
        pg8::Gemm g{cx.MERGED(), cx.WOUT(), MPAD, DM, DM}; Sched3 S; S.init(DM, DM, G, bid, 2);
        EpiResNorm<1> E{cx.I(0), cx.MOD(), cx.I(31), cx.out, cx.XN2(), cx.X1B(), cx.PART(), (unsigned*)cx.ws + 3648, RmsPanel{(float*)(cx.ws + WS_XSLOT + 262144), (unsigned*)cx.ws + 8192, 1.f / DM, EPS}};
        pg8::gemm_phase<EpiResNorm<1>, Sched3, true, true>(lds, g, S, E);
        if (bid >= 240) { wait_partials((unsigned*)cx.ws + 3648, 32u * 8u);
            const int r = MPR + (bid - 240) * 8 + wave; const float* md = cx.MOD() + (size_t)mod_row(r) * NMOD;
            const float* pp = cx.PART() + (size_t)(r - MPR) * 1024; const float* xr = cx.I(1) + (size_t)(r - MPR) * DM; float* orow = cx.out + (size_t)r * DM;
#pragma unroll
            for (int j = 0; j < 4; ++j) { const int col = 4 * (lane + 64 * j); f32x4 sm = (f32x4){0.f, 0.f, 0.f, 0.f};
#pragma unroll
                for (int sl = 0; sl < 8; ++sl) sm += *(const f32x4*)(pp + (size_t)sl * 128 * 1024 + col);
                *(f32x4*)(orow + col) = *(const f32x4*)(xr + col) + *(const f32x4*)(md + 2048 + col) * sm; }
            norm_mod_row(cx.out + (size_t)r * DM, cx.I(31), md + 4096, md + 3072, cx.XN2() + (size_t)r * DM, lane); }
    }
    SEAM(9);
    if (IN(10)) for (int rep_ = 0; rep_ < 1 + ((REPMASK >> 10) & 1); ++rep_) {
        pg8::Gemm g{cx.XN2(), cx.WGU(), MPAD, 2 * DFF, DM}; Sched2 S; S.init(2 * DFF, DM, G, bid, DM / 64);
        EpiSwiglu E{cx.HB()};
        pg8::gemm_phase<EpiSwiglu, Sched2, true, true>(lds, g, S, E);
    }
    SEAM(10);
    if (IN(11)) for (int rep_ = 0; rep_ < 1 + ((REPMASK >> 11) & 1); ++rep_) {
        pg8::Gemm g{cx.HB(), cx.WDN(), MPAD, DM, DFF}; Sched3 S; S.init(DM, DFF, G, bid, 2);
        EpiResNorm<2> E{nullptr, cx.MOD(), cx.I(35), cx.out, nullptr, cx.X1B(), cx.PART(), (unsigned*)cx.ws + 3712, RmsPanel{(float*)(cx.ws + WS_XSLOT + 524288), (unsigned*)cx.ws + 12288, 1.f / DM, EPS}};
        pg8::gemm_phase<EpiResNorm<2>, Sched3, true, true>(lds, g, S, E);
        if (bid >= 192) { wait_partials((unsigned*)cx.ws + 3712, 88u * 8u);
            const float* fg = cx.I(35); const int r = MPR + (bid - 192) * 2 + (wave >> 2), col = 256 * (wave & 3) + 4 * lane; float* xr = cx.out + (size_t)r * DM + col;
            const float* pp = cx.PART() + (size_t)(r - MPR) * 1024 + col; f32x4 sm = (f32x4){0.f, 0.f, 0.f, 0.f};
            f32x4 v = *(const f32x4*)xr; const f32x4 g2v = *(const f32x4*)(cx.MOD() + (size_t)mod_row(r) * NMOD + 5120 + col), fgv = *(const f32x4*)(fg + col);
#pragma unroll
            for (int sl = 0; sl < 22; ++sl) sm += *(const f32x4*)(pp + (size_t)sl * 128 * 1024);
            v += g2v * sm;
            const float ssw = wave_sum((v.x * v.x + v.y * v.y) + (v.z * v.z + v.w * v.w));
            LAS float* red = (LAS float*)lds;
            if (lane == 0) red[wave] = ssw;
            __syncthreads();
            const int w0 = wave & 4; const float ss = (red[w0] + red[w0 + 1]) + (red[w0 + 2] + red[w0 + 3]);
            const float rstd = rsqrtf(ss * (1.f / DM) + EPS);
            *(f32x4*)xr = v * rstd * fgv; }
    }
    PEND(12);
#undef IN
#undef SEAM
}

constexpr int LDS_BYTES = 131072 + 256;
#ifndef MK_SINGLE
#define MK_SINGLE 1
#endif
extern "C" void kernel_launch(void* const* d_in, const int* in_sizes, int n_in, void* d_out, int out_size, void* d_ws, size_t ws_size, hipStream_t stream) {
    static int grid = 0;
    if (grid == 0) {
        if (n_in != 36 || (size_t)out_size != O_END || ws_size < WS_END) { fprintf(stderr, "kernel_launch: unexpected shapes n_in %d out %d ws %zu\n", n_in, out_size, ws_size); grid = -1; return; }
        int dev = 0, cus = 0, per_cu = 0;
        hipGetDevice(&dev); hipDeviceGetAttribute(&cus, hipDeviceAttributeMultiprocessorCount, dev);
        hipFuncSetAttribute((const void*)fwd_kernel, hipFuncAttributeMaxDynamicSharedMemorySize, LDS_BYTES);
        hipOccupancyMaxActiveBlocksPerMultiprocessor(&per_cu, (const void*)fwd_kernel, 512, LDS_BYTES);
        if (per_cu < 1) { fprintf(stderr, "kernel_launch: occupancy query says %d blocks per CU\n", per_cu); grid = -1; return; }
        if (cus != 256) { fprintf(stderr, "kernel_launch: built for 256 CUs (one 256x256 unit per workgroup in the fused-norm GEMM phases), found %d\n", cus); grid = -1; return; }
        grid = cus;
    }
    if (grid < 0) return;
    if (hipMemsetAsync(d_ws, 0, 65536, stream) != hipSuccess) { fprintf(stderr, "kernel_launch: memset of the barrier words failed\n"); return; }
    KArgs a{};
    for (int i = 0; i < 36; ++i) a.in[i] = (const float*)d_in[i];
    a.out = (float*)d_out; a.ws = (unsigned char*)d_ws;
#if MK_SINGLE
    a.lo = 0; a.hi = NPHASE;
    void* args[] = {&a};
#ifdef PLAIN_LAUNCH
    hipLaunchKernelGGL(fwd_kernel, dim3(grid), dim3(512), LDS_BYTES, stream, a); hipError_t e = hipPeekAtLastError(); (void)args;
#else
    hipError_t e = hipLaunchCooperativeKernel((const void*)fwd_kernel, dim3(grid), dim3(512), args, LDS_BYTES, stream);
#endif
    if (e != hipSuccess) fprintf(stderr, "cooperative launch failed: %s (grid %d)\n", hipGetErrorString(e), grid);
#else
    for (int p = 0; p < NPHASE; ++p) { a.lo = p; a.hi = p + 1; hipLaunchKernelGGL(fwd_kernel, dim3(grid), dim3(512), LDS_BYTES, stream, a); }
#endif
}
```
